# Optimizing an MI355X kernel written in HIP

```python
import math
import jax, jax.numpy as jnp
from jax import lax
import numpy as np

D_MODEL = 1024
BATCH = 4
SEQ = 8192
DEPTH = 2

N_ATTN = (DEPTH + 1) // 2
N_LRU = DEPTH // 2
N_DENSE = (DEPTH + 1) // 2
N_MOE = DEPTH // 2

N_HEADS = 8
HEAD_DIM = D_MODEL // N_HEADS // 2
V_DIM = 2 * HEAD_DIM
Q_BLOCK = 128
SCALE = HEAD_DIM ** -0.5
NEG_INF = -1e30

NUM_BUCKETS = 32
MAX_EXACT = NUM_BUCKETS // 2
MAX_DISTANCE = 128

D_RNN = 1280
N_LRU_BLOCKS = 10
LRU_BLOCK = D_RNN // N_LRU_BLOCKS
CONV_WIDTH = 4
LRU_C = 8.0

D_FF = 2816
N_EXPERTS = 8
TOP_K = 2
D_FF_EXPERT = 3584

NORM_EPS = 1e-6
SUBLN_EPS = 1e-5

kernel_name = "hybrid_diffattn_rglru_moe"


def rmsnorm(x, g, eps=NORM_EPS):
    xf = x.astype(jnp.float32)
    y = xf * lax.rsqrt(jnp.mean(xf * xf, axis=-1, keepdims=True) + eps)
    return (y * g.astype(jnp.float32)).astype(x.dtype)


def t5_bucket(n):
    nf = jnp.maximum(n, 1).astype(jnp.float32)
    large = MAX_EXACT + (jnp.log(nf / MAX_EXACT) / math.log(MAX_DISTANCE / MAX_EXACT)
                         * (NUM_BUCKETS - MAX_EXACT)).astype(jnp.int32)
    large = jnp.minimum(large, NUM_BUCKETS - 1)
    return jnp.where(n < MAX_EXACT, n, large)


def diff_attention(h, w_qkv, w_o, lq1, lk1, lq2, lk2, subln_g, rel_bias, lam_init):
    B, S, _ = h.shape
    q, k, v = jnp.split(h @ w_qkv, 3, axis=-1)
    q = q.reshape(B, S, N_HEADS, 2, HEAD_DIM)
    k = k.reshape(B, S, N_HEADS, 2, HEAD_DIM)
    v = v.reshape(B, S, N_HEADS, V_DIM)
    lam = (jnp.exp(jnp.sum(lq1.astype(jnp.float32) * lk1.astype(jnp.float32)))
           - jnp.exp(jnp.sum(lq2.astype(jnp.float32) * lk2.astype(jnp.float32)))
           + lam_init)
    nb = S // Q_BLOCK
    qb = q.reshape(B, nb, Q_BLOCK, N_HEADS, 2, HEAD_DIM).transpose(1, 0, 2, 3, 4, 5)
    k_pos = jnp.arange(S, dtype=jnp.int32)

    def block(args):
        q_blk, blk = args
        q_pos = blk * Q_BLOCK + jnp.arange(Q_BLOCK, dtype=jnp.int32)
        dist = q_pos[:, None] - k_pos[None, :]
        bias = rel_bias[t5_bucket(jnp.maximum(dist, 0))]
        bias = jnp.transpose(bias, (2, 0, 1)).astype(jnp.float32)[None, :, None]
        s = jnp.einsum('bqhcd,bkhcd->bhcqk', q_blk, k).astype(jnp.float32) * SCALE + bias
        s = jnp.where(dist >= 0, s, NEG_INF)
        p = jax.nn.softmax(s, axis=-1)
        a = p[:, :, 0] - lam * p[:, :, 1]
        return jnp.einsum('bhqk,bkhe->bqhe', a.astype(v.dtype), v)

    o = lax.map(block, (qb, jnp.arange(nb, dtype=jnp.int32)))
    o = o.transpose(1, 0, 2, 3, 4).reshape(B, S, N_HEADS, V_DIM)
    o = rmsnorm(o, subln_g, SUBLN_EPS) * (1.0 - lam_init)
    return o.reshape(B, S, N_HEADS * V_DIM) @ w_o


def _lin_combine(c1, c2):
    a1, b1 = c1
    a2, b2 = c2
    return a1 * a2, a2 * b1 + b2


def rglru_block(h, w_in, conv_w, conv_b, ga_w, ga_b, gx_w, gx_b, lam_param, w_out):
    B, S, _ = h.shape
    gate_br, x_br = jnp.split(h @ w_in, 2, axis=-1)
    gate_br = jax.nn.gelu(gate_br)
    xp = jnp.pad(x_br, ((0, 0), (CONV_WIDTH - 1, 0), (0, 0)))
    xc = conv_b + sum(xp[:, j:j + S] * conv_w[j] for j in range(CONV_WIDTH))
    xblk = xc.reshape(B, S, N_LRU_BLOCKS, LRU_BLOCK)
    r = jax.nn.sigmoid(jnp.einsum('bsnd,nde->bsne', xblk, ga_w).reshape(B, S, D_RNN) + ga_b)
    i = jax.nn.sigmoid(jnp.einsum('bsnd,nde->bsne', xblk, gx_w).reshape(B, S, D_RNN) + gx_b)
    log_a = -LRU_C * r.astype(jnp.float32) * jax.nn.softplus(-lam_param.astype(jnp.float32))
    a = jnp.exp(log_a)
    mult = jnp.sqrt(-jnp.expm1(2.0 * log_a))
    b = mult * (i * xc).astype(jnp.float32)
    _, hs = lax.associative_scan(_lin_combine, (a, b), axis=1)
    y = hs.astype(h.dtype) * gate_br
    return y @ w_out


def swiglu(t, wg, wu, wd):
    return (jax.nn.silu(t @ wg) * (t @ wu)) @ wd


def moe_swiglu(h, router, wg, wu, wd):
    B, S, D = h.shape
    t = h.reshape(B * S, D)
    logits = (t @ router).astype(jnp.float32)
    top_v, top_i = lax.top_k(logits, TOP_K)
    gates = jax.nn.softmax(top_v, axis=-1)
    comb = jnp.sum(jax.nn.one_hot(top_i, N_EXPERTS, dtype=jnp.float32) * gates[..., None], axis=1)
    out = jnp.zeros_like(t)
    for e in range(N_EXPERTS):
        out = out + comb[:, e:e + 1].astype(t.dtype) * swiglu(t, wg[e], wu[e], wd[e])
    return out.reshape(B, S, D)


def setup_inputs(seed: int = 0) -> dict:
    key = jax.random.key(seed)
    ks = iter(jax.random.split(key, 40))

    def w(shape, fan_in):
        return jax.random.normal(next(ks), shape, jnp.float32) * (fan_in ** -0.5)

    def gain(shape):
        return 1.0 + 0.01 * jax.random.normal(next(ks), shape, jnp.float32)

    def small(shape, s=0.01):
        return s * jax.random.normal(next(ks), shape, jnp.float32)

    x = jax.random.normal(next(ks), (BATCH, SEQ, D_MODEL), jnp.float32)
    u = jax.random.uniform(next(ks), (N_LRU, D_RNN), jnp.float32, 0.9, 0.999)
    a0 = u ** (1.0 / LRU_C)
    lru_lambda = jnp.log(a0) - jnp.log1p(-a0)
    return {
        "x": x,
        "norm_mix": gain((DEPTH, D_MODEL)),
        "norm_ffn": gain((DEPTH, D_MODEL)),
        "norm_final": gain((D_MODEL,)),
        "rel_bias": small((NUM_BUCKETS, N_HEADS), 0.5),
        "attn_w_qkv": w((N_ATTN, D_MODEL, 3 * D_MODEL), D_MODEL),
        "attn_w_o": w((N_ATTN, N_HEADS * V_DIM, D_MODEL), N_HEADS * V_DIM),
        "attn_lambda_q1": small((N_ATTN, HEAD_DIM), 0.1),
        "attn_lambda_k1": small((N_ATTN, HEAD_DIM), 0.1),
        "attn_lambda_q2": small((N_ATTN, HEAD_DIM), 0.1),
        "attn_lambda_k2": small((N_ATTN, HEAD_DIM), 0.1),
        "attn_subln": gain((N_ATTN, V_DIM)),
        "lru_w_in": w((N_LRU, D_MODEL, 2 * D_RNN), D_MODEL),
        "lru_conv_w": w((N_LRU, CONV_WIDTH, D_RNN), CONV_WIDTH),
        "lru_conv_b": small((N_LRU, D_RNN)),
        "lru_gate_a_w": w((N_LRU, N_LRU_BLOCKS, LRU_BLOCK, LRU_BLOCK), LRU_BLOCK),
        "lru_gate_a_b": small((N_LRU, D_RNN)),
        "lru_gate_x_w": w((N_LRU, N_LRU_BLOCKS, LRU_BLOCK, LRU_BLOCK), LRU_BLOCK),
        "lru_gate_x_b": small((N_LRU, D_RNN)),
        "lru_lambda": lru_lambda,
        "lru_w_out": w((N_LRU, D_RNN, D_MODEL), D_RNN),
        "ffn_w_gate": w((N_DENSE, D_MODEL, D_FF), D_MODEL),
        "ffn_w_up": w((N_DENSE, D_MODEL, D_FF), D_MODEL),
        "ffn_w_down": w((N_DENSE, D_FF, D_MODEL), D_FF),
        "moe_router": w((N_MOE, D_MODEL, N_EXPERTS), D_MODEL),
        "moe_w_gate": w((N_MOE, N_EXPERTS, D_MODEL, D_FF_EXPERT), D_MODEL),
        "moe_w_up": w((N_MOE, N_EXPERTS, D_MODEL, D_FF_EXPERT), D_MODEL),
        "moe_w_down": w((N_MOE, N_EXPERTS, D_FF_EXPERT, D_MODEL), D_FF_EXPERT),
    }


def reference(x, norm_mix, norm_ffn, norm_final, rel_bias,
              attn_w_qkv, attn_w_o, attn_lambda_q1, attn_lambda_k1, attn_lambda_q2, attn_lambda_k2, attn_subln,
              lru_w_in, lru_conv_w, lru_conv_b, lru_gate_a_w, lru_gate_a_b, lru_gate_x_w, lru_gate_x_b,
              lru_lambda, lru_w_out,
              ffn_w_gate, ffn_w_up, ffn_w_down,
              moe_router, moe_w_gate, moe_w_up, moe_w_down):
    for i in range(DEPTH):
        h = rmsnorm(x, norm_mix[i])
        if i % 2 == 0:
            j = i // 2
            lam_init = 0.8 - 0.6 * math.exp(-0.3 * i)
            m = diff_attention(h, attn_w_qkv[j], attn_w_o[j], attn_lambda_q1[j], attn_lambda_k1[j],
                               attn_lambda_q2[j], attn_lambda_k2[j], attn_subln[j], rel_bias, lam_init)
        else:
            j = i // 2
            m = rglru_block(h, lru_w_in[j], lru_conv_w[j], lru_conv_b[j], lru_gate_a_w[j], lru_gate_a_b[j],
                            lru_gate_x_w[j], lru_gate_x_b[j], lru_lambda[j], lru_w_out[j])
        x = x + m
        h = rmsnorm(x, norm_ffn[i])
        if i % 2 == 0:
            j = i // 2
            f = swiglu(h, ffn_w_gate[j], ffn_w_up[j], ffn_w_down[j])
        else:
            j = i // 2
            f = moe_swiglu(h, moe_router[j], moe_w_gate[j], moe_w_up[j], moe_w_down[j])
        x = x + f
    return rmsnorm(x, norm_final)
```

```cpp
#include <hip/hip_runtime.h>
#include <cstdio>
#include <cstdint>

#ifndef MK_ONE_LAUNCH
#define MK_ONE_LAUNCH 0
#endif

#define GAS __attribute__((address_space(1)))
#define LAS __attribute__((address_space(3)))
typedef unsigned short bf16;
typedef unsigned v4u __attribute__((ext_vector_type(4)));
typedef unsigned v2u __attribute__((ext_vector_type(2)));
typedef float f32x4 __attribute__((ext_vector_type(4)));
typedef GAS unsigned gu32;
#define RLX_AGENT __ATOMIC_RELAXED, __HIP_MEMORY_SCOPE_AGENT

constexpr int NB_ = 4, SEQ = 8192, DM = 1024, NT = NB_ * SEQ;
constexpr int NH = 8, HD = 64, VD = 128;
constexpr int DRNN = 1280, NLB = 10, LBK = 128, CW = 4;
constexpr int DFF = 2816, NE = 8, DFE = 3584;
constexpr float NORM_EPS = 1e-6f, SUBLN_EPS = 1e-5f, LOG2E = 1.4426950408889634f;
constexpr float C2 = 0.125f * LOG2E;
constexpr float LAM_INIT = 0.2f;
constexpr int NWAVES = 8, NTHR = 512;
constexpr int LCH = 64, NCH = SEQ / LCH;
constexpr int SLOT_ROWS = NT + NE * 256;

constexpr size_t MiB = 1u << 20;
constexpr size_t WS_CTL = 0, CTL_ZERO_BYTES = 1 * MiB;
constexpr size_t WS_SMALL = 1 * MiB;
constexpr size_t SM_TB = 0;
constexpr size_t SM_ROUTE = 64 * 1024;
constexpr size_t SM_CNT = 1 * MiB;
constexpr size_t SM_BASE = 1 * MiB + 16 * 1024;
constexpr size_t SM_TOK = 2 * MiB;
constexpr size_t SM_GATEV = 2 * MiB + 512 * 1024;
constexpr size_t SM_AEND = 4 * MiB;
constexpr size_t SM_HEND = 7 * MiB;
constexpr size_t SM_CIN = 10 * MiB;
constexpr size_t WS_WA = 17 * MiB;
constexpr size_t WS_WM = 50 * MiB;
constexpr size_t WS_O0 = 50 * MiB, WS_O1 = 114 * MiB;
constexpr size_t WS_HL = 50 * MiB, WS_CA = 130 * MiB;
constexpr size_t WS_H = 218 * MiB;
constexpr size_t WS_SCR = 282 * MiB;
constexpr size_t WS_Q = WS_SCR, WS_K = WS_SCR + 64 * MiB, WS_V = WS_SCR + 128 * MiB;
constexpr size_t WS_ACT = WS_SCR;
constexpr size_t WS_G = WS_SCR, WS_XB = WS_SCR + 80 * MiB, WS_Y = WS_SCR + 160 * MiB;
constexpr size_t WS_ACTM = WS_SCR;
constexpr size_t WS_END = 522 * MiB;
static_assert(WS_ACTM + (size_t)SLOT_ROWS * DFE * 2 <= WS_END && WS_Y + (size_t)NT * DRNN * 2 <= WS_END, "ws map");
static_assert(SM_CIN + (size_t)NB_ * NCH * DRNN * 4 <= 16 * MiB, "small map");
constexpr int CW_BAR = 4096;

__device__ __forceinline__ int fresh_tid() { int t = threadIdx.x; asm volatile("" : "+v"(t)); return t; }
__device__ __forceinline__ unsigned f2bf(float f) { unsigned u = __builtin_bit_cast(unsigned, f); return (u + 0x7fffu + ((u >> 16) & 1u)) >> 16; }
__device__ __forceinline__ unsigned pk2(float lo, float hi) { return f2bf(lo) | (f2bf(hi) << 16); }
__device__ __forceinline__ float bflo(unsigned u) { return __builtin_bit_cast(float, u << 16); }
__device__ __forceinline__ float bfhi(unsigned u) { return __builtin_bit_cast(float, u & 0xffff0000u); }
__device__ __forceinline__ float bf2f(bf16 v) { return __builtin_bit_cast(float, (unsigned)v << 16); }
__device__ __forceinline__ float wave_sum(float v) {
#pragma unroll
    for (int o = 1; o < 64; o <<= 1) v += __shfl_xor(v, o);
    return v;
}
__device__ __forceinline__ float sigmoidf_(float x) { return 1.f / (1.f + __expf(-x)); }

#define XB_TMO      128
#define XB_XCNT(j)  (256  + 64 * (j))
#define XB_XSUB(j)  (1280 + 64 * (j))
#define XB_XGEN(j)  (2304 + 64 * (j))
#define XB_TOP      3328
#define XB_TOPGEN   3392
#define XCD_BAR_WORDS 3456
#define XB_SPIN_CAP (1u << 18)
__device__ __forceinline__ unsigned xb_ld(unsigned* p)              { return __hip_atomic_load(p, __ATOMIC_RELAXED, __HIP_MEMORY_SCOPE_AGENT); }
__device__ __forceinline__ unsigned xb_add(unsigned* p, unsigned v) { return __hip_atomic_fetch_add(p, v, __ATOMIC_RELAXED, __HIP_MEMORY_SCOPE_AGENT); }
__device__ __forceinline__ unsigned xb_xcc_id() { return (unsigned)__builtin_amdgcn_s_getreg((3 << 11) | 20) & 0xFu; }
#define XB_SPIN(cond, bar) do { unsigned _sp = 0; while (cond) { __builtin_amdgcn_s_sleep(1); \
    if ((++_sp & 255u) == 0u) { if (xb_ld(&(bar)[XB_TMO])) break; if (_sp > XB_SPIN_CAP) { atomicAdd(&(bar)[XB_TMO], 1u); break; } } } } while (0)
struct XcdBarrier { unsigned* bar; unsigned x; volatile LAS unsigned* st; };
__device__ __forceinline__ XcdBarrier xcd_barrier_post(unsigned* bar, volatile LAS unsigned* st) {
    XcdBarrier b; b.bar = bar; b.x = xb_xcc_id(); b.st = st;
    if (threadIdx.x == 0) (void)xb_add(&bar[XB_XCNT(b.x)], 1u);
    return b;
}
__device__ __forceinline__ void xcd_barrier_complete(unsigned* bar, unsigned x, unsigned& nloc, unsigned& nx) {
    const unsigned G = gridDim.x * gridDim.y * gridDim.z;
    unsigned sum, cnt, mine, sp = 0u;
    for (;;) {
        sum = 0u; cnt = 0u; mine = 0u;
#pragma unroll
        for (unsigned j = 0; j < 16; ++j) { const unsigned c = xb_ld(&bar[XB_XCNT(j)]); sum += c; cnt += (c > 0u) ? 1u : 0u; mine = (j == x) ? c : mine; }
        if (sum == G) break;
        __builtin_amdgcn_s_sleep(1);
        if ((++sp & 255u) == 0u) { if (xb_ld(&bar[XB_TMO])) break; if (sp > XB_SPIN_CAP) { atomicAdd(&bar[XB_TMO], 1u); break; } }
    }
    nloc = mine > 0u ? mine : 1u; nx = cnt > 0u ? cnt : 1u;
}
__device__ __forceinline__ void xcd_barrier(const XcdBarrier& b) {
    asm volatile("s_waitcnt vmcnt(0)" ::: "memory");
    __syncthreads();
    if (threadIdx.x == 0) {
        unsigned* bar = b.bar;
        __builtin_amdgcn_s_waitcnt(0);
        unsigned nloc = b.st[0], nx = b.st[1];
        if (nloc == 0u) { xcd_barrier_complete(bar, b.x, nloc, nx); b.st[0] = nloc; b.st[1] = nx; }
        const unsigned old = xb_add(&bar[XB_XSUB(b.x)], 1u);
        const unsigned gen = old / nloc;
        if (old + 1u == (gen + 1u) * nloc) {
            __builtin_amdgcn_fence(__ATOMIC_RELEASE, "agent");
            asm volatile("s_waitcnt vmcnt(0)" ::: "memory");
            const unsigned og = xb_add(&bar[XB_TOP], 1u);
            const unsigned tg = og / nx;
            if (og + 1u == (tg + 1u) * nx) xb_add(&bar[XB_TOPGEN], 1u);
            else XB_SPIN(xb_ld(&bar[XB_TOPGEN]) == tg, bar);
            __builtin_amdgcn_fence(__ATOMIC_ACQUIRE, "agent");
            xb_add(&bar[XB_XGEN(b.x)], 1u);
            asm volatile("s_waitcnt vmcnt(0)" ::: "memory");
        } else {
            XB_SPIN(xb_ld(&bar[XB_XGEN(b.x)]) == gen, bar);
            __builtin_amdgcn_fence(__ATOMIC_ACQUIRE, "agent");
            asm volatile("s_waitcnt vmcnt(0)" ::: "memory");
        }
    }
    __syncthreads();
}

constexpr int RING_BYTES = 131072;
constexpr int LDSCTL_OFF = RING_BYTES, MISC_OFF = LDSCTL_OFF + 320;
constexpr int LDS_BYTES = 147456;

struct Args { const float* in[28]; float* out; unsigned char* ws; int ph_lo, ph_hi; };

__device__ __forceinline__ void rms_rows_bf16(const float* X, const float* g, bf16* H, int bid, int nb) {
    const int tid_ = fresh_tid(); const int lane = tid_ & 63, wave = tid_ >> 6;
    f32x4 gv[4];
#pragma unroll
    for (int j = 0; j < 4; ++j) gv[j] = *(const f32x4*)(g + 4 * lane + 256 * j);
    for (int m = bid * NWAVES + wave; m < NT; m += nb * NWAVES) {
        const f32x4* xr = (const f32x4*)(X + (size_t)m * DM) + lane;
        f32x4 v[4]; float s = 0.f;
#pragma unroll
        for (int j = 0; j < 4; ++j) { v[j] = xr[64 * j]; s += (v[j].x * v[j].x + v[j].y * v[j].y) + (v[j].z * v[j].z + v[j].w * v[j].w); }
        const float r = 1.f / sqrtf(wave_sum(s) * (1.f / DM) + NORM_EPS);
        unsigned long long* o8 = (unsigned long long*)(H + (size_t)m * DM) + lane;
#pragma unroll
        for (int j = 0; j < 4; ++j) { const f32x4 y = v[j] * r * gv[j]; o8[64 * j] = (unsigned long long)pk2(y.x, y.y) | ((unsigned long long)pk2(y.z, y.w) << 32); }
    }
}
__device__ __forceinline__ void rms_rows_f32_inplace(float* X, const float* g, int bid, int nb) {
    const int tid_ = fresh_tid(); const int lane = tid_ & 63, wave = tid_ >> 6;
    f32x4 gv[4];
#pragma unroll
    for (int j = 0; j < 4; ++j) gv[j] = *(const f32x4*)(g + 4 * lane + 256 * j);
    for (int m = bid * NWAVES + wave; m < NT; m += nb * NWAVES) {
        f32x4* xr = (f32x4*)(X + (size_t)m * DM) + lane;
        f32x4 v[4]; float s = 0.f;
#pragma unroll
        for (int j = 0; j < 4; ++j) { v[j] = xr[64 * j]; s += (v[j].x * v[j].x + v[j].y * v[j].y) + (v[j].z * v[j].z + v[j].w * v[j].w); }
        const float r = 1.f / sqrtf(wave_sum(s) * (1.f / DM) + NORM_EPS);
#pragma unroll
        for (int j = 0; j < 4; ++j) xr[64 * j] = v[j] * r * gv[j];
    }
}

template <int NB, class P>
__device__ __forceinline__ void ref_gemm(const P& p, LAS float* sm, int bid, int nb) {
    constexpr int LDP = 132;
    LAS float* As = sm; LAS float* Bs = sm + 16 * LDP;
    const int tid = fresh_tid(), ty = tid >> 4, tx = tid & 15;
    const int nt = p.ntiles();
    for (int it = bid; it < nt; it += nb) {
        int m0, n0; const float* W[2]; p.tile(it, m0, n0, W[0], W[1]);
        float acc[NB][4][8];
#pragma unroll
        for (int b = 0; b < NB; ++b)
#pragma unroll
            for (int i = 0; i < 4; ++i)
#pragma unroll
                for (int j = 0; j < 8; ++j) acc[b][i][j] = 0.f;
        const bf16* ap = p.arow(m0 + (tid >> 2)) + (tid & 3) * 4;
        for (int k0 = 0; k0 < p.K; k0 += 16) {
            { const v2u v = *(const v2u*)(ap + k0); const int r = tid >> 2, kq = (tid & 3) * 4;
              As[(kq + 0) * LDP + r] = bflo(v.x); As[(kq + 1) * LDP + r] = bfhi(v.x); As[(kq + 2) * LDP + r] = bflo(v.y); As[(kq + 3) * LDP + r] = bfhi(v.y); }
#pragma unroll
            for (int b = 0; b < NB; ++b) { const int k = tid >> 5, n4 = (tid & 31) * 4;
                const f32x4 v = *(const f32x4*)(W[b] + (size_t)(k0 + k) * p.ldw + n0 + n4);
                *(LAS f32x4*)(Bs + (b * 16 + k) * LDP + n4) = v; }
            __syncthreads();
#pragma unroll 2
            for (int kk = 0; kk < 16; ++kk) {
                const f32x4 a = *(const LAS f32x4*)(As + kk * LDP + ty * 4);
#pragma unroll
                for (int b = 0; b < NB; ++b) {
                    const f32x4 b0 = *(const LAS f32x4*)(Bs + (b * 16 + kk) * LDP + tx * 8), b1 = *(const LAS f32x4*)(Bs + (b * 16 + kk) * LDP + tx * 8 + 4);
#pragma unroll
                    for (int i = 0; i < 4; ++i) {
                        acc[b][i][0] += a[i] * b0.x; acc[b][i][1] += a[i] * b0.y; acc[b][i][2] += a[i] * b0.z; acc[b][i][3] += a[i] * b0.w;
                        acc[b][i][4] += a[i] * b1.x; acc[b][i][5] += a[i] * b1.y; acc[b][i][6] += a[i] * b1.z; acc[b][i][7] += a[i] * b1.w; }
                }
            }
            __syncthreads();
        }
#pragma unroll
        for (int i = 0; i < 4; ++i) {
            float a[NB][8];
#pragma unroll
            for (int b = 0; b < NB; ++b)
#pragma unroll
                for (int j = 0; j < 8; ++j) a[b][j] = acc[b][i][j];
            p.epi(m0 + ty * 4 + i, n0 + tx * 8, a);
        }
    }
}
__device__ __forceinline__ void st_bf16x8(bf16* p, const float* v) { v4u w; w.x = pk2(v[0], v[1]); w.y = pk2(v[2], v[3]); w.z = pk2(v[4], v[5]); w.w = pk2(v[6], v[7]); *(v4u*)p = w; }
__device__ __forceinline__ float silu_(float x) { return x / (1.f + __expf(-x)); }
__device__ __forceinline__ float gelu_tanh_(float x) { const float u = 0.7978845608028654f * (x + 0.044715f * x * x * x); return 0.5f * x * (1.f + tanhf(u)); }

struct PQkv {
    int K, ldw; const bf16* H; const float* W; bf16 *Q, *Kb, *V;
    __device__ int ntiles() const { return (NT / 128) * (3 * DM / 128); }
    __device__ void tile(int i, int& m0, int& n0, const float*& W0, const float*& W1) const { m0 = (i / 24) * 128; n0 = (i % 24) * 128; W0 = W; W1 = W; }
    __device__ const bf16* arow(int r) const { return H + (size_t)r * DM; }
    __device__ void epi(int r, int c0, const float (&a)[1][8]) const {
        const int t = c0 >> 10, c = c0 & 1023; float v[8]; const float sc = (t == 0) ? C2 : 1.f;
#pragma unroll
        for (int j = 0; j < 8; ++j) v[j] = a[0][j] * sc;
        st_bf16x8(Q + (size_t)t * (size_t)(32u << 20) + (size_t)r * DM + c, v); }
};
struct PResid {
    int K, ldw; const bf16* A; int lda; const float* W; const float* base; float* out;
    __device__ int ntiles() const { return (NT / 128) * (DM / 128); }
    __device__ void tile(int i, int& m0, int& n0, const float*& W0, const float*& W1) const { m0 = (i / 8) * 128; n0 = (i % 8) * 128; W0 = W; W1 = W; }
    __device__ const bf16* arow(int r) const { return A + (size_t)r * lda; }
    __device__ void epi(int r, int c0, const float (&a)[1][8]) const {
        const f32x4 b0 = *(const f32x4*)(base + (size_t)r * DM + c0), b1 = *(const f32x4*)(base + (size_t)r * DM + c0 + 4);
        *(f32x4*)(out + (size_t)r * DM + c0) = (f32x4){b0.x + a[0][0], b0.y + a[0][1], b0.z + a[0][2], b0.w + a[0][3]};
        *(f32x4*)(out + (size_t)r * DM + c0 + 4) = (f32x4){b1.x + a[0][4], b1.y + a[0][5], b1.z + a[0][6], b1.w + a[0][7]}; }
};
struct PSwiglu {
    int K, ldw; const bf16* H; const float *Wg, *Wu; bf16* ACT;
    __device__ int ntiles() const { return (NT / 128) * (DFF / 128); }
    __device__ void tile(int i, int& m0, int& n0, const float*& W0, const float*& W1) const { m0 = (i / 22) * 128; n0 = (i % 22) * 128; W0 = Wg; W1 = Wu; }
    __device__ const bf16* arow(int r) const { return H + (size_t)r * DM; }
    __device__ void epi(int r, int c0, const float (&a)[2][8]) const { float v[8];
#pragma unroll
        for (int j = 0; j < 8; ++j) v[j] = silu_(a[0][j]) * a[1][j];
        st_bf16x8(ACT + (size_t)r * DFF + c0, v); }
};
struct PWin {
    int K, ldw; const bf16* H; const float* W; bf16 *G, *XB;
    __device__ int ntiles() const { return (NT / 128) * (2 * DRNN / 128); }
    __device__ void tile(int i, int& m0, int& n0, const float*& W0, const float*& W1) const { m0 = (i / 20) * 128; n0 = (i % 20) * 128; W0 = W; W1 = W; }
    __device__ const bf16* arow(int r) const { return H + (size_t)r * DM; }
    __device__ void epi(int r, int c0, const float (&a)[1][8]) const { float v[8];
        if (c0 < DRNN) {
#pragma unroll
            for (int j = 0; j < 8; ++j) v[j] = gelu_tanh_(a[0][j]);
            st_bf16x8(G + (size_t)r * DRNN + c0, v);
        } else {
#pragma unroll
            for (int j = 0; j < 8; ++j) v[j] = a[0][j];
            st_bf16x8(XB + (size_t)r * DRNN + (c0 - DRNN), v); } }
};
struct PMoeGU {
    int K, ldw; const bf16* H; const float *Wg, *Wu; bf16* ACT; const int* tok; const int* base;
    __device__ int ntiles() const { return (base[8] / 128) * (DFE / 128); }
    __device__ void tile(int i, int& m0, int& n0, const float*& W0, const float*& W1) const {
        m0 = (i / 28) * 128; n0 = (i % 28) * 128; int e = 0;
#pragma unroll
        for (int j = 1; j < 8; ++j) e += (m0 >= base[j]) ? 1 : 0;
        W0 = Wg + (size_t)e * DM * DFE; W1 = Wu + (size_t)e * DM * DFE; }
    __device__ const bf16* arow(int r) const { int t = tok[r]; if (t < 0) t = 0; return H + (size_t)t * DM; }
    __device__ void epi(int r, int c0, const float (&a)[2][8]) const { float v[8];
#pragma unroll
        for (int j = 0; j < 8; ++j) v[j] = silu_(a[0][j]) * a[1][j];
        st_bf16x8(ACT + (size_t)r * DFE + c0, v); }
};
struct PMoeDown {
    int K, ldw; const bf16* ACT; const float* Wd; float* out; const int* tok; const float* gatev; const int* base;
    __device__ int ntiles() const { return (base[8] / 128) * (DM / 128); }
    __device__ void tile(int i, int& m0, int& n0, const float*& W0, const float*& W1) const {
        m0 = (i / 8) * 128; n0 = (i % 8) * 128; int e = 0;
#pragma unroll
        for (int j = 1; j < 8; ++j) e += (m0 >= base[j]) ? 1 : 0;
        W0 = Wd + (size_t)e * DFE * DM; W1 = W0; }
    __device__ const bf16* arow(int r) const { return ACT + (size_t)r * DFE; }
    __device__ void epi(int r, int c0, const float (&a)[1][8]) const {
        const int t = tok[r]; if (t < 0) return; const float g = gatev[r];
        float* o = out + (size_t)t * DM + c0; const f32x4 b0 = *(const f32x4*)o, b1 = *(const f32x4*)(o + 4);
        *(f32x4*)o = (f32x4){b0.x + g * a[0][0], b0.y + g * a[0][1], b0.z + g * a[0][2], b0.w + g * a[0][3]};
        *(f32x4*)(o + 4) = (f32x4){b1.x + g * a[0][4], b1.y + g * a[0][5], b1.z + g * a[0][6], b1.w + g * a[0][7]}; }
};

__device__ __forceinline__ int t5_bucket(int n) {
    const float nf = (float)(n < 1 ? 1 : n);
    int large = 16 + (int)(logf(nf / 16.0f) / 2.0794415416798357f * 16.0f);
    large = large < 31 ? large : 31;
    return n < 16 ? n : large;
}
__device__ __forceinline__ void build_tables(const float* rel_bias, float* TB) {
    for (int i = fresh_tid(); i < NH * 128; i += NTHR) { const int h = i >> 7, n = i & 127; TB[i] = rel_bias[t5_bucket(n) * NH + h] * LOG2E; }
}
__device__ __forceinline__ float compute_lam(const float* lq1, const float* lk1, const float* lq2, const float* lk2) {
    const int lane = fresh_tid() & 63;
    const float s1 = wave_sum(lq1[lane] * lk1[lane]), s2 = wave_sum(lq2[lane] * lk2[lane]);
    return expf(s1) - expf(s2) + LAM_INIT;
}

__device__ __forceinline__ void ref_attention(const bf16* Q, const bf16* Kb, const bf16* V, bf16* O0, bf16* O1, const float* TB, LAS float* sm, int bid, int nb) {
    LAS float* Ks = sm; LAS float* Vs = sm + 32 * 128; LAS float* tb = sm + 2 * 32 * 128;
    const int tid = fresh_tid(), qr = tid & 127, cv = tid >> 7, c = cv >> 1, vh = cv & 1;
    const int NU = NB_ * NH * (SEQ / 128);
    for (int u = bid; u < NU; u += nb) {
        const int uu = NU - 1 - u;
        const int qblk = uu / (NB_ * NH), bh = uu % (NB_ * NH), b = bh / NH, h = bh % NH;
        const int q0 = qblk * 128, q = q0 + qr; const size_t rb = (size_t)b * SEQ;
        __syncthreads();
        if (tid < 128) tb[tid] = TB[h * 128 + tid];
        float qv[64];
        { const v4u* qp = (const v4u*)(Q + (rb + q) * DM + h * 128 + c * 64);
#pragma unroll
          for (int i = 0; i < 8; ++i) { const v4u w = qp[i]; qv[8 * i] = bflo(w.x); qv[8 * i + 1] = bfhi(w.x); qv[8 * i + 2] = bflo(w.y); qv[8 * i + 3] = bfhi(w.y); qv[8 * i + 4] = bflo(w.z); qv[8 * i + 5] = bfhi(w.z); qv[8 * i + 6] = bflo(w.w); qv[8 * i + 7] = bfhi(w.w); } }
        float o[64]; float m = -INFINITY, l = 0.f;
#pragma unroll
        for (int d = 0; d < 64; ++d) o[d] = 0.f;
        const int nkt = (q0 + 127) / 32 + 1;
        for (int kt = 0; kt < nkt; ++kt) {
            __syncthreads();
            { const int r = tid >> 4, c8 = (tid & 15) * 8; const size_t g = (rb + kt * 32 + r) * DM + h * 128 + c8;
              const v4u kw = *(const v4u*)(Kb + g), vw = *(const v4u*)(V + g);
              LAS float* kd = Ks + r * 128 + c8; LAS float* vd = Vs + r * 128 + c8;
              kd[0] = bflo(kw.x); kd[1] = bfhi(kw.x); kd[2] = bflo(kw.y); kd[3] = bfhi(kw.y); kd[4] = bflo(kw.z); kd[5] = bfhi(kw.z); kd[6] = bflo(kw.w); kd[7] = bfhi(kw.w);
              vd[0] = bflo(vw.x); vd[1] = bfhi(vw.x); vd[2] = bflo(vw.y); vd[3] = bfhi(vw.y); vd[4] = bflo(vw.z); vd[5] = bfhi(vw.z); vd[6] = bflo(vw.w); vd[7] = bfhi(vw.w); }
            __syncthreads();
            if (kt * 32 <= q) {
#pragma unroll 1
                for (int j = 0; j < 32; ++j) {
                    const int dist = q - (kt * 32 + j);
                    if (dist >= 0) {
                        const LAS float* kr = Ks + j * 128 + c * 64; float a = 0.f;
#pragma unroll
                        for (int d = 0; d < 64; d += 4) { const f32x4 kv = *(const LAS f32x4*)(kr + d); a += qv[d] * kv.x + qv[d + 1] * kv.y + qv[d + 2] * kv.z + qv[d + 3] * kv.w; }
                        a += tb[dist > 127 ? 127 : dist];
                        const float mn = fmaxf(m, a), al = exp2f(m - mn), pj = exp2f(a - mn); m = mn; l = l * al + pj;
                        const LAS float* vr = Vs + j * 128 + vh * 64;
#pragma unroll
                        for (int d = 0; d < 64; d += 4) { const f32x4 vv = *(const LAS f32x4*)(vr + d);
                            o[d] = o[d] * al + pj * vv.x; o[d + 1] = o[d + 1] * al + pj * vv.y; o[d + 2] = o[d + 2] * al + pj * vv.z; o[d + 3] = o[d + 3] * al + pj * vv.w; }
                    }
                }
            }
        }
        const float rl = 1.f / l;
        bf16* op = (c == 0 ? O0 : O1) + (rb + q) * DM + h * 128 + vh * 64;
#pragma unroll
        for (int i = 0; i < 8; ++i) { float v[8];
#pragma unroll
            for (int j = 0; j < 8; ++j) v[j] = o[8 * i + j] * rl;
            st_bf16x8(op + 8 * i, v); }
    }
}
__device__ __forceinline__ void combine_rows(const bf16* O0, const bf16* O1, bf16* OC, const float* subg, float lam, int bid, int nb) {
    const int tid_ = fresh_tid(); const int lane = tid_ & 63, wave = tid_ >> 6;
    const float g0 = subg[2 * lane], g1 = subg[2 * lane + 1];
    for (long it = (long)bid * NWAVES + wave; it < (long)NT * NH; it += (long)nb * NWAVES) {
        const size_t off = (size_t)it * 128 + 2 * lane;
        const unsigned a = *(const unsigned*)(O0 + off), b = *(const unsigned*)(O1 + off);
        const float x0 = bflo(a) - lam * bflo(b), x1 = bfhi(a) - lam * bfhi(b);
        const float r = 1.f / sqrtf(wave_sum(x0 * x0 + x1 * x1) * (1.f / 128.f) + SUBLN_EPS) * (1.f - LAM_INIT);
        *(unsigned*)(OC + off) = pk2(x0 * r * g0, x1 * r * g1);
    }
}

__device__ __forceinline__ void ref_lru_local(const bf16* XB, const float* convw, const float* convb, const float* gaw, const float* gab, const float* gxw, const float* gxb,
                                              const float* lamp, bf16* HL, bf16* CA, float* AEND, float* HEND, LAS float* sm, int bid, int nb) {
    LAS float* xc = sm;
    LAS float* av = sm + 64 * 128;
    LAS float* bv = sm + 2 * 64 * 128;
    const int tid = fresh_tid();
    const int NU = NB_ * NCH * NLB;
    for (int u = bid; u < NU; u += nb) {
        const int n = u % NLB, ch = (u / NLB) % NCH, b = u / (NLB * NCH);
        const int t0 = ch * LCH; const size_t rb = (size_t)b * SEQ;
        __syncthreads();
        for (int i = tid; i < LCH * 128; i += NTHR) { const int t = i >> 7, c = i & 127, cg = n * 128 + c; float a = convb[cg];
#pragma unroll
            for (int j = 0; j < CW; ++j) { const int tt = t0 + t + j - (CW - 1); if (tt >= 0) a += bf2f(XB[(rb + tt) * DRNN + cg]) * convw[j * DRNN + cg]; }
            xc[i] = a; }
        __syncthreads();
        { const int e = tid & 127, tq = tid >> 7, cg = n * 128 + e;
          const float* wa = gaw + (size_t)n * 128 * 128 + e; const float* wx = gxw + (size_t)n * 128 * 128 + e;
          const float ba = gab[cg], bx = gxb[cg]; const float sp = log1pf(expf(-lamp[cg]));
          for (int tb4 = 0; tb4 < 4; ++tb4) {
              float ar[4] = {0.f, 0.f, 0.f, 0.f}, ai[4] = {0.f, 0.f, 0.f, 0.f};
              const int tbase = tq * 16 + tb4 * 4;
              for (int d = 0; d < 128; ++d) { const float w1 = wa[d * 128], w2 = wx[d * 128];
#pragma unroll
                  for (int k = 0; k < 4; ++k) { const float xv = xc[(tbase + k) * 128 + d]; ar[k] += xv * w1; ai[k] += xv * w2; } }
#pragma unroll
              for (int k = 0; k < 4; ++k) { const int t = tbase + k; const float r = sigmoidf_(ar[k] + ba), ig = sigmoidf_(ai[k] + bx);
                  const float la = -8.0f * r * sp, a = expf(la), mult = sqrtf(-expm1f(2.0f * la));
                  av[t * 128 + e] = a; bv[t * 128 + e] = mult * (ig * xc[t * 128 + e]); }
          } }
        __syncthreads();
        if (tid < 128) { const int cg = n * 128 + tid; float hh = 0.f, cp = 1.f;
            for (int t = 0; t < LCH; ++t) { const float a = av[t * 128 + tid]; hh = a * hh + bv[t * 128 + tid]; cp *= a;
                HL[(rb + t0 + t) * DRNN + cg] = (bf16)f2bf(hh); CA[(rb + t0 + t) * DRNN + cg] = (bf16)f2bf(cp); }
            AEND[((size_t)b * NCH + ch) * DRNN + cg] = cp; HEND[((size_t)b * NCH + ch) * DRNN + cg] = hh; }
    }
}
__device__ __forceinline__ void lru_carry(const float* AEND, const float* HEND, float* CIN, int bid, int nb) {
    for (int i = bid * NTHR + fresh_tid(); i < NB_ * DRNN; i += nb * NTHR) { const int b = i / DRNN, c = i % DRNN; float cin = 0.f;
        for (int ch = 0; ch < NCH; ++ch) { const size_t o = ((size_t)b * NCH + ch) * DRNN + c; CIN[o] = cin; cin = AEND[o] * cin + HEND[o]; } }
}
__device__ __forceinline__ void lru_fixup(const bf16* HL, const bf16* CA, const bf16* G, const float* CIN, bf16* Y, int bid, int nb) {
    const size_t total = (size_t)NT * DRNN / 2;
    for (size_t i = (size_t)bid * NTHR + fresh_tid(); i < total; i += (size_t)nb * NTHR) {
        const size_t el = 2 * i; const int row = (int)(el / DRNN), c = (int)(el % DRNN); const int b = row / SEQ, ch = (row % SEQ) / LCH;
        const unsigned hl = *(const unsigned*)(HL + el), ca = *(const unsigned*)(CA + el), g = *(const unsigned*)(G + el);
        const float* ci = CIN + ((size_t)b * NCH + ch) * DRNN + c;
        const float h0 = bflo(hl) + bflo(ca) * ci[0], h1 = bfhi(hl) + bfhi(ca) * ci[1];
        *(unsigned*)(Y + el) = pk2(h0 * bflo(g), h1 * bfhi(g));
    }
}

__device__ __forceinline__ void moe_route(const float* X, const float* g, const float* router, bf16* H, int* RE, float* RG, int* RR, int* CNT, LAS float* sm, int bid, int nb) {
    LAS int* e_s = (LAS int*)sm;
    const int tid = fresh_tid(), lane = tid & 63, wave = tid >> 6;
    f32x4 gv[4];
#pragma unroll
    for (int j = 0; j < 4; ++j) gv[j] = *(const f32x4*)(g + 4 * lane + 256 * j);
    for (int tile = bid; tile < NT / 256; tile += nb) {
        __syncthreads();
        for (int rr = 0; rr < 32; ++rr) {
            const int lr = wave * 32 + rr, m = tile * 256 + lr;
            const f32x4* xr = (const f32x4*)(X + (size_t)m * DM) + lane;
            f32x4 v[4]; float s = 0.f;
#pragma unroll
            for (int j = 0; j < 4; ++j) { v[j] = xr[64 * j]; s += (v[j].x * v[j].x + v[j].y * v[j].y) + (v[j].z * v[j].z + v[j].w * v[j].w); }
            const float r = 1.f / sqrtf(wave_sum(s) * (1.f / DM) + NORM_EPS);
            unsigned long long* o8 = (unsigned long long*)(H + (size_t)m * DM) + lane;
            float lg[NE];
#pragma unroll
            for (int e = 0; e < NE; ++e) lg[e] = 0.f;
#pragma unroll
            for (int j = 0; j < 4; ++j) { const f32x4 y = v[j] * r * gv[j]; o8[64 * j] = (unsigned long long)pk2(y.x, y.y) | ((unsigned long long)pk2(y.z, y.w) << 32);
                const float* rp = router + (size_t)(4 * lane + 256 * j) * NE;
#pragma unroll
                for (int q = 0; q < 4; ++q) { const f32x4 r0 = *(const f32x4*)(rp + q * NE), r1 = *(const f32x4*)(rp + q * NE + 4); const float yy = y[q];
                    lg[0] += yy * r0.x; lg[1] += yy * r0.y; lg[2] += yy * r0.z; lg[3] += yy * r0.w; lg[4] += yy * r1.x; lg[5] += yy * r1.y; lg[6] += yy * r1.z; lg[7] += yy * r1.w; } }
#pragma unroll
            for (int e = 0; e < NE; ++e) lg[e] = wave_sum(lg[e]);
            int i0 = 0; float v0 = lg[0];
#pragma unroll
            for (int e = 1; e < NE; ++e) if (lg[e] > v0) { v0 = lg[e]; i0 = e; }
            int i1 = -1; float v1 = -INFINITY;
#pragma unroll
            for (int e = 0; e < NE; ++e) if (e != i0 && lg[e] > v1) { v1 = lg[e]; i1 = e; }
            const float g1 = 1.f / (1.f + expf(v0 - v1)), g0 = 1.f - g1;
            if (lane == 0) { e_s[lr] = i0; e_s[256 + lr] = i1; RE[m] = i0; RE[NT + m] = i1; RG[m] = g0; RG[NT + m] = g1; }
        }
        __syncthreads();
        { const int s = tid >> 8, i = tid & 255; const int me = e_s[s * 256 + i]; int rk = 0;
          for (int j = 0; j < i; ++j) rk += (e_s[s * 256 + j] == me) ? 1 : 0;
          RR[s * NT + tile * 256 + i] = rk; }
        if (tid < 16) { const int s = tid >> 3, e = tid & 7; int c = 0; for (int j = 0; j < 256; ++j) c += (e_s[s * 256 + j] == e) ? 1 : 0; CNT[tile * 16 + tid] = c; }
    }
}
__device__ __forceinline__ void moe_scatter(const int* RE, const float* RG, const int* RR, const int* CNT, int* BASE, int* TOK, float* GATEV, LAS float* sm, int bid, int nb) {
    LAS int* tbase = (LAS int*)sm;
    LAS int* gbase = tbase + 128 * 16;
    LAS int* tot = gbase + 32;
    const int tid = fresh_tid();
    __syncthreads();
    if (tid < 16) { int run = 0; for (int t = 0; t < NT / 256; ++t) { tbase[t * 16 + tid] = run; run += CNT[t * 16 + tid]; } tot[tid] = run; }
    __syncthreads();
    if (tid < 2) { int run = 0; for (int e = 0; e < NE; ++e) { gbase[tid * 9 + e] = run; run += (tot[tid * 8 + e] + 255) & ~255; } gbase[tid * 9 + 8] = run; }
    __syncthreads();
    if (bid == 0 && tid < 18) BASE[tid] = gbase[tid];
    for (int i = bid * NTHR + tid; i < 2 * NT; i += nb * NTHR) { const int s = i / NT, m = i % NT; const int e = RE[i];
        const int pos = gbase[s * 9 + e] + tbase[(m >> 8) * 16 + s * 8 + e] + RR[i];
        TOK[s * SLOT_ROWS + pos] = m; GATEV[s * SLOT_ROWS + pos] = RG[i]; }
    for (int gi = bid; gi < 16; gi += nb) { const int s = gi >> 3, e = gi & 7; const int lo = gbase[s * 9 + e] + tot[gi], hi = gbase[s * 9 + e + 1];
        for (int p = lo + tid; p < hi; p += NTHR) { TOK[s * SLOT_ROWS + p] = -1; GATEV[s * SLOT_ROWS + p] = 0.f; } }
}

constexpr int N_PHASES = 21;
__global__ void __launch_bounds__(NTHR, 2) fwd(Args args) {
    extern __shared__ __attribute__((aligned(16))) unsigned char lds[];
    LAS unsigned char* L = (LAS unsigned char*)lds;
    LAS float* sm = (LAS float*)L;
    volatile LAS unsigned* MISC = (volatile LAS unsigned*)(L + MISC_OFF);
    const int tid = threadIdx.x, bid = blockIdx.x, nb = gridDim.x;
    unsigned char* ws = args.ws;
    for (int u = tid; u < (LDS_BYTES - LDSCTL_OFF) / 4; u += NTHR) ((LAS unsigned*)(L + LDSCTL_OFF))[u] = 0u;
    __syncthreads();
    XcdBarrier bar; bar.bar = (unsigned*)(ws + WS_CTL) + CW_BAR; bar.x = 0; bar.st = nullptr;
#if MK_ONE_LAUNCH
    bar = xcd_barrier_post((unsigned*)(ws + WS_CTL) + CW_BAR, MISC + 8);
#endif
    const int lo = args.ph_lo, hi = args.ph_hi;
#ifndef PH_MASK
#define PH_MASK 0x1FFFFF
#endif
#define IN(k) (((PH_MASK >> (k)) & 1) && lo <= (k) && (k) < hi)
#if MK_ONE_LAUNCH
#define SEAM(k) do { if (IN(k) && IN((k) + 1)) xcd_barrier(bar); } while (0)
#else
#define SEAM(k) do { } while (0)
#endif
    const float* x = args.in[0]; float* out = args.out;
    float* TB = (float*)(ws + WS_SMALL + SM_TB);
    int* RE = (int*)(ws + WS_SMALL + SM_ROUTE); float* RG = (float*)(RE + 2 * NT); int* RR = (int*)(RG + 2 * NT);
    int* CNT = (int*)(ws + WS_SMALL + SM_CNT); int* BASE = (int*)(ws + WS_SMALL + SM_BASE);
    int* TOK = (int*)(ws + WS_SMALL + SM_TOK); float* GATEV = (float*)(ws + WS_SMALL + SM_GATEV);
    float* AEND = (float*)(ws + WS_SMALL + SM_AEND); float* HEND = (float*)(ws + WS_SMALL + SM_HEND); float* CIN = (float*)(ws + WS_SMALL + SM_CIN);
    bf16* H = (bf16*)(ws + WS_H); bf16* Q = (bf16*)(ws + WS_Q); bf16* Kb = (bf16*)(ws + WS_K); bf16* V = (bf16*)(ws + WS_V);
    bf16* O0 = (bf16*)(ws + WS_O0); bf16* O1 = (bf16*)(ws + WS_O1); bf16* OC = H;
    bf16* ACT = (bf16*)(ws + WS_ACT); bf16* G = (bf16*)(ws + WS_G); bf16* XB = (bf16*)(ws + WS_XB); bf16* Y = (bf16*)(ws + WS_Y);
    bf16* HL = (bf16*)(ws + WS_HL); bf16* CA = (bf16*)(ws + WS_CA); bf16* ACTM = (bf16*)(ws + WS_ACTM);

    if (IN(0)) { if (bid == 0) build_tables(args.in[4], TB); rms_rows_bf16(x, args.in[1], H, bid, nb); } SEAM(0);
    if (IN(1)) { PQkv p{DM, 3 * DM, H, args.in[5], Q, Kb, V}; ref_gemm<1>(p, sm, bid, nb); } SEAM(1);
    if (IN(2)) { ref_attention(Q, Kb, V, O0, O1, TB, sm, bid, nb); } SEAM(2);
    if (IN(3)) { const float lam = compute_lam(args.in[7], args.in[8], args.in[9], args.in[10]); combine_rows(O0, O1, OC, args.in[11], lam, bid, nb); } SEAM(3);
    if (IN(4)) { PResid p{DM, DM, OC, DM, args.in[6], x, out}; ref_gemm<1>(p, sm, bid, nb); } SEAM(4);
    if (IN(5)) { rms_rows_bf16(out, args.in[2], H, bid, nb); } SEAM(5);
    if (IN(6)) { PSwiglu p{DM, DFF, H, args.in[21], args.in[22], ACT}; ref_gemm<2>(p, sm, bid, nb); } SEAM(6);
    if (IN(7)) { PResid p{DFF, DM, ACT, DFF, args.in[23], out, out}; ref_gemm<1>(p, sm, bid, nb); } SEAM(7);
    if (IN(8)) { rms_rows_bf16(out, args.in[1] + DM, H, bid, nb); } SEAM(8);
    if (IN(9)) { PWin p{DM, 2 * DRNN, H, args.in[12], G, XB}; ref_gemm<1>(p, sm, bid, nb); } SEAM(9);
    if (IN(10)) { ref_lru_local(XB, args.in[13], args.in[14], args.in[15], args.in[16], args.in[17], args.in[18], args.in[19], HL, CA, AEND, HEND, sm, bid, nb); } SEAM(10);
    if (IN(11)) { lru_carry(AEND, HEND, CIN, bid, nb); } SEAM(11);
    if (IN(12)) { lru_fixup(HL, CA, G, CIN, Y, bid, nb); } SEAM(12);
    if (IN(13)) { PResid p{DRNN, DM, Y, DRNN, args.in[20], out, out}; ref_gemm<1>(p, sm, bid, nb); } SEAM(13);
    if (IN(14)) { moe_route(out, args.in[2] + DM, args.in[24], H, RE, RG, RR, CNT, sm, bid, nb); } SEAM(14);
    if (IN(15)) { moe_scatter(RE, RG, RR, CNT, BASE, TOK, GATEV, sm, bid, nb); } SEAM(15);
    if (IN(16)) { PMoeGU p{DM, DFE, H, args.in[25], args.in[26], ACTM, TOK, BASE}; ref_gemm<2>(p, sm, bid, nb); } SEAM(16);
    if (IN(17)) { PMoeDown p{DFE, DM, ACTM, args.in[27], out, TOK, GATEV, BASE}; ref_gemm<1>(p, sm, bid, nb); } SEAM(17);
    if (IN(18)) { PMoeGU p{DM, DFE, H, args.in[25], args.in[26], ACTM, TOK + SLOT_ROWS, BASE + 9}; ref_gemm<2>(p, sm, bid, nb); } SEAM(18);
    if (IN(19)) { PMoeDown p{DFE, DM, ACTM, args.in[27], out, TOK + SLOT_ROWS, GATEV + SLOT_ROWS, BASE + 9}; ref_gemm<1>(p, sm, bid, nb); } SEAM(19);
    if (IN(20)) { rms_rows_f32_inplace(out, args.in[3], bid, nb); }
#undef IN
#undef SEAM
}

extern "C" void kernel_launch(void* const* d_in, const int* in_sizes, int n_in, void* d_out, int out_size, void* d_ws, size_t ws_size, hipStream_t stream) {
    static int grid = 0;
    if (grid == 0) {
        if (n_in != 28 || in_sizes[0] != NT * DM || out_size != NT * DM || ws_size < WS_END) { fprintf(stderr, "kernel_launch: unexpected shapes (n_in %d, in0 %d, out %d, ws %zu); nothing launched\n", n_in, n_in > 0 ? in_sizes[0] : -1, out_size, ws_size); grid = -1; return; }
        int dev = 0, cus = 0, per_cu = 0;
        if (hipGetDevice(&dev) != hipSuccess || hipDeviceGetAttribute(&cus, hipDeviceAttributeMultiprocessorCount, dev) != hipSuccess) { grid = -1; return; }
        if (hipFuncSetAttribute((const void*)fwd, hipFuncAttributeMaxDynamicSharedMemorySize, LDS_BYTES) != hipSuccess) { fprintf(stderr, "kernel_launch: hipFuncSetAttribute failed\n"); grid = -1; return; }
        if (hipOccupancyMaxActiveBlocksPerMultiprocessor(&per_cu, (const void*)fwd, NTHR, LDS_BYTES) != hipSuccess || per_cu < 1) { fprintf(stderr, "kernel_launch: occupancy query reports %d\n", per_cu); }
        (void)hipGetLastError();
        grid = cus;
    }
    if (grid < 0) return;
    if (hipMemsetAsync((char*)d_ws + WS_CTL, 0, CTL_ZERO_BYTES, stream) != hipSuccess) return;
    Args a{};
    for (int i = 0; i < 28; ++i) a.in[i] = (const float*)d_in[i];
    a.out = (float*)d_out; a.ws = (unsigned char*)d_ws;
#if MK_ONE_LAUNCH
    a.ph_lo = 0; a.ph_hi = N_PHASES;
    hipLaunchKernelGGL(fwd, dim3(grid), dim3(NTHR), LDS_BYTES, stream, a);
#else
    for (int p = 0; p < N_PHASES; ++p) { a.ph_lo = p; a.ph_hi = p + 1; hipLaunchKernelGGL(fwd, dim3(grid), dim3(NTHR), LDS_BYTES, stream, a); }
#endif
}
```

```cpp
#include <hip/hip_runtime.h>
#include <cstdio>
#include <cstdint>

#ifndef MK_ONE_LAUNCH
#define MK_ONE_LAUNCH 1
#endif

#define GAS __attribute__((address_space(1)))
#define LAS __attribute__((address_space(3)))
typedef unsigned short bf16;
typedef unsigned v4u __attribute__((ext_vector_type(4)));
typedef unsigned v2u __attribute__((ext_vector_type(2)));
typedef float f32x4 __attribute__((ext_vector_type(4)));
typedef GAS unsigned gu32;
#define RLX_AGENT __ATOMIC_RELAXED, __HIP_MEMORY_SCOPE_AGENT

constexpr int NB_ = 4, SEQ = 8192, DM = 1024, NT = NB_ * SEQ;
constexpr int NH = 8, HD = 64, VD = 128;
constexpr int DRNN = 1280, NLB = 10, LBK = 128, CW = 4;
constexpr int DFF = 2816, NE = 8, DFE = 3584;
constexpr float NORM_EPS = 1e-6f, SUBLN_EPS = 1e-5f, LOG2E = 1.4426950408889634f;
constexpr float C2 = 0.125f * LOG2E;
constexpr float LAM_INIT = 0.2f;
constexpr int NWAVES = 8, NTHR = 512;
constexpr int LCH = 64, NCH = SEQ / LCH;
constexpr int SLOT_ROWS = NT + NE * 256;

constexpr size_t MiB = 1u << 20;
constexpr size_t WS_CTL = 0, CTL_ZERO_BYTES = 1 * MiB;
constexpr size_t WS_SMALL = 1 * MiB;
constexpr size_t SM_TB = 0;
constexpr size_t SM_ROUTE = 64 * 1024;
constexpr size_t SM_CNT = 1 * MiB;
constexpr size_t SM_BASE = 1 * MiB + 16 * 1024;
constexpr size_t SM_TOK = 2 * MiB;
constexpr size_t SM_GATEV = 2 * MiB + 512 * 1024;
constexpr size_t SM_AEND = 4 * MiB;
constexpr size_t SM_HEND = 7 * MiB;
constexpr size_t SM_CIN = 10 * MiB;
constexpr size_t WS_WA = 17 * MiB;
constexpr size_t WS_WM = 50 * MiB;
constexpr size_t WS_O0 = 50 * MiB, WS_O1 = 114 * MiB;
constexpr size_t WS_HL = 50 * MiB, WS_CA = 130 * MiB;
constexpr size_t WS_H = 218 * MiB;
constexpr size_t WS_SCR = 282 * MiB;
constexpr size_t WS_Q = WS_SCR, WS_K = WS_SCR + 64 * MiB, WS_V = WS_SCR + 128 * MiB;
constexpr size_t WS_ACT = WS_SCR;
constexpr size_t WS_G = WS_SCR, WS_XB = WS_SCR + 80 * MiB, WS_Y = WS_SCR + 160 * MiB;
constexpr size_t WS_ACTM = WS_SCR;
constexpr size_t WS_END = 522 * MiB;
static_assert(WS_ACTM + (size_t)SLOT_ROWS * DFE * 2 <= WS_END && WS_Y + (size_t)NT * DRNN * 2 <= WS_END, "ws map");
static_assert(SM_CIN + (size_t)NB_ * NCH * DRNN * 4 <= 16 * MiB, "small map");
constexpr int CW_BAR = 4096;

__device__ __forceinline__ int fresh_tid() { int t = threadIdx.x; asm volatile("" : "+v"(t)); return t; }
__device__ __forceinline__ unsigned f2bf(float f) { unsigned u = __builtin_bit_cast(unsigned, f); return (u + 0x7fffu + ((u >> 16) & 1u)) >> 16; }
__device__ __forceinline__ unsigned pk2(float lo, float hi) { return f2bf(lo) | (f2bf(hi) << 16); }
__device__ __forceinline__ float bflo(unsigned u) { return __builtin_bit_cast(float, u << 16); }
__device__ __forceinline__ float bfhi(unsigned u) { return __builtin_bit_cast(float, u & 0xffff0000u); }
__device__ __forceinline__ float bf2f(bf16 v) { return __builtin_bit_cast(float, (unsigned)v << 16); }
__device__ __forceinline__ float wave_sum(float v) {
#pragma unroll
    for (int o = 1; o < 64; o <<= 1) v += __shfl_xor(v, o);
    return v;
}
__device__ __forceinline__ float sigmoidf_(float x) { return 1.f / (1.f + __expf(-x)); }

#define XB_TMO      128
#define XB_XCNT(j)  (256  + 64 * (j))
#define XB_XSUB(j)  (1280 + 64 * (j))
#define XB_XGEN(j)  (2304 + 64 * (j))
#define XB_TOP      3328
#define XB_TOPGEN   3392
#define XCD_BAR_WORDS 3456
#define XB_SPIN_CAP (1u << 18)
__device__ __forceinline__ unsigned xb_ld(unsigned* p)              { return __hip_atomic_load(p, __ATOMIC_RELAXED, __HIP_MEMORY_SCOPE_AGENT); }
__device__ __forceinline__ unsigned xb_add(unsigned* p, unsigned v) { return __hip_atomic_fetch_add(p, v, __ATOMIC_RELAXED, __HIP_MEMORY_SCOPE_AGENT); }
__device__ __forceinline__ unsigned xb_xcc_id() { return (unsigned)__builtin_amdgcn_s_getreg((3 << 11) | 20) & 0xFu; }
#define XB_SPIN(cond, bar) do { unsigned _sp = 0; while (cond) { __builtin_amdgcn_s_sleep(1); \
    if ((++_sp & 255u) == 0u) { if (xb_ld(&(bar)[XB_TMO])) break; if (_sp > XB_SPIN_CAP) { atomicAdd(&(bar)[XB_TMO], 1u); break; } } } } while (0)
struct XcdBarrier { unsigned* bar; unsigned x; volatile LAS unsigned* st; };
__device__ __forceinline__ XcdBarrier xcd_barrier_post(unsigned* bar, volatile LAS unsigned* st) {
    XcdBarrier b; b.bar = bar; b.x = xb_xcc_id(); b.st = st;
    if (threadIdx.x == 0) (void)xb_add(&bar[XB_XCNT(b.x)], 1u);
    return b;
}
__device__ __forceinline__ void xcd_barrier_complete(unsigned* bar, unsigned x, unsigned& nloc, unsigned& nx) {
    const unsigned G = gridDim.x * gridDim.y * gridDim.z;
    unsigned sum, cnt, mine, sp = 0u;
    for (;;) {
        sum = 0u; cnt = 0u; mine = 0u;
#pragma unroll
        for (unsigned j = 0; j < 16; ++j) { const unsigned c = xb_ld(&bar[XB_XCNT(j)]); sum += c; cnt += (c > 0u) ? 1u : 0u; mine = (j == x) ? c : mine; }
        if (sum == G) break;
        __builtin_amdgcn_s_sleep(1);
        if ((++sp & 255u) == 0u) { if (xb_ld(&bar[XB_TMO])) break; if (sp > XB_SPIN_CAP) { atomicAdd(&bar[XB_TMO], 1u); break; } }
    }
    nloc = mine > 0u ? mine : 1u; nx = cnt > 0u ? cnt : 1u;
}
__device__ __forceinline__ void xcd_barrier(const XcdBarrier& b) {
    asm volatile("s_waitcnt vmcnt(0)" ::: "memory");
    __syncthreads();
    if (threadIdx.x == 0) {
        unsigned* bar = b.bar;
        __builtin_amdgcn_s_waitcnt(0);
        unsigned nloc = b.st[0], nx = b.st[1];
        if (nloc == 0u) { xcd_barrier_complete(bar, b.x, nloc, nx); b.st[0] = nloc; b.st[1] = nx; }
        const unsigned old = xb_add(&bar[XB_XSUB(b.x)], 1u);
        const unsigned gen = old / nloc;
        if (old + 1u == (gen + 1u) * nloc) {
            __builtin_amdgcn_fence(__ATOMIC_RELEASE, "agent");
            asm volatile("s_waitcnt vmcnt(0)" ::: "memory");
            const unsigned og = xb_add(&bar[XB_TOP], 1u);
            const unsigned tg = og / nx;
            if (og + 1u == (tg + 1u) * nx) xb_add(&bar[XB_TOPGEN], 1u);
            else XB_SPIN(xb_ld(&bar[XB_TOPGEN]) == tg, bar);
            __builtin_amdgcn_fence(__ATOMIC_ACQUIRE, "agent");
            xb_add(&bar[XB_XGEN(b.x)], 1u);
            asm volatile("s_waitcnt vmcnt(0)" ::: "memory");
        } else {
            XB_SPIN(xb_ld(&bar[XB_XGEN(b.x)]) == gen, bar);
            __builtin_amdgcn_fence(__ATOMIC_ACQUIRE, "agent");
            asm volatile("s_waitcnt vmcnt(0)" ::: "memory");
        }
    }
    __syncthreads();
}

constexpr int RING_BYTES = 131072;
constexpr int LDSCTL_OFF = RING_BYTES, MISC_OFF = LDSCTL_OFF + 320;
constexpr int LDS_BYTES = 147456;

struct Args { const float* in[28]; float* out; unsigned char* ws; int ph_lo, ph_hi; };

__device__ __forceinline__ void rms_rows_bf16(const float* X, const float* g, bf16* H, int bid, int nb) {
    const int tid_ = fresh_tid(); const int lane = tid_ & 63, wave = tid_ >> 6;
    f32x4 gv[4];
#pragma unroll
    for (int j = 0; j < 4; ++j) gv[j] = *(const f32x4*)(g + 4 * lane + 256 * j);
    for (int m = bid * NWAVES + wave; m < NT; m += nb * NWAVES) {
        const f32x4* xr = (const f32x4*)(X + (size_t)m * DM) + lane;
        f32x4 v[4]; float s = 0.f;
#pragma unroll
        for (int j = 0; j < 4; ++j) { v[j] = xr[64 * j]; s += (v[j].x * v[j].x + v[j].y * v[j].y) + (v[j].z * v[j].z + v[j].w * v[j].w); }
        const float r = 1.f / sqrtf(wave_sum(s) * (1.f / DM) + NORM_EPS);
        unsigned long long* o8 = (unsigned long long*)(H + (size_t)m * DM) + lane;
#pragma unroll
        for (int j = 0; j < 4; ++j) { const f32x4 y = v[j] * r * gv[j]; o8[64 * j] = (unsigned long long)pk2(y.x, y.y) | ((unsigned long long)pk2(y.z, y.w) << 32); }
    }
}
__device__ __forceinline__ void rms_rows_f32_inplace(float* X, const float* g, int bid, int nb) {
    const int tid_ = fresh_tid(); const int lane = tid_ & 63, wave = tid_ >> 6;
    f32x4 gv[4];
#pragma unroll
    for (int j = 0; j < 4; ++j) gv[j] = *(const f32x4*)(g + 4 * lane + 256 * j);
    for (int m = bid * NWAVES + wave; m < NT; m += nb * NWAVES) {
        f32x4* xr = (f32x4*)(X + (size_t)m * DM) + lane;
        f32x4 v[4]; float s = 0.f;
#pragma unroll
        for (int j = 0; j < 4; ++j) { v[j] = xr[64 * j]; s += (v[j].x * v[j].x + v[j].y * v[j].y) + (v[j].z * v[j].z + v[j].w * v[j].w); }
        const float r = 1.f / sqrtf(wave_sum(s) * (1.f / DM) + NORM_EPS);
#pragma unroll
        for (int j = 0; j < 4; ++j) xr[64 * j] = v[j] * r * gv[j];
    }
}

template <int NB, class P>
__device__ __forceinline__ void ref_gemm(const P& p, LAS float* sm, int bid, int nb) {
    constexpr int LDP = 132;
    LAS float* As = sm; LAS float* Bs = sm + 16 * LDP;
    const int tid = fresh_tid(), ty = tid >> 4, tx = tid & 15;
    const int nt = p.ntiles();
    for (int it = bid; it < nt; it += nb) {
        int m0, n0; const float* W[2]; p.tile(it, m0, n0, W[0], W[1]);
        float acc[NB][4][8];
#pragma unroll
        for (int b = 0; b < NB; ++b)
#pragma unroll
            for (int i = 0; i < 4; ++i)
#pragma unroll
                for (int j = 0; j < 8; ++j) acc[b][i][j] = 0.f;
        const bf16* ap = p.arow(m0 + (tid >> 2)) + (tid & 3) * 4;
        for (int k0 = 0; k0 < p.K; k0 += 16) {
            { const v2u v = *(const v2u*)(ap + k0); const int r = tid >> 2, kq = (tid & 3) * 4;
              As[(kq + 0) * LDP + r] = bflo(v.x); As[(kq + 1) * LDP + r] = bfhi(v.x); As[(kq + 2) * LDP + r] = bflo(v.y); As[(kq + 3) * LDP + r] = bfhi(v.y); }
#pragma unroll
            for (int b = 0; b < NB; ++b) { const int k = tid >> 5, n4 = (tid & 31) * 4;
                const f32x4 v = *(const f32x4*)(W[b] + (size_t)(k0 + k) * p.ldw + n0 + n4);
                *(LAS f32x4*)(Bs + (b * 16 + k) * LDP + n4) = v; }
            __syncthreads();
#pragma unroll 2
            for (int kk = 0; kk < 16; ++kk) {
                const f32x4 a = *(const LAS f32x4*)(As + kk * LDP + ty * 4);
#pragma unroll
                for (int b = 0; b < NB; ++b) {
                    const f32x4 b0 = *(const LAS f32x4*)(Bs + (b * 16 + kk) * LDP + tx * 8), b1 = *(const LAS f32x4*)(Bs + (b * 16 + kk) * LDP + tx * 8 + 4);
#pragma unroll
                    for (int i = 0; i < 4; ++i) {
                        acc[b][i][0] += a[i] * b0.x; acc[b][i][1] += a[i] * b0.y; acc[b][i][2] += a[i] * b0.z; acc[b][i][3] += a[i] * b0.w;
                        acc[b][i][4] += a[i] * b1.x; acc[b][i][5] += a[i] * b1.y; acc[b][i][6] += a[i] * b1.z; acc[b][i][7] += a[i] * b1.w; }
                }
            }
            __syncthreads();
        }
#pragma unroll
        for (int i = 0; i < 4; ++i) {
            float a[NB][8];
#pragma unroll
            for (int b = 0; b < NB; ++b)
#pragma unroll
                for (int j = 0; j < 8; ++j) a[b][j] = acc[b][i][j];
            p.epi(m0 + ty * 4 + i, n0 + tx * 8, a);
        }
    }
}
__device__ __forceinline__ void st_bf16x8(bf16* p, const float* v) { v4u w; w.x = pk2(v[0], v[1]); w.y = pk2(v[2], v[3]); w.z = pk2(v[4], v[5]); w.w = pk2(v[6], v[7]); *(v4u*)p = w; }
__device__ __forceinline__ float silu_(float x) { return x / (1.f + __expf(-x)); }
__device__ __forceinline__ float gelu_tanh_(float x) { const float u = 0.7978845608028654f * (x + 0.044715f * x * x * x); return 0.5f * x * (1.f + tanhf(u)); }

struct PQkv {
    int K, ldw; const bf16* H; const float* W; bf16 *Q, *Kb, *V;
    __device__ int ntiles() const { return (NT / 128) * (3 * DM / 128); }
    __device__ void tile(int i, int& m0, int& n0, const float*& W0, const float*& W1) const { m0 = (i / 24) * 128; n0 = (i % 24) * 128; W0 = W; W1 = W; }
    __device__ const bf16* arow(int r) const { return H + (size_t)r * DM; }
    __device__ void epi(int r, int c0, const float (&a)[1][8]) const {
        const int t = c0 >> 10, c = c0 & 1023; float v[8]; const float sc = (t == 0) ? C2 : 1.f;
#pragma unroll
        for (int j = 0; j < 8; ++j) v[j] = a[0][j] * sc;
        st_bf16x8(Q + (size_t)t * (size_t)(32u << 20) + (size_t)r * DM + c, v); }
};
struct PResid {
    int K, ldw; const bf16* A; int lda; const float* W; const float* base; float* out;
    __device__ int ntiles() const { return (NT / 128) * (DM / 128); }
    __device__ void tile(int i, int& m0, int& n0, const float*& W0, const float*& W1) const { m0 = (i / 8) * 128; n0 = (i % 8) * 128; W0 = W; W1 = W; }
    __device__ const bf16* arow(int r) const { return A + (size_t)r * lda; }
    __device__ void epi(int r, int c0, const float (&a)[1][8]) const {
        const f32x4 b0 = *(const f32x4*)(base + (size_t)r * DM + c0), b1 = *(const f32x4*)(base + (size_t)r * DM + c0 + 4);
        *(f32x4*)(out + (size_t)r * DM + c0) = (f32x4){b0.x + a[0][0], b0.y + a[0][1], b0.z + a[0][2], b0.w + a[0][3]};
        *(f32x4*)(out + (size_t)r * DM + c0 + 4) = (f32x4){b1.x + a[0][4], b1.y + a[0][5], b1.z + a[0][6], b1.w + a[0][7]}; }
};
struct PSwiglu {
    int K, ldw; const bf16* H; const float *Wg, *Wu; bf16* ACT;
    __device__ int ntiles() const { return (NT / 128) * (DFF / 128); }
    __device__ void tile(int i, int& m0, int& n0, const float*& W0, const float*& W1) const { m0 = (i / 22) * 128; n0 = (i % 22) * 128; W0 = Wg; W1 = Wu; }
    __device__ const bf16* arow(int r) const { return H + (size_t)r * DM; }
    __device__ void epi(int r, int c0, const float (&a)[2][8]) const { float v[8];
#pragma unroll
        for (int j = 0; j < 8; ++j) v[j] = silu_(a[0][j]) * a[1][j];
        st_bf16x8(ACT + (size_t)r * DFF + c0, v); }
};
struct PWin {
    int K, ldw; const bf16* H; const float* W; bf16 *G, *XB;
    __device__ int ntiles() const { return (NT / 128) * (2 * DRNN / 128); }
    __device__ void tile(int i, int& m0, int& n0, const float*& W0, const float*& W1) const { m0 = (i / 20) * 128; n0 = (i % 20) * 128; W0 = W; W1 = W; }
    __device__ const bf16* arow(int r) const { return H + (size_t)r * DM; }
    __device__ void epi(int r, int c0, const float (&a)[1][8]) const { float v[8];
        if (c0 < DRNN) {
#pragma unroll
            for (int j = 0; j < 8; ++j) v[j] = gelu_tanh_(a[0][j]);
            st_bf16x8(G + (size_t)r * DRNN + c0, v);
        } else {
#pragma unroll
            for (int j = 0; j < 8; ++j) v[j] = a[0][j];
            st_bf16x8(XB + (size_t)r * DRNN + (c0 - DRNN), v); } }
};
struct PMoeGU {
    int K, ldw; const bf16* H; const float *Wg, *Wu; bf16* ACT; const int* tok; const int* base;
    __device__ int ntiles() const { return (base[8] / 128) * (DFE / 128); }
    __device__ void tile(int i, int& m0, int& n0, const float*& W0, const float*& W1) const {
        m0 = (i / 28) * 128; n0 = (i % 28) * 128; int e = 0;
#pragma unroll
        for (int j = 1; j < 8; ++j) e += (m0 >= base[j]) ? 1 : 0;
        W0 = Wg + (size_t)e * DM * DFE; W1 = Wu + (size_t)e * DM * DFE; }
    __device__ const bf16* arow(int r) const { int t = tok[r]; if (t < 0) t = 0; return H + (size_t)t * DM; }
    __device__ void epi(int r, int c0, const float (&a)[2][8]) const { float v[8];
#pragma unroll
        for (int j = 0; j < 8; ++j) v[j] = silu_(a[0][j]) * a[1][j];
        st_bf16x8(ACT + (size_t)r * DFE + c0, v); }
};
struct PMoeDown {
    int K, ldw; const bf16* ACT; const float* Wd; float* out; const int* tok; const float* gatev; const int* base;
    __device__ int ntiles() const { return (base[8] / 128) * (DM / 128); }
    __device__ void tile(int i, int& m0, int& n0, const float*& W0, const float*& W1) const {
        m0 = (i / 8) * 128; n0 = (i % 8) * 128; int e = 0;
#pragma unroll
        for (int j = 1; j < 8; ++j) e += (m0 >= base[j]) ? 1 : 0;
        W0 = Wd + (size_t)e * DFE * DM; W1 = W0; }
    __device__ const bf16* arow(int r) const { return ACT + (size_t)r * DFE; }
    __device__ void epi(int r, int c0, const float (&a)[1][8]) const {
        const int t = tok[r]; if (t < 0) return; const float g = gatev[r];
        float* o = out + (size_t)t * DM + c0; const f32x4 b0 = *(const f32x4*)o, b1 = *(const f32x4*)(o + 4);
        *(f32x4*)o = (f32x4){b0.x + g * a[0][0], b0.y + g * a[0][1], b0.z + g * a[0][2], b0.w + g * a[0][3]};
        *(f32x4*)(o + 4) = (f32x4){b1.x + g * a[0][4], b1.y + g * a[0][5], b1.z + g * a[0][6], b1.w + g * a[0][7]}; }
};

__device__ __forceinline__ int t5_bucket(int n) {
    const float nf = (float)(n < 1 ? 1 : n);
    int large = 16 + (int)(logf(nf / 16.0f) / 2.0794415416798357f * 16.0f);
    large = large < 31 ? large : 31;
    return n < 16 ? n : large;
}
__device__ __forceinline__ void build_tables(const float* rel_bias, float* TB) {
    for (int i = fresh_tid(); i < NH * 128; i += NTHR) { const int h = i >> 7, n = i & 127; TB[i] = rel_bias[t5_bucket(n) * NH + h] * LOG2E; }
}
__device__ __forceinline__ float compute_lam(const float* lq1, const float* lk1, const float* lq2, const float* lk2) {
    const int lane = fresh_tid() & 63;
    const float s1 = wave_sum(lq1[lane] * lk1[lane]), s2 = wave_sum(lq2[lane] * lk2[lane]);
    return expf(s1) - expf(s2) + LAM_INIT;
}

__device__ __forceinline__ void ref_attention(const bf16* Q, const bf16* Kb, const bf16* V, bf16* O0, bf16* O1, const float* TB, LAS float* sm, int bid, int nb) {
    LAS float* Ks = sm; LAS float* Vs = sm + 32 * 128; LAS float* tb = sm + 2 * 32 * 128;
    const int tid = fresh_tid(), qr = tid & 127, cv = tid >> 7, c = cv >> 1, vh = cv & 1;
    const int NU = NB_ * NH * (SEQ / 128);
    for (int u = bid; u < NU; u += nb) {
        const int uu = NU - 1 - u;
        const int qblk = uu / (NB_ * NH), bh = uu % (NB_ * NH), b = bh / NH, h = bh % NH;
        const int q0 = qblk * 128, q = q0 + qr; const size_t rb = (size_t)b * SEQ;
        __syncthreads();
        if (tid < 128) tb[tid] = TB[h * 128 + tid];
        float qv[64];
        { const v4u* qp = (const v4u*)(Q + (rb + q) * DM + h * 128 + c * 64);
#pragma unroll
          for (int i = 0; i < 8; ++i) { const v4u w = qp[i]; qv[8 * i] = bflo(w.x); qv[8 * i + 1] = bfhi(w.x); qv[8 * i + 2] = bflo(w.y); qv[8 * i + 3] = bfhi(w.y); qv[8 * i + 4] = bflo(w.z); qv[8 * i + 5] = bfhi(w.z); qv[8 * i + 6] = bflo(w.w); qv[8 * i + 7] = bfhi(w.w); } }
        float o[64]; float m = -INFINITY, l = 0.f;
#pragma unroll
        for (int d = 0; d < 64; ++d) o[d] = 0.f;
        const int nkt = (q0 + 127) / 32 + 1;
        for (int kt = 0; kt < nkt; ++kt) {
            __syncthreads();
            { const int r = tid >> 4, c8 = (tid & 15) * 8; const size_t g = (rb + kt * 32 + r) * DM + h * 128 + c8;
              const v4u kw = *(const v4u*)(Kb + g), vw = *(const v4u*)(V + g);
              LAS float* kd = Ks + r * 128 + c8; LAS float* vd = Vs + r * 128 + c8;
              kd[0] = bflo(kw.x); kd[1] = bfhi(kw.x); kd[2] = bflo(kw.y); kd[3] = bfhi(kw.y); kd[4] = bflo(kw.z); kd[5] = bfhi(kw.z); kd[6] = bflo(kw.w); kd[7] = bfhi(kw.w);
              vd[0] = bflo(vw.x); vd[1] = bfhi(vw.x); vd[2] = bflo(vw.y); vd[3] = bfhi(vw.y); vd[4] = bflo(vw.z); vd[5] = bfhi(vw.z); vd[6] = bflo(vw.w); vd[7] = bfhi(vw.w); }
            __syncthreads();
            if (kt * 32 <= q) {
#pragma unroll 1
                for (int j = 0; j < 32; ++j) {
                    const int dist = q - (kt * 32 + j);
                    if (dist >= 0) {
                        const LAS float* kr = Ks + j * 128 + c * 64; float a = 0.f;
#pragma unroll
                        for (int d = 0; d < 64; d += 4) { const f32x4 kv = *(const LAS f32x4*)(kr + d); a += qv[d] * kv.x + qv[d + 1] * kv.y + qv[d + 2] * kv.z + qv[d + 3] * kv.w; }
                        a += tb[dist > 127 ? 127 : dist];
                        const float mn = fmaxf(m, a), al = exp2f(m - mn), pj = exp2f(a - mn); m = mn; l = l * al + pj;
                        const LAS float* vr = Vs + j * 128 + vh * 64;
#pragma unroll
                        for (int d = 0; d < 64; d += 4) { const f32x4 vv = *(const LAS f32x4*)(vr + d);
                            o[d] = o[d] * al + pj * vv.x; o[d + 1] = o[d + 1] * al + pj * vv.y; o[d + 2] = o[d + 2] * al + pj * vv.z; o[d + 3] = o[d + 3] * al + pj * vv.w; }
                    }
                }
            }
        }
        const float rl = 1.f / l;
        bf16* op = (c == 0 ? O0 : O1) + (rb + q) * DM + h * 128 + vh * 64;
#pragma unroll
        for (int i = 0; i < 8; ++i) { float v[8];
#pragma unroll
            for (int j = 0; j < 8; ++j) v[j] = o[8 * i + j] * rl;
            st_bf16x8(op + 8 * i, v); }
    }
}
__device__ __forceinline__ void combine_rows(const bf16* O0, const bf16* O1, bf16* OC, const float* subg, float lam, int bid, int nb) {
    const int tid_ = fresh_tid(); const int lane = tid_ & 63, wave = tid_ >> 6;
    const float g0 = subg[2 * lane], g1 = subg[2 * lane + 1];
    for (long it = (long)bid * NWAVES + wave; it < (long)NT * NH; it += (long)nb * NWAVES) {
        const size_t off = (size_t)it * 128 + 2 * lane;
        const unsigned a = *(const unsigned*)(O0 + off), b = *(const unsigned*)(O1 + off);
        const float x0 = bflo(a) - lam * bflo(b), x1 = bfhi(a) - lam * bfhi(b);
        const float r = 1.f / sqrtf(wave_sum(x0 * x0 + x1 * x1) * (1.f / 128.f) + SUBLN_EPS) * (1.f - LAM_INIT);
        *(unsigned*)(OC + off) = pk2(x0 * r * g0, x1 * r * g1);
    }
}

__device__ __forceinline__ void ref_lru_local(const bf16* XB, const float* convw, const float* convb, const float* gaw, const float* gab, const float* gxw, const float* gxb,
                                              const float* lamp, bf16* HL, bf16* CA, float* AEND, float* HEND, LAS float* sm, int bid, int nb) {
    LAS float* xc = sm;
    LAS float* av = sm + 64 * 128;
    LAS float* bv = sm + 2 * 64 * 128;
    const int tid = fresh_tid();
    const int NU = NB_ * NCH * NLB;
    for (int u = bid; u < NU; u += nb) {
        const int n = u % NLB, ch = (u / NLB) % NCH, b = u / (NLB * NCH);
        const int t0 = ch * LCH; const size_t rb = (size_t)b * SEQ;
        __syncthreads();
        for (int i = tid; i < LCH * 128; i += NTHR) { const int t = i >> 7, c = i & 127, cg = n * 128 + c; float a = convb[cg];
#pragma unroll
            for (int j = 0; j < CW; ++j) { const int tt = t0 + t + j - (CW - 1); if (tt >= 0) a += bf2f(XB[(rb + tt) * DRNN + cg]) * convw[j * DRNN + cg]; }
            xc[i] = a; }
        __syncthreads();
        { const int e = tid & 127, tq = tid >> 7, cg = n * 128 + e;
          const float* wa = gaw + (size_t)n * 128 * 128 + e; const float* wx = gxw + (size_t)n * 128 * 128 + e;
          const float ba = gab[cg], bx = gxb[cg]; const float sp = log1pf(expf(-lamp[cg]));
          for (int tb4 = 0; tb4 < 4; ++tb4) {
              float ar[4] = {0.f, 0.f, 0.f, 0.f}, ai[4] = {0.f, 0.f, 0.f, 0.f};
              const int tbase = tq * 16 + tb4 * 4;
              for (int d = 0; d < 128; ++d) { const float w1 = wa[d * 128], w2 = wx[d * 128];
#pragma unroll
                  for (int k = 0; k < 4; ++k) { const float xv = xc[(tbase + k) * 128 + d]; ar[k] += xv * w1; ai[k] += xv * w2; } }
#pragma unroll
              for (int k = 0; k < 4; ++k) { const int t = tbase + k; const float r = sigmoidf_(ar[k] + ba), ig = sigmoidf_(ai[k] + bx);
                  const float la = -8.0f * r * sp, a = expf(la), mult = sqrtf(-expm1f(2.0f * la));
                  av[t * 128 + e] = a; bv[t * 128 + e] = mult * (ig * xc[t * 128 + e]); }
          } }
        __syncthreads();
        if (tid < 128) { const int cg = n * 128 + tid; float hh = 0.f, cp = 1.f;
            for (int t = 0; t < LCH; ++t) { const float a = av[t * 128 + tid]; hh = a * hh + bv[t * 128 + tid]; cp *= a;
                HL[(rb + t0 + t) * DRNN + cg] = (bf16)f2bf(hh); CA[(rb + t0 + t) * DRNN + cg] = (bf16)f2bf(cp); }
            AEND[((size_t)b * NCH + ch) * DRNN + cg] = cp; HEND[((size_t)b * NCH + ch) * DRNN + cg] = hh; }
    }
}
__device__ __forceinline__ void lru_carry(const float* AEND, const float* HEND, float* CIN, int bid, int nb) {
    for (int i = bid * NTHR + fresh_tid(); i < NB_ * DRNN; i += nb * NTHR) { const int b = i / DRNN, c = i % DRNN; float cin = 0.f;
        for (int ch = 0; ch < NCH; ++ch) { const size_t o = ((size_t)b * NCH + ch) * DRNN + c; CIN[o] = cin; cin = AEND[o] * cin + HEND[o]; } }
}
__device__ __forceinline__ void lru_fixup(const bf16* HL, const bf16* CA, const bf16* G, const float* CIN, bf16* Y, int bid, int nb) {
    const size_t total = (size_t)NT * DRNN / 2;
    for (size_t i = (size_t)bid * NTHR + fresh_tid(); i < total; i += (size_t)nb * NTHR) {
        const size_t el = 2 * i; const int row = (int)(el / DRNN), c = (int)(el % DRNN); const int b = row / SEQ, ch = (row % SEQ) / LCH;
        const unsigned hl = *(const unsigned*)(HL + el), ca = *(const unsigned*)(CA + el), g = *(const unsigned*)(G + el);
        const float* ci = CIN + ((size_t)b * NCH + ch) * DRNN + c;
        const float h0 = bflo(hl) + bflo(ca) * ci[0], h1 = bfhi(hl) + bfhi(ca) * ci[1];
        *(unsigned*)(Y + el) = pk2(h0 * bflo(g), h1 * bfhi(g));
    }
}

__device__ __forceinline__ void moe_route(const float* X, const float* g, const float* router, bf16* H, int* RE, float* RG, int* RR, int* CNT, LAS float* sm, int bid, int nb) {
    LAS int* e_s = (LAS int*)sm;
    const int tid = fresh_tid(), lane = tid & 63, wave = tid >> 6;
    f32x4 gv[4];
#pragma unroll
    for (int j = 0; j < 4; ++j) gv[j] = *(const f32x4*)(g + 4 * lane + 256 * j);
    for (int tile = bid; tile < NT / 256; tile += nb) {
        __syncthreads();
        for (int rr = 0; rr < 32; ++rr) {
            const int lr = wave * 32 + rr, m = tile * 256 + lr;
            const f32x4* xr = (const f32x4*)(X + (size_t)m * DM) + lane;
            f32x4 v[4]; float s = 0.f;
#pragma unroll
            for (int j = 0; j < 4; ++j) { v[j] = xr[64 * j]; s += (v[j].x * v[j].x + v[j].y * v[j].y) + (v[j].z * v[j].z + v[j].w * v[j].w); }
            const float r = 1.f / sqrtf(wave_sum(s) * (1.f / DM) + NORM_EPS);
            unsigned long long* o8 = (unsigned long long*)(H + (size_t)m * DM) + lane;
            float lg[NE];
#pragma unroll
            for (int e = 0; e < NE; ++e) lg[e] = 0.f;
#pragma unroll
            for (int j = 0; j < 4; ++j) { const f32x4 y = v[j] * r * gv[j]; o8[64 * j] = (unsigned long long)pk2(y.x, y.y) | ((unsigned long long)pk2(y.z, y.w) << 32);
                const float* rp = router + (size_t)(4 * lane + 256 * j) * NE;
#pragma unroll
                for (int q = 0; q < 4; ++q) { const f32x4 r0 = *(const f32x4*)(rp + q * NE), r1 = *(const f32x4*)(rp + q * NE + 4); const float yy = y[q];
                    lg[0] += yy * r0.x; lg[1] += yy * r0.y; lg[2] += yy * r0.z; lg[3] += yy * r0.w; lg[4] += yy * r1.x; lg[5] += yy * r1.y; lg[6] += yy * r1.z; lg[7] += yy * r1.w; } }
#pragma unroll
            for (int e = 0; e < NE; ++e) lg[e] = wave_sum(lg[e]);
            int i0 = 0; float v0 = lg[0];
#pragma unroll
            for (int e = 1; e < NE; ++e) if (lg[e] > v0) { v0 = lg[e]; i0 = e; }
            int i1 = -1; float v1 = -INFINITY;
#pragma unroll
            for (int e = 0; e < NE; ++e) if (e != i0 && lg[e] > v1) { v1 = lg[e]; i1 = e; }
            const float g1 = 1.f / (1.f + expf(v0 - v1)), g0 = 1.f - g1;
            if (lane == 0) { e_s[lr] = i0; e_s[256 + lr] = i1; RE[m] = i0; RE[NT + m] = i1; RG[m] = g0; RG[NT + m] = g1; }
        }
        __syncthreads();
        { const int s = tid >> 8, i = tid & 255; const int me = e_s[s * 256 + i]; int rk = 0;
          for (int j = 0; j < i; ++j) rk += (e_s[s * 256 + j] == me) ? 1 : 0;
          RR[s * NT + tile * 256 + i] = rk; }
        if (tid < 16) { const int s = tid >> 3, e = tid & 7; int c = 0; for (int j = 0; j < 256; ++j) c += (e_s[s * 256 + j] == e) ? 1 : 0; CNT[tile * 16 + tid] = c; }
    }
}
__device__ __forceinline__ void moe_scatter(const int* RE, const float* RG, const int* RR, const int* CNT, int* BASE, int* TOK, float* GATEV, LAS float* sm, int bid, int nb) {
    LAS int* tbase = (LAS int*)sm;
    LAS int* gbase = tbase + 128 * 16;
    LAS int* tot = gbase + 32;
    const int tid = fresh_tid();
    __syncthreads();
    if (tid < 16) { int run = 0; for (int t = 0; t < NT / 256; ++t) { tbase[t * 16 + tid] = run; run += CNT[t * 16 + tid]; } tot[tid] = run; }
    __syncthreads();
    if (tid < 2) { int run = 0; for (int e = 0; e < NE; ++e) { gbase[tid * 9 + e] = run; run += (tot[tid * 8 + e] + 255) & ~255; } gbase[tid * 9 + 8] = run; }
    __syncthreads();
    if (bid == 0 && tid < 18) BASE[tid] = gbase[tid];
    for (int i = bid * NTHR + tid; i < 2 * NT; i += nb * NTHR) { const int s = i / NT, m = i % NT; const int e = RE[i];
        const int pos = gbase[s * 9 + e] + tbase[(m >> 8) * 16 + s * 8 + e] + RR[i];
        TOK[s * SLOT_ROWS + pos] = m; GATEV[s * SLOT_ROWS + pos] = RG[i]; }
    for (int gi = bid; gi < 16; gi += nb) { const int s = gi >> 3, e = gi & 7; const int lo = gbase[s * 9 + e] + tot[gi], hi = gbase[s * 9 + e + 1];
        for (int p = lo + tid; p < hi; p += NTHR) { TOK[s * SLOT_ROWS + p] = -1; GATEV[s * SLOT_ROWS + p] = 0.f; } }
}

constexpr int N_PHASES = 21;
__global__ void __launch_bounds__(NTHR, 2) fwd(Args args) {
    extern __shared__ __attribute__((aligned(16))) unsigned char lds[];
    LAS unsigned char* L = (LAS unsigned char*)lds;
    LAS float* sm = (LAS float*)L;
    volatile LAS unsigned* MISC = (volatile LAS unsigned*)(L + MISC_OFF);
    const int tid = threadIdx.x, bid = blockIdx.x, nb = gridDim.x;
    unsigned char* ws = args.ws;
    for (int u = tid; u < (LDS_BYTES - LDSCTL_OFF) / 4; u += NTHR) ((LAS unsigned*)(L + LDSCTL_OFF))[u] = 0u;
    __syncthreads();
    XcdBarrier bar; bar.bar = (unsigned*)(ws + WS_CTL) + CW_BAR; bar.x = 0; bar.st = nullptr;
#if MK_ONE_LAUNCH
    bar = xcd_barrier_post((unsigned*)(ws + WS_CTL) + CW_BAR, MISC + 8);
#endif
    const int lo = args.ph_lo, hi = args.ph_hi;
#ifndef PH_MASK
#define PH_MASK 0x1FFFFF
#endif
#define IN(k) (((PH_MASK >> (k)) & 1) && lo <= (k) && (k) < hi)
#if MK_ONE_LAUNCH
#define SEAM(k) do { if (IN(k) && IN((k) + 1)) xcd_barrier(bar); } while (0)
#else
#define SEAM(k) do { } while (0)
#endif
    const float* x = args.in[0]; float* out = args.out;
    float* TB = (float*)(ws + WS_SMALL + SM_TB);
    int* RE = (int*)(ws + WS_SMALL + SM_ROUTE); float* RG = (float*)(RE + 2 * NT); int* RR = (int*)(RG + 2 * NT);
    int* CNT = (int*)(ws + WS_SMALL + SM_CNT); int* BASE = (int*)(ws + WS_SMALL + SM_BASE);
    int* TOK = (int*)(ws + WS_SMALL + SM_TOK); float* GATEV = (float*)(ws + WS_SMALL + SM_GATEV);
    float* AEND = (float*)(ws + WS_SMALL + SM_AEND); float* HEND = (float*)(ws + WS_SMALL + SM_HEND); float* CIN = (float*)(ws + WS_SMALL + SM_CIN);
    bf16* H = (bf16*)(ws + WS_H); bf16* Q = (bf16*)(ws + WS_Q); bf16* Kb = (bf16*)(ws + WS_K); bf16* V = (bf16*)(ws + WS_V);
    bf16* O0 = (bf16*)(ws + WS_O0); bf16* O1 = (bf16*)(ws + WS_O1); bf16* OC = H;
    bf16* ACT = (bf16*)(ws + WS_ACT); bf16* G = (bf16*)(ws + WS_G); bf16* XB = (bf16*)(ws + WS_XB); bf16* Y = (bf16*)(ws + WS_Y);
    bf16* HL = (bf16*)(ws + WS_HL); bf16* CA = (bf16*)(ws + WS_CA); bf16* ACTM = (bf16*)(ws + WS_ACTM);

    if (IN(0)) { if (bid == 0) build_tables(args.in[4], TB); rms_rows_bf16(x, args.in[1], H, bid, nb); } SEAM(0);
    if (IN(1)) { PQkv p{DM, 3 * DM, H, args.in[5], Q, Kb, V}; ref_gemm<1>(p, sm, bid, nb); } SEAM(1);
    if (IN(2)) { ref_attention(Q, Kb, V, O0, O1, TB, sm, bid, nb); } SEAM(2);
    if (IN(3)) { const float lam = compute_lam(args.in[7], args.in[8], args.in[9], args.in[10]); combine_rows(O0, O1, OC, args.in[11], lam, bid, nb); } SEAM(3);
    if (IN(4)) { PResid p{DM, DM, OC, DM, args.in[6], x, out}; ref_gemm<1>(p, sm, bid, nb); } SEAM(4);
    if (IN(5)) { rms_rows_bf16(out, args.in[2], H, bid, nb); } SEAM(5);
    if (IN(6)) { PSwiglu p{DM, DFF, H, args.in[21], args.in[22], ACT}; ref_gemm<2>(p, sm, bid, nb); } SEAM(6);
    if (IN(7)) { PResid p{DFF, DM, ACT, DFF, args.in[23], out, out}; ref_gemm<1>(p, sm, bid, nb); } SEAM(7);
    if (IN(8)) { rms_rows_bf16(out, args.in[1] + DM, H, bid, nb); } SEAM(8);
    if (IN(9)) { PWin p{DM, 2 * DRNN, H, args.in[12], G, XB}; ref_gemm<1>(p, sm, bid, nb); } SEAM(9);
    if (IN(10)) { ref_lru_local(XB, args.in[13], args.in[14], args.in[15], args.in[16], args.in[17], args.in[18], args.in[19], HL, CA, AEND, HEND, sm, bid, nb); } SEAM(10);
    if (IN(11)) { lru_carry(AEND, HEND, CIN, bid, nb); } SEAM(11);
    if (IN(12)) { lru_fixup(HL, CA, G, CIN, Y, bid, nb); } SEAM(12);
    if (IN(13)) { PResid p{DRNN, DM, Y, DRNN, args.in[20], out, out}; ref_gemm<1>(p, sm, bid, nb); } SEAM(13);
    if (IN(14)) { moe_route(out, args.in[2] + DM, args.in[24], H, RE, RG, RR, CNT, sm, bid, nb); } SEAM(14);
    if (IN(15)) { moe_scatter(RE, RG, RR, CNT, BASE, TOK, GATEV, sm, bid, nb); } SEAM(15);
    if (IN(16)) { PMoeGU p{DM, DFE, H, args.in[25], args.in[26], ACTM, TOK, BASE}; ref_gemm<2>(p, sm, bid, nb); } SEAM(16);
    if (IN(17)) { PMoeDown p{DFE, DM, ACTM, args.in[27], out, TOK, GATEV, BASE}; ref_gemm<1>(p, sm, bid, nb); } SEAM(17);
    if (IN(18)) { PMoeGU p{DM, DFE, H, args.in[25], args.in[26], ACTM, TOK + SLOT_ROWS, BASE + 9}; ref_gemm<2>(p, sm, bid, nb); } SEAM(18);
    if (IN(19)) { PMoeDown p{DFE, DM, ACTM, args.in[27], out, TOK + SLOT_ROWS, GATEV + SLOT_ROWS, BASE + 9}; ref_gemm<1>(p, sm, bid, nb); } SEAM(19);
    if (IN(20)) { rms_rows_f32_inplace(out, args.in[3], bid, nb); }
#undef IN
#undef SEAM
}

extern "C" void kernel_launch(void* const* d_in, const int* in_sizes, int n_in, void* d_out, int out_size, void* d_ws, size_t ws_size, hipStream_t stream) {
    static int grid = 0;
    if (grid == 0) {
        if (n_in != 28 || in_sizes[0] != NT * DM || out_size != NT * DM || ws_size < WS_END) { fprintf(stderr, "kernel_launch: unexpected shapes (n_in %d, in0 %d, out %d, ws %zu); nothing launched\n", n_in, n_in > 0 ? in_sizes[0] : -1, out_size, ws_size); grid = -1; return; }
        int dev = 0, cus = 0, per_cu = 0;
        if (hipGetDevice(&dev) != hipSuccess || hipDeviceGetAttribute(&cus, hipDeviceAttributeMultiprocessorCount, dev) != hipSuccess) { grid = -1; return; }
        if (hipFuncSetAttribute((const void*)fwd, hipFuncAttributeMaxDynamicSharedMemorySize, LDS_BYTES) != hipSuccess) { fprintf(stderr, "kernel_launch: hipFuncSetAttribute failed\n"); grid = -1; return; }
        if (hipOccupancyMaxActiveBlocksPerMultiprocessor(&per_cu, (const void*)fwd, NTHR, LDS_BYTES) != hipSuccess || per_cu < 1) { fprintf(stderr, "kernel_launch: occupancy query reports %d\n", per_cu); }
        (void)hipGetLastError();
        grid = cus;
    }
    if (grid < 0) return;
    if (hipMemsetAsync((char*)d_ws + WS_CTL, 0, CTL_ZERO_BYTES, stream) != hipSuccess) return;
    Args a{};
    for (int i = 0; i < 28; ++i) a.in[i] = (const float*)d_in[i];
    a.out = (float*)d_out; a.ws = (unsigned char*)d_ws;
#if MK_ONE_LAUNCH
    a.ph_lo = 0; a.ph_hi = N_PHASES;
    hipLaunchKernelGGL(fwd, dim3(grid), dim3(NTHR), LDS_BYTES, stream, a);
#else
    for (int p = 0; p < N_PHASES; ++p) { a.ph_lo = p; a.ph_hi = p + 1; hipLaunchKernelGGL(fwd, dim3(grid), dim3(NTHR), LDS_BYTES, stream, a); }
#endif
}
```

```cpp
#include <hip/hip_runtime.h>
#include <cstdio>
#include <cstdint>

#ifndef FAST_GEMM
#define FAST_GEMM 1
#endif
#ifndef FAST_MOE
#define FAST_MOE 1
#endif
#ifndef MK_ONE_LAUNCH
#define MK_ONE_LAUNCH 1
#endif

#define GAS __attribute__((address_space(1)))
#define LAS __attribute__((address_space(3)))
typedef unsigned short bf16;
typedef unsigned v4u __attribute__((ext_vector_type(4)));
typedef unsigned v2u __attribute__((ext_vector_type(2)));
typedef float f32x4 __attribute__((ext_vector_type(4)));
typedef GAS unsigned gu32;
#define RLX_AGENT __ATOMIC_RELAXED, __HIP_MEMORY_SCOPE_AGENT

constexpr int NB_ = 4, SEQ = 8192, DM = 1024, NT = NB_ * SEQ;
constexpr int NH = 8, HD = 64, VD = 128;
constexpr int DRNN = 1280, NLB = 10, LBK = 128, CW = 4;
constexpr int DFF = 2816, NE = 8, DFE = 3584;
constexpr float NORM_EPS = 1e-6f, SUBLN_EPS = 1e-5f, LOG2E = 1.4426950408889634f;
constexpr float C2 = 0.125f * LOG2E;
constexpr float LAM_INIT = 0.2f;
constexpr int NWAVES = 8, NTHR = 512;
constexpr int LCH = 64, NCH = SEQ / LCH;
constexpr int SLOT_ROWS = NT + NE * 256;

constexpr size_t MiB = 1u << 20;
constexpr size_t WS_CTL = 0, CTL_ZERO_BYTES = 1 * MiB;
constexpr size_t WS_SMALL = 1 * MiB;
constexpr size_t SM_TB = 0;
constexpr size_t SM_ROUTE = 64 * 1024;
constexpr size_t SM_CNT = 1 * MiB;
constexpr size_t SM_BASE = 1 * MiB + 16 * 1024;
constexpr size_t SM_TOK = 2 * MiB;
constexpr size_t SM_GATEV = 2 * MiB + 512 * 1024;
constexpr size_t SM_AEND = 4 * MiB;
constexpr size_t SM_HEND = 7 * MiB;
constexpr size_t SM_CIN = 10 * MiB;
constexpr size_t WS_WA = 17 * MiB;
constexpr size_t WS_WM = 50 * MiB;
constexpr size_t WS_O0 = 50 * MiB, WS_O1 = 114 * MiB;
constexpr size_t WS_HL = 50 * MiB, WS_CA = 130 * MiB;
constexpr size_t WS_H = 218 * MiB;
constexpr size_t WS_SCR = 282 * MiB;
constexpr size_t WS_Q = WS_SCR, WS_K = WS_SCR + 64 * MiB, WS_V = WS_SCR + 128 * MiB;
constexpr size_t WS_ACT = WS_SCR;
constexpr size_t WS_G = WS_SCR, WS_XB = WS_SCR + 80 * MiB, WS_Y = WS_SCR + 160 * MiB;
constexpr size_t WS_ACTM = WS_SCR;
constexpr size_t WS_END = 522 * MiB;
static_assert(WS_ACTM + (size_t)SLOT_ROWS * DFE * 2 <= WS_END && WS_Y + (size_t)NT * DRNN * 2 <= WS_END, "ws map");
static_assert(SM_CIN + (size_t)NB_ * NCH * DRNN * 4 <= 16 * MiB, "small map");
constexpr int CW_BAR = 4096;

__device__ __forceinline__ int fresh_tid() { int t = threadIdx.x; asm volatile("" : "+v"(t)); return t; }
__device__ __forceinline__ unsigned f2bf(float f) { unsigned u = __builtin_bit_cast(unsigned, f); return (u + 0x7fffu + ((u >> 16) & 1u)) >> 16; }
__device__ __forceinline__ unsigned pk2(float lo, float hi) { return f2bf(lo) | (f2bf(hi) << 16); }
__device__ __forceinline__ float bflo(unsigned u) { return __builtin_bit_cast(float, u << 16); }
__device__ __forceinline__ float bfhi(unsigned u) { return __builtin_bit_cast(float, u & 0xffff0000u); }
__device__ __forceinline__ float bf2f(bf16 v) { return __builtin_bit_cast(float, (unsigned)v << 16); }
__device__ __forceinline__ float wave_sum(float v) {
#pragma unroll
    for (int o = 1; o < 64; o <<= 1) v += __shfl_xor(v, o);
    return v;
}
__device__ __forceinline__ float sigmoidf_(float x) { return 1.f / (1.f + __expf(-x)); }

#define XB_TMO      128
#define XB_XCNT(j)  (256  + 64 * (j))
#define XB_XSUB(j)  (1280 + 64 * (j))
#define XB_XGEN(j)  (2304 + 64 * (j))
#define XB_TOP      3328
#define XB_TOPGEN   3392
#define XCD_BAR_WORDS 3456
#define XB_SPIN_CAP (1u << 18)
__device__ __forceinline__ unsigned xb_ld(unsigned* p)              { return __hip_atomic_load(p, __ATOMIC_RELAXED, __HIP_MEMORY_SCOPE_AGENT); }
__device__ __forceinline__ unsigned xb_add(unsigned* p, unsigned v) { return __hip_atomic_fetch_add(p, v, __ATOMIC_RELAXED, __HIP_MEMORY_SCOPE_AGENT); }
__device__ __forceinline__ unsigned xb_xcc_id() { return (unsigned)__builtin_amdgcn_s_getreg((3 << 11) | 20) & 0xFu; }
#define XB_SPIN(cond, bar) do { unsigned _sp = 0; while (cond) { __builtin_amdgcn_s_sleep(1); \
    if ((++_sp & 255u) == 0u) { if (xb_ld(&(bar)[XB_TMO])) break; if (_sp > XB_SPIN_CAP) { atomicAdd(&(bar)[XB_TMO], 1u); break; } } } } while (0)
struct XcdBarrier { unsigned* bar; unsigned x; volatile LAS unsigned* st; };
__device__ __forceinline__ XcdBarrier xcd_barrier_post(unsigned* bar, volatile LAS unsigned* st) {
    XcdBarrier b; b.bar = bar; b.x = xb_xcc_id(); b.st = st;
    if (threadIdx.x == 0) (void)xb_add(&bar[XB_XCNT(b.x)], 1u);
    return b;
}
__device__ __forceinline__ void xcd_barrier_complete(unsigned* bar, unsigned x, unsigned& nloc, unsigned& nx) {
    const unsigned G = gridDim.x * gridDim.y * gridDim.z;
    unsigned sum, cnt, mine, sp = 0u;
    for (;;) {
        sum = 0u; cnt = 0u; mine = 0u;
#pragma unroll
        for (unsigned j = 0; j < 16; ++j) { const unsigned c = xb_ld(&bar[XB_XCNT(j)]); sum += c; cnt += (c > 0u) ? 1u : 0u; mine = (j == x) ? c : mine; }
        if (sum == G) break;
        __builtin_amdgcn_s_sleep(1);
        if ((++sp & 255u) == 0u) { if (xb_ld(&bar[XB_TMO])) break; if (sp > XB_SPIN_CAP) { atomicAdd(&bar[XB_TMO], 1u); break; } }
    }
    nloc = mine > 0u ? mine : 1u; nx = cnt > 0u ? cnt : 1u;
}
__device__ __forceinline__ void xcd_barrier(const XcdBarrier& b) {
    asm volatile("s_waitcnt vmcnt(0)" ::: "memory");
    __syncthreads();
    if (threadIdx.x == 0) {
        unsigned* bar = b.bar;
        __builtin_amdgcn_s_waitcnt(0);
        unsigned nloc = b.st[0], nx = b.st[1];
        if (nloc == 0u) { xcd_barrier_complete(bar, b.x, nloc, nx); b.st[0] = nloc; b.st[1] = nx; }
        const unsigned old = xb_add(&bar[XB_XSUB(b.x)], 1u);
        const unsigned gen = old / nloc;
        if (old + 1u == (gen + 1u) * nloc) {
            __builtin_amdgcn_fence(__ATOMIC_RELEASE, "agent");
            asm volatile("s_waitcnt vmcnt(0)" ::: "memory");
            const unsigned og = xb_add(&bar[XB_TOP], 1u);
            const unsigned tg = og / nx;
            if (og + 1u == (tg + 1u) * nx) xb_add(&bar[XB_TOPGEN], 1u);
            else XB_SPIN(xb_ld(&bar[XB_TOPGEN]) == tg, bar);
            __builtin_amdgcn_fence(__ATOMIC_ACQUIRE, "agent");
            xb_add(&bar[XB_XGEN(b.x)], 1u);
            asm volatile("s_waitcnt vmcnt(0)" ::: "memory");
        } else {
            XB_SPIN(xb_ld(&bar[XB_XGEN(b.x)]) == gen, bar);
            __builtin_amdgcn_fence(__ATOMIC_ACQUIRE, "agent");
            asm volatile("s_waitcnt vmcnt(0)" ::: "memory");
        }
    }
    __syncthreads();
}

namespace pg8 {
#define PG8_LAS __attribute__((address_space(3)))
typedef unsigned short bf16_t;
typedef short bf16x8 __attribute__((ext_vector_type(8)));
typedef float f32x4 __attribute__((ext_vector_type(4)));
typedef unsigned u32x4 __attribute__((ext_vector_type(4)));
constexpr int BM = 256, BK = 64, HALF = 128, HTB = HALF * BK * 2  , STAGE_BYTES = 8 * HTB, NXCD = 8, WGM = 8;

__host__ __device__ __forceinline__ int lds_byte(int r, int c) { const int st = (r >> 4) * 2 + (c >> 5), rr = r & 15, cc = c & 31, ob = rr * 64 + cc * 2; return st * 1024 + (ob ^ (((ob >> 9) & 1) << 5)); }
__host__ __device__ __forceinline__ void stage_rc(int b, int& R, int& C) { const int st = b / 1024, sb = b % 1024, swz = sb ^ (((sb >> 9) & 1) << 5); R = (st >> 1) * 16 + swz / 64; C = (st & 1) * 32 + (swz % 64) / 2; }
__host__ __device__ __forceinline__ int perm32(int rho) { const int n = rho >> 4, i = rho & 15; return 8 * (i >> 2) + 4 * n + (i & 3); }

struct Unit { int pm, pn, pb; };
struct Gemm { const bf16_t* A; const bf16_t* Bt; int M, N, K; };

struct StaticOrder {
    int nM, nN, nwg, G, c;
    __host__ __device__ void init(int M, int N, int G_, int c_) { nM = M / BM; nN = N / BM; nwg = nM * nN; G = G_; c = c_; }
    __host__ __device__ bool next(int i, Unit& u) const {
        const long L = (long)i * G + c; if (L >= nwg) return false;
        int wgid = (int)L; { const int q = nwg / NXCD, r = nwg % NXCD, xcd = wgid % NXCD, off = wgid / NXCD; wgid = (xcd < r ? xcd * (q + 1) : r * (q + 1) + (xcd - r) * q) + off; }
        const int nig = WGM * nN, gid = wgid / nig, fm = gid * WGM, gsz = (nM - fm) < WGM ? (nM - fm) : WGM;
        u.pm = fm + ((wgid % nig) % gsz); u.pn = (wgid % nig) / gsz; u.pb = u.pn; return true;
    }
    __device__ __forceinline__ void a_ready(const Unit&) const {}
    __device__ __forceinline__ void done(const Unit&) const {}
};

__device__ __forceinline__ unsigned cvt_pk_bf16(float lo, float hi) { unsigned r; asm volatile("v_cvt_pk_bf16_f32 %0, %1, %2" : "=v"(r) : "v"(lo), "v"(hi)); return r; }
typedef float f32x2 __attribute__((ext_vector_type(2)));

template <int ACT  > struct EpiBf16 {
    static constexpr bool PERM = true, AFTER_DRAIN = false; static_assert(ACT == 0, "EpiBf16: only ACT 0 here");
    bf16_t* O; int ldc; const float* bias; int split_cols; size_t split_stride; float scale0;
    __device__ __forceinline__ void operator()(const f32x4 (&acc)[2][2][4][2], const Unit& u, int wr, int wc, int fr, int fq) const {
        const int row0 = u.pm * BM + wr * 64 + fr; int colt = u.pn * BM; bf16_t* base = O;
        float sc = 1.f; if (split_cols) { const int t = colt / split_cols; base += (size_t)t * split_stride; colt -= t * split_cols; if (t == 0) sc = scale0; }
        const int col0 = colt + wc * 32 + 8 * fq, bcol0 = u.pn * BM + wc * 32 + 8 * fq;
        f32x4 bv[2][2];
#pragma unroll
        for (int bj = 0; bj < 2; ++bj)
#pragma unroll
            for (int n = 0; n < 2; ++n) bv[bj][n] = bias ? *(const f32x4*)(bias + bcol0 + bj * HALF + 4 * n) : (f32x4){0.f, 0.f, 0.f, 0.f};
#pragma unroll
        for (int ai = 0; ai < 2; ++ai)
#pragma unroll
            for (int m = 0; m < 4; ++m) { bf16_t* rowp = base + (size_t)(row0 + ai * HALF + m * 16) * ldc + col0;
#pragma unroll
                for (int bj = 0; bj < 2; ++bj) { f32x4 v0 = acc[ai][bj][m][0] + bv[bj][0], v1 = acc[ai][bj][m][1] + bv[bj][1];
                    v0 = v0 * sc; v1 = v1 * sc; u32x4 w; w.x = cvt_pk_bf16(v0[0], v0[1]); w.y = cvt_pk_bf16(v0[2], v0[3]); w.z = cvt_pk_bf16(v1[0], v1[1]); w.w = cvt_pk_bf16(v1[2], v1[3]);
                    *(u32x4*)(rowp + bj * HALF) = w; } }
    }
};

__device__ __forceinline__ float silu_f(float x) { return x * __builtin_amdgcn_rcpf(1.0f + __builtin_amdgcn_exp2f(-1.4426950408889634f * x)); }
__device__ __forceinline__ float gelu_tanh_f(float x) { const float u = x * (0.7978845608028654f + 0.035677408136300125f * x * x);
    return x * __builtin_amdgcn_rcpf(1.0f + __builtin_amdgcn_exp2f(-2.0f * 1.4426950408889634f * u)); }
struct EpiResF32 {
    static constexpr bool PERM = false, AFTER_DRAIN = false;
    const float* base; float* out; int ldc;
    __device__ __forceinline__ void operator()(const f32x4 (&acc)[2][2][4][2], const Unit& u, int wr, int wc, int fr, int fq) const {
        const int row0 = u.pm * BM + wr * 64 + fr, col0 = u.pn * BM + wc * 32 + 4 * fq;
#pragma unroll
        for (int ai = 0; ai < 2; ++ai)
#pragma unroll
            for (int m = 0; m < 4; ++m) { const size_t off = (size_t)(row0 + ai * HALF + m * 16) * ldc + col0;
                f32x4 b[2][2];
#pragma unroll
                for (int bj = 0; bj < 2; ++bj)
#pragma unroll
                    for (int n = 0; n < 2; ++n) b[bj][n] = *(const f32x4*)(base + off + bj * HALF + n * 16);
#pragma unroll
                for (int bj = 0; bj < 2; ++bj)
#pragma unroll
                    for (int n = 0; n < 2; ++n) *(f32x4*)(out + off + bj * HALF + n * 16) = b[bj][n] + acc[ai][bj][m][n];
                asm volatile("" ::: "memory"); }
    }
};
struct EpiSwiglu {
    static constexpr bool PERM = true, AFTER_DRAIN = false;
    bf16_t* O; int ldc;
    __device__ __forceinline__ void operator()(const f32x4 (&acc)[2][2][4][2], const Unit& u, int wr, int wc, int fr, int fq) const {
        const int row0 = u.pm * BM + wr * 64 + fr, col0 = u.pn * HALF + wc * 32 + 8 * fq;
#pragma unroll
        for (int ai = 0; ai < 2; ++ai)
#pragma unroll
            for (int m = 0; m < 4; ++m) { bf16_t* rowp = O + (size_t)(row0 + ai * HALF + m * 16) * ldc + col0;
                const f32x4 g0 = acc[ai][0][m][0], g1 = acc[ai][0][m][1], u0 = acc[ai][1][m][0], u1 = acc[ai][1][m][1];
                u32x4 w; w.x = cvt_pk_bf16(silu_f(g0[0]) * u0[0], silu_f(g0[1]) * u0[1]); w.y = cvt_pk_bf16(silu_f(g0[2]) * u0[2], silu_f(g0[3]) * u0[3]);
                w.z = cvt_pk_bf16(silu_f(g1[0]) * u1[0], silu_f(g1[1]) * u1[1]); w.w = cvt_pk_bf16(silu_f(g1[2]) * u1[2], silu_f(g1[3]) * u1[3]);
                *(u32x4*)rowp = w; }
    }
};
struct EpiWin {
    static constexpr bool PERM = true, AFTER_DRAIN = false;
    bf16_t* G; bf16_t* XB; int ldc; int nsplit;
    __device__ __forceinline__ void operator()(const f32x4 (&acc)[2][2][4][2], const Unit& u, int wr, int wc, int fr, int fq) const {
        const bool isg = u.pn < nsplit; bf16_t* base = isg ? G : XB; const int colt = (isg ? u.pn : u.pn - nsplit) * BM;
        const int row0 = u.pm * BM + wr * 64 + fr, col0 = colt + wc * 32 + 8 * fq;
#pragma unroll
        for (int ai = 0; ai < 2; ++ai)
#pragma unroll
            for (int m = 0; m < 4; ++m) { bf16_t* rowp = base + (size_t)(row0 + ai * HALF + m * 16) * ldc + col0;
#pragma unroll
                for (int bj = 0; bj < 2; ++bj) { f32x4 v0 = acc[ai][bj][m][0], v1 = acc[ai][bj][m][1];
                    if (isg) { v0 = (f32x4){gelu_tanh_f(v0[0]), gelu_tanh_f(v0[1]), gelu_tanh_f(v0[2]), gelu_tanh_f(v0[3])}; v1 = (f32x4){gelu_tanh_f(v1[0]), gelu_tanh_f(v1[1]), gelu_tanh_f(v1[2]), gelu_tanh_f(v1[3])}; }
                    u32x4 w; w.x = cvt_pk_bf16(v0[0], v0[1]); w.y = cvt_pk_bf16(v0[2], v0[3]); w.z = cvt_pk_bf16(v1[0], v1[1]); w.w = cvt_pk_bf16(v1[2], v1[3]);
                    *(u32x4*)(rowp + bj * HALF) = w; } }
    }
};
struct EpiMoeDown {
    static constexpr bool PERM = false, AFTER_DRAIN = false;
    float* out; int ldc; const int* tok; const float* gatev;
    __device__ __forceinline__ void operator()(const f32x4 (&acc)[2][2][4][2], const Unit& u, int wr, int wc, int fr, int fq) const {
        const int row0 = u.pm * BM + wr * 64 + fr, col0 = u.pn * BM + wc * 32 + 4 * fq;
#pragma unroll
        for (int ai = 0; ai < 2; ++ai)
#pragma unroll
            for (int m = 0; m < 4; ++m) { const int r = row0 + ai * HALF + m * 16; const int t = tok[r]; const float g = gatev[r];
                if (t >= 0) { float* o = out + (size_t)t * ldc + col0; f32x4 b[2][2];
#pragma unroll
                    for (int bj = 0; bj < 2; ++bj)
#pragma unroll
                        for (int n = 0; n < 2; ++n) b[bj][n] = *(const f32x4*)(o + bj * HALF + n * 16);
#pragma unroll
                    for (int bj = 0; bj < 2; ++bj)
#pragma unroll
                        for (int n = 0; n < 2; ++n) *(f32x4*)(o + bj * HALF + n * 16) = b[bj][n] + acc[ai][bj][m][n] * g; }
                asm volatile("" ::: "memory"); }
    }
};
struct MoeOrder : StaticOrder {
    const int* tok; int gb[8]; int nNe;
    __device__ void init_moe(int rows, int N, int G_, int c_, const int* tok_, const int* base) { init(rows, N, G_, c_); tok = tok_; nNe = N / BM;
#pragma unroll
        for (int j = 0; j < 8; ++j) gb[j] = base[j]; }
    __device__ __forceinline__ bool next(int i, Unit& u) const {
        if (!StaticOrder::next(i, u)) return false;
        int e = 0;
#pragma unroll
        for (int j = 1; j < 8; ++j) e += (u.pm * BM >= gb[j]) ? 1 : 0;
        u.pb = e * nNe + u.pn; return true; }
    __device__ __forceinline__ int arow(int r) const { const int t = tok[r]; return t < 0 ? 0 : t; }
};

template <class Epi, class Sched, bool ALIGN_EPI = false, bool SP2 = false, bool GATHER = false>
__device__ __forceinline__ void gemm_phase(PG8_LAS unsigned char* lds, const Gemm g, const Sched& S, const Epi& E) {
    int tid_ = threadIdx.x; asm volatile("" : "+v"(tid_));
    const int tid = tid_, wid = __builtin_amdgcn_readfirstlane(tid >> 6), lane = tid & 63, wr = wid >> 2, wc = wid & 3, fr = lane & 15, fq = lane >> 4;
    static_assert(!GATHER || SP2, "GATHER is written for the SP2 loop");
    const int K = g.K, nt = K / BK;
    unsigned voffA[2], voffB[2];
#pragma unroll
    for (int i = 0; i < 2; ++i) { int R, C; stage_rc(tid * 16 + i * 8192, R, C); const int Rb = Epi::PERM ? ((R & ~31) + perm32(R & 31)) : R;
        voffA[i] = (unsigned)(R * K + C) * 2u; voffB[i] = (unsigned)(Rb * K + C) * 2u; }
    unsigned tk[2], tn[2]; unsigned cC2 = 0; int gR0 = 0;
    if constexpr (GATHER) { int R_, C_; stage_rc(tid * 16, R_, C_); gR0 = R_; cC2 = (unsigned)C_ * 2u; }
#define PG8_GTOK(dst, u) do { _Pragma("unroll") for (int _h = 0; _h < 2; ++_h) dst[_h] = (unsigned)S.arow((u).pm * BM + _h * HALF + gR0) | ((unsigned)S.arow((u).pm * BM + _h * HALF + gR0 + 64) << 16); } while (0)
    const size_t kstep = (size_t)(BK * 2);
    const size_t hstep = (size_t)HALF * K * 2;
    const size_t tstep = 2 * hstep;
    const unsigned ldsw = (unsigned)wid * 1024u;
    const int aoff = lds_byte(wr * 64 + fr, fq * 8), boff = lds_byte(wc * 32 + fr, fq * 8);
#define PG8_SA(b, h) (((b) * 2 + (h)) * HTB)
#define PG8_SB(b, h) ((4 + (b) * 2 + (h)) * HTB)
#define PG8_STAGE(bufoff, gbase, voff) do { _Pragma("unroll") for (int _i = 0; _i < 2; ++_i) \
        __builtin_amdgcn_global_load_lds((const unsigned*)((const char*)(gbase) + (voff)[_i]), (PG8_LAS unsigned*)(lds + (bufoff) + ldsw + _i * 8192), 16, 0, 0); } while (0)
#define PG8_STAGEG(bufoff, gbase, tkw) do { _Pragma("unroll") for (int _i = 0; _i < 2; ++_i) { const unsigned _o = (((tkw) >> (16 * _i)) & 0xffffu) * (unsigned)(K * 2) + cC2; \
        __builtin_amdgcn_global_load_lds((const unsigned*)((const char*)(gbase) + _o), (PG8_LAS unsigned*)(lds + (bufoff) + ldsw + _i * 8192), 16, 0, 0); } } while (0)
#define PG8_STA(bufoff, ptr, h, nx) do { if constexpr (GATHER) { if (nx) PG8_STAGEG(bufoff, ptr, tn[h]); else PG8_STAGEG(bufoff, ptr, tk[h]); } else PG8_STAGE(bufoff, (ptr) + (h) * hstep, voffA); } while (0)
#define PG8_LDA(dst, b, h) do { _Pragma("unroll") for (int m = 0; m < 4; ++m) _Pragma("unroll") for (int k = 0; k < 2; ++k) dst[m][k] = *(const PG8_LAS bf16x8*)(lds + PG8_SA(b, h) + aoff + m * 2048 + k * 1024); } while (0)
#define PG8_LDB(dst, b, h) do { _Pragma("unroll") for (int n = 0; n < 2; ++n) _Pragma("unroll") for (int k = 0; k < 2; ++k) dst[n][k] = *(const PG8_LAS bf16x8*)(lds + PG8_SB(b, h) + boff + n * 2048 + k * 1024); } while (0)
#define PG8_MMA(ai, bj, At, Bt) do { __builtin_amdgcn_s_setprio(1); _Pragma("unroll") for (int m = 0; m < 4; ++m) _Pragma("unroll") for (int n = 0; n < 2; ++n) _Pragma("unroll") for (int k = 0; k < 2; ++k) \
        acc[ai][bj][m][n] = __builtin_amdgcn_mfma_f32_16x16x32_bf16(Bt[n][k], At[m][k], acc[ai][bj][m][n], 0, 0, 0); __builtin_amdgcn_s_setprio(0); } while (0)
#define PG8_WAIT_V(n) asm volatile("s_waitcnt vmcnt(" #n ")" ::: "memory")
#define PG8_WAIT_L(n) asm volatile("s_waitcnt lgkmcnt(" #n ")" ::: "memory")
#define PG8_BAR __builtin_amdgcn_s_barrier()
#define PG8_SCHED __builtin_amdgcn_sched_barrier(0)
    Unit cur, nxt; int ui = 0;
    if (!S.next(0, cur)) return;
    f32x4 acc[2][2][4][2];
#pragma unroll
    for (int a = 0; a < 2; ++a)
#pragma unroll
        for (int b = 0; b < 2; ++b)
#pragma unroll
            for (int m = 0; m < 4; ++m)
#pragma unroll
                for (int n = 0; n < 2; ++n) acc[a][b][m][n] = (f32x4){0.f, 0.f, 0.f, 0.f};
    bf16x8 At[4][2], B0[2][2], B1[2][2];
    const char* cA = GATHER ? (const char*)g.A : (const char*)g.A + (size_t)cur.pm * tstep; const char* cB = (const char*)g.Bt + (size_t)cur.pb * tstep;
    if constexpr (GATHER) { PG8_GTOK(tk, cur); }
    S.a_ready(cur);
    if constexpr (SP2) {
        PG8_STAGE(PG8_SB(0, 0), cB, voffB); PG8_STAGE(PG8_SB(0, 1), cB + hstep, voffB); PG8_STA(PG8_SA(0, 0), cA, 0, false); PG8_STA(PG8_SA(0, 1), cA, 1, false);
        if (wr == 1) PG8_BAR;
        PG8_WAIT_V(2); PG8_BAR;
        PG8_STAGE(PG8_SB(1, 0), cB + kstep, voffB); PG8_STA(PG8_SA(1, 0), cA + kstep, 0, false); PG8_STAGE(PG8_SB(1, 1), cB + hstep + kstep, voffB);
        PG8_WAIT_V(6); PG8_BAR;
    } else {
        PG8_STAGE(PG8_SB(0, 0), cB, voffB); PG8_STAGE(PG8_SA(0, 0), cA, voffA); PG8_STAGE(PG8_SB(0, 1), cB + hstep, voffB); PG8_STAGE(PG8_SA(0, 1), cA + hstep, voffA);
        if (wr == 1) PG8_BAR;
        PG8_WAIT_V(4); PG8_BAR;
        PG8_STAGE(PG8_SB(1, 0), cB + kstep, voffB); PG8_STAGE(PG8_SA(1, 0), cA + kstep, voffA); PG8_STAGE(PG8_SB(1, 1), cB + hstep + kstep, voffB);
        PG8_WAIT_V(6); PG8_BAR;
    }
    for (;;) {
        const bool has_next = S.next(ui + 1, nxt);
        if constexpr (GATHER) { if (has_next) { PG8_GTOK(tn, nxt); } else { tn[0] = tk[0]; tn[1] = tk[1]; } }
        const char* nA = GATHER ? (const char*)g.A : (has_next ? (const char*)g.A + (size_t)nxt.pm * tstep : cA); const char* nB = has_next ? (const char*)g.Bt + (size_t)nxt.pb * tstep : cB;
        for (int t = 0; t < nt; t += 2) {
            const bool last = (t == nt - 2);
            const char* a1 = cA + (size_t)(t + 1) * kstep;
            const char* a2 = last ? nA : cA + (size_t)(t + 2) * kstep; const char* b2 = last ? nB : cB + (size_t)(t + 2) * kstep;
            const char* a3 = a2 + kstep; const char* b3 = b2 + kstep;
            if (last && has_next) S.a_ready(nxt);
            if constexpr (SP2) {
            PG8_LDB(B0, 0, 0); PG8_LDB(B1, 0, 1); PG8_SCHED; PG8_LDA(At, 0, 0); PG8_STA(PG8_SA(1, 1), a1, 1, false);
            PG8_WAIT_V(8); PG8_WAIT_L(0); PG8_BAR; PG8_MMA(0, 0, At, B0); PG8_MMA(0, 1, At, B1); PG8_BAR; PG8_SCHED;
            PG8_LDA(At, 0, 1); PG8_STAGE(PG8_SB(0, 0), b2, voffB); PG8_STAGE(PG8_SB(0, 1), b2 + hstep, voffB); PG8_STA(PG8_SA(0, 0), a2, 0, last);
            PG8_WAIT_V(8); PG8_WAIT_L(0); PG8_BAR; PG8_MMA(1, 0, At, B0); PG8_MMA(1, 1, At, B1); PG8_BAR; PG8_SCHED;
            PG8_LDB(B0, 1, 0); PG8_LDB(B1, 1, 1); PG8_SCHED; PG8_LDA(At, 1, 0); PG8_STA(PG8_SA(0, 1), a2, 1, last);
            PG8_WAIT_V(8); PG8_WAIT_L(0); PG8_BAR; PG8_MMA(0, 0, At, B0); PG8_MMA(0, 1, At, B1); PG8_BAR; PG8_SCHED;
            PG8_LDA(At, 1, 1); PG8_STAGE(PG8_SB(1, 0), b3, voffB); PG8_STAGE(PG8_SB(1, 1), b3 + hstep, voffB); PG8_STA(PG8_SA(1, 0), a3, 0, last);
            PG8_WAIT_V(8); PG8_WAIT_L(0); PG8_BAR; PG8_MMA(1, 0, At, B0); PG8_MMA(1, 1, At, B1); PG8_BAR; PG8_SCHED;
            } else {
            PG8_LDB(B0, 0, 0); PG8_SCHED; PG8_LDA(At, 0, 0); PG8_STAGE(PG8_SA(1, 1), a1 + hstep, voffA);
            PG8_WAIT_L(8); PG8_BAR; PG8_WAIT_L(0); PG8_MMA(0, 0, At, B0); PG8_BAR; PG8_SCHED;
            PG8_LDB(B1, 0, 1); PG8_STAGE(PG8_SB(0, 0), b2, voffB);
            PG8_BAR; PG8_WAIT_L(0); PG8_MMA(0, 1, At, B1); PG8_BAR;
            PG8_LDA(At, 0, 1); PG8_STAGE(PG8_SA(0, 0), a2, voffA);
            PG8_BAR; PG8_WAIT_L(0); PG8_MMA(1, 0, At, B0); PG8_BAR; PG8_SCHED;
            PG8_STAGE(PG8_SB(0, 1), b2 + hstep, voffB);
            PG8_WAIT_V(6); PG8_BAR; PG8_MMA(1, 1, At, B1); PG8_BAR;
            PG8_LDB(B0, 1, 0); PG8_SCHED; PG8_LDA(At, 1, 0); PG8_STAGE(PG8_SA(0, 1), a2 + hstep, voffA);
            PG8_WAIT_L(8); PG8_BAR; PG8_WAIT_L(0); PG8_MMA(0, 0, At, B0); PG8_BAR; PG8_SCHED;
            PG8_LDB(B1, 1, 1); PG8_STAGE(PG8_SB(1, 0), b3, voffB);
            PG8_BAR; PG8_WAIT_L(0); PG8_MMA(0, 1, At, B1); PG8_BAR;
            PG8_LDA(At, 1, 1); PG8_STAGE(PG8_SA(1, 0), a3, voffA);
            PG8_BAR; PG8_WAIT_L(0); PG8_MMA(1, 0, At, B0); PG8_BAR; PG8_SCHED;
            PG8_STAGE(PG8_SB(1, 1), b3 + hstep, voffB);
            PG8_WAIT_V(6); PG8_BAR; PG8_MMA(1, 1, At, B1); PG8_BAR;
            }
        }
        if constexpr (ALIGN_EPI) { if (wr == 0) PG8_BAR; }
        if constexpr (!Epi::AFTER_DRAIN) { E(acc, cur, wr, wc, fr, fq); S.done(cur); }
        if (!has_next) break;
#pragma unroll
        for (int a = 0; a < 2; ++a)
#pragma unroll
            for (int b = 0; b < 2; ++b)
#pragma unroll
                for (int m = 0; m < 4; ++m)
#pragma unroll
                    for (int n = 0; n < 2; ++n) acc[a][b][m][n] = (f32x4){0.f, 0.f, 0.f, 0.f};
        cur = nxt; cA = nA; cB = nB; ++ui;
        if constexpr (GATHER) { tk[0] = tn[0]; tk[1] = tn[1]; }
        if constexpr (ALIGN_EPI) { if (wr == 1) PG8_BAR; }
    }
    PG8_WAIT_V(0);
    if constexpr (!ALIGN_EPI) { if (wr == 0) PG8_BAR; }
    PG8_BAR;
    if constexpr (Epi::AFTER_DRAIN) { E.fused(acc, cur, wr, wc, fr, fq, lds, wid, lane); S.done(cur); }
#undef PG8_SA
#undef PG8_SB
#undef PG8_STAGE
#undef PG8_STA
#undef PG8_STAGEG
#undef PG8_GTOK
#undef PG8_LDA
#undef PG8_LDB
#undef PG8_MMA
#undef PG8_WAIT_V
#undef PG8_WAIT_L
#undef PG8_BAR
#undef PG8_SCHED
}
}

constexpr int RING_BYTES = 131072;
constexpr int LDSCTL_OFF = RING_BYTES, MISC_OFF = LDSCTL_OFF + 320;
constexpr int LDS_BYTES = 147456;

struct Args { const float* in[28]; float* out; unsigned char* ws; int ph_lo, ph_hi; };

__device__ __forceinline__ void rms_rows_bf16(const float* X, const float* g, bf16* H, int bid, int nb) {
    const int tid_ = fresh_tid(); const int lane = tid_ & 63, wave = tid_ >> 6;
    f32x4 gv[4];
#pragma unroll
    for (int j = 0; j < 4; ++j) gv[j] = *(const f32x4*)(g + 4 * lane + 256 * j);
    for (int m = bid * NWAVES + wave; m < NT; m += nb * NWAVES) {
        const f32x4* xr = (const f32x4*)(X + (size_t)m * DM) + lane;
        f32x4 v[4]; float s = 0.f;
#pragma unroll
        for (int j = 0; j < 4; ++j) { v[j] = xr[64 * j]; s += (v[j].x * v[j].x + v[j].y * v[j].y) + (v[j].z * v[j].z + v[j].w * v[j].w); }
        const float r = 1.f / sqrtf(wave_sum(s) * (1.f / DM) + NORM_EPS);
        unsigned long long* o8 = (unsigned long long*)(H + (size_t)m * DM) + lane;
#pragma unroll
        for (int j = 0; j < 4; ++j) { const f32x4 y = v[j] * r * gv[j]; o8[64 * j] = (unsigned long long)pk2(y.x, y.y) | ((unsigned long long)pk2(y.z, y.w) << 32); }
    }
}
__device__ __forceinline__ void rms_rows_f32_inplace(float* X, const float* g, int bid, int nb) {
    const int tid_ = fresh_tid(); const int lane = tid_ & 63, wave = tid_ >> 6;
    f32x4 gv[4];
#pragma unroll
    for (int j = 0; j < 4; ++j) gv[j] = *(const f32x4*)(g + 4 * lane + 256 * j);
    for (int m = bid * NWAVES + wave; m < NT; m += nb * NWAVES) {
        f32x4* xr = (f32x4*)(X + (size_t)m * DM) + lane;
        f32x4 v[4]; float s = 0.f;
#pragma unroll
        for (int j = 0; j < 4; ++j) { v[j] = xr[64 * j]; s += (v[j].x * v[j].x + v[j].y * v[j].y) + (v[j].z * v[j].z + v[j].w * v[j].w); }
        const float r = 1.f / sqrtf(wave_sum(s) * (1.f / DM) + NORM_EPS);
#pragma unroll
        for (int j = 0; j < 4; ++j) xr[64 * j] = v[j] * r * gv[j];
    }
}

template <int NB, class P>
__device__ __forceinline__ void ref_gemm(const P& p, LAS float* sm, int bid, int nb) {
    constexpr int LDP = 132;
    LAS float* As = sm; LAS float* Bs = sm + 16 * LDP;
    const int tid = fresh_tid(), ty = tid >> 4, tx = tid & 15;
    const int nt = p.ntiles();
    for (int it = bid; it < nt; it += nb) {
        int m0, n0; const float* W[2]; p.tile(it, m0, n0, W[0], W[1]);
        float acc[NB][4][8];
#pragma unroll
        for (int b = 0; b < NB; ++b)
#pragma unroll
            for (int i = 0; i < 4; ++i)
#pragma unroll
                for (int j = 0; j < 8; ++j) acc[b][i][j] = 0.f;
        const bf16* ap = p.arow(m0 + (tid >> 2)) + (tid & 3) * 4;
        for (int k0 = 0; k0 < p.K; k0 += 16) {
            { const v2u v = *(const v2u*)(ap + k0); const int r = tid >> 2, kq = (tid & 3) * 4;
              As[(kq + 0) * LDP + r] = bflo(v.x); As[(kq + 1) * LDP + r] = bfhi(v.x); As[(kq + 2) * LDP + r] = bflo(v.y); As[(kq + 3) * LDP + r] = bfhi(v.y); }
#pragma unroll
            for (int b = 0; b < NB; ++b) { const int k = tid >> 5, n4 = (tid & 31) * 4;
                const f32x4 v = *(const f32x4*)(W[b] + (size_t)(k0 + k) * p.ldw + n0 + n4);
                *(LAS f32x4*)(Bs + (b * 16 + k) * LDP + n4) = v; }
            __syncthreads();
#pragma unroll 2
            for (int kk = 0; kk < 16; ++kk) {
                const f32x4 a = *(const LAS f32x4*)(As + kk * LDP + ty * 4);
#pragma unroll
                for (int b = 0; b < NB; ++b) {
                    const f32x4 b0 = *(const LAS f32x4*)(Bs + (b * 16 + kk) * LDP + tx * 8), b1 = *(const LAS f32x4*)(Bs + (b * 16 + kk) * LDP + tx * 8 + 4);
#pragma unroll
                    for (int i = 0; i < 4; ++i) {
                        acc[b][i][0] += a[i] * b0.x; acc[b][i][1] += a[i] * b0.y; acc[b][i][2] += a[i] * b0.z; acc[b][i][3] += a[i] * b0.w;
                        acc[b][i][4] += a[i] * b1.x; acc[b][i][5] += a[i] * b1.y; acc[b][i][6] += a[i] * b1.z; acc[b][i][7] += a[i] * b1.w; }
                }
            }
            __syncthreads();
        }
#pragma unroll
        for (int i = 0; i < 4; ++i) {
            float a[NB][8];
#pragma unroll
            for (int b = 0; b < NB; ++b)
#pragma unroll
                for (int j = 0; j < 8; ++j) a[b][j] = acc[b][i][j];
            p.epi(m0 + ty * 4 + i, n0 + tx * 8, a);
        }
    }
}
__device__ __forceinline__ void st_bf16x8(bf16* p, const float* v) { v4u w; w.x = pk2(v[0], v[1]); w.y = pk2(v[2], v[3]); w.z = pk2(v[4], v[5]); w.w = pk2(v[6], v[7]); *(v4u*)p = w; }
__device__ __forceinline__ float silu_(float x) { return x / (1.f + __expf(-x)); }
__device__ __forceinline__ float gelu_tanh_(float x) { const float u = 0.7978845608028654f * (x + 0.044715f * x * x * x); return 0.5f * x * (1.f + tanhf(u)); }

struct PQkv {
    int K, ldw; const bf16* H; const float* W; bf16 *Q, *Kb, *V;
    __device__ int ntiles() const { return (NT / 128) * (3 * DM / 128); }
    __device__ void tile(int i, int& m0, int& n0, const float*& W0, const float*& W1) const { m0 = (i / 24) * 128; n0 = (i % 24) * 128; W0 = W; W1 = W; }
    __device__ const bf16* arow(int r) const { return H + (size_t)r * DM; }
    __device__ void epi(int r, int c0, const float (&a)[1][8]) const {
        const int t = c0 >> 10, c = c0 & 1023; float v[8]; const float sc = (t == 0) ? C2 : 1.f;
#pragma unroll
        for (int j = 0; j < 8; ++j) v[j] = a[0][j] * sc;
        st_bf16x8(Q + (size_t)t * (size_t)(32u << 20) + (size_t)r * DM + c, v); }
};
struct PResid {
    int K, ldw; const bf16* A; int lda; const float* W; const float* base; float* out;
    __device__ int ntiles() const { return (NT / 128) * (DM / 128); }
    __device__ void tile(int i, int& m0, int& n0, const float*& W0, const float*& W1) const { m0 = (i / 8) * 128; n0 = (i % 8) * 128; W0 = W; W1 = W; }
    __device__ const bf16* arow(int r) const { return A + (size_t)r * lda; }
    __device__ void epi(int r, int c0, const float (&a)[1][8]) const {
        const f32x4 b0 = *(const f32x4*)(base + (size_t)r * DM + c0), b1 = *(const f32x4*)(base + (size_t)r * DM + c0 + 4);
        *(f32x4*)(out + (size_t)r * DM + c0) = (f32x4){b0.x + a[0][0], b0.y + a[0][1], b0.z + a[0][2], b0.w + a[0][3]};
        *(f32x4*)(out + (size_t)r * DM + c0 + 4) = (f32x4){b1.x + a[0][4], b1.y + a[0][5], b1.z + a[0][6], b1.w + a[0][7]}; }
};
struct PSwiglu {
    int K, ldw; const bf16* H; const float *Wg, *Wu; bf16* ACT;
    __device__ int ntiles() const { return (NT / 128) * (DFF / 128); }
    __device__ void tile(int i, int& m0, int& n0, const float*& W0, const float*& W1) const { m0 = (i / 22) * 128; n0 = (i % 22) * 128; W0 = Wg; W1 = Wu; }
    __device__ const bf16* arow(int r) const { return H + (size_t)r * DM; }
    __device__ void epi(int r, int c0, const float (&a)[2][8]) const { float v[8];
#pragma unroll
        for (int j = 0; j < 8; ++j) v[j] = silu_(a[0][j]) * a[1][j];
        st_bf16x8(ACT + (size_t)r * DFF + c0, v); }
};
struct PWin {
    int K, ldw; const bf16* H; const float* W; bf16 *G, *XB;
    __device__ int ntiles() const { return (NT / 128) * (2 * DRNN / 128); }
    __device__ void tile(int i, int& m0, int& n0, const float*& W0, const float*& W1) const { m0 = (i / 20) * 128; n0 = (i % 20) * 128; W0 = W; W1 = W; }
    __device__ const bf16* arow(int r) const { return H + (size_t)r * DM; }
    __device__ void epi(int r, int c0, const float (&a)[1][8]) const { float v[8];
        if (c0 < DRNN) {
#pragma unroll
            for (int j = 0; j < 8; ++j) v[j] = gelu_tanh_(a[0][j]);
            st_bf16x8(G + (size_t)r * DRNN + c0, v);
        } else {
#pragma unroll
            for (int j = 0; j < 8; ++j) v[j] = a[0][j];
            st_bf16x8(XB + (size_t)r * DRNN + (c0 - DRNN), v); } }
};
struct PMoeGU {
    int K, ldw; const bf16* H; const float *Wg, *Wu; bf16* ACT; const int* tok; const int* base;
    __device__ int ntiles() const { return (base[8] / 128) * (DFE / 128); }
    __device__ void tile(int i, int& m0, int& n0, const float*& W0, const float*& W1) const {
        m0 = (i / 28) * 128; n0 = (i % 28) * 128; int e = 0;
#pragma unroll
        for (int j = 1; j < 8; ++j) e += (m0 >= base[j]) ? 1 : 0;
        W0 = Wg + (size_t)e * DM * DFE; W1 = Wu + (size_t)e * DM * DFE; }
    __device__ const bf16* arow(int r) const { int t = tok[r]; if (t < 0) t = 0; return H + (size_t)t * DM; }
    __device__ void epi(int r, int c0, const float (&a)[2][8]) const { float v[8];
#pragma unroll
        for (int j = 0; j < 8; ++j) v[j] = silu_(a[0][j]) * a[1][j];
        st_bf16x8(ACT + (size_t)r * DFE + c0, v); }
};
struct PMoeDown {
    int K, ldw; const bf16* ACT; const float* Wd; float* out; const int* tok; const float* gatev; const int* base;
    __device__ int ntiles() const { return (base[8] / 128) * (DM / 128); }
    __device__ void tile(int i, int& m0, int& n0, const float*& W0, const float*& W1) const {
        m0 = (i / 8) * 128; n0 = (i % 8) * 128; int e = 0;
#pragma unroll
        for (int j = 1; j < 8; ++j) e += (m0 >= base[j]) ? 1 : 0;
        W0 = Wd + (size_t)e * DFE * DM; W1 = W0; }
    __device__ const bf16* arow(int r) const { return ACT + (size_t)r * DFE; }
    __device__ void epi(int r, int c0, const float (&a)[1][8]) const {
        const int t = tok[r]; if (t < 0) return; const float g = gatev[r];
        float* o = out + (size_t)t * DM + c0; const f32x4 b0 = *(const f32x4*)o, b1 = *(const f32x4*)(o + 4);
        *(f32x4*)o = (f32x4){b0.x + g * a[0][0], b0.y + g * a[0][1], b0.z + g * a[0][2], b0.w + g * a[0][3]};
        *(f32x4*)(o + 4) = (f32x4){b1.x + g * a[0][4], b1.y + g * a[0][5], b1.z + g * a[0][6], b1.w + g * a[0][7]}; }
};

__device__ __forceinline__ int t5_bucket(int n) {
    const float nf = (float)(n < 1 ? 1 : n);
    int large = 16 + (int)(logf(nf / 16.0f) / 2.0794415416798357f * 16.0f);
    large = large < 31 ? large : 31;
    return n < 16 ? n : large;
}
__device__ __forceinline__ void build_tables(const float* rel_bias, float* TB) {
    for (int i = fresh_tid(); i < NH * 128; i += NTHR) { const int h = i >> 7, n = i & 127; TB[i] = rel_bias[t5_bucket(n) * NH + h] * LOG2E; }
}
__device__ __forceinline__ float compute_lam(const float* lq1, const float* lk1, const float* lq2, const float* lk2) {
    const int lane = fresh_tid() & 63;
    const float s1 = wave_sum(lq1[lane] * lk1[lane]), s2 = wave_sum(lq2[lane] * lk2[lane]);
    return expf(s1) - expf(s2) + LAM_INIT;
}

__device__ __forceinline__ void ref_attention(const bf16* Q, const bf16* Kb, const bf16* V, bf16* O0, bf16* O1, const float* TB, LAS float* sm, int bid, int nb) {
    LAS float* Ks = sm; LAS float* Vs = sm + 32 * 128; LAS float* tb = sm + 2 * 32 * 128;
    const int tid = fresh_tid(), qr = tid & 127, cv = tid >> 7, c = cv >> 1, vh = cv & 1;
    const int NU = NB_ * NH * (SEQ / 128);
    for (int u = bid; u < NU; u += nb) {
        const int uu = NU - 1 - u;
        const int qblk = uu / (NB_ * NH), bh = uu % (NB_ * NH), b = bh / NH, h = bh % NH;
        const int q0 = qblk * 128, q = q0 + qr; const size_t rb = (size_t)b * SEQ;
        __syncthreads();
        if (tid < 128) tb[tid] = TB[h * 128 + tid];
        float qv[64];
        { const v4u* qp = (const v4u*)(Q + (rb + q) * DM + h * 128 + c * 64);
#pragma unroll
          for (int i = 0; i < 8; ++i) { const v4u w = qp[i]; qv[8 * i] = bflo(w.x); qv[8 * i + 1] = bfhi(w.x); qv[8 * i + 2] = bflo(w.y); qv[8 * i + 3] = bfhi(w.y); qv[8 * i + 4] = bflo(w.z); qv[8 * i + 5] = bfhi(w.z); qv[8 * i + 6] = bflo(w.w); qv[8 * i + 7] = bfhi(w.w); } }
        float o[64]; float m = -INFINITY, l = 0.f;
#pragma unroll
        for (int d = 0; d < 64; ++d) o[d] = 0.f;
        const int nkt = (q0 + 127) / 32 + 1;
        for (int kt = 0; kt < nkt; ++kt) {
            __syncthreads();
            { const int r = tid >> 4, c8 = (tid & 15) * 8; const size_t g = (rb + kt * 32 + r) * DM + h * 128 + c8;
              const v4u kw = *(const v4u*)(Kb + g), vw = *(const v4u*)(V + g);
              LAS float* kd = Ks + r * 128 + c8; LAS float* vd = Vs + r * 128 + c8;
              kd[0] = bflo(kw.x); kd[1] = bfhi(kw.x); kd[2] = bflo(kw.y); kd[3] = bfhi(kw.y); kd[4] = bflo(kw.z); kd[5] = bfhi(kw.z); kd[6] = bflo(kw.w); kd[7] = bfhi(kw.w);
              vd[0] = bflo(vw.x); vd[1] = bfhi(vw.x); vd[2] = bflo(vw.y); vd[3] = bfhi(vw.y); vd[4] = bflo(vw.z); vd[5] = bfhi(vw.z); vd[6] = bflo(vw.w); vd[7] = bfhi(vw.w); }
            __syncthreads();
            if (kt * 32 <= q) {
#pragma unroll 1
                for (int j = 0; j < 32; ++j) {
                    const int dist = q - (kt * 32 + j);
                    if (dist >= 0) {
                        const LAS float* kr = Ks + j * 128 + c * 64; float a = 0.f;
#pragma unroll
                        for (int d = 0; d < 64; d += 4) { const f32x4 kv = *(const LAS f32x4*)(kr + d); a += qv[d] * kv.x + qv[d + 1] * kv.y + qv[d + 2] * kv.z + qv[d + 3] * kv.w; }
                        a += tb[dist > 127 ? 127 : dist];
                        const float mn = fmaxf(m, a), al = exp2f(m - mn), pj = exp2f(a - mn); m = mn; l = l * al + pj;
                        const LAS float* vr = Vs + j * 128 + vh * 64;
#pragma unroll
                        for (int d = 0; d < 64; d += 4) { const f32x4 vv = *(const LAS f32x4*)(vr + d);
                            o[d] = o[d] * al + pj * vv.x; o[d + 1] = o[d + 1] * al + pj * vv.y; o[d + 2] = o[d + 2] * al + pj * vv.z; o[d + 3] = o[d + 3] * al + pj * vv.w; }
                    }
                }
            }
        }
        const float rl = 1.f / l;
        bf16* op = (c == 0 ? O0 : O1) + (rb + q) * DM + h * 128 + vh * 64;
#pragma unroll
        for (int i = 0; i < 8; ++i) { float v[8];
#pragma unroll
            for (int j = 0; j < 8; ++j) v[j] = o[8 * i + j] * rl;
            st_bf16x8(op + 8 * i, v); }
    }
}
__device__ __forceinline__ void combine_rows(const bf16* O0, const bf16* O1, bf16* OC, const float* subg, float lam, int bid, int nb) {
    const int tid_ = fresh_tid(); const int lane = tid_ & 63, wave = tid_ >> 6;
    const float g0 = subg[2 * lane], g1 = subg[2 * lane + 1];
    for (long it = (long)bid * NWAVES + wave; it < (long)NT * NH; it += (long)nb * NWAVES) {
        const size_t off = (size_t)it * 128 + 2 * lane;
        const unsigned a = *(const unsigned*)(O0 + off), b = *(const unsigned*)(O1 + off);
        const float x0 = bflo(a) - lam * bflo(b), x1 = bfhi(a) - lam * bfhi(b);
        const float r = 1.f / sqrtf(wave_sum(x0 * x0 + x1 * x1) * (1.f / 128.f) + SUBLN_EPS) * (1.f - LAM_INIT);
        *(unsigned*)(OC + off) = pk2(x0 * r * g0, x1 * r * g1);
    }
}

__device__ __forceinline__ void ref_lru_local(const bf16* XB, const float* convw, const float* convb, const float* gaw, const float* gab, const float* gxw, const float* gxb,
                                              const float* lamp, bf16* HL, bf16* CA, float* AEND, float* HEND, LAS float* sm, int bid, int nb) {
    LAS float* xc = sm;
    LAS float* av = sm + 64 * 128;
    LAS float* bv = sm + 2 * 64 * 128;
    const int tid = fresh_tid();
    const int NU = NB_ * NCH * NLB;
    for (int u = bid; u < NU; u += nb) {
        const int n = u % NLB, ch = (u / NLB) % NCH, b = u / (NLB * NCH);
        const int t0 = ch * LCH; const size_t rb = (size_t)b * SEQ;
        __syncthreads();
        for (int i = tid; i < LCH * 128; i += NTHR) { const int t = i >> 7, c = i & 127, cg = n * 128 + c; float a = convb[cg];
#pragma unroll
            for (int j = 0; j < CW; ++j) { const int tt = t0 + t + j - (CW - 1); if (tt >= 0) a += bf2f(XB[(rb + tt) * DRNN + cg]) * convw[j * DRNN + cg]; }
            xc[i] = a; }
        __syncthreads();
        { const int e = tid & 127, tq = tid >> 7, cg = n * 128 + e;
          const float* wa = gaw + (size_t)n * 128 * 128 + e; const float* wx = gxw + (size_t)n * 128 * 128 + e;
          const float ba = gab[cg], bx = gxb[cg]; const float sp = log1pf(expf(-lamp[cg]));
          for (int tb4 = 0; tb4 < 4; ++tb4) {
              float ar[4] = {0.f, 0.f, 0.f, 0.f}, ai[4] = {0.f, 0.f, 0.f, 0.f};
              const int tbase = tq * 16 + tb4 * 4;
              for (int d = 0; d < 128; ++d) { const float w1 = wa[d * 128], w2 = wx[d * 128];
#pragma unroll
                  for (int k = 0; k < 4; ++k) { const float xv = xc[(tbase + k) * 128 + d]; ar[k] += xv * w1; ai[k] += xv * w2; } }
#pragma unroll
              for (int k = 0; k < 4; ++k) { const int t = tbase + k; const float r = sigmoidf_(ar[k] + ba), ig = sigmoidf_(ai[k] + bx);
                  const float la = -8.0f * r * sp, a = expf(la), mult = sqrtf(-expm1f(2.0f * la));
                  av[t * 128 + e] = a; bv[t * 128 + e] = mult * (ig * xc[t * 128 + e]); }
          } }
        __syncthreads();
        if (tid < 128) { const int cg = n * 128 + tid; float hh = 0.f, cp = 1.f;
            for (int t = 0; t < LCH; ++t) { const float a = av[t * 128 + tid]; hh = a * hh + bv[t * 128 + tid]; cp *= a;
                HL[(rb + t0 + t) * DRNN + cg] = (bf16)f2bf(hh); CA[(rb + t0 + t) * DRNN + cg] = (bf16)f2bf(cp); }
            AEND[((size_t)b * NCH + ch) * DRNN + cg] = cp; HEND[((size_t)b * NCH + ch) * DRNN + cg] = hh; }
    }
}
__device__ __forceinline__ void lru_carry(const float* AEND, const float* HEND, float* CIN, int bid, int nb) {
    for (int i = bid * NTHR + fresh_tid(); i < NB_ * DRNN; i += nb * NTHR) { const int b = i / DRNN, c = i % DRNN; float cin = 0.f;
        for (int ch = 0; ch < NCH; ++ch) { const size_t o = ((size_t)b * NCH + ch) * DRNN + c; CIN[o] = cin; cin = AEND[o] * cin + HEND[o]; } }
}
__device__ __forceinline__ void lru_fixup(const bf16* HL, const bf16* CA, const bf16* G, const float* CIN, bf16* Y, int bid, int nb) {
    const size_t total = (size_t)NT * DRNN / 2;
    for (size_t i = (size_t)bid * NTHR + fresh_tid(); i < total; i += (size_t)nb * NTHR) {
        const size_t el = 2 * i; const int row = (int)(el / DRNN), c = (int)(el % DRNN); const int b = row / SEQ, ch = (row % SEQ) / LCH;
        const unsigned hl = *(const unsigned*)(HL + el), ca = *(const unsigned*)(CA + el), g = *(const unsigned*)(G + el);
        const float* ci = CIN + ((size_t)b * NCH + ch) * DRNN + c;
        const float h0 = bflo(hl) + bflo(ca) * ci[0], h1 = bfhi(hl) + bfhi(ca) * ci[1];
        *(unsigned*)(Y + el) = pk2(h0 * bflo(g), h1 * bfhi(g));
    }
}

__device__ __forceinline__ void moe_route(const float* X, const float* g, const float* router, bf16* H, int* RE, float* RG, int* RR, int* CNT, LAS float* sm, int bid, int nb) {
    LAS int* e_s = (LAS int*)sm;
    const int tid = fresh_tid(), lane = tid & 63, wave = tid >> 6;
    f32x4 gv[4];
#pragma unroll
    for (int j = 0; j < 4; ++j) gv[j] = *(const f32x4*)(g + 4 * lane + 256 * j);
    for (int tile = bid; tile < NT / 256; tile += nb) {
        __syncthreads();
        for (int rr = 0; rr < 32; ++rr) {
            const int lr = wave * 32 + rr, m = tile * 256 + lr;
            const f32x4* xr = (const f32x4*)(X + (size_t)m * DM) + lane;
            f32x4 v[4]; float s = 0.f;
#pragma unroll
            for (int j = 0; j < 4; ++j) { v[j] = xr[64 * j]; s += (v[j].x * v[j].x + v[j].y * v[j].y) + (v[j].z * v[j].z + v[j].w * v[j].w); }
            const float r = 1.f / sqrtf(wave_sum(s) * (1.f / DM) + NORM_EPS);
            unsigned long long* o8 = (unsigned long long*)(H + (size_t)m * DM) + lane;
            float lg[NE];
#pragma unroll
            for (int e = 0; e < NE; ++e) lg[e] = 0.f;
#pragma unroll
            for (int j = 0; j < 4; ++j) { const f32x4 y = v[j] * r * gv[j]; o8[64 * j] = (unsigned long long)pk2(y.x, y.y) | ((unsigned long long)pk2(y.z, y.w) << 32);
                const float* rp = router + (size_t)(4 * lane + 256 * j) * NE;
#pragma unroll
                for (int q = 0; q < 4; ++q) { const f32x4 r0 = *(const f32x4*)(rp + q * NE), r1 = *(const f32x4*)(rp + q * NE + 4); const float yy = y[q];
                    lg[0] += yy * r0.x; lg[1] += yy * r0.y; lg[2] += yy * r0.z; lg[3] += yy * r0.w; lg[4] += yy * r1.x; lg[5] += yy * r1.y; lg[6] += yy * r1.z; lg[7] += yy * r1.w; } }
#pragma unroll
            for (int e = 0; e < NE; ++e) lg[e] = wave_sum(lg[e]);
            int i0 = 0; float v0 = lg[0];
#pragma unroll
            for (int e = 1; e < NE; ++e) if (lg[e] > v0) { v0 = lg[e]; i0 = e; }
            int i1 = -1; float v1 = -INFINITY;
#pragma unroll
            for (int e = 0; e < NE; ++e) if (e != i0 && lg[e] > v1) { v1 = lg[e]; i1 = e; }
            const float g1 = 1.f / (1.f + expf(v0 - v1)), g0 = 1.f - g1;
            if (lane == 0) { e_s[lr] = i0; e_s[256 + lr] = i1; RE[m] = i0; RE[NT + m] = i1; RG[m] = g0; RG[NT + m] = g1; }
        }
        __syncthreads();
        { const int s = tid >> 8, i = tid & 255; const int me = e_s[s * 256 + i]; int rk = 0;
          for (int j = 0; j < i; ++j) rk += (e_s[s * 256 + j] == me) ? 1 : 0;
          RR[s * NT + tile * 256 + i] = rk; }
        if (tid < 16) { const int s = tid >> 3, e = tid & 7; int c = 0; for (int j = 0; j < 256; ++j) c += (e_s[s * 256 + j] == e) ? 1 : 0; CNT[tile * 16 + tid] = c; }
    }
}
__device__ __forceinline__ void moe_scatter(const int* RE, const float* RG, const int* RR, const int* CNT, int* BASE, int* TOK, float* GATEV, LAS float* sm, int bid, int nb) {
    LAS int* tbase = (LAS int*)sm;
    LAS int* gbase = tbase + 128 * 16;
    LAS int* tot = gbase + 32;
    const int tid = fresh_tid();
    __syncthreads();
    if (tid < 16) { int run = 0; for (int t = 0; t < NT / 256; ++t) { tbase[t * 16 + tid] = run; run += CNT[t * 16 + tid]; } tot[tid] = run; }
    __syncthreads();
    if (tid < 2) { int run = 0; for (int e = 0; e < NE; ++e) { gbase[tid * 9 + e] = run; run += (tot[tid * 8 + e] + 255) & ~255; } gbase[tid * 9 + 8] = run; }
    __syncthreads();
    if (bid == 0 && tid < 18) BASE[tid] = gbase[tid];
    for (int i = bid * NTHR + tid; i < 2 * NT; i += nb * NTHR) { const int s = i / NT, m = i % NT; const int e = RE[i];
        const int pos = gbase[s * 9 + e] + tbase[(m >> 8) * 16 + s * 8 + e] + RR[i];
        TOK[s * SLOT_ROWS + pos] = m; GATEV[s * SLOT_ROWS + pos] = RG[i]; }
    for (int gi = bid; gi < 16; gi += nb) { const int s = gi >> 3, e = gi & 7; const int lo = gbase[s * 9 + e] + tot[gi], hi = gbase[s * 9 + e + 1];
        for (int p = lo + tid; p < hi; p += NTHR) { TOK[s * SLOT_ROWS + p] = -1; GATEV[s * SLOT_ROWS + p] = 0.f; } }
}

#define LDS_WAIT() asm volatile("s_waitcnt lgkmcnt(0)" ::: "memory")
__device__ __forceinline__ void transpose_item(const float* W, int N, bf16* WT, int K, int k0, int n0, int drow0, LAS float* scr, int lane) {
#pragma unroll 8
    for (int i = 0; i < 32; ++i) { const int kk = 2 * i + (lane >> 5); scr[kk * 33 + (lane & 31)] = W[(size_t)(k0 + kk) * N + n0 + (lane & 31)]; }
    LDS_WAIT(); asm volatile("" ::: "memory");
    const int c = lane & 7;
#pragma unroll
    for (int j = 0; j < 4; ++j) { const int n = (lane >> 3) + 8 * j; const LAS float* sp = scr + (8 * c) * 33 + n;
        v4u o; o.x = pk2(sp[0 * 33], sp[1 * 33]); o.y = pk2(sp[2 * 33], sp[3 * 33]); o.z = pk2(sp[4 * 33], sp[5 * 33]); o.w = pk2(sp[6 * 33], sp[7 * 33]);
        *(v4u*)(WT + (size_t)(drow0 + n) * K + k0 + 8 * c) = o; }
    LDS_WAIT(); asm volatile("" ::: "memory");
}
__device__ __forceinline__ void convert_matrix(const float* W, int K, int N, bf16* WT, int mode, LAS float* scr, int gw, int ngw, int lane) {
    const int nblk = N / 32, nitems = (K / 64) * nblk;
    for (int it = gw; it < nitems; it += ngw) { const int kb = it / nblk, nbk = it % nblk, n0 = 32 * nbk;
        const int drow0 = mode == 0 ? n0 : ((n0 >> 7) * 256 + (mode == 2 ? 128 : 0) + (n0 & 127));
        transpose_item(W, N, WT, K, 64 * kb, n0, drow0, scr, lane); }
}
constexpr size_t WA_QKV = 0, WA_O = 6 * MiB, WA_GU = 8 * MiB, WA_D = 19 * MiB, WA_IN = 19 * MiB + 5632 * 1024, WA_OUT = WA_IN + 5 * MiB, WA_GATES = WA_OUT + 2560 * 1024;
static_assert(WA_GATES + 2 * NLB * 128 * 128 * 2 <= 33 * MiB, "weights map");
__device__ __forceinline__ void convert_weights_a(const Args& args, unsigned char* ws, LAS unsigned char* L, int bid, int nb) {
    const int tid = fresh_tid(), lane = tid & 63, wave = tid >> 6; LAS float* scr = (LAS float*)(L + wave * 16384);
    const int gw = bid * NWAVES + wave, ngw = nb * NWAVES; unsigned char* wa = ws + WS_WA;
    convert_matrix(args.in[5], DM, 3 * DM, (bf16*)(wa + WA_QKV), 0, scr, gw, ngw, lane);
    convert_matrix(args.in[6], DM, DM, (bf16*)(wa + WA_O), 0, scr, gw, ngw, lane);
    convert_matrix(args.in[21], DM, DFF, (bf16*)(wa + WA_GU), 1, scr, gw, ngw, lane);
    convert_matrix(args.in[22], DM, DFF, (bf16*)(wa + WA_GU), 2, scr, gw, ngw, lane);
    convert_matrix(args.in[23], DFF, DM, (bf16*)(wa + WA_D), 0, scr, gw, ngw, lane);
    convert_matrix(args.in[12], DM, 2 * DRNN, (bf16*)(wa + WA_IN), 0, scr, gw, ngw, lane);
    convert_matrix(args.in[20], DRNN, DM, (bf16*)(wa + WA_OUT), 0, scr, gw, ngw, lane);
}
constexpr size_t WM_GU = 0, WM_D = 112 * MiB;
__device__ __forceinline__ void convert_weights_moe(const Args& args, unsigned char* ws, LAS unsigned char* L, int bid, int nb) {
    const int tid = fresh_tid(), lane = tid & 63, wave = tid >> 6; LAS float* scr = (LAS float*)(L + wave * 16384);
    const int gw = bid * NWAVES + wave, ngw = nb * NWAVES; unsigned char* wm = ws + WS_WM;
    for (int e = 0; e < NE; ++e) {
        convert_matrix(args.in[25] + (size_t)e * DM * DFE, DM, DFE, (bf16*)(wm + WM_GU) + (size_t)e * 2 * DFE * DM, 1, scr, gw, ngw, lane);
        convert_matrix(args.in[26] + (size_t)e * DM * DFE, DM, DFE, (bf16*)(wm + WM_GU) + (size_t)e * 2 * DFE * DM, 2, scr, gw, ngw, lane);
        convert_matrix(args.in[27] + (size_t)e * DFE * DM, DFE, DM, (bf16*)(wm + WM_D) + (size_t)e * DM * DFE, 0, scr, gw, ngw, lane);
    }
}
constexpr int N_PHASES = 21;
__global__ void __launch_bounds__(NTHR, 2) fwd(Args args) {
    extern __shared__ __attribute__((aligned(16))) unsigned char lds[];
    LAS unsigned char* L = (LAS unsigned char*)lds;
    LAS float* sm = (LAS float*)L;
    volatile LAS unsigned* MISC = (volatile LAS unsigned*)(L + MISC_OFF);
    const int tid = threadIdx.x, bid = blockIdx.x, nb = gridDim.x;
    unsigned char* ws = args.ws;
    for (int u = tid; u < (LDS_BYTES - LDSCTL_OFF) / 4; u += NTHR) ((LAS unsigned*)(L + LDSCTL_OFF))[u] = 0u;
    __syncthreads();
    XcdBarrier bar; bar.bar = (unsigned*)(ws + WS_CTL) + CW_BAR; bar.x = 0; bar.st = nullptr;
#if MK_ONE_LAUNCH
    bar = xcd_barrier_post((unsigned*)(ws + WS_CTL) + CW_BAR, MISC + 8);
#endif
    const int lo = args.ph_lo, hi = args.ph_hi;
#ifndef PH_MASK
#define PH_MASK 0x1FFFFF
#endif
#define IN(k) (((PH_MASK >> (k)) & 1) && lo <= (k) && (k) < hi)
#if MK_ONE_LAUNCH
#define SEAM(k) do { if (IN(k) && IN((k) + 1)) xcd_barrier(bar); } while (0)
#else
#define SEAM(k) do { } while (0)
#endif
    const float* x = args.in[0]; float* out = args.out;
    float* TB = (float*)(ws + WS_SMALL + SM_TB);
    int* RE = (int*)(ws + WS_SMALL + SM_ROUTE); float* RG = (float*)(RE + 2 * NT); int* RR = (int*)(RG + 2 * NT);
    int* CNT = (int*)(ws + WS_SMALL + SM_CNT); int* BASE = (int*)(ws + WS_SMALL + SM_BASE);
    int* TOK = (int*)(ws + WS_SMALL + SM_TOK); float* GATEV = (float*)(ws + WS_SMALL + SM_GATEV);
    float* AEND = (float*)(ws + WS_SMALL + SM_AEND); float* HEND = (float*)(ws + WS_SMALL + SM_HEND); float* CIN = (float*)(ws + WS_SMALL + SM_CIN);
    bf16* H = (bf16*)(ws + WS_H); bf16* Q = (bf16*)(ws + WS_Q); bf16* Kb = (bf16*)(ws + WS_K); bf16* V = (bf16*)(ws + WS_V);
    bf16* O0 = (bf16*)(ws + WS_O0); bf16* O1 = (bf16*)(ws + WS_O1); bf16* OC = H;
    bf16* ACT = (bf16*)(ws + WS_ACT); bf16* G = (bf16*)(ws + WS_G); bf16* XB = (bf16*)(ws + WS_XB); bf16* Y = (bf16*)(ws + WS_Y);
    bf16* HL = (bf16*)(ws + WS_HL); bf16* CA = (bf16*)(ws + WS_CA); bf16* ACTM = (bf16*)(ws + WS_ACTM);

    if (IN(0)) { if (bid == 0) build_tables(args.in[4], TB);
#if FAST_GEMM
        convert_weights_a(args, ws, L, bid, nb); __syncthreads();
#endif
        rms_rows_bf16(x, args.in[1], H, bid, nb); } SEAM(0);
#if FAST_GEMM
    const pg8::bf16_t* WA = (const pg8::bf16_t*)(ws + WS_WA);
#define WAT(off) ((const pg8::bf16_t*)(ws + WS_WA + (off)))
    if (IN(1)) { pg8::Gemm g{H, WAT(WA_QKV), NT, 3 * DM, DM}; pg8::StaticOrder S; S.init(NT, 3 * DM, nb, bid);
        pg8::EpiBf16<0> E{Q, DM, nullptr, DM, (size_t)(WS_K - WS_Q) / 2, C2};
        pg8::gemm_phase<pg8::EpiBf16<0>, pg8::StaticOrder, true, true>(L, g, S, E); } SEAM(1);
#else
    if (IN(1)) { PQkv p{DM, 3 * DM, H, args.in[5], Q, Kb, V}; ref_gemm<1>(p, sm, bid, nb); } SEAM(1);
#endif
    if (IN(2)) { ref_attention(Q, Kb, V, O0, O1, TB, sm, bid, nb); } SEAM(2);
    if (IN(3)) { const float lam = compute_lam(args.in[7], args.in[8], args.in[9], args.in[10]); combine_rows(O0, O1, OC, args.in[11], lam, bid, nb); } SEAM(3);
#if FAST_GEMM
    if (IN(4)) { pg8::Gemm g{OC, WAT(WA_O), NT, DM, DM}; pg8::StaticOrder S; S.init(NT, DM, nb, bid);
        pg8::EpiResF32 E{x, out, DM};
        pg8::gemm_phase<pg8::EpiResF32, pg8::StaticOrder, true, true>(L, g, S, E); } SEAM(4);
#else
    if (IN(4)) { PResid p{DM, DM, OC, DM, args.in[6], x, out}; ref_gemm<1>(p, sm, bid, nb); } SEAM(4);
#endif
    if (IN(5)) { rms_rows_bf16(out, args.in[2], H, bid, nb); } SEAM(5);
#if FAST_GEMM
    if (IN(6)) { pg8::Gemm g{H, WAT(WA_GU), NT, 2 * DFF, DM}; pg8::StaticOrder S; S.init(NT, 2 * DFF, nb, bid);
        pg8::EpiSwiglu E{ACT, DFF};
        pg8::gemm_phase<pg8::EpiSwiglu, pg8::StaticOrder, true, true>(L, g, S, E); } SEAM(6);
#else
    if (IN(6)) { PSwiglu p{DM, DFF, H, args.in[21], args.in[22], ACT}; ref_gemm<2>(p, sm, bid, nb); } SEAM(6);
#endif
#if FAST_GEMM
    if (IN(7)) { pg8::Gemm g{ACT, WAT(WA_D), NT, DM, DFF}; pg8::StaticOrder S; S.init(NT, DM, nb, bid);
        pg8::EpiResF32 E{out, out, DM};
        pg8::gemm_phase<pg8::EpiResF32, pg8::StaticOrder, true, true>(L, g, S, E); } SEAM(7);
#else
    if (IN(7)) { PResid p{DFF, DM, ACT, DFF, args.in[23], out, out}; ref_gemm<1>(p, sm, bid, nb); } SEAM(7);
#endif
    if (IN(8)) { rms_rows_bf16(out, args.in[1] + DM, H, bid, nb); } SEAM(8);
#if FAST_GEMM
    if (IN(9)) { pg8::Gemm g{H, WAT(WA_IN), NT, 2 * DRNN, DM}; pg8::StaticOrder S; S.init(NT, 2 * DRNN, nb, bid);
        pg8::EpiWin E{G, XB, DRNN, DRNN / 256};
        pg8::gemm_phase<pg8::EpiWin, pg8::StaticOrder, true, true>(L, g, S, E); } SEAM(9);
#else
    if (IN(9)) { PWin p{DM, 2 * DRNN, H, args.in[12], G, XB}; ref_gemm<1>(p, sm, bid, nb); } SEAM(9);
#endif
    if (IN(10)) { ref_lru_local(XB, args.in[13], args.in[14], args.in[15], args.in[16], args.in[17], args.in[18], args.in[19], HL, CA, AEND, HEND, sm, bid, nb); } SEAM(10);
    if (IN(11)) { lru_carry(AEND, HEND, CIN, bid, nb); } SEAM(11);
    if (IN(12)) { lru_fixup(HL, CA, G, CIN, Y, bid, nb); } SEAM(12);
#if FAST_GEMM
    if (IN(13)) { pg8::Gemm g{Y, WAT(WA_OUT), NT, DM, DRNN}; pg8::StaticOrder S; S.init(NT, DM, nb, bid);
        pg8::EpiResF32 E{out, out, DM};
        pg8::gemm_phase<pg8::EpiResF32, pg8::StaticOrder, true, true>(L, g, S, E); } SEAM(13);
#else
    if (IN(13)) { PResid p{DRNN, DM, Y, DRNN, args.in[20], out, out}; ref_gemm<1>(p, sm, bid, nb); } SEAM(13);
#endif
    if (IN(14)) { moe_route(out, args.in[2] + DM, args.in[24], H, RE, RG, RR, CNT, sm, bid, nb); } SEAM(14);
    if (IN(15)) { moe_scatter(RE, RG, RR, CNT, BASE, TOK, GATEV, sm, bid, nb);
#if FAST_MOE
        __syncthreads(); convert_weights_moe(args, ws, L, bid, nb);
#endif
    } SEAM(15);
#if FAST_MOE
    for (int sl = 0; sl < 2; ++sl) {
        const int* tok_s = TOK + sl * SLOT_ROWS; const float* gate_s = GATEV + sl * SLOT_ROWS; const int* base_s = BASE + sl * 9;
        if (IN(16 + 2 * sl)) { const int rows = base_s[8];
            pg8::Gemm g{H, (const pg8::bf16_t*)(ws + WS_WM + WM_GU), rows, 2 * DFE, DM}; pg8::MoeOrder S; S.init_moe(rows, 2 * DFE, nb, bid, tok_s, base_s);
            pg8::EpiSwiglu E{ACTM, DFE};
            pg8::gemm_phase<pg8::EpiSwiglu, pg8::MoeOrder, true, true, true>(L, g, S, E); } SEAM(16 + 2 * sl);
        if (IN(17 + 2 * sl)) { const int rows = base_s[8];
            pg8::Gemm g{ACTM, (const pg8::bf16_t*)(ws + WS_WM + WM_D), rows, DM, DFE}; pg8::MoeOrder S; S.init_moe(rows, DM, nb, bid, tok_s, base_s);
            pg8::EpiMoeDown E{out, DM, tok_s, gate_s};
            pg8::gemm_phase<pg8::EpiMoeDown, pg8::MoeOrder, true, true, false>(L, g, S, E); } SEAM(17 + 2 * sl);
    }
#else
    if (IN(16)) { PMoeGU p{DM, DFE, H, args.in[25], args.in[26], ACTM, TOK, BASE}; ref_gemm<2>(p, sm, bid, nb); } SEAM(16);
    if (IN(17)) { PMoeDown p{DFE, DM, ACTM, args.in[27], out, TOK, GATEV, BASE}; ref_gemm<1>(p, sm, bid, nb); } SEAM(17);
    if (IN(18)) { PMoeGU p{DM, DFE, H, args.in[25], args.in[26], ACTM, TOK + SLOT_ROWS, BASE + 9}; ref_gemm<2>(p, sm, bid, nb); } SEAM(18);
    if (IN(19)) { PMoeDown p{DFE, DM, ACTM, args.in[27], out, TOK + SLOT_ROWS, GATEV + SLOT_ROWS, BASE + 9}; ref_gemm<1>(p, sm, bid, nb); } SEAM(19);
#endif
    if (IN(20)) { rms_rows_f32_inplace(out, args.in[3], bid, nb); }
#undef IN
#undef SEAM
}

extern "C" void kernel_launch(void* const* d_in, const int* in_sizes, int n_in, void* d_out, int out_size, void* d_ws, size_t ws_size, hipStream_t stream) {
    static int grid = 0;
    if (grid == 0) {
        if (n_in != 28 || in_sizes[0] != NT * DM || out_size != NT * DM || ws_size < WS_END) { fprintf(stderr, "kernel_launch: unexpected shapes (n_in %d, in0 %d, out %d, ws %zu); nothing launched\n", n_in, n_in > 0 ? in_sizes[0] : -1, out_size, ws_size); grid = -1; return; }
        int dev = 0, cus = 0, per_cu = 0;
        if (hipGetDevice(&dev) != hipSuccess || hipDeviceGetAttribute(&cus, hipDeviceAttributeMultiprocessorCount, dev) != hipSuccess) { grid = -1; return; }
        if (hipFuncSetAttribute((const void*)fwd, hipFuncAttributeMaxDynamicSharedMemorySize, LDS_BYTES) != hipSuccess) { fprintf(stderr, "kernel_launch: hipFuncSetAttribute failed\n"); grid = -1; return; }
        if (hipOccupancyMaxActiveBlocksPerMultiprocessor(&per_cu, (const void*)fwd, NTHR, LDS_BYTES) != hipSuccess || per_cu < 1) { fprintf(stderr, "kernel_launch: occupancy query reports %d\n", per_cu); }
        (void)hipGetLastError();
        grid = cus;
    }
    if (grid < 0) return;
    if (hipMemsetAsync((char*)d_ws + WS_CTL, 0, CTL_ZERO_BYTES, stream) != hipSuccess) return;
    Args a{};
    for (int i = 0; i < 28; ++i) a.in[i] = (const float*)d_in[i];
    a.out = (float*)d_out; a.ws = (unsigned char*)d_ws;
#if MK_ONE_LAUNCH
    a.ph_lo = 0; a.ph_hi = N_PHASES;
    hipLaunchKernelGGL(fwd, dim3(grid), dim3(NTHR), LDS_BYTES, stream, a);
#else
    for (int p = 0; p < N_PHASES; ++p) { a.ph_lo = p; a.ph_hi = p + 1; hipLaunchKernelGGL(fwd, dim3(grid), dim3(NTHR), LDS_BYTES, stream, a); }
#endif
}
```

```cpp
#include <hip/hip_runtime.h>
#include <cstdio>
#include <cstdint>

#ifndef FAST_GEMM
#define FAST_GEMM 1
#endif
#ifndef FAST_ATTN
#define FAST_ATTN 1
#endif
#ifndef FAST_MOE
#define FAST_MOE 1
#endif
#ifndef MK_ONE_LAUNCH
#define MK_ONE_LAUNCH 1
#endif

#define GAS __attribute__((address_space(1)))
#define LAS __attribute__((address_space(3)))
typedef unsigned short bf16;
typedef unsigned v4u __attribute__((ext_vector_type(4)));
typedef unsigned v2u __attribute__((ext_vector_type(2)));
typedef float f32x4 __attribute__((ext_vector_type(4)));
typedef GAS unsigned gu32;
#define RLX_AGENT __ATOMIC_RELAXED, __HIP_MEMORY_SCOPE_AGENT

constexpr int NB_ = 4, SEQ = 8192, DM = 1024, NT = NB_ * SEQ;
constexpr int NH = 8, HD = 64, VD = 128;
constexpr int DRNN = 1280, NLB = 10, LBK = 128, CW = 4;
constexpr int DFF = 2816, NE = 8, DFE = 3584;
constexpr float NORM_EPS = 1e-6f, SUBLN_EPS = 1e-5f, LOG2E = 1.4426950408889634f;
constexpr float C2 = 0.125f * LOG2E;
constexpr float LAM_INIT = 0.2f;
constexpr int NWAVES = 8, NTHR = 512;
constexpr int LCH = 64, NCH = SEQ / LCH;
constexpr int SLOT_ROWS = NT + NE * 256;

constexpr size_t MiB = 1u << 20;
constexpr size_t WS_CTL = 0, CTL_ZERO_BYTES = 1 * MiB;
constexpr size_t WS_SMALL = 1 * MiB;
constexpr size_t SM_TB = 0;
constexpr size_t SM_ROUTE = 64 * 1024;
constexpr size_t SM_CNT = 1 * MiB;
constexpr size_t SM_BASE = 1 * MiB + 16 * 1024;
constexpr size_t SM_TOK = 2 * MiB;
constexpr size_t SM_GATEV = 2 * MiB + 512 * 1024;
constexpr size_t SM_AEND = 4 * MiB;
constexpr size_t SM_HEND = 7 * MiB;
constexpr size_t SM_CIN = 10 * MiB;
constexpr size_t WS_WA = 17 * MiB;
constexpr size_t WS_WM = 50 * MiB;
constexpr size_t WS_O0 = 50 * MiB, WS_O1 = 114 * MiB;
constexpr size_t WS_HL = 50 * MiB, WS_CA = 130 * MiB;
constexpr size_t WS_H = 218 * MiB;
constexpr size_t WS_SCR = 282 * MiB;
constexpr size_t WS_Q = WS_SCR, WS_K = WS_SCR + 64 * MiB, WS_V = WS_SCR + 128 * MiB;
constexpr size_t WS_ACT = WS_SCR;
constexpr size_t WS_G = WS_SCR, WS_XB = WS_SCR + 80 * MiB, WS_Y = WS_SCR + 160 * MiB;
constexpr size_t WS_ACTM = WS_SCR;
constexpr size_t WS_END = 522 * MiB;
static_assert(WS_ACTM + (size_t)SLOT_ROWS * DFE * 2 <= WS_END && WS_Y + (size_t)NT * DRNN * 2 <= WS_END, "ws map");
static_assert(SM_CIN + (size_t)NB_ * NCH * DRNN * 4 <= 16 * MiB, "small map");
constexpr int CW_BAR = 4096;

__device__ __forceinline__ int fresh_tid() { int t = threadIdx.x; asm volatile("" : "+v"(t)); return t; }
__device__ __forceinline__ unsigned f2bf(float f) { unsigned u = __builtin_bit_cast(unsigned, f); return (u + 0x7fffu + ((u >> 16) & 1u)) >> 16; }
__device__ __forceinline__ unsigned pk2(float lo, float hi) { return f2bf(lo) | (f2bf(hi) << 16); }
__device__ __forceinline__ float bflo(unsigned u) { return __builtin_bit_cast(float, u << 16); }
__device__ __forceinline__ float bfhi(unsigned u) { return __builtin_bit_cast(float, u & 0xffff0000u); }
__device__ __forceinline__ float bf2f(bf16 v) { return __builtin_bit_cast(float, (unsigned)v << 16); }
__device__ __forceinline__ float wave_sum(float v) {
#pragma unroll
    for (int o = 1; o < 64; o <<= 1) v += __shfl_xor(v, o);
    return v;
}
__device__ __forceinline__ float sigmoidf_(float x) { return 1.f / (1.f + __expf(-x)); }

#define XB_TMO      128
#define XB_XCNT(j)  (256  + 64 * (j))
#define XB_XSUB(j)  (1280 + 64 * (j))
#define XB_XGEN(j)  (2304 + 64 * (j))
#define XB_TOP      3328
#define XB_TOPGEN   3392
#define XCD_BAR_WORDS 3456
#define XB_SPIN_CAP (1u << 18)
__device__ __forceinline__ unsigned xb_ld(unsigned* p)              { return __hip_atomic_load(p, __ATOMIC_RELAXED, __HIP_MEMORY_SCOPE_AGENT); }
__device__ __forceinline__ unsigned xb_add(unsigned* p, unsigned v) { return __hip_atomic_fetch_add(p, v, __ATOMIC_RELAXED, __HIP_MEMORY_SCOPE_AGENT); }
__device__ __forceinline__ unsigned xb_xcc_id() { return (unsigned)__builtin_amdgcn_s_getreg((3 << 11) | 20) & 0xFu; }
#define XB_SPIN(cond, bar) do { unsigned _sp = 0; while (cond) { __builtin_amdgcn_s_sleep(1); \
    if ((++_sp & 255u) == 0u) { if (xb_ld(&(bar)[XB_TMO])) break; if (_sp > XB_SPIN_CAP) { atomicAdd(&(bar)[XB_TMO], 1u); break; } } } } while (0)
struct XcdBarrier { unsigned* bar; unsigned x; volatile LAS unsigned* st; };
__device__ __forceinline__ XcdBarrier xcd_barrier_post(unsigned* bar, volatile LAS unsigned* st) {
    XcdBarrier b; b.bar = bar; b.x = xb_xcc_id(); b.st = st;
    if (threadIdx.x == 0) (void)xb_add(&bar[XB_XCNT(b.x)], 1u);
    return b;
}
__device__ __forceinline__ void xcd_barrier_complete(unsigned* bar, unsigned x, unsigned& nloc, unsigned& nx) {
    const unsigned G = gridDim.x * gridDim.y * gridDim.z;
    unsigned sum, cnt, mine, sp = 0u;
    for (;;) {
        sum = 0u; cnt = 0u; mine = 0u;
#pragma unroll
        for (unsigned j = 0; j < 16; ++j) { const unsigned c = xb_ld(&bar[XB_XCNT(j)]); sum += c; cnt += (c > 0u) ? 1u : 0u; mine = (j == x) ? c : mine; }
        if (sum == G) break;
        __builtin_amdgcn_s_sleep(1);
        if ((++sp & 255u) == 0u) { if (xb_ld(&bar[XB_TMO])) break; if (sp > XB_SPIN_CAP) { atomicAdd(&bar[XB_TMO], 1u); break; } }
    }
    nloc = mine > 0u ? mine : 1u; nx = cnt > 0u ? cnt : 1u;
}
__device__ __forceinline__ void xcd_barrier(const XcdBarrier& b) {
    asm volatile("s_waitcnt vmcnt(0)" ::: "memory");
    __syncthreads();
    if (threadIdx.x == 0) {
        unsigned* bar = b.bar;
        __builtin_amdgcn_s_waitcnt(0);
        unsigned nloc = b.st[0], nx = b.st[1];
        if (nloc == 0u) { xcd_barrier_complete(bar, b.x, nloc, nx); b.st[0] = nloc; b.st[1] = nx; }
        const unsigned old = xb_add(&bar[XB_XSUB(b.x)], 1u);
        const unsigned gen = old / nloc;
        if (old + 1u == (gen + 1u) * nloc) {
            __builtin_amdgcn_fence(__ATOMIC_RELEASE, "agent");
            asm volatile("s_waitcnt vmcnt(0)" ::: "memory");
            const unsigned og = xb_add(&bar[XB_TOP], 1u);
            const unsigned tg = og / nx;
            if (og + 1u == (tg + 1u) * nx) xb_add(&bar[XB_TOPGEN], 1u);
            else XB_SPIN(xb_ld(&bar[XB_TOPGEN]) == tg, bar);
            __builtin_amdgcn_fence(__ATOMIC_ACQUIRE, "agent");
            xb_add(&bar[XB_XGEN(b.x)], 1u);
            asm volatile("s_waitcnt vmcnt(0)" ::: "memory");
        } else {
            XB_SPIN(xb_ld(&bar[XB_XGEN(b.x)]) == gen, bar);
            __builtin_amdgcn_fence(__ATOMIC_ACQUIRE, "agent");
            asm volatile("s_waitcnt vmcnt(0)" ::: "memory");
        }
    }
    __syncthreads();
}

namespace pg8 {
#define PG8_LAS __attribute__((address_space(3)))
typedef unsigned short bf16_t;
typedef short bf16x8 __attribute__((ext_vector_type(8)));
typedef float f32x4 __attribute__((ext_vector_type(4)));
typedef unsigned u32x4 __attribute__((ext_vector_type(4)));
constexpr int BM = 256, BK = 64, HALF = 128, HTB = HALF * BK * 2  , STAGE_BYTES = 8 * HTB, NXCD = 8, WGM = 8;

__host__ __device__ __forceinline__ int lds_byte(int r, int c) { const int st = (r >> 4) * 2 + (c >> 5), rr = r & 15, cc = c & 31, ob = rr * 64 + cc * 2; return st * 1024 + (ob ^ (((ob >> 9) & 1) << 5)); }
__host__ __device__ __forceinline__ void stage_rc(int b, int& R, int& C) { const int st = b / 1024, sb = b % 1024, swz = sb ^ (((sb >> 9) & 1) << 5); R = (st >> 1) * 16 + swz / 64; C = (st & 1) * 32 + (swz % 64) / 2; }
__host__ __device__ __forceinline__ int perm32(int rho) { const int n = rho >> 4, i = rho & 15; return 8 * (i >> 2) + 4 * n + (i & 3); }

struct Unit { int pm, pn, pb; };
struct Gemm { const bf16_t* A; const bf16_t* Bt; int M, N, K; };

struct StaticOrder {
    int nM, nN, nwg, G, c;
    __host__ __device__ void init(int M, int N, int G_, int c_) { nM = M / BM; nN = N / BM; nwg = nM * nN; G = G_; c = c_; }
    __host__ __device__ bool next(int i, Unit& u) const {
        const long L = (long)i * G + c; if (L >= nwg) return false;
        int wgid = (int)L; { const int q = nwg / NXCD, r = nwg % NXCD, xcd = wgid % NXCD, off = wgid / NXCD; wgid = (xcd < r ? xcd * (q + 1) : r * (q + 1) + (xcd - r) * q) + off; }
        const int nig = WGM * nN, gid = wgid / nig, fm = gid * WGM, gsz = (nM - fm) < WGM ? (nM - fm) : WGM;
        u.pm = fm + ((wgid % nig) % gsz); u.pn = (wgid % nig) / gsz; u.pb = u.pn; return true;
    }
    __device__ __forceinline__ void a_ready(const Unit&) const {}
    __device__ __forceinline__ void done(const Unit&) const {}
};

__device__ __forceinline__ unsigned cvt_pk_bf16(float lo, float hi) { unsigned r; asm volatile("v_cvt_pk_bf16_f32 %0, %1, %2" : "=v"(r) : "v"(lo), "v"(hi)); return r; }
typedef float f32x2 __attribute__((ext_vector_type(2)));

template <int ACT  > struct EpiBf16 {
    static constexpr bool PERM = true, AFTER_DRAIN = false; static_assert(ACT == 0, "EpiBf16: only ACT 0 here");
    bf16_t* O; int ldc; const float* bias; int split_cols; size_t split_stride; float scale0;
    __device__ __forceinline__ void operator()(const f32x4 (&acc)[2][2][4][2], const Unit& u, int wr, int wc, int fr, int fq) const {
        const int row0 = u.pm * BM + wr * 64 + fr; int colt = u.pn * BM; bf16_t* base = O;
        float sc = 1.f; if (split_cols) { const int t = colt / split_cols; base += (size_t)t * split_stride; colt -= t * split_cols; if (t == 0) sc = scale0; }
        const int col0 = colt + wc * 32 + 8 * fq, bcol0 = u.pn * BM + wc * 32 + 8 * fq;
        f32x4 bv[2][2];
#pragma unroll
        for (int bj = 0; bj < 2; ++bj)
#pragma unroll
            for (int n = 0; n < 2; ++n) bv[bj][n] = bias ? *(const f32x4*)(bias + bcol0 + bj * HALF + 4 * n) : (f32x4){0.f, 0.f, 0.f, 0.f};
#pragma unroll
        for (int ai = 0; ai < 2; ++ai)
#pragma unroll
            for (int m = 0; m < 4; ++m) { bf16_t* rowp = base + (size_t)(row0 + ai * HALF + m * 16) * ldc + col0;
#pragma unroll
                for (int bj = 0; bj < 2; ++bj) { f32x4 v0 = acc[ai][bj][m][0] + bv[bj][0], v1 = acc[ai][bj][m][1] + bv[bj][1];
                    v0 = v0 * sc; v1 = v1 * sc; u32x4 w; w.x = cvt_pk_bf16(v0[0], v0[1]); w.y = cvt_pk_bf16(v0[2], v0[3]); w.z = cvt_pk_bf16(v1[0], v1[1]); w.w = cvt_pk_bf16(v1[2], v1[3]);
                    *(u32x4*)(rowp + bj * HALF) = w; } }
    }
};

__device__ __forceinline__ float silu_f(float x) { return x * __builtin_amdgcn_rcpf(1.0f + __builtin_amdgcn_exp2f(-1.4426950408889634f * x)); }
__device__ __forceinline__ float gelu_tanh_f(float x) { const float u = x * (0.7978845608028654f + 0.035677408136300125f * x * x);
    return x * __builtin_amdgcn_rcpf(1.0f + __builtin_amdgcn_exp2f(-2.0f * 1.4426950408889634f * u)); }
struct EpiResF32 {
    static constexpr bool PERM = false, AFTER_DRAIN = false;
    const float* base; float* out; int ldc;
    __device__ __forceinline__ void operator()(const f32x4 (&acc)[2][2][4][2], const Unit& u, int wr, int wc, int fr, int fq) const {
        const int row0 = u.pm * BM + wr * 64 + fr, col0 = u.pn * BM + wc * 32 + 4 * fq;
#pragma unroll
        for (int ai = 0; ai < 2; ++ai)
#pragma unroll
            for (int m = 0; m < 4; ++m) { const size_t off = (size_t)(row0 + ai * HALF + m * 16) * ldc + col0;
                f32x4 b[2][2];
#pragma unroll
                for (int bj = 0; bj < 2; ++bj)
#pragma unroll
                    for (int n = 0; n < 2; ++n) b[bj][n] = *(const f32x4*)(base + off + bj * HALF + n * 16);
#pragma unroll
                for (int bj = 0; bj < 2; ++bj)
#pragma unroll
                    for (int n = 0; n < 2; ++n) *(f32x4*)(out + off + bj * HALF + n * 16) = b[bj][n] + acc[ai][bj][m][n];
                asm volatile("" ::: "memory"); }
    }
};
struct EpiSwiglu {
    static constexpr bool PERM = true, AFTER_DRAIN = false;
    bf16_t* O; int ldc;
    __device__ __forceinline__ void operator()(const f32x4 (&acc)[2][2][4][2], const Unit& u, int wr, int wc, int fr, int fq) const {
        const int row0 = u.pm * BM + wr * 64 + fr, col0 = u.pn * HALF + wc * 32 + 8 * fq;
#pragma unroll
        for (int ai = 0; ai < 2; ++ai)
#pragma unroll
            for (int m = 0; m < 4; ++m) { bf16_t* rowp = O + (size_t)(row0 + ai * HALF + m * 16) * ldc + col0;
                const f32x4 g0 = acc[ai][0][m][0], g1 = acc[ai][0][m][1], u0 = acc[ai][1][m][0], u1 = acc[ai][1][m][1];
                u32x4 w; w.x = cvt_pk_bf16(silu_f(g0[0]) * u0[0], silu_f(g0[1]) * u0[1]); w.y = cvt_pk_bf16(silu_f(g0[2]) * u0[2], silu_f(g0[3]) * u0[3]);
                w.z = cvt_pk_bf16(silu_f(g1[0]) * u1[0], silu_f(g1[1]) * u1[1]); w.w = cvt_pk_bf16(silu_f(g1[2]) * u1[2], silu_f(g1[3]) * u1[3]);
                *(u32x4*)rowp = w; }
    }
};
struct EpiWin {
    static constexpr bool PERM = true, AFTER_DRAIN = false;
    bf16_t* G; bf16_t* XB; int ldc; int nsplit;
    __device__ __forceinline__ void operator()(const f32x4 (&acc)[2][2][4][2], const Unit& u, int wr, int wc, int fr, int fq) const {
        const bool isg = u.pn < nsplit; bf16_t* base = isg ? G : XB; const int colt = (isg ? u.pn : u.pn - nsplit) * BM;
        const int row0 = u.pm * BM + wr * 64 + fr, col0 = colt + wc * 32 + 8 * fq;
#pragma unroll
        for (int ai = 0; ai < 2; ++ai)
#pragma unroll
            for (int m = 0; m < 4; ++m) { bf16_t* rowp = base + (size_t)(row0 + ai * HALF + m * 16) * ldc + col0;
#pragma unroll
                for (int bj = 0; bj < 2; ++bj) { f32x4 v0 = acc[ai][bj][m][0], v1 = acc[ai][bj][m][1];
                    if (isg) { v0 = (f32x4){gelu_tanh_f(v0[0]), gelu_tanh_f(v0[1]), gelu_tanh_f(v0[2]), gelu_tanh_f(v0[3])}; v1 = (f32x4){gelu_tanh_f(v1[0]), gelu_tanh_f(v1[1]), gelu_tanh_f(v1[2]), gelu_tanh_f(v1[3])}; }
                    u32x4 w; w.x = cvt_pk_bf16(v0[0], v0[1]); w.y = cvt_pk_bf16(v0[2], v0[3]); w.z = cvt_pk_bf16(v1[0], v1[1]); w.w = cvt_pk_bf16(v1[2], v1[3]);
                    *(u32x4*)(rowp + bj * HALF) = w; } }
    }
};
struct EpiMoeDown {
    static constexpr bool PERM = false, AFTER_DRAIN = false;
    float* out; int ldc; const int* tok; const float* gatev;
    __device__ __forceinline__ void operator()(const f32x4 (&acc)[2][2][4][2], const Unit& u, int wr, int wc, int fr, int fq) const {
        const int row0 = u.pm * BM + wr * 64 + fr, col0 = u.pn * BM + wc * 32 + 4 * fq;
#pragma unroll
        for (int ai = 0; ai < 2; ++ai)
#pragma unroll
            for (int m = 0; m < 4; ++m) { const int r = row0 + ai * HALF + m * 16; const int t = tok[r]; const float g = gatev[r];
                if (t >= 0) { float* o = out + (size_t)t * ldc + col0; f32x4 b[2][2];
#pragma unroll
                    for (int bj = 0; bj < 2; ++bj)
#pragma unroll
                        for (int n = 0; n < 2; ++n) b[bj][n] = *(const f32x4*)(o + bj * HALF + n * 16);
#pragma unroll
                    for (int bj = 0; bj < 2; ++bj)
#pragma unroll
                        for (int n = 0; n < 2; ++n) *(f32x4*)(o + bj * HALF + n * 16) = b[bj][n] + acc[ai][bj][m][n] * g; }
                asm volatile("" ::: "memory"); }
    }
};
struct MoeOrder : StaticOrder {
    const int* tok; int gb[8]; int nNe;
    __device__ void init_moe(int rows, int N, int G_, int c_, const int* tok_, const int* base) { init(rows, N, G_, c_); tok = tok_; nNe = N / BM;
#pragma unroll
        for (int j = 0; j < 8; ++j) gb[j] = base[j]; }
    __device__ __forceinline__ bool next(int i, Unit& u) const {
        if (!StaticOrder::next(i, u)) return false;
        int e = 0;
#pragma unroll
        for (int j = 1; j < 8; ++j) e += (u.pm * BM >= gb[j]) ? 1 : 0;
        u.pb = e * nNe + u.pn; return true; }
    __device__ __forceinline__ int arow(int r) const { const int t = tok[r]; return t < 0 ? 0 : t; }
};

template <class Epi, class Sched, bool ALIGN_EPI = false, bool SP2 = false, bool GATHER = false>
__device__ __forceinline__ void gemm_phase(PG8_LAS unsigned char* lds, const Gemm g, const Sched& S, const Epi& E) {
    int tid_ = threadIdx.x; asm volatile("" : "+v"(tid_));
    const int tid = tid_, wid = __builtin_amdgcn_readfirstlane(tid >> 6), lane = tid & 63, wr = wid >> 2, wc = wid & 3, fr = lane & 15, fq = lane >> 4;
    static_assert(!GATHER || SP2, "GATHER is written for the SP2 loop");
    const int K = g.K, nt = K / BK;
    unsigned voffA[2], voffB[2];
#pragma unroll
    for (int i = 0; i < 2; ++i) { int R, C; stage_rc(tid * 16 + i * 8192, R, C); const int Rb = Epi::PERM ? ((R & ~31) + perm32(R & 31)) : R;
        voffA[i] = (unsigned)(R * K + C) * 2u; voffB[i] = (unsigned)(Rb * K + C) * 2u; }
    unsigned tk[2], tn[2]; unsigned cC2 = 0; int gR0 = 0;
    if constexpr (GATHER) { int R_, C_; stage_rc(tid * 16, R_, C_); gR0 = R_; cC2 = (unsigned)C_ * 2u; }
#define PG8_GTOK(dst, u) do { _Pragma("unroll") for (int _h = 0; _h < 2; ++_h) dst[_h] = (unsigned)S.arow((u).pm * BM + _h * HALF + gR0) | ((unsigned)S.arow((u).pm * BM + _h * HALF + gR0 + 64) << 16); } while (0)
    const size_t kstep = (size_t)(BK * 2);
    const size_t hstep = (size_t)HALF * K * 2;
    const size_t tstep = 2 * hstep;
    const unsigned ldsw = (unsigned)wid * 1024u;
    const int aoff = lds_byte(wr * 64 + fr, fq * 8), boff = lds_byte(wc * 32 + fr, fq * 8);
#define PG8_SA(b, h) (((b) * 2 + (h)) * HTB)
#define PG8_SB(b, h) ((4 + (b) * 2 + (h)) * HTB)
#define PG8_STAGE(bufoff, gbase, voff) do { _Pragma("unroll") for (int _i = 0; _i < 2; ++_i) \
        __builtin_amdgcn_global_load_lds((const unsigned*)((const char*)(gbase) + (voff)[_i]), (PG8_LAS unsigned*)(lds + (bufoff) + ldsw + _i * 8192), 16, 0, 0); } while (0)
#define PG8_STAGEG(bufoff, gbase, tkw) do { _Pragma("unroll") for (int _i = 0; _i < 2; ++_i) { const unsigned _o = (((tkw) >> (16 * _i)) & 0xffffu) * (unsigned)(K * 2) + cC2; \
        __builtin_amdgcn_global_load_lds((const unsigned*)((const char*)(gbase) + _o), (PG8_LAS unsigned*)(lds + (bufoff) + ldsw + _i * 8192), 16, 0, 0); } } while (0)
#define PG8_STA(bufoff, ptr, h, nx) do { if constexpr (GATHER) { if (nx) PG8_STAGEG(bufoff, ptr, tn[h]); else PG8_STAGEG(bufoff, ptr, tk[h]); } else PG8_STAGE(bufoff, (ptr) + (h) * hstep, voffA); } while (0)
#define PG8_LDA(dst, b, h) do { _Pragma("unroll") for (int m = 0; m < 4; ++m) _Pragma("unroll") for (int k = 0; k < 2; ++k) dst[m][k] = *(const PG8_LAS bf16x8*)(lds + PG8_SA(b, h) + aoff + m * 2048 + k * 1024); } while (0)
#define PG8_LDB(dst, b, h) do { _Pragma("unroll") for (int n = 0; n < 2; ++n) _Pragma("unroll") for (int k = 0; k < 2; ++k) dst[n][k] = *(const PG8_LAS bf16x8*)(lds + PG8_SB(b, h) + boff + n * 2048 + k * 1024); } while (0)
#define PG8_MMA(ai, bj, At, Bt) do { __builtin_amdgcn_s_setprio(1); _Pragma("unroll") for (int m = 0; m < 4; ++m) _Pragma("unroll") for (int n = 0; n < 2; ++n) _Pragma("unroll") for (int k = 0; k < 2; ++k) \
        acc[ai][bj][m][n] = __builtin_amdgcn_mfma_f32_16x16x32_bf16(Bt[n][k], At[m][k], acc[ai][bj][m][n], 0, 0, 0); __builtin_amdgcn_s_setprio(0); } while (0)
#define PG8_WAIT_V(n) asm volatile("s_waitcnt vmcnt(" #n ")" ::: "memory")
#define PG8_WAIT_L(n) asm volatile("s_waitcnt lgkmcnt(" #n ")" ::: "memory")
#define PG8_BAR __builtin_amdgcn_s_barrier()
#define PG8_SCHED __builtin_amdgcn_sched_barrier(0)
    Unit cur, nxt; int ui = 0;
    if (!S.next(0, cur)) return;
    f32x4 acc[2][2][4][2];
#pragma unroll
    for (int a = 0; a < 2; ++a)
#pragma unroll
        for (int b = 0; b < 2; ++b)
#pragma unroll
            for (int m = 0; m < 4; ++m)
#pragma unroll
                for (int n = 0; n < 2; ++n) acc[a][b][m][n] = (f32x4){0.f, 0.f, 0.f, 0.f};
    bf16x8 At[4][2], B0[2][2], B1[2][2];
    const char* cA = GATHER ? (const char*)g.A : (const char*)g.A + (size_t)cur.pm * tstep; const char* cB = (const char*)g.Bt + (size_t)cur.pb * tstep;
    if constexpr (GATHER) { PG8_GTOK(tk, cur); }
    S.a_ready(cur);
    if constexpr (SP2) {
        PG8_STAGE(PG8_SB(0, 0), cB, voffB); PG8_STAGE(PG8_SB(0, 1), cB + hstep, voffB); PG8_STA(PG8_SA(0, 0), cA, 0, false); PG8_STA(PG8_SA(0, 1), cA, 1, false);
        if (wr == 1) PG8_BAR;
        PG8_WAIT_V(2); PG8_BAR;
        PG8_STAGE(PG8_SB(1, 0), cB + kstep, voffB); PG8_STA(PG8_SA(1, 0), cA + kstep, 0, false); PG8_STAGE(PG8_SB(1, 1), cB + hstep + kstep, voffB);
        PG8_WAIT_V(6); PG8_BAR;
    } else {
        PG8_STAGE(PG8_SB(0, 0), cB, voffB); PG8_STAGE(PG8_SA(0, 0), cA, voffA); PG8_STAGE(PG8_SB(0, 1), cB + hstep, voffB); PG8_STAGE(PG8_SA(0, 1), cA + hstep, voffA);
        if (wr == 1) PG8_BAR;
        PG8_WAIT_V(4); PG8_BAR;
        PG8_STAGE(PG8_SB(1, 0), cB + kstep, voffB); PG8_STAGE(PG8_SA(1, 0), cA + kstep, voffA); PG8_STAGE(PG8_SB(1, 1), cB + hstep + kstep, voffB);
        PG8_WAIT_V(6); PG8_BAR;
    }
    for (;;) {
        const bool has_next = S.next(ui + 1, nxt);
        if constexpr (GATHER) { if (has_next) { PG8_GTOK(tn, nxt); } else { tn[0] = tk[0]; tn[1] = tk[1]; } }
        const char* nA = GATHER ? (const char*)g.A : (has_next ? (const char*)g.A + (size_t)nxt.pm * tstep : cA); const char* nB = has_next ? (const char*)g.Bt + (size_t)nxt.pb * tstep : cB;
        for (int t = 0; t < nt; t += 2) {
            const bool last = (t == nt - 2);
            const char* a1 = cA + (size_t)(t + 1) * kstep;
            const char* a2 = last ? nA : cA + (size_t)(t + 2) * kstep; const char* b2 = last ? nB : cB + (size_t)(t + 2) * kstep;
            const char* a3 = a2 + kstep; const char* b3 = b2 + kstep;
            if (last && has_next) S.a_ready(nxt);
            if constexpr (SP2) {
            PG8_LDB(B0, 0, 0); PG8_LDB(B1, 0, 1); PG8_SCHED; PG8_LDA(At, 0, 0); PG8_STA(PG8_SA(1, 1), a1, 1, false);
            PG8_WAIT_V(8); PG8_WAIT_L(0); PG8_BAR; PG8_MMA(0, 0, At, B0); PG8_MMA(0, 1, At, B1); PG8_BAR; PG8_SCHED;
            PG8_LDA(At, 0, 1); PG8_STAGE(PG8_SB(0, 0), b2, voffB); PG8_STAGE(PG8_SB(0, 1), b2 + hstep, voffB); PG8_STA(PG8_SA(0, 0), a2, 0, last);
            PG8_WAIT_V(8); PG8_WAIT_L(0); PG8_BAR; PG8_MMA(1, 0, At, B0); PG8_MMA(1, 1, At, B1); PG8_BAR; PG8_SCHED;
            PG8_LDB(B0, 1, 0); PG8_LDB(B1, 1, 1); PG8_SCHED; PG8_LDA(At, 1, 0); PG8_STA(PG8_SA(0, 1), a2, 1, last);
            PG8_WAIT_V(8); PG8_WAIT_L(0); PG8_BAR; PG8_MMA(0, 0, At, B0); PG8_MMA(0, 1, At, B1); PG8_BAR; PG8_SCHED;
            PG8_LDA(At, 1, 1); PG8_STAGE(PG8_SB(1, 0), b3, voffB); PG8_STAGE(PG8_SB(1, 1), b3 + hstep, voffB); PG8_STA(PG8_SA(1, 0), a3, 0, last);
            PG8_WAIT_V(8); PG8_WAIT_L(0); PG8_BAR; PG8_MMA(1, 0, At, B0); PG8_MMA(1, 1, At, B1); PG8_BAR; PG8_SCHED;
            } else {
            PG8_LDB(B0, 0, 0); PG8_SCHED; PG8_LDA(At, 0, 0); PG8_STAGE(PG8_SA(1, 1), a1 + hstep, voffA);
            PG8_WAIT_L(8); PG8_BAR; PG8_WAIT_L(0); PG8_MMA(0, 0, At, B0); PG8_BAR; PG8_SCHED;
            PG8_LDB(B1, 0, 1); PG8_STAGE(PG8_SB(0, 0), b2, voffB);
            PG8_BAR; PG8_WAIT_L(0); PG8_MMA(0, 1, At, B1); PG8_BAR;
            PG8_LDA(At, 0, 1); PG8_STAGE(PG8_SA(0, 0), a2, voffA);
            PG8_BAR; PG8_WAIT_L(0); PG8_MMA(1, 0, At, B0); PG8_BAR; PG8_SCHED;
            PG8_STAGE(PG8_SB(0, 1), b2 + hstep, voffB);
            PG8_WAIT_V(6); PG8_BAR; PG8_MMA(1, 1, At, B1); PG8_BAR;
            PG8_LDB(B0, 1, 0); PG8_SCHED; PG8_LDA(At, 1, 0); PG8_STAGE(PG8_SA(0, 1), a2 + hstep, voffA);
            PG8_WAIT_L(8); PG8_BAR; PG8_WAIT_L(0); PG8_MMA(0, 0, At, B0); PG8_BAR; PG8_SCHED;
            PG8_LDB(B1, 1, 1); PG8_STAGE(PG8_SB(1, 0), b3, voffB);
            PG8_BAR; PG8_WAIT_L(0); PG8_MMA(0, 1, At, B1); PG8_BAR;
            PG8_LDA(At, 1, 1); PG8_STAGE(PG8_SA(1, 0), a3, voffA);
            PG8_BAR; PG8_WAIT_L(0); PG8_MMA(1, 0, At, B0); PG8_BAR; PG8_SCHED;
            PG8_STAGE(PG8_SB(1, 1), b3 + hstep, voffB);
            PG8_WAIT_V(6); PG8_BAR; PG8_MMA(1, 1, At, B1); PG8_BAR;
            }
        }
        if constexpr (ALIGN_EPI) { if (wr == 0) PG8_BAR; }
        if constexpr (!Epi::AFTER_DRAIN) { E(acc, cur, wr, wc, fr, fq); S.done(cur); }
        if (!has_next) break;
#pragma unroll
        for (int a = 0; a < 2; ++a)
#pragma unroll
            for (int b = 0; b < 2; ++b)
#pragma unroll
                for (int m = 0; m < 4; ++m)
#pragma unroll
                    for (int n = 0; n < 2; ++n) acc[a][b][m][n] = (f32x4){0.f, 0.f, 0.f, 0.f};
        cur = nxt; cA = nA; cB = nB; ++ui;
        if constexpr (GATHER) { tk[0] = tn[0]; tk[1] = tn[1]; }
        if constexpr (ALIGN_EPI) { if (wr == 1) PG8_BAR; }
    }
    PG8_WAIT_V(0);
    if constexpr (!ALIGN_EPI) { if (wr == 0) PG8_BAR; }
    PG8_BAR;
    if constexpr (Epi::AFTER_DRAIN) { E.fused(acc, cur, wr, wc, fr, fq, lds, wid, lane); S.done(cur); }
#undef PG8_SA
#undef PG8_SB
#undef PG8_STAGE
#undef PG8_STA
#undef PG8_STAGEG
#undef PG8_GTOK
#undef PG8_LDA
#undef PG8_LDB
#undef PG8_MMA
#undef PG8_WAIT_V
#undef PG8_WAIT_L
#undef PG8_BAR
#undef PG8_SCHED
}
}

#include <hip/hip_bf16.h>
#include <cmath>
namespace attn_body {
using bf16=__hip_bfloat16;
using bf16x8=__attribute__((ext_vector_type(8)))short;
using s16x4=__attribute__((ext_vector_type(4)))short;
using f32x16=__attribute__((ext_vector_type(16)))float;
using u32x4=__attribute__((ext_vector_type(4)))unsigned;
constexpr int BATCH=4,NHEAD=16,SEQ=8192,D=64,DM=NHEAD*D;
constexpr int NW=8,QBLK=32,QB=QBLK*NW,KVBLK=64,NQB=SEQ/QB;
constexpr int ATTN_PITCH=DM, ATTN_UNIT_ROWS=QB;
__device__ __forceinline__ int crow(int r,int hi){return (r&3)+8*(r>>2)+4*hi;}
#define SBAR() __builtin_amdgcn_sched_barrier(0)
typedef __attribute__((address_space(3))) const float* lds_cfptr;
__device__ __forceinline__ void cmask(f32x16&p0,f32x16&p1,int jb,int qrel,int hi,lds_cfptr tabd){
  const float NEG=-INFINITY; const int d0=qrel-(64*jb+4*hi);
  #pragma unroll
  for(int r=0;r<16;++r){const int dA=d0-((r&3)+8*(r>>2)),dB=dA-32;
    const float tA=tabd[dA<0?0:(dA>127?127:dA)],tB=tabd[dB<0?0:(dB>127?127:dB)];
    p0[r]=dA<0?NEG:p0[r]+tA; p1[r]=dB<0?NEG:p1[r]+tB;}
}

constexpr int NSLOT=3, SLOTB=8192;
constexpr int LDS_K=0, LDS_V=NSLOT*SLOTB, LDS_WS=2*NSLOT*SLOTB, LDS_OST=LDS_WS+NW*64*4, LDS_BYTES=LDS_OST+NW*4096;
constexpr float C2=0.125f*1.4426950408889634f;
__device__ __forceinline__ void glds16(const void*sbase,unsigned voff,unsigned lds_dst){unsigned keep;
  asm volatile("s_mov_b32 %0, m0\n\ts_mov_b32 m0, %3\n\ts_nop 0\n\tglobal_load_lds_dwordx4 %1, %2\n\ts_mov_b32 m0, %0":"=&s"(keep):"v"(voff),"s"(sbase),"s"(lds_dst):"memory");}
__device__ __forceinline__ float max3f(float a,float b,float c){float r;asm("v_max3_f32 %0, %1, %2, %3":"=v"(r):"v"(a),"v"(b),"v"(c));return r;}
__device__ __forceinline__ float max2f(float a,float b){float r;asm("v_max_f32_e32 %0, %1, %2":"=v"(r):"v"(a),"v"(b));return r;}
__device__ __forceinline__ float fadd_s(float a,float b){float r;asm("v_add_f32_e32 %0, %1, %2":"=v"(r):"v"(a),"v"(b));return r;}
__device__ __forceinline__ float fsub_s(float a,float b){float r;asm("v_sub_f32_e32 %0, %1, %2":"=v"(r):"v"(a),"v"(b));return r;}
typedef float f32x2_t __attribute__((ext_vector_type(2))); typedef __bf16 bf16x2_t __attribute__((ext_vector_type(2)));
__device__ __forceinline__ unsigned cvtpk_s(float lo,float hi){f32x2_t v={lo,hi};bf16x2_t b=__builtin_convertvector(v,bf16x2_t);return __builtin_bit_cast(unsigned,b);}
#define WAIT_BAR(N) asm volatile("s_waitcnt vmcnt(" #N ") lgkmcnt(0)\n\ts_barrier":::"memory")

__device__ __forceinline__ void qkt(f32x16&p0,f32x16&p1,const char*Kslot,const bf16x8*qr,const f32x16&negm,int r32,int hi){
  const char*kb=Kslot+hi*1024+r32*16;
  #pragma unroll
  for(int d0=0;d0<4;++d0){
    const bf16x8 b0=*reinterpret_cast<const bf16x8*>(kb+d0*2048);
    const bf16x8 b1=*reinterpret_cast<const bf16x8*>(kb+d0*2048+512);
    if(d0==0){p0=__builtin_amdgcn_mfma_f32_32x32x16_bf16(b0,qr[0],negm,0,0,0);p1=__builtin_amdgcn_mfma_f32_32x32x16_bf16(b1,qr[0],negm,0,0,0);}
    else{p0=__builtin_amdgcn_mfma_f32_32x32x16_bf16(b0,qr[d0],p0,0,0,0);p1=__builtin_amdgcn_mfma_f32_32x32x16_bf16(b1,qr[d0],p1,0,0,0);}}
}
typedef __attribute__((address_space(3))) const char* lds_cptr;
typedef short v4i16_t __attribute__((ext_vector_type(4)));
__device__ __forceinline__ void kload8(bf16x8*kf,lds_cptr kp){
  kf[0]=*(const __attribute__((address_space(3))) bf16x8*)(kp);      kf[1]=*(const __attribute__((address_space(3))) bf16x8*)(kp+512);
  kf[2]=*(const __attribute__((address_space(3))) bf16x8*)(kp+2048); kf[3]=*(const __attribute__((address_space(3))) bf16x8*)(kp+2560);
  kf[4]=*(const __attribute__((address_space(3))) bf16x8*)(kp+4096); kf[5]=*(const __attribute__((address_space(3))) bf16x8*)(kp+4608);
  kf[6]=*(const __attribute__((address_space(3))) bf16x8*)(kp+6144); kf[7]=*(const __attribute__((address_space(3))) bf16x8*)(kp+6656);
}
__device__ __forceinline__ void kload2(bf16x8*kf,lds_cptr kp,int j){ kf[2*j]=*(const __attribute__((address_space(3))) bf16x8*)(kp+j*2048); kf[2*j+1]=*(const __attribute__((address_space(3))) bf16x8*)(kp+j*2048+512); }
__device__ __forceinline__ s16x4 vtr(lds_cptr p){ return __builtin_bit_cast(s16x4,__builtin_amdgcn_ds_read_tr16_b64_v4i16((__attribute__((address_space(3))) v4i16_t*)p)); }
__device__ __forceinline__ float rowmax(const f32x16&p0,const f32x16&p1){
  float a=max3f(p0[0],p0[1],p1[0]),b=max3f(p0[2],p0[3],p1[1]);a=max3f(a,p1[2],p1[3]);
  #pragma unroll
  for(int r=4;r<16;r+=4){a=max3f(a,p0[r],p0[r+1]);b=max3f(b,p0[r+2],p0[r+3]);a=max3f(a,p1[r],p1[r+1]);b=max3f(b,p1[r+2],p1[r+3]);}
  const float m=max2f(a,b);
  auto rr=__builtin_amdgcn_permlane32_swap(__float_as_uint(m),__float_as_uint(m),false,false);
  return max2f(__uint_as_float(rr[0]),__uint_as_float(rr[1]));
}
__device__ __forceinline__ void pv(f32x16*o,int vb,bf16x8 pa0,bf16x8 pa1,bf16x8 pa2,bf16x8 pa3){
  #pragma unroll
  for(int d0=0;d0<2;++d0){s16x4 lo[4],hi[4];
    #pragma unroll
    for(int ks=0;ks<4;++ks){
      asm volatile("ds_read_b64_tr_b16 %0,%1 offset:%c2":"=&v"(lo[ks]):"v"(vb),"i"(d0*4096+ks*1024):"memory");
      asm volatile("ds_read_b64_tr_b16 %0,%1 offset:%c2":"=&v"(hi[ks]):"v"(vb),"i"(d0*4096+ks*1024+512):"memory");}
    asm volatile("s_waitcnt lgkmcnt(0)":::"memory");SBAR();
    #define PK(k) (bf16x8){lo[k][0],lo[k][1],lo[k][2],lo[k][3],hi[k][0],hi[k][1],hi[k][2],hi[k][3]}
    o[d0]=__builtin_amdgcn_mfma_f32_32x32x16_bf16(pa0,PK(0),o[d0],0,0,0);
    o[d0]=__builtin_amdgcn_mfma_f32_32x32x16_bf16(pa1,PK(1),o[d0],0,0,0);
    o[d0]=__builtin_amdgcn_mfma_f32_32x32x16_bf16(pa2,PK(2),o[d0],0,0,0);
    o[d0]=__builtin_amdgcn_mfma_f32_32x32x16_bf16(pa3,PK(3),o[d0],0,0,0);
    #undef PK
  }
}

#ifndef ATTN_STORE16
#define ATTN_STORE16(p,v) (*(u32x4*)(p)=(v))
#endif
template<int THRL> __device__ __forceinline__ void attn_unit(int b,int hq,int hv,int qb,const bf16*Q,const bf16*__restrict__ K,const bf16*__restrict__ V,bf16*O,char*shm,float b31s,lds_cfptr tabd){
  const int tid=threadIdx.x,lane=tid&63,r32=lane&31,hi=lane>>5; const int wid=__builtin_amdgcn_readfirstlane(tid>>6);
  const long rowbase=(long)b*SEQ; const int q0=qb*QB;
  const bf16*Qw=Q+(rowbase+q0+wid*QBLK)*DM+hq*D;
  const bf16*Kh=K+rowbase*DM+hq*D,*Vh=V+rowbase*DM+hv*D;
  const unsigned lds0=(unsigned)(uintptr_t)shm;
  float*wsf=(float*)(shm+LDS_WS)+wid*64;
  const unsigned koff=(unsigned)(lane*DM+wid*8)*2u;
  const unsigned voff=(unsigned)((16*(wid&3)+(lane>>2))*DM+(wid>>2)*32+(lane&3)*8)*2u;
  const unsigned kdst=lds0+LDS_K+wid*1024, vdst=lds0+LDS_V+wid*1024;
  #define DMA_K(t,slot) glds16(Kh+(long)(t)*KVBLK*DM,koff,(unsigned)__builtin_amdgcn_readfirstlane(kdst+(slot)))
  #define DMA_V(t,slot) glds16(Vh+(long)(t)*KVBLK*DM,voff,(unsigned)__builtin_amdgcn_readfirstlane(vdst+(slot)))
  const int vb0=(int)(lds0+LDS_V)+((lane>>4)&1)*32+(lane&3)*8+(4*hi+((lane&15)>>2))*64;
  const char*Kbase=shm+LDS_K; bf16x8 kf[8];
  const lds_cptr shm3=(lds_cptr)shm; const lds_cptr kp0=shm3+LDS_K+hi*1024+r32*16; const lds_cptr vp0=shm3+LDS_V+((lane>>4)&1)*32+(lane&3)*8+(4*hi+((lane&15)>>2))*64;
  const int NT=(q0+QB)/KVBLK;
  DMA_K(0,0);DMA_V(0,0);DMA_K(1,SLOTB);
  bf16x8 qr[4];
  { int lq=lane; asm volatile("":"+v"(lq));
  #pragma unroll
  for(int d0=0;d0<4;++d0)qr[d0]=*reinterpret_cast<const bf16x8*>(&Qw[(long)(lq&31)*DM+d0*16+(lq>>5)*8]); }
  float mhat=0.f,l_reg=0.f;f32x16 o[2];o[0]=f32x16{};o[1]=f32x16{};f32x16 negm;
  #pragma unroll
  for(int r=0;r<16;++r)negm[r]=b31s;
  asm volatile("":"+v"(negm));
  const int qrel=wid*QBLK+r32;
  #define CMASK(P0,P1,t) do{int jb_=(t)-(NT-4); if(jb_>=-2)cmask(P0,P1,jb_,qrel,hi,tabd);}while(0)
  bool resc=false;
  #define START(P0,P1) do{ const float rm=rowmax(P0,P1); resc=false; \
    { const float dl=rm; mhat=fadd_s(mhat,dl); \
      _Pragma("unroll") for(int r=0;r<16;++r){P0[r]=fsub_s(P0[r],dl);P1[r]=fsub_s(P1[r],dl);} \
      _Pragma("unroll") for(int r=0;r<16;++r)negm[r]=b31s-mhat; asm volatile("":"+v"(negm)); } \
    _Pragma("unroll") for(int r=0;r<16;++r)P0[r]=__builtin_amdgcn_exp2f(P0[r]); }while(0)
  #define RESC() do{ if(resc){ asm volatile("s_waitcnt lgkmcnt(0)":::"memory"); \
      _Pragma("unroll") for(int d_=0;d_<2;++d_) _Pragma("unroll") for(int r=0;r<16;++r)o[d_][r]*=wsf[crow(r,hi)]; } }while(0)
  f32x16 pA0,pA1,pB0,pB1;
  int sl_prev=0,sl_cur=0,sl_next=SLOTB;
  #define ROT() do{sl_prev=sl_cur;sl_cur=sl_next;sl_next=(sl_next==(NSLOT-1)*SLOTB)?0:sl_next+SLOTB;}while(0)
  DMA_K(2,2*SLOTB);
  WAIT_BAR(3);
  qkt(pA0,pA1,Kbase,qr,negm,r32,hi);asm volatile("s_nop 15\n\ts_nop 7":"+v"(pA0),"+v"(pA1));CMASK(pA0,pA1,0);
  START(pA0,pA1);
  _Pragma("unroll") for(int r=0;r<16;++r)pA1[r]=__builtin_amdgcn_exp2f(pA1[r]);
  WAIT_BAR(0);
  DMA_K(3,0);DMA_V(1,SLOTB);
  ROT();
  kload8(kf,kp0+sl_cur);
  WAIT_BAR(2);
  s16x4 vlo[8],vhi[8]; u32x4 pw0,pw1,pw2,pw3;
  #define PKW(P,B) cvtpk_s(P[B],P[B+1])
  #define PAF(k) __builtin_bit_cast(bf16x8,pw##k)
  #define VFR(i) (bf16x8){vlo[i][0],vlo[i][1],vlo[i][2],vlo[i][3],vhi[i][0],vhi[i][1],vhi[i][2],vhi[i][3]}
  #define PIN(x) asm volatile("":"+v"(x))
  #define MX3(a,b,c) __builtin_fmaxf(__builtin_fmaxf((a),(b)),(c))
  #define GAPA(MF,A0,A1,A2,A3,W0,W1,PW) do{ MF; sacc+=A0; sacc+=A1; sacc+=A2; sacc+=A3; PIN(sacc); W0; W1; PIN(PW); SBAR(); }while(0)
  #define EX(v) __builtin_amdgcn_exp2f(v)
  #define GAPB(MF,X,B) do{ MF; X[B]=EX(X[B]); X[B+1]=EX(X[B+1]); X[B+2]=EX(X[B+2]); X[B+3]=EX(X[B+3]); PIN(X); SBAR(); }while(0)
  #define VRD(i) do{ vlo[i]=vtr(vp_+(((i)>>2)*4096+((i)&3)*1024)); vhi[i]=vtr(vp_+(((i)>>2)*4096+((i)&3)*1024+512)); }while(0)
  #define KRD(G,j) do{ if(G){ kload2(kf,kp0+sl_next,j); SBAR(); } }while(0)
  #define STEP(C0,C1,P0,P1,t,GK,GV,GL) do{ SBAR(); \
    const lds_cptr vp_=vp0+sl_prev; \
    VRD(0); SBAR(); float sacc=(P0[0]+P0[1]); \
    GAPA(C0=__builtin_amdgcn_mfma_f32_32x32x16_bf16(kf[0],qr[0],negm,0,0,0), P0[2],P0[3],P0[4],P0[5],     pw0[0]=PKW(P0,0), pw0[1]=PKW(P0,2), pw0); \
    VRD(4); SBAR(); GAPA(C1=__builtin_amdgcn_mfma_f32_32x32x16_bf16(kf[1],qr[0],negm,0,0,0), P0[6],P0[7],P0[8],P0[9],     pw0[2]=PKW(P0,4), pw0[3]=PKW(P0,6), pw0); \
    VRD(1); SBAR(); GAPA(C0=__builtin_amdgcn_mfma_f32_32x32x16_bf16(kf[2],qr[1],C0,0,0,0),   P0[10],P0[11],P0[12],P0[13], pw1[0]=PKW(P0,8), pw1[1]=PKW(P0,10), pw1); \
    VRD(5); SBAR(); GAPA(C1=__builtin_amdgcn_mfma_f32_32x32x16_bf16(kf[3],qr[1],C1,0,0,0),   P0[14],P0[15],P1[0],P1[1],   pw1[2]=PKW(P0,12),pw1[3]=PKW(P0,14), pw1); \
    VRD(2); SBAR(); GAPA(C0=__builtin_amdgcn_mfma_f32_32x32x16_bf16(kf[4],qr[2],C0,0,0,0),   P1[2],P1[3],P1[4],P1[5],     pw2[0]=PKW(P1,0), pw2[1]=PKW(P1,2), pw2); \
    VRD(6); SBAR(); GAPA(C1=__builtin_amdgcn_mfma_f32_32x32x16_bf16(kf[5],qr[2],C1,0,0,0),   P1[6],P1[7],P1[8],P1[9],     pw2[2]=PKW(P1,4), pw2[3]=PKW(P1,6), pw2); \
    VRD(3); SBAR(); GAPA(C0=__builtin_amdgcn_mfma_f32_32x32x16_bf16(kf[6],qr[3],C0,0,0,0),   P1[10],P1[11],P1[12],P1[13], pw3[0]=PKW(P1,8), pw3[1]=PKW(P1,10), pw3); \
    VRD(7); SBAR(); GAPA(C1=__builtin_amdgcn_mfma_f32_32x32x16_bf16(kf[7],qr[3],C1,0,0,0),   P1[14],P1[15],0.f,0.f,       pw3[2]=PKW(P1,12),pw3[3]=PKW(P1,14), pw3); \
    l_reg+=sacc; \
    if(GK){DMA_K((t)+3,sl_cur);} if(GV){DMA_V((t)+1,sl_next);} \
    CMASK(C0,C1,t); \
    { float a=MX3(C0[0],C0[1],C1[0]),b=MX3(C0[2],C0[3],C1[1]); a=MX3(a,C1[2],C1[3]); \
      _Pragma("unroll") for(int r=4;r<16;r+=4){a=MX3(a,C0[r],C0[r+1]);b=MX3(b,C0[r+2],C0[r+3]);a=MX3(a,C1[r],C1[r+1]);b=MX3(b,C1[r+2],C1[r+3]);} \
      float rm=__builtin_fmaxf(a,b); { auto rr=__builtin_amdgcn_permlane32_swap(__float_as_uint(rm),__float_as_uint(rm),false,false); rm=__builtin_fmaxf(__uint_as_float(rr[0]),__uint_as_float(rr[1])); } \
      resc=false; \
      if(__builtin_expect(__any(rm>(float)THRL),0)){ const float dl=__builtin_fmaxf(rm,0.f); mhat+=dl; \
        _Pragma("unroll") for(int r=0;r<16;++r){C0[r]-=dl;C1[r]-=dl;} \
        _Pragma("unroll") for(int r=0;r<16;++r)negm[r]=b31s-mhat; asm volatile("":"+v"(negm)); \
        const float f=__builtin_amdgcn_exp2f(-dl); l_reg*=f; if(hi==0)wsf[r32]=f; resc=true; } } \
    SBAR(); \
    GAPB(o[0]=__builtin_amdgcn_mfma_f32_32x32x16_bf16(PAF(0),VFR(0),o[0],0,0,0), C0,0); \
    GAPB(o[1]=__builtin_amdgcn_mfma_f32_32x32x16_bf16(PAF(0),VFR(4),o[1],0,0,0), C0,4); \
    KRD(GL,0); GAPB(o[0]=__builtin_amdgcn_mfma_f32_32x32x16_bf16(PAF(1),VFR(1),o[0],0,0,0), C0,8); \
    KRD(GL,1); GAPB(o[1]=__builtin_amdgcn_mfma_f32_32x32x16_bf16(PAF(1),VFR(5),o[1],0,0,0), C0,12); \
    KRD(GL,2); GAPB(o[0]=__builtin_amdgcn_mfma_f32_32x32x16_bf16(PAF(2),VFR(2),o[0],0,0,0), C1,0); \
    KRD(GL,3); GAPB(o[1]=__builtin_amdgcn_mfma_f32_32x32x16_bf16(PAF(2),VFR(6),o[1],0,0,0), C1,4); \
    GAPB(o[0]=__builtin_amdgcn_mfma_f32_32x32x16_bf16(PAF(3),VFR(3),o[0],0,0,0), C1,8); \
    GAPB(o[1]=__builtin_amdgcn_mfma_f32_32x32x16_bf16(PAF(3),VFR(7),o[1],0,0,0), C1,12); \
    }while(0)
  int t=1;
  #undef CMASK
  #define CMASK(P0,P1,t) do{}while(0)
  for(;t+7<NT;t+=2){
    STEP(pB0,pB1,pA0,pA1,t,true,true,true);     WAIT_BAR(2); RESC(); ROT();
    STEP(pA0,pA1,pB0,pB1,t+1,true,true,true);   WAIT_BAR(2); RESC(); ROT();
  }
  #undef CMASK
  #define CMASK(P0,P1,t) do{int jb_=(t)-(NT-4); if(jb_>=-2)cmask(P0,P1,jb_,qrel,hi,tabd);}while(0)
  #define ENDW(tt) do{ if((tt)+3<NT){WAIT_BAR(2);} else if((tt)+2<NT){WAIT_BAR(1);} else {WAIT_BAR(0);} }while(0)
  for(;t+1<NT;t+=2){
    STEP(pB0,pB1,pA0,pA1,t,(t+3<NT),(t+1<NT),(t+1<NT));       ENDW(t);   RESC(); ROT();
    STEP(pA0,pA1,pB0,pB1,t+1,(t+4<NT),(t+2<NT),(t+2<NT));     ENDW(t+1); RESC(); ROT();
  }
  STEP(pB0,pB1,pA0,pA1,NT-1,false,false,false); RESC();
  { float sacc=pB0[0]+pB0[1]; _Pragma("unroll") for(int r=2;r<16;++r)sacc+=pB0[r]; _Pragma("unroll") for(int r=0;r<16;++r)sacc+=pB1[r]; l_reg+=sacc;
    pw0=(u32x4){PKW(pB0,0),PKW(pB0,2),PKW(pB0,4),PKW(pB0,6)};pw1=(u32x4){PKW(pB0,8),PKW(pB0,10),PKW(pB0,12),PKW(pB0,14)};pw2=(u32x4){PKW(pB1,0),PKW(pB1,2),PKW(pB1,4),PKW(pB1,6)};pw3=(u32x4){PKW(pB1,8),PKW(pB1,10),PKW(pB1,12),PKW(pB1,14)};
    SBAR(); pv(o,vb0+sl_cur,PAF(0),PAF(1),PAF(2),PAF(3)); }
  #undef PKW
  #undef PAF
  #undef VFR
  #undef PIN
  #undef MX3
  #undef GAPA
  #undef GAPB
  #undef EX
  #undef VRD
  #undef KRD
  #undef STEP
  #undef ENDW
  {auto rr=__builtin_amdgcn_permlane32_swap(__float_as_uint(l_reg),__float_as_uint(l_reg),false,false);l_reg=__uint_as_float(rr[0])+__uint_as_float(rr[1]);}
  if(hi==0)wsf[32+r32]=l_reg;asm volatile("s_waitcnt lgkmcnt(0)":::"memory");
  float rli[16];
  #pragma unroll
  for(int r=0;r<16;++r)rli[r]=__builtin_amdgcn_rcpf(wsf[32+crow(r,hi)]);
  bf16*Ow=O+(rowbase+q0+wid*QBLK)*DM+hv*D;
  { bf16*stg=(bf16*)(shm+LDS_OST)+wid*2048;
    #pragma unroll
    for(int r=0;r<16;++r){const int orow=crow(r,hi);
      #pragma unroll
      for(int d0=0;d0<2;++d0)stg[orow*64+d0*32+r32]=__float2bfloat16(o[d0][r]*rli[r]);}
    asm volatile("s_waitcnt lgkmcnt(0)":::"memory");
    int le=lane; asm volatile("":"+v"(le));
    #pragma unroll
    for(int i=0;i<4;++i){const int row=i*8+(le>>3),ch=le&7; const u32x4 v=*(const u32x4*)(stg+row*64+ch*8); ATTN_STORE16(Ow+(long)row*DM+ch*8,v);} }
  asm volatile("s_waitcnt lgkmcnt(0)\n\ts_barrier":::"memory");
  #undef DMA_K
  #undef DMA_V
  #undef CMASK
  #undef START
  #undef RESC
  #undef ROT
}
constexpr int ATTN_LDS_BYTES=LDS_BYTES, LDS_TAB=LDS_BYTES;
struct AttnTensors { const bf16* Q; const bf16* K; const bf16* V; bf16* O0; bf16* O1; const float* TB; };
template<int THRL=8> __device__ __forceinline__ void attn_phase(char*lds,const AttnTensors&T,int grid,int block){
  const int vcu=(grid%8==0)?(block%8)*(grid/8)+block/8:block;
  lds_cfptr tab=(lds_cfptr)((__attribute__((address_space(3))) const char*)lds+LDS_TAB);
  { __attribute__((address_space(3))) float* tw=(__attribute__((address_space(3))) float*)((__attribute__((address_space(3))) char*)lds+LDS_TAB);
    for(int i=threadIdx.x;i<8*128;i+=512){const int h=i>>7; tw[i]=T.TB[i]-T.TB[h*128+127];}
    asm volatile("s_waitcnt vmcnt(0) lgkmcnt(0)\n\ts_barrier":::"memory"); }
  for(int bh=vcu>>3;bh<BATCH*8;bh+=grid>>3){ const int b=bh>>3,h=bh&7,s=vcu&7; const float b31s=T.TB[h*128+127];
    for(int j=0;j<4;++j){ const int c=j>>1,vh=j&1;
      for(int i=0;i<4;++i){ const int qb=(i==0)?s:(i==1)?15-s:(i==2)?16+s:31-s;
        attn_unit<THRL>(b,h*2+c,h*2+vh,qb,T.Q,T.K,T.V,c?T.O1:T.O0,lds,b31s,tab+h*128); } } }
}
#undef SBAR
#undef WAIT_BAR
}

constexpr int RING_BYTES = 131072;
constexpr int LDSCTL_OFF = RING_BYTES, MISC_OFF = LDSCTL_OFF + 320;
constexpr int LDS_BYTES = 147456;

struct Args { const float* in[28]; float* out; unsigned char* ws; int ph_lo, ph_hi; };

__device__ __forceinline__ void rms_rows_bf16(const float* X, const float* g, bf16* H, int bid, int nb) {
    const int tid_ = fresh_tid(); const int lane = tid_ & 63, wave = tid_ >> 6;
    f32x4 gv[4];
#pragma unroll
    for (int j = 0; j < 4; ++j) gv[j] = *(const f32x4*)(g + 4 * lane + 256 * j);
    for (int m = bid * NWAVES + wave; m < NT; m += nb * NWAVES) {
        const f32x4* xr = (const f32x4*)(X + (size_t)m * DM) + lane;
        f32x4 v[4]; float s = 0.f;
#pragma unroll
        for (int j = 0; j < 4; ++j) { v[j] = xr[64 * j]; s += (v[j].x * v[j].x + v[j].y * v[j].y) + (v[j].z * v[j].z + v[j].w * v[j].w); }
        const float r = 1.f / sqrtf(wave_sum(s) * (1.f / DM) + NORM_EPS);
        unsigned long long* o8 = (unsigned long long*)(H + (size_t)m * DM) + lane;
#pragma unroll
        for (int j = 0; j < 4; ++j) { const f32x4 y = v[j] * r * gv[j]; o8[64 * j] = (unsigned long long)pk2(y.x, y.y) | ((unsigned long long)pk2(y.z, y.w) << 32); }
    }
}
__device__ __forceinline__ void rms_rows_f32_inplace(float* X, const float* g, int bid, int nb) {
    const int tid_ = fresh_tid(); const int lane = tid_ & 63, wave = tid_ >> 6;
    f32x4 gv[4];
#pragma unroll
    for (int j = 0; j < 4; ++j) gv[j] = *(const f32x4*)(g + 4 * lane + 256 * j);
    for (int m = bid * NWAVES + wave; m < NT; m += nb * NWAVES) {
        f32x4* xr = (f32x4*)(X + (size_t)m * DM) + lane;
        f32x4 v[4]; float s = 0.f;
#pragma unroll
        for (int j = 0; j < 4; ++j) { v[j] = xr[64 * j]; s += (v[j].x * v[j].x + v[j].y * v[j].y) + (v[j].z * v[j].z + v[j].w * v[j].w); }
        const float r = 1.f / sqrtf(wave_sum(s) * (1.f / DM) + NORM_EPS);
#pragma unroll
        for (int j = 0; j < 4; ++j) xr[64 * j] = v[j] * r * gv[j];
    }
}

template <int NB, class P>
__device__ __forceinline__ void ref_gemm(const P& p, LAS float* sm, int bid, int nb) {
    constexpr int LDP = 132;
    LAS float* As = sm; LAS float* Bs = sm + 16 * LDP;
    const int tid = fresh_tid(), ty = tid >> 4, tx = tid & 15;
    const int nt = p.ntiles();
    for (int it = bid; it < nt; it += nb) {
        int m0, n0; const float* W[2]; p.tile(it, m0, n0, W[0], W[1]);
        float acc[NB][4][8];
#pragma unroll
        for (int b = 0; b < NB; ++b)
#pragma unroll
            for (int i = 0; i < 4; ++i)
#pragma unroll
                for (int j = 0; j < 8; ++j) acc[b][i][j] = 0.f;
        const bf16* ap = p.arow(m0 + (tid >> 2)) + (tid & 3) * 4;
        for (int k0 = 0; k0 < p.K; k0 += 16) {
            { const v2u v = *(const v2u*)(ap + k0); const int r = tid >> 2, kq = (tid & 3) * 4;
              As[(kq + 0) * LDP + r] = bflo(v.x); As[(kq + 1) * LDP + r] = bfhi(v.x); As[(kq + 2) * LDP + r] = bflo(v.y); As[(kq + 3) * LDP + r] = bfhi(v.y); }
#pragma unroll
            for (int b = 0; b < NB; ++b) { const int k = tid >> 5, n4 = (tid & 31) * 4;
                const f32x4 v = *(const f32x4*)(W[b] + (size_t)(k0 + k) * p.ldw + n0 + n4);
                *(LAS f32x4*)(Bs + (b * 16 + k) * LDP + n4) = v; }
            __syncthreads();
#pragma unroll 2
            for (int kk = 0; kk < 16; ++kk) {
                const f32x4 a = *(const LAS f32x4*)(As + kk * LDP + ty * 4);
#pragma unroll
                for (int b = 0; b < NB; ++b) {
                    const f32x4 b0 = *(const LAS f32x4*)(Bs + (b * 16 + kk) * LDP + tx * 8), b1 = *(const LAS f32x4*)(Bs + (b * 16 + kk) * LDP + tx * 8 + 4);
#pragma unroll
                    for (int i = 0; i < 4; ++i) {
                        acc[b][i][0] += a[i] * b0.x; acc[b][i][1] += a[i] * b0.y; acc[b][i][2] += a[i] * b0.z; acc[b][i][3] += a[i] * b0.w;
                        acc[b][i][4] += a[i] * b1.x; acc[b][i][5] += a[i] * b1.y; acc[b][i][6] += a[i] * b1.z; acc[b][i][7] += a[i] * b1.w; }
                }
            }
            __syncthreads();
        }
#pragma unroll
        for (int i = 0; i < 4; ++i) {
            float a[NB][8];
#pragma unroll
            for (int b = 0; b < NB; ++b)
#pragma unroll
                for (int j = 0; j < 8; ++j) a[b][j] = acc[b][i][j];
            p.epi(m0 + ty * 4 + i, n0 + tx * 8, a);
        }
    }
}
__device__ __forceinline__ void st_bf16x8(bf16* p, const float* v) { v4u w; w.x = pk2(v[0], v[1]); w.y = pk2(v[2], v[3]); w.z = pk2(v[4], v[5]); w.w = pk2(v[6], v[7]); *(v4u*)p = w; }
__device__ __forceinline__ float silu_(float x) { return x / (1.f + __expf(-x)); }
__device__ __forceinline__ float gelu_tanh_(float x) { const float u = 0.7978845608028654f * (x + 0.044715f * x * x * x); return 0.5f * x * (1.f + tanhf(u)); }

struct PQkv {
    int K, ldw; const bf16* H; const float* W; bf16 *Q, *Kb, *V;
    __device__ int ntiles() const { return (NT / 128) * (3 * DM / 128); }
    __device__ void tile(int i, int& m0, int& n0, const float*& W0, const float*& W1) const { m0 = (i / 24) * 128; n0 = (i % 24) * 128; W0 = W; W1 = W; }
    __device__ const bf16* arow(int r) const { return H + (size_t)r * DM; }
    __device__ void epi(int r, int c0, const float (&a)[1][8]) const {
        const int t = c0 >> 10, c = c0 & 1023; float v[8]; const float sc = (t == 0) ? C2 : 1.f;
#pragma unroll
        for (int j = 0; j < 8; ++j) v[j] = a[0][j] * sc;
        st_bf16x8(Q + (size_t)t * (size_t)(32u << 20) + (size_t)r * DM + c, v); }
};
struct PResid {
    int K, ldw; const bf16* A; int lda; const float* W; const float* base; float* out;
    __device__ int ntiles() const { return (NT / 128) * (DM / 128); }
    __device__ void tile(int i, int& m0, int& n0, const float*& W0, const float*& W1) const { m0 = (i / 8) * 128; n0 = (i % 8) * 128; W0 = W; W1 = W; }
    __device__ const bf16* arow(int r) const { return A + (size_t)r * lda; }
    __device__ void epi(int r, int c0, const float (&a)[1][8]) const {
        const f32x4 b0 = *(const f32x4*)(base + (size_t)r * DM + c0), b1 = *(const f32x4*)(base + (size_t)r * DM + c0 + 4);
        *(f32x4*)(out + (size_t)r * DM + c0) = (f32x4){b0.x + a[0][0], b0.y + a[0][1], b0.z + a[0][2], b0.w + a[0][3]};
        *(f32x4*)(out + (size_t)r * DM + c0 + 4) = (f32x4){b1.x + a[0][4], b1.y + a[0][5], b1.z + a[0][6], b1.w + a[0][7]}; }
};
struct PSwiglu {
    int K, ldw; const bf16* H; const float *Wg, *Wu; bf16* ACT;
    __device__ int ntiles() const { return (NT / 128) * (DFF / 128); }
    __device__ void tile(int i, int& m0, int& n0, const float*& W0, const float*& W1) const { m0 = (i / 22) * 128; n0 = (i % 22) * 128; W0 = Wg; W1 = Wu; }
    __device__ const bf16* arow(int r) const { return H + (size_t)r * DM; }
    __device__ void epi(int r, int c0, const float (&a)[2][8]) const { float v[8];
#pragma unroll
        for (int j = 0; j < 8; ++j) v[j] = silu_(a[0][j]) * a[1][j];
        st_bf16x8(ACT + (size_t)r * DFF + c0, v); }
};
struct PWin {
    int K, ldw; const bf16* H; const float* W; bf16 *G, *XB;
    __device__ int ntiles() const { return (NT / 128) * (2 * DRNN / 128); }
    __device__ void tile(int i, int& m0, int& n0, const float*& W0, const float*& W1) const { m0 = (i / 20) * 128; n0 = (i % 20) * 128; W0 = W; W1 = W; }
    __device__ const bf16* arow(int r) const { return H + (size_t)r * DM; }
    __device__ void epi(int r, int c0, const float (&a)[1][8]) const { float v[8];
        if (c0 < DRNN) {
#pragma unroll
            for (int j = 0; j < 8; ++j) v[j] = gelu_tanh_(a[0][j]);
            st_bf16x8(G + (size_t)r * DRNN + c0, v);
        } else {
#pragma unroll
            for (int j = 0; j < 8; ++j) v[j] = a[0][j];
            st_bf16x8(XB + (size_t)r * DRNN + (c0 - DRNN), v); } }
};
struct PMoeGU {
    int K, ldw; const bf16* H; const float *Wg, *Wu; bf16* ACT; const int* tok; const int* base;
    __device__ int ntiles() const { return (base[8] / 128) * (DFE / 128); }
    __device__ void tile(int i, int& m0, int& n0, const float*& W0, const float*& W1) const {
        m0 = (i / 28) * 128; n0 = (i % 28) * 128; int e = 0;
#pragma unroll
        for (int j = 1; j < 8; ++j) e += (m0 >= base[j]) ? 1 : 0;
        W0 = Wg + (size_t)e * DM * DFE; W1 = Wu + (size_t)e * DM * DFE; }
    __device__ const bf16* arow(int r) const { int t = tok[r]; if (t < 0) t = 0; return H + (size_t)t * DM; }
    __device__ void epi(int r, int c0, const float (&a)[2][8]) const { float v[8];
#pragma unroll
        for (int j = 0; j < 8; ++j) v[j] = silu_(a[0][j]) * a[1][j];
        st_bf16x8(ACT + (size_t)r * DFE + c0, v); }
};
struct PMoeDown {
    int K, ldw; const bf16* ACT; const float* Wd; float* out; const int* tok; const float* gatev; const int* base;
    __device__ int ntiles() const { return (base[8] / 128) * (DM / 128); }
    __device__ void tile(int i, int& m0, int& n0, const float*& W0, const float*& W1) const {
        m0 = (i / 8) * 128; n0 = (i % 8) * 128; int e = 0;
#pragma unroll
        for (int j = 1; j < 8; ++j) e += (m0 >= base[j]) ? 1 : 0;
        W0 = Wd + (size_t)e * DFE * DM; W1 = W0; }
    __device__ const bf16* arow(int r) const { return ACT + (size_t)r * DFE; }
    __device__ void epi(int r, int c0, const float (&a)[1][8]) const {
        const int t = tok[r]; if (t < 0) return; const float g = gatev[r];
        float* o = out + (size_t)t * DM + c0; const f32x4 b0 = *(const f32x4*)o, b1 = *(const f32x4*)(o + 4);
        *(f32x4*)o = (f32x4){b0.x + g * a[0][0], b0.y + g * a[0][1], b0.z + g * a[0][2], b0.w + g * a[0][3]};
        *(f32x4*)(o + 4) = (f32x4){b1.x + g * a[0][4], b1.y + g * a[0][5], b1.z + g * a[0][6], b1.w + g * a[0][7]}; }
};

__device__ __forceinline__ int t5_bucket(int n) {
    const float nf = (float)(n < 1 ? 1 : n);
    int large = 16 + (int)(logf(nf / 16.0f) / 2.0794415416798357f * 16.0f);
    large = large < 31 ? large : 31;
    return n < 16 ? n : large;
}
__device__ __forceinline__ void build_tables(const float* rel_bias, float* TB) {
    for (int i = fresh_tid(); i < NH * 128; i += NTHR) { const int h = i >> 7, n = i & 127; TB[i] = rel_bias[t5_bucket(n) * NH + h] * LOG2E; }
}
__device__ __forceinline__ float compute_lam(const float* lq1, const float* lk1, const float* lq2, const float* lk2) {
    const int lane = fresh_tid() & 63;
    const float s1 = wave_sum(lq1[lane] * lk1[lane]), s2 = wave_sum(lq2[lane] * lk2[lane]);
    return expf(s1) - expf(s2) + LAM_INIT;
}

__device__ __forceinline__ void ref_attention(const bf16* Q, const bf16* Kb, const bf16* V, bf16* O0, bf16* O1, const float* TB, LAS float* sm, int bid, int nb) {
    LAS float* Ks = sm; LAS float* Vs = sm + 32 * 128; LAS float* tb = sm + 2 * 32 * 128;
    const int tid = fresh_tid(), qr = tid & 127, cv = tid >> 7, c = cv >> 1, vh = cv & 1;
    const int NU = NB_ * NH * (SEQ / 128);
    for (int u = bid; u < NU; u += nb) {
        const int uu = NU - 1 - u;
        const int qblk = uu / (NB_ * NH), bh = uu % (NB_ * NH), b = bh / NH, h = bh % NH;
        const int q0 = qblk * 128, q = q0 + qr; const size_t rb = (size_t)b * SEQ;
        __syncthreads();
        if (tid < 128) tb[tid] = TB[h * 128 + tid];
        float qv[64];
        { const v4u* qp = (const v4u*)(Q + (rb + q) * DM + h * 128 + c * 64);
#pragma unroll
          for (int i = 0; i < 8; ++i) { const v4u w = qp[i]; qv[8 * i] = bflo(w.x); qv[8 * i + 1] = bfhi(w.x); qv[8 * i + 2] = bflo(w.y); qv[8 * i + 3] = bfhi(w.y); qv[8 * i + 4] = bflo(w.z); qv[8 * i + 5] = bfhi(w.z); qv[8 * i + 6] = bflo(w.w); qv[8 * i + 7] = bfhi(w.w); } }
        float o[64]; float m = -INFINITY, l = 0.f;
#pragma unroll
        for (int d = 0; d < 64; ++d) o[d] = 0.f;
        const int nkt = (q0 + 127) / 32 + 1;
        for (int kt = 0; kt < nkt; ++kt) {
            __syncthreads();
            { const int r = tid >> 4, c8 = (tid & 15) * 8; const size_t g = (rb + kt * 32 + r) * DM + h * 128 + c8;
              const v4u kw = *(const v4u*)(Kb + g), vw = *(const v4u*)(V + g);
              LAS float* kd = Ks + r * 128 + c8; LAS float* vd = Vs + r * 128 + c8;
              kd[0] = bflo(kw.x); kd[1] = bfhi(kw.x); kd[2] = bflo(kw.y); kd[3] = bfhi(kw.y); kd[4] = bflo(kw.z); kd[5] = bfhi(kw.z); kd[6] = bflo(kw.w); kd[7] = bfhi(kw.w);
              vd[0] = bflo(vw.x); vd[1] = bfhi(vw.x); vd[2] = bflo(vw.y); vd[3] = bfhi(vw.y); vd[4] = bflo(vw.z); vd[5] = bfhi(vw.z); vd[6] = bflo(vw.w); vd[7] = bfhi(vw.w); }
            __syncthreads();
            if (kt * 32 <= q) {
#pragma unroll 1
                for (int j = 0; j < 32; ++j) {
                    const int dist = q - (kt * 32 + j);
                    if (dist >= 0) {
                        const LAS float* kr = Ks + j * 128 + c * 64; float a = 0.f;
#pragma unroll
                        for (int d = 0; d < 64; d += 4) { const f32x4 kv = *(const LAS f32x4*)(kr + d); a += qv[d] * kv.x + qv[d + 1] * kv.y + qv[d + 2] * kv.z + qv[d + 3] * kv.w; }
                        a += tb[dist > 127 ? 127 : dist];
                        const float mn = fmaxf(m, a), al = exp2f(m - mn), pj = exp2f(a - mn); m = mn; l = l * al + pj;
                        const LAS float* vr = Vs + j * 128 + vh * 64;
#pragma unroll
                        for (int d = 0; d < 64; d += 4) { const f32x4 vv = *(const LAS f32x4*)(vr + d);
                            o[d] = o[d] * al + pj * vv.x; o[d + 1] = o[d + 1] * al + pj * vv.y; o[d + 2] = o[d + 2] * al + pj * vv.z; o[d + 3] = o[d + 3] * al + pj * vv.w; }
                    }
                }
            }
        }
        const float rl = 1.f / l;
        bf16* op = (c == 0 ? O0 : O1) + (rb + q) * DM + h * 128 + vh * 64;
#pragma unroll
        for (int i = 0; i < 8; ++i) { float v[8];
#pragma unroll
            for (int j = 0; j < 8; ++j) v[j] = o[8 * i + j] * rl;
            st_bf16x8(op + 8 * i, v); }
    }
}
__device__ __forceinline__ void combine_rows(const bf16* O0, const bf16* O1, bf16* OC, const float* subg, float lam, int bid, int nb) {
    const int tid_ = fresh_tid(); const int lane = tid_ & 63, wave = tid_ >> 6;
    const float g0 = subg[2 * lane], g1 = subg[2 * lane + 1];
    for (long it = (long)bid * NWAVES + wave; it < (long)NT * NH; it += (long)nb * NWAVES) {
        const size_t off = (size_t)it * 128 + 2 * lane;
        const unsigned a = *(const unsigned*)(O0 + off), b = *(const unsigned*)(O1 + off);
        const float x0 = bflo(a) - lam * bflo(b), x1 = bfhi(a) - lam * bfhi(b);
        const float r = 1.f / sqrtf(wave_sum(x0 * x0 + x1 * x1) * (1.f / 128.f) + SUBLN_EPS) * (1.f - LAM_INIT);
        *(unsigned*)(OC + off) = pk2(x0 * r * g0, x1 * r * g1);
    }
}

__device__ __forceinline__ void ref_lru_local(const bf16* XB, const float* convw, const float* convb, const float* gaw, const float* gab, const float* gxw, const float* gxb,
                                              const float* lamp, bf16* HL, bf16* CA, float* AEND, float* HEND, LAS float* sm, int bid, int nb) {
    LAS float* xc = sm;
    LAS float* av = sm + 64 * 128;
    LAS float* bv = sm + 2 * 64 * 128;
    const int tid = fresh_tid();
    const int NU = NB_ * NCH * NLB;
    for (int u = bid; u < NU; u += nb) {
        const int n = u % NLB, ch = (u / NLB) % NCH, b = u / (NLB * NCH);
        const int t0 = ch * LCH; const size_t rb = (size_t)b * SEQ;
        __syncthreads();
        for (int i = tid; i < LCH * 128; i += NTHR) { const int t = i >> 7, c = i & 127, cg = n * 128 + c; float a = convb[cg];
#pragma unroll
            for (int j = 0; j < CW; ++j) { const int tt = t0 + t + j - (CW - 1); if (tt >= 0) a += bf2f(XB[(rb + tt) * DRNN + cg]) * convw[j * DRNN + cg]; }
            xc[i] = a; }
        __syncthreads();
        { const int e = tid & 127, tq = tid >> 7, cg = n * 128 + e;
          const float* wa = gaw + (size_t)n * 128 * 128 + e; const float* wx = gxw + (size_t)n * 128 * 128 + e;
          const float ba = gab[cg], bx = gxb[cg]; const float sp = log1pf(expf(-lamp[cg]));
          for (int tb4 = 0; tb4 < 4; ++tb4) {
              float ar[4] = {0.f, 0.f, 0.f, 0.f}, ai[4] = {0.f, 0.f, 0.f, 0.f};
              const int tbase = tq * 16 + tb4 * 4;
              for (int d = 0; d < 128; ++d) { const float w1 = wa[d * 128], w2 = wx[d * 128];
#pragma unroll
                  for (int k = 0; k < 4; ++k) { const float xv = xc[(tbase + k) * 128 + d]; ar[k] += xv * w1; ai[k] += xv * w2; } }
#pragma unroll
              for (int k = 0; k < 4; ++k) { const int t = tbase + k; const float r = sigmoidf_(ar[k] + ba), ig = sigmoidf_(ai[k] + bx);
                  const float la = -8.0f * r * sp, a = expf(la), mult = sqrtf(-expm1f(2.0f * la));
                  av[t * 128 + e] = a; bv[t * 128 + e] = mult * (ig * xc[t * 128 + e]); }
          } }
        __syncthreads();
        if (tid < 128) { const int cg = n * 128 + tid; float hh = 0.f, cp = 1.f;
            for (int t = 0; t < LCH; ++t) { const float a = av[t * 128 + tid]; hh = a * hh + bv[t * 128 + tid]; cp *= a;
                HL[(rb + t0 + t) * DRNN + cg] = (bf16)f2bf(hh); CA[(rb + t0 + t) * DRNN + cg] = (bf16)f2bf(cp); }
            AEND[((size_t)b * NCH + ch) * DRNN + cg] = cp; HEND[((size_t)b * NCH + ch) * DRNN + cg] = hh; }
    }
}
__device__ __forceinline__ void lru_carry(const float* AEND, const float* HEND, float* CIN, int bid, int nb) {
    for (int i = bid * NTHR + fresh_tid(); i < NB_ * DRNN; i += nb * NTHR) { const int b = i / DRNN, c = i % DRNN; float cin = 0.f;
        for (int ch = 0; ch < NCH; ++ch) { const size_t o = ((size_t)b * NCH + ch) * DRNN + c; CIN[o] = cin; cin = AEND[o] * cin + HEND[o]; } }
}
__device__ __forceinline__ void lru_fixup(const bf16* HL, const bf16* CA, const bf16* G, const float* CIN, bf16* Y, int bid, int nb) {
    const size_t total = (size_t)NT * DRNN / 2;
    for (size_t i = (size_t)bid * NTHR + fresh_tid(); i < total; i += (size_t)nb * NTHR) {
        const size_t el = 2 * i; const int row = (int)(el / DRNN), c = (int)(el % DRNN); const int b = row / SEQ, ch = (row % SEQ) / LCH;
        const unsigned hl = *(const unsigned*)(HL + el), ca = *(const unsigned*)(CA + el), g = *(const unsigned*)(G + el);
        const float* ci = CIN + ((size_t)b * NCH + ch) * DRNN + c;
        const float h0 = bflo(hl) + bflo(ca) * ci[0], h1 = bfhi(hl) + bfhi(ca) * ci[1];
        *(unsigned*)(Y + el) = pk2(h0 * bflo(g), h1 * bfhi(g));
    }
}

__device__ __forceinline__ void moe_route(const float* X, const float* g, const float* router, bf16* H, int* RE, float* RG, int* RR, int* CNT, LAS float* sm, int bid, int nb) {
    LAS int* e_s = (LAS int*)sm;
    const int tid = fresh_tid(), lane = tid & 63, wave = tid >> 6;
    f32x4 gv[4];
#pragma unroll
    for (int j = 0; j < 4; ++j) gv[j] = *(const f32x4*)(g + 4 * lane + 256 * j);
    for (int tile = bid; tile < NT / 256; tile += nb) {
        __syncthreads();
        for (int rr = 0; rr < 32; ++rr) {
            const int lr = wave * 32 + rr, m = tile * 256 + lr;
            const f32x4* xr = (const f32x4*)(X + (size_t)m * DM) + lane;
            f32x4 v[4]; float s = 0.f;
#pragma unroll
            for (int j = 0; j < 4; ++j) { v[j] = xr[64 * j]; s += (v[j].x * v[j].x + v[j].y * v[j].y) + (v[j].z * v[j].z + v[j].w * v[j].w); }
            const float r = 1.f / sqrtf(wave_sum(s) * (1.f / DM) + NORM_EPS);
            unsigned long long* o8 = (unsigned long long*)(H + (size_t)m * DM) + lane;
            float lg[NE];
#pragma unroll
            for (int e = 0; e < NE; ++e) lg[e] = 0.f;
#pragma unroll
            for (int j = 0; j < 4; ++j) { const f32x4 y = v[j] * r * gv[j]; o8[64 * j] = (unsigned long long)pk2(y.x, y.y) | ((unsigned long long)pk2(y.z, y.w) << 32);
                const float* rp = router + (size_t)(4 * lane + 256 * j) * NE;
#pragma unroll
                for (int q = 0; q < 4; ++q) { const f32x4 r0 = *(const f32x4*)(rp + q * NE), r1 = *(const f32x4*)(rp + q * NE + 4); const float yy = y[q];
                    lg[0] += yy * r0.x; lg[1] += yy * r0.y; lg[2] += yy * r0.z; lg[3] += yy * r0.w; lg[4] += yy * r1.x; lg[5] += yy * r1.y; lg[6] += yy * r1.z; lg[7] += yy * r1.w; } }
#pragma unroll
            for (int e = 0; e < NE; ++e) lg[e] = wave_sum(lg[e]);
            int i0 = 0; float v0 = lg[0];
#pragma unroll
            for (int e = 1; e < NE; ++e) if (lg[e] > v0) { v0 = lg[e]; i0 = e; }
            int i1 = -1; float v1 = -INFINITY;
#pragma unroll
            for (int e = 0; e < NE; ++e) if (e != i0 && lg[e] > v1) { v1 = lg[e]; i1 = e; }
            const float g1 = 1.f / (1.f + expf(v0 - v1)), g0 = 1.f - g1;
            if (lane == 0) { e_s[lr] = i0; e_s[256 + lr] = i1; RE[m] = i0; RE[NT + m] = i1; RG[m] = g0; RG[NT + m] = g1; }
        }
        __syncthreads();
        { const int s = tid >> 8, i = tid & 255; const int me = e_s[s * 256 + i]; int rk = 0;
          for (int j = 0; j < i; ++j) rk += (e_s[s * 256 + j] == me) ? 1 : 0;
          RR[s * NT + tile * 256 + i] = rk; }
        if (tid < 16) { const int s = tid >> 3, e = tid & 7; int c = 0; for (int j = 0; j < 256; ++j) c += (e_s[s * 256 + j] == e) ? 1 : 0; CNT[tile * 16 + tid] = c; }
    }
}
__device__ __forceinline__ void moe_scatter(const int* RE, const float* RG, const int* RR, const int* CNT, int* BASE, int* TOK, float* GATEV, LAS float* sm, int bid, int nb) {
    LAS int* tbase = (LAS int*)sm;
    LAS int* gbase = tbase + 128 * 16;
    LAS int* tot = gbase + 32;
    const int tid = fresh_tid();
    __syncthreads();
    if (tid < 16) { int run = 0; for (int t = 0; t < NT / 256; ++t) { tbase[t * 16 + tid] = run; run += CNT[t * 16 + tid]; } tot[tid] = run; }
    __syncthreads();
    if (tid < 2) { int run = 0; for (int e = 0; e < NE; ++e) { gbase[tid * 9 + e] = run; run += (tot[tid * 8 + e] + 255) & ~255; } gbase[tid * 9 + 8] = run; }
    __syncthreads();
    if (bid == 0 && tid < 18) BASE[tid] = gbase[tid];
    for (int i = bid * NTHR + tid; i < 2 * NT; i += nb * NTHR) { const int s = i / NT, m = i % NT; const int e = RE[i];
        const int pos = gbase[s * 9 + e] + tbase[(m >> 8) * 16 + s * 8 + e] + RR[i];
        TOK[s * SLOT_ROWS + pos] = m; GATEV[s * SLOT_ROWS + pos] = RG[i]; }
    for (int gi = bid; gi < 16; gi += nb) { const int s = gi >> 3, e = gi & 7; const int lo = gbase[s * 9 + e] + tot[gi], hi = gbase[s * 9 + e + 1];
        for (int p = lo + tid; p < hi; p += NTHR) { TOK[s * SLOT_ROWS + p] = -1; GATEV[s * SLOT_ROWS + p] = 0.f; } }
}

#define LDS_WAIT() asm volatile("s_waitcnt lgkmcnt(0)" ::: "memory")
__device__ __forceinline__ void transpose_item(const float* W, int N, bf16* WT, int K, int k0, int n0, int drow0, LAS float* scr, int lane) {
#pragma unroll 8
    for (int i = 0; i < 32; ++i) { const int kk = 2 * i + (lane >> 5); scr[kk * 33 + (lane & 31)] = W[(size_t)(k0 + kk) * N + n0 + (lane & 31)]; }
    LDS_WAIT(); asm volatile("" ::: "memory");
    const int c = lane & 7;
#pragma unroll
    for (int j = 0; j < 4; ++j) { const int n = (lane >> 3) + 8 * j; const LAS float* sp = scr + (8 * c) * 33 + n;
        v4u o; o.x = pk2(sp[0 * 33], sp[1 * 33]); o.y = pk2(sp[2 * 33], sp[3 * 33]); o.z = pk2(sp[4 * 33], sp[5 * 33]); o.w = pk2(sp[6 * 33], sp[7 * 33]);
        *(v4u*)(WT + (size_t)(drow0 + n) * K + k0 + 8 * c) = o; }
    LDS_WAIT(); asm volatile("" ::: "memory");
}
__device__ __forceinline__ void convert_matrix(const float* W, int K, int N, bf16* WT, int mode, LAS float* scr, int gw, int ngw, int lane) {
    const int nblk = N / 32, nitems = (K / 64) * nblk;
    for (int it = gw; it < nitems; it += ngw) { const int kb = it / nblk, nbk = it % nblk, n0 = 32 * nbk;
        const int drow0 = mode == 0 ? n0 : ((n0 >> 7) * 256 + (mode == 2 ? 128 : 0) + (n0 & 127));
        transpose_item(W, N, WT, K, 64 * kb, n0, drow0, scr, lane); }
}
constexpr size_t WA_QKV = 0, WA_O = 6 * MiB, WA_GU = 8 * MiB, WA_D = 19 * MiB, WA_IN = 19 * MiB + 5632 * 1024, WA_OUT = WA_IN + 5 * MiB, WA_GATES = WA_OUT + 2560 * 1024;
static_assert(WA_GATES + 2 * NLB * 128 * 128 * 2 <= 33 * MiB, "weights map");
__device__ __forceinline__ void convert_weights_a(const __attribute__((address_space(4))) Args* args, unsigned char* ws, LAS unsigned char* L, int bid, int nb) {
    const int tid = fresh_tid(), lane = tid & 63, wave = tid >> 6; LAS float* scr = (LAS float*)(L + wave * 16384);
    const int gw = bid * NWAVES + wave, ngw = nb * NWAVES; unsigned char* wa = ws + WS_WA;
    convert_matrix(args->in[5], DM, 3 * DM, (bf16*)(wa + WA_QKV), 0, scr, gw, ngw, lane);
    convert_matrix(args->in[6], DM, DM, (bf16*)(wa + WA_O), 0, scr, gw, ngw, lane);
    convert_matrix(args->in[21], DM, DFF, (bf16*)(wa + WA_GU), 1, scr, gw, ngw, lane);
    convert_matrix(args->in[22], DM, DFF, (bf16*)(wa + WA_GU), 2, scr, gw, ngw, lane);
    convert_matrix(args->in[23], DFF, DM, (bf16*)(wa + WA_D), 0, scr, gw, ngw, lane);
    convert_matrix(args->in[12], DM, 2 * DRNN, (bf16*)(wa + WA_IN), 0, scr, gw, ngw, lane);
    convert_matrix(args->in[20], DRNN, DM, (bf16*)(wa + WA_OUT), 0, scr, gw, ngw, lane);
}
constexpr size_t WM_GU = 0, WM_D = 112 * MiB;
__device__ __forceinline__ void convert_weights_moe(const __attribute__((address_space(4))) Args* args, unsigned char* ws, LAS unsigned char* L, int bid, int nb) {
    const int tid = fresh_tid(), lane = tid & 63, wave = tid >> 6; LAS float* scr = (LAS float*)(L + wave * 16384);
    const int gw = bid * NWAVES + wave, ngw = nb * NWAVES; unsigned char* wm = ws + WS_WM;
    for (int e = 0; e < NE; ++e) {
        convert_matrix(args->in[25] + (size_t)e * DM * DFE, DM, DFE, (bf16*)(wm + WM_GU) + (size_t)e * 2 * DFE * DM, 1, scr, gw, ngw, lane);
        convert_matrix(args->in[26] + (size_t)e * DM * DFE, DM, DFE, (bf16*)(wm + WM_GU) + (size_t)e * 2 * DFE * DM, 2, scr, gw, ngw, lane);
        convert_matrix(args->in[27] + (size_t)e * DFE * DM, DFE, DM, (bf16*)(wm + WM_D) + (size_t)e * DM * DFE, 0, scr, gw, ngw, lane);
    }
}
constexpr int N_PHASES = 21;
typedef const __attribute__((address_space(4))) Args* KArgs;
__device__ __forceinline__ KArgs fresh_args() { KArgs k = (KArgs)__builtin_amdgcn_kernarg_segment_ptr(); asm volatile("" : "+s"(k)); return k; }
#define WSP(T, off) ((T*)(ws + (off)))
__global__ void __launch_bounds__(NTHR, 2) fwd(Args args_unused) {
    extern __shared__ __attribute__((aligned(16))) unsigned char lds[];
    LAS unsigned char* L = (LAS unsigned char*)lds;
    LAS float* sm = (LAS float*)L;
    volatile LAS unsigned* MISC = (volatile LAS unsigned*)(L + MISC_OFF);
    const int bid = blockIdx.x, nb = gridDim.x;
    { const int tid = threadIdx.x; for (int u = tid; u < (LDS_BYTES - LDSCTL_OFF) / 4; u += NTHR) ((LAS unsigned*)(L + LDSCTL_OFF))[u] = 0u; }
    __syncthreads();
    int lo, hi;
    XcdBarrier bar;
    { KArgs ka = fresh_args(); lo = ka->ph_lo; hi = ka->ph_hi; bar.bar = (unsigned*)(ka->ws + WS_CTL) + CW_BAR; bar.x = 0; bar.st = nullptr; }
#if MK_ONE_LAUNCH
    bar = xcd_barrier_post(bar.bar, MISC + 8);
#endif
#ifndef PH_MASK
#define PH_MASK 0x1FFFFF
#endif
#define IN(k) (((PH_MASK >> (k)) & 1) && lo <= (k) && (k) < hi)
#if MK_ONE_LAUNCH
#define SEAM(k) do { if (IN(k) && IN((k) + 1)) xcd_barrier(bar); } while (0)
#else
#define SEAM(k) do { } while (0)
#endif
#define PH_BEGIN KArgs ka = fresh_args(); unsigned char* ws = ka->ws; (void)ws;
#define SMALLP(T, off) WSP(T, WS_SMALL + (off))
#define WAT(off) WSP(const pg8::bf16_t, WS_WA + (off))

    if (IN(0)) { PH_BEGIN if (bid == 0) build_tables(ka->in[4], SMALLP(float, SM_TB));
        convert_weights_a(ka, ws, L, bid, nb); __syncthreads();
        rms_rows_bf16(ka->in[0], ka->in[1], WSP(bf16, WS_H), bid, nb); } SEAM(0);
    if (IN(1)) { PH_BEGIN pg8::Gemm g{WSP(bf16, WS_H), WAT(WA_QKV), NT, 3 * DM, DM}; pg8::StaticOrder S; S.init(NT, 3 * DM, nb, bid);
        pg8::EpiBf16<0> E{WSP(bf16, WS_Q), DM, nullptr, DM, (size_t)(WS_K - WS_Q) / 2, C2};
        pg8::gemm_phase<pg8::EpiBf16<0>, pg8::StaticOrder, true, true>(L, g, S, E); } SEAM(1);
#if FAST_ATTN
    if (IN(2)) { PH_BEGIN const attn_body::AttnTensors AT{WSP(const attn_body::bf16, WS_Q), WSP(const attn_body::bf16, WS_K), WSP(const attn_body::bf16, WS_V), WSP(attn_body::bf16, WS_O0), WSP(attn_body::bf16, WS_O1), SMALLP(const float, SM_TB)};
        attn_body::attn_phase<8>((char*)lds, AT, nb, bid); } SEAM(2);
#else
    if (IN(2)) { PH_BEGIN ref_attention(WSP(bf16, WS_Q), WSP(bf16, WS_K), WSP(bf16, WS_V), WSP(bf16, WS_O0), WSP(bf16, WS_O1), SMALLP(float, SM_TB), sm, bid, nb); } SEAM(2);
#endif
    if (IN(3)) { PH_BEGIN const float lam = compute_lam(ka->in[7], ka->in[8], ka->in[9], ka->in[10]); combine_rows(WSP(bf16, WS_O0), WSP(bf16, WS_O1), WSP(bf16, WS_H), ka->in[11], lam, bid, nb); } SEAM(3);
    if (IN(4)) { PH_BEGIN pg8::Gemm g{WSP(bf16, WS_H), WAT(WA_O), NT, DM, DM}; pg8::StaticOrder S; S.init(NT, DM, nb, bid);
        pg8::EpiResF32 E{ka->in[0], ka->out, DM};
        pg8::gemm_phase<pg8::EpiResF32, pg8::StaticOrder, true, true>(L, g, S, E); } SEAM(4);
    if (IN(5)) { PH_BEGIN rms_rows_bf16(ka->out, ka->in[2], WSP(bf16, WS_H), bid, nb); } SEAM(5);
    if (IN(6)) { PH_BEGIN pg8::Gemm g{WSP(bf16, WS_H), WAT(WA_GU), NT, 2 * DFF, DM}; pg8::StaticOrder S; S.init(NT, 2 * DFF, nb, bid);
        pg8::EpiSwiglu E{WSP(bf16, WS_ACT), DFF};
        pg8::gemm_phase<pg8::EpiSwiglu, pg8::StaticOrder, true, true>(L, g, S, E); } SEAM(6);
    if (IN(7)) { PH_BEGIN pg8::Gemm g{WSP(bf16, WS_ACT), WAT(WA_D), NT, DM, DFF}; pg8::StaticOrder S; S.init(NT, DM, nb, bid);
        pg8::EpiResF32 E{ka->out, ka->out, DM};
        pg8::gemm_phase<pg8::EpiResF32, pg8::StaticOrder, true, true>(L, g, S, E); } SEAM(7);
    if (IN(8)) { PH_BEGIN rms_rows_bf16(ka->out, ka->in[1] + DM, WSP(bf16, WS_H), bid, nb); } SEAM(8);
    if (IN(9)) { PH_BEGIN pg8::Gemm g{WSP(bf16, WS_H), WAT(WA_IN), NT, 2 * DRNN, DM}; pg8::StaticOrder S; S.init(NT, 2 * DRNN, nb, bid);
        pg8::EpiWin E{WSP(bf16, WS_G), WSP(bf16, WS_XB), DRNN, DRNN / 256};
        pg8::gemm_phase<pg8::EpiWin, pg8::StaticOrder, true, true>(L, g, S, E); } SEAM(9);
    if (IN(10)) { PH_BEGIN ref_lru_local(WSP(bf16, WS_XB), ka->in[13], ka->in[14], ka->in[15], ka->in[16], ka->in[17], ka->in[18], ka->in[19], WSP(bf16, WS_HL), WSP(bf16, WS_CA), SMALLP(float, SM_AEND), SMALLP(float, SM_HEND), sm, bid, nb); } SEAM(10);
    if (IN(11)) { PH_BEGIN lru_carry(SMALLP(float, SM_AEND), SMALLP(float, SM_HEND), SMALLP(float, SM_CIN), bid, nb); } SEAM(11);
    if (IN(12)) { PH_BEGIN lru_fixup(WSP(bf16, WS_HL), WSP(bf16, WS_CA), WSP(bf16, WS_G), SMALLP(float, SM_CIN), WSP(bf16, WS_Y), bid, nb); } SEAM(12);
    if (IN(13)) { PH_BEGIN pg8::Gemm g{WSP(bf16, WS_Y), WAT(WA_OUT), NT, DM, DRNN}; pg8::StaticOrder S; S.init(NT, DM, nb, bid);
        pg8::EpiResF32 E{ka->out, ka->out, DM};
        pg8::gemm_phase<pg8::EpiResF32, pg8::StaticOrder, true, true>(L, g, S, E); } SEAM(13);
    if (IN(14)) { PH_BEGIN int* RE = SMALLP(int, SM_ROUTE); moe_route(ka->out, ka->in[2] + DM, ka->in[24], WSP(bf16, WS_H), RE, (float*)(RE + 2 * NT), RE + 4 * NT, SMALLP(int, SM_CNT), sm, bid, nb); } SEAM(14);
    if (IN(15)) { PH_BEGIN int* RE = SMALLP(int, SM_ROUTE); moe_scatter(RE, (float*)(RE + 2 * NT), RE + 4 * NT, SMALLP(int, SM_CNT), SMALLP(int, SM_BASE), SMALLP(int, SM_TOK), SMALLP(float, SM_GATEV), sm, bid, nb);
        __syncthreads(); convert_weights_moe(ka, ws, L, bid, nb); } SEAM(15);
    for (int sl = 0; sl < 2; ++sl) {
        if (IN(16 + 2 * sl)) { PH_BEGIN const int* tok_s = SMALLP(int, SM_TOK) + sl * SLOT_ROWS; const int* base_s = SMALLP(int, SM_BASE) + sl * 9; const int rows = base_s[8];
            pg8::Gemm g{WSP(bf16, WS_H), WSP(const pg8::bf16_t, WS_WM + WM_GU), rows, 2 * DFE, DM}; pg8::MoeOrder S; S.init_moe(rows, 2 * DFE, nb, bid, tok_s, base_s);
            pg8::EpiSwiglu E{WSP(bf16, WS_ACTM), DFE};
            pg8::gemm_phase<pg8::EpiSwiglu, pg8::MoeOrder, true, true, true>(L, g, S, E); } SEAM(16 + 2 * sl);
        if (IN(17 + 2 * sl)) { PH_BEGIN const int* tok_s = SMALLP(int, SM_TOK) + sl * SLOT_ROWS; const float* gate_s = SMALLP(float, SM_GATEV) + sl * SLOT_ROWS; const int* base_s = SMALLP(int, SM_BASE) + sl * 9; const int rows = base_s[8];
            pg8::Gemm g{WSP(bf16, WS_ACTM), WSP(const pg8::bf16_t, WS_WM + WM_D), rows, DM, DFE}; pg8::MoeOrder S; S.init_moe(rows, DM, nb, bid, tok_s, base_s);
            pg8::EpiMoeDown E{ka->out, DM, tok_s, gate_s};
            pg8::gemm_phase<pg8::EpiMoeDown, pg8::MoeOrder, true, true, false>(L, g, S, E); } SEAM(17 + 2 * sl);
    }
    if (IN(20)) { PH_BEGIN rms_rows_f32_inplace(ka->out, ka->in[3], bid, nb); }
#undef IN
#undef SEAM
}

extern "C" void kernel_launch(void* const* d_in, const int* in_sizes, int n_in, void* d_out, int out_size, void* d_ws, size_t ws_size, hipStream_t stream) {
    static int grid = 0;
    if (grid == 0) {
        if (n_in != 28 || in_sizes[0] != NT * DM || out_size != NT * DM || ws_size < WS_END) { fprintf(stderr, "kernel_launch: unexpected shapes (n_in %d, in0 %d, out %d, ws %zu); nothing launched\n", n_in, n_in > 0 ? in_sizes[0] : -1, out_size, ws_size); grid = -1; return; }
        int dev = 0, cus = 0, per_cu = 0;
        if (hipGetDevice(&dev) != hipSuccess || hipDeviceGetAttribute(&cus, hipDeviceAttributeMultiprocessorCount, dev) != hipSuccess) { grid = -1; return; }
        if (hipFuncSetAttribute((const void*)fwd, hipFuncAttributeMaxDynamicSharedMemorySize, LDS_BYTES) != hipSuccess) { fprintf(stderr, "kernel_launch: hipFuncSetAttribute failed\n"); grid = -1; return; }
        if (hipOccupancyMaxActiveBlocksPerMultiprocessor(&per_cu, (const void*)fwd, NTHR, LDS_BYTES) != hipSuccess || per_cu < 1) { fprintf(stderr, "kernel_launch: occupancy query reports %d\n", per_cu); }
        (void)hipGetLastError();
        grid = cus & ~7;
    }
    if (grid < 0) return;
    if (hipMemsetAsync((char*)d_ws + WS_CTL, 0, CTL_ZERO_BYTES, stream) != hipSuccess) return;
    Args a{};
    for (int i = 0; i < 28; ++i) a.in[i] = (const float*)d_in[i];
    a.out = (float*)d_out; a.ws = (unsigned char*)d_ws;
#if MK_ONE_LAUNCH
    a.ph_lo = 0; a.ph_hi = N_PHASES;
    hipLaunchKernelGGL(fwd, dim3(grid), dim3(NTHR), LDS_BYTES, stream, a);
#else
    for (int p = 0; p < N_PHASES; ++p) { a.ph_lo = p; a.ph_hi = p + 1; hipLaunchKernelGGL(fwd, dim3(grid), dim3(NTHR), LDS_BYTES, stream, a); }
#endif
}
```

```cpp
#include <hip/hip_runtime.h>
#include <cstdio>
#include <cstdint>

#ifndef FAST_GEMM
#define FAST_GEMM 1
#endif
#ifndef FAST_ATTN
#define FAST_ATTN 1
#endif
#ifndef FAST_LRU
#define FAST_LRU 1
#endif
#ifndef FAST_MOE
#define FAST_MOE 1
#endif
#ifndef MK_ONE_LAUNCH
#define MK_ONE_LAUNCH 1
#endif

#define GAS __attribute__((address_space(1)))
#define LAS __attribute__((address_space(3)))
typedef unsigned short bf16;
typedef unsigned v4u __attribute__((ext_vector_type(4)));
typedef unsigned v2u __attribute__((ext_vector_type(2)));
typedef float f32x4 __attribute__((ext_vector_type(4)));
typedef GAS unsigned gu32;
#define RLX_AGENT __ATOMIC_RELAXED, __HIP_MEMORY_SCOPE_AGENT

constexpr int NB_ = 4, SEQ = 8192, DM = 1024, NT = NB_ * SEQ;
constexpr int NH = 8, HD = 64, VD = 128;
constexpr int DRNN = 1280, NLB = 10, LBK = 128, CW = 4;
constexpr int DFF = 2816, NE = 8, DFE = 3584;
constexpr float NORM_EPS = 1e-6f, SUBLN_EPS = 1e-5f, LOG2E = 1.4426950408889634f;
constexpr float C2 = 0.125f * LOG2E;
constexpr float LAM_INIT = 0.2f;
constexpr int NWAVES = 8, NTHR = 512;
constexpr int LCH = 64, NCH = SEQ / LCH;
constexpr int SLOT_ROWS = NT + NE * 256;

constexpr size_t MiB = 1u << 20;
constexpr size_t WS_CTL = 0, CTL_ZERO_BYTES = 1 * MiB;
constexpr size_t WS_SMALL = 1 * MiB;
constexpr size_t SM_TB = 0;
constexpr size_t SM_ROUTE = 64 * 1024;
constexpr size_t SM_CNT = 1 * MiB;
constexpr size_t SM_BASE = 1 * MiB + 16 * 1024;
constexpr size_t SM_TOK = 2 * MiB;
constexpr size_t SM_GATEV = 2 * MiB + 512 * 1024;
constexpr size_t SM_AEND = 4 * MiB;
constexpr size_t SM_HEND = 7 * MiB;
constexpr size_t SM_CIN = 10 * MiB;
constexpr size_t WS_WA = 17 * MiB;
constexpr size_t WS_WM = 50 * MiB;
constexpr size_t WS_O0 = 50 * MiB, WS_O1 = 114 * MiB;
constexpr size_t WS_HL = 50 * MiB, WS_CA = 130 * MiB;
constexpr size_t WS_H = 218 * MiB;
constexpr size_t WS_SCR = 282 * MiB;
constexpr size_t WS_Q = WS_SCR, WS_K = WS_SCR + 64 * MiB, WS_V = WS_SCR + 128 * MiB;
constexpr size_t WS_ACT = WS_SCR;
constexpr size_t WS_G = WS_SCR, WS_XB = WS_SCR + 80 * MiB, WS_Y = WS_SCR + 160 * MiB;
constexpr size_t WS_ACTM = WS_SCR;
constexpr size_t WS_END = 522 * MiB;
static_assert(WS_ACTM + (size_t)SLOT_ROWS * DFE * 2 <= WS_END && WS_Y + (size_t)NT * DRNN * 2 <= WS_END, "ws map");
static_assert(SM_CIN + (size_t)NB_ * NCH * DRNN * 4 <= 16 * MiB, "small map");
constexpr int CW_BAR = 4096, CW_TICKET = 8192;

__device__ __forceinline__ int fresh_tid() { int t = threadIdx.x; asm volatile("" : "+v"(t)); return t; }
__device__ __forceinline__ unsigned f2bf(float f) { unsigned u = __builtin_bit_cast(unsigned, f); return (u + 0x7fffu + ((u >> 16) & 1u)) >> 16; }
__device__ __forceinline__ unsigned pk2(float lo, float hi) { return f2bf(lo) | (f2bf(hi) << 16); }
__device__ __forceinline__ float bflo(unsigned u) { return __builtin_bit_cast(float, u << 16); }
__device__ __forceinline__ float bfhi(unsigned u) { return __builtin_bit_cast(float, u & 0xffff0000u); }
__device__ __forceinline__ float bf2f(bf16 v) { return __builtin_bit_cast(float, (unsigned)v << 16); }
__device__ __forceinline__ float wave_sum(float v) {
#pragma unroll
    for (int o = 1; o < 64; o <<= 1) v += __shfl_xor(v, o);
    return v;
}
__device__ __forceinline__ float sigmoidf_(float x) { return 1.f / (1.f + __expf(-x)); }

#define XB_TMO      128
#define XB_XCNT(j)  (256  + 64 * (j))
#define XB_XSUB(j)  (1280 + 64 * (j))
#define XB_XGEN(j)  (2304 + 64 * (j))
#define XB_TOP      3328
#define XB_TOPGEN   3392
#define XCD_BAR_WORDS 3456
#define XB_SPIN_CAP (1u << 18)
__device__ __forceinline__ unsigned xb_ld(unsigned* p)              { return __hip_atomic_load(p, __ATOMIC_RELAXED, __HIP_MEMORY_SCOPE_AGENT); }
__device__ __forceinline__ unsigned xb_add(unsigned* p, unsigned v) { return __hip_atomic_fetch_add(p, v, __ATOMIC_RELAXED, __HIP_MEMORY_SCOPE_AGENT); }
__device__ __forceinline__ unsigned xb_xcc_id() { return (unsigned)__builtin_amdgcn_s_getreg((3 << 11) | 20) & 0xFu; }
#define XB_SPIN(cond, bar) do { unsigned _sp = 0; while (cond) { __builtin_amdgcn_s_sleep(1); \
    if ((++_sp & 255u) == 0u) { if (xb_ld(&(bar)[XB_TMO])) break; if (_sp > XB_SPIN_CAP) { atomicAdd(&(bar)[XB_TMO], 1u); break; } } } } while (0)
struct XcdBarrier { unsigned* bar; unsigned x; volatile LAS unsigned* st; };
__device__ __forceinline__ XcdBarrier xcd_barrier_post(unsigned* bar, volatile LAS unsigned* st) {
    XcdBarrier b; b.bar = bar; b.x = xb_xcc_id(); b.st = st;
    if (threadIdx.x == 0) (void)xb_add(&bar[XB_XCNT(b.x)], 1u);
    return b;
}
__device__ __forceinline__ void xcd_barrier_complete(unsigned* bar, unsigned x, unsigned& nloc, unsigned& nx) {
    const unsigned G = gridDim.x * gridDim.y * gridDim.z;
    unsigned sum, cnt, mine, sp = 0u;
    for (;;) {
        sum = 0u; cnt = 0u; mine = 0u;
#pragma unroll
        for (unsigned j = 0; j < 16; ++j) { const unsigned c = xb_ld(&bar[XB_XCNT(j)]); sum += c; cnt += (c > 0u) ? 1u : 0u; mine = (j == x) ? c : mine; }
        if (sum == G) break;
        __builtin_amdgcn_s_sleep(1);
        if ((++sp & 255u) == 0u) { if (xb_ld(&bar[XB_TMO])) break; if (sp > XB_SPIN_CAP) { atomicAdd(&bar[XB_TMO], 1u); break; } }
    }
    nloc = mine > 0u ? mine : 1u; nx = cnt > 0u ? cnt : 1u;
}
__device__ __forceinline__ void xcd_barrier(const XcdBarrier& b) {
    asm volatile("s_waitcnt vmcnt(0)" ::: "memory");
    __syncthreads();
    if (threadIdx.x == 0) {
        unsigned* bar = b.bar;
        __builtin_amdgcn_s_waitcnt(0);
        unsigned nloc = b.st[0], nx = b.st[1];
        if (nloc == 0u) { xcd_barrier_complete(bar, b.x, nloc, nx); b.st[0] = nloc; b.st[1] = nx; }
        const unsigned old = xb_add(&bar[XB_XSUB(b.x)], 1u);
        const unsigned gen = old / nloc;
        if (old + 1u == (gen + 1u) * nloc) {
            __builtin_amdgcn_fence(__ATOMIC_RELEASE, "agent");
            asm volatile("s_waitcnt vmcnt(0)" ::: "memory");
            const unsigned og = xb_add(&bar[XB_TOP], 1u);
            const unsigned tg = og / nx;
            if (og + 1u == (tg + 1u) * nx) xb_add(&bar[XB_TOPGEN], 1u);
            else XB_SPIN(xb_ld(&bar[XB_TOPGEN]) == tg, bar);
            __builtin_amdgcn_fence(__ATOMIC_ACQUIRE, "agent");
            xb_add(&bar[XB_XGEN(b.x)], 1u);
            asm volatile("s_waitcnt vmcnt(0)" ::: "memory");
        } else {
            XB_SPIN(xb_ld(&bar[XB_XGEN(b.x)]) == gen, bar);
            __builtin_amdgcn_fence(__ATOMIC_ACQUIRE, "agent");
            asm volatile("s_waitcnt vmcnt(0)" ::: "memory");
        }
    }
    __syncthreads();
}

namespace pg8 {
#define PG8_LAS __attribute__((address_space(3)))
typedef unsigned short bf16_t;
typedef short bf16x8 __attribute__((ext_vector_type(8)));
typedef float f32x4 __attribute__((ext_vector_type(4)));
typedef unsigned u32x4 __attribute__((ext_vector_type(4)));
constexpr int BM = 256, BK = 64, HALF = 128, HTB = HALF * BK * 2  , STAGE_BYTES = 8 * HTB, NXCD = 8, WGM = 8;

__host__ __device__ __forceinline__ int lds_byte(int r, int c) { const int st = (r >> 4) * 2 + (c >> 5), rr = r & 15, cc = c & 31, ob = rr * 64 + cc * 2; return st * 1024 + (ob ^ (((ob >> 9) & 1) << 5)); }
__host__ __device__ __forceinline__ void stage_rc(int b, int& R, int& C) { const int st = b / 1024, sb = b % 1024, swz = sb ^ (((sb >> 9) & 1) << 5); R = (st >> 1) * 16 + swz / 64; C = (st & 1) * 32 + (swz % 64) / 2; }
__host__ __device__ __forceinline__ int perm32(int rho) { const int n = rho >> 4, i = rho & 15; return 8 * (i >> 2) + 4 * n + (i & 3); }

struct Unit { int pm, pn, pb; };
struct Gemm { const bf16_t* A; const bf16_t* Bt; int M, N, K; };

struct StaticOrder {
    int nM, nN, nwg, G, c;
    __host__ __device__ void init(int M, int N, int G_, int c_) { nM = M / BM; nN = N / BM; nwg = nM * nN; G = G_; c = c_; }
    __host__ __device__ bool next(int i, Unit& u) const {
        const long L = (long)i * G + c; if (L >= nwg) return false;
        int wgid = (int)L; { const int q = nwg / NXCD, r = nwg % NXCD, xcd = wgid % NXCD, off = wgid / NXCD; wgid = (xcd < r ? xcd * (q + 1) : r * (q + 1) + (xcd - r) * q) + off; }
        const int nig = WGM * nN, gid = wgid / nig, fm = gid * WGM, gsz = (nM - fm) < WGM ? (nM - fm) : WGM;
        u.pm = fm + ((wgid % nig) % gsz); u.pn = (wgid % nig) / gsz; u.pb = u.pn; return true;
    }
    __device__ __forceinline__ void a_ready(const Unit&) const {}
    __device__ __forceinline__ void done(const Unit&) const {}
};

__device__ __forceinline__ unsigned cvt_pk_bf16(float lo, float hi) { unsigned r; asm volatile("v_cvt_pk_bf16_f32 %0, %1, %2" : "=v"(r) : "v"(lo), "v"(hi)); return r; }
typedef float f32x2 __attribute__((ext_vector_type(2)));

template <int ACT  > struct EpiBf16 {
    static constexpr bool PERM = true, AFTER_DRAIN = false; static_assert(ACT == 0, "EpiBf16: only ACT 0 here");
    bf16_t* O; int ldc; const float* bias; int split_cols; size_t split_stride; float scale0;
    __device__ __forceinline__ void operator()(const f32x4 (&acc)[2][2][4][2], const Unit& u, int wr, int wc, int fr, int fq) const {
        const int row0 = u.pm * BM + wr * 64 + fr; int colt = u.pn * BM; bf16_t* base = O;
        float sc = 1.f; if (split_cols) { const int t = colt / split_cols; base += (size_t)t * split_stride; colt -= t * split_cols; if (t == 0) sc = scale0; }
        const int col0 = colt + wc * 32 + 8 * fq, bcol0 = u.pn * BM + wc * 32 + 8 * fq;
        f32x4 bv[2][2];
#pragma unroll
        for (int bj = 0; bj < 2; ++bj)
#pragma unroll
            for (int n = 0; n < 2; ++n) bv[bj][n] = bias ? *(const f32x4*)(bias + bcol0 + bj * HALF + 4 * n) : (f32x4){0.f, 0.f, 0.f, 0.f};
#pragma unroll
        for (int ai = 0; ai < 2; ++ai)
#pragma unroll
            for (int m = 0; m < 4; ++m) { bf16_t* rowp = base + (size_t)(row0 + ai * HALF + m * 16) * ldc + col0;
#pragma unroll
                for (int bj = 0; bj < 2; ++bj) { f32x4 v0 = acc[ai][bj][m][0] + bv[bj][0], v1 = acc[ai][bj][m][1] + bv[bj][1];
                    v0 = v0 * sc; v1 = v1 * sc; u32x4 w; w.x = cvt_pk_bf16(v0[0], v0[1]); w.y = cvt_pk_bf16(v0[2], v0[3]); w.z = cvt_pk_bf16(v1[0], v1[1]); w.w = cvt_pk_bf16(v1[2], v1[3]);
                    *(u32x4*)(rowp + bj * HALF) = w; } }
    }
};

__device__ __forceinline__ float silu_f(float x) { return x * __builtin_amdgcn_rcpf(1.0f + __builtin_amdgcn_exp2f(-1.4426950408889634f * x)); }
__device__ __forceinline__ float gelu_tanh_f(float x) { const float u = x * (0.7978845608028654f + 0.035677408136300125f * x * x);
    return x * __builtin_amdgcn_rcpf(1.0f + __builtin_amdgcn_exp2f(-2.0f * 1.4426950408889634f * u)); }
struct EpiResF32 {
    static constexpr bool PERM = false, AFTER_DRAIN = false;
    const float* base; float* out; int ldc;
    __device__ __forceinline__ void operator()(const f32x4 (&acc)[2][2][4][2], const Unit& u, int wr, int wc, int fr, int fq) const {
        const int row0 = u.pm * BM + wr * 64 + fr, col0 = u.pn * BM + wc * 32 + 4 * fq;
#pragma unroll
        for (int ai = 0; ai < 2; ++ai)
#pragma unroll
            for (int m = 0; m < 4; ++m) { const size_t off = (size_t)(row0 + ai * HALF + m * 16) * ldc + col0;
                f32x4 b[2][2];
#pragma unroll
                for (int bj = 0; bj < 2; ++bj)
#pragma unroll
                    for (int n = 0; n < 2; ++n) b[bj][n] = *(const f32x4*)(base + off + bj * HALF + n * 16);
#pragma unroll
                for (int bj = 0; bj < 2; ++bj)
#pragma unroll
                    for (int n = 0; n < 2; ++n) *(f32x4*)(out + off + bj * HALF + n * 16) = b[bj][n] + acc[ai][bj][m][n];
                asm volatile("" ::: "memory"); }
    }
};
struct EpiSwiglu {
    static constexpr bool PERM = true, AFTER_DRAIN = false;
    bf16_t* O; int ldc;
    __device__ __forceinline__ void operator()(const f32x4 (&acc)[2][2][4][2], const Unit& u, int wr, int wc, int fr, int fq) const {
        const int row0 = u.pm * BM + wr * 64 + fr, col0 = u.pn * HALF + wc * 32 + 8 * fq;
#pragma unroll
        for (int ai = 0; ai < 2; ++ai)
#pragma unroll
            for (int m = 0; m < 4; ++m) { bf16_t* rowp = O + (size_t)(row0 + ai * HALF + m * 16) * ldc + col0;
                const f32x4 g0 = acc[ai][0][m][0], g1 = acc[ai][0][m][1], u0 = acc[ai][1][m][0], u1 = acc[ai][1][m][1];
                u32x4 w; w.x = cvt_pk_bf16(silu_f(g0[0]) * u0[0], silu_f(g0[1]) * u0[1]); w.y = cvt_pk_bf16(silu_f(g0[2]) * u0[2], silu_f(g0[3]) * u0[3]);
                w.z = cvt_pk_bf16(silu_f(g1[0]) * u1[0], silu_f(g1[1]) * u1[1]); w.w = cvt_pk_bf16(silu_f(g1[2]) * u1[2], silu_f(g1[3]) * u1[3]);
                *(u32x4*)rowp = w; }
    }
};
struct EpiWin {
    static constexpr bool PERM = true, AFTER_DRAIN = false;
    bf16_t* G; bf16_t* XB; int ldc; int nsplit;
    __device__ __forceinline__ void operator()(const f32x4 (&acc)[2][2][4][2], const Unit& u, int wr, int wc, int fr, int fq) const {
        const bool isg = u.pn < nsplit; bf16_t* base = isg ? G : XB; const int colt = (isg ? u.pn : u.pn - nsplit) * BM;
        const int row0 = u.pm * BM + wr * 64 + fr, col0 = colt + wc * 32 + 8 * fq;
#pragma unroll
        for (int ai = 0; ai < 2; ++ai)
#pragma unroll
            for (int m = 0; m < 4; ++m) { bf16_t* rowp = base + (size_t)(row0 + ai * HALF + m * 16) * ldc + col0;
#pragma unroll
                for (int bj = 0; bj < 2; ++bj) { f32x4 v0 = acc[ai][bj][m][0], v1 = acc[ai][bj][m][1];
                    if (isg) { v0 = (f32x4){gelu_tanh_f(v0[0]), gelu_tanh_f(v0[1]), gelu_tanh_f(v0[2]), gelu_tanh_f(v0[3])}; v1 = (f32x4){gelu_tanh_f(v1[0]), gelu_tanh_f(v1[1]), gelu_tanh_f(v1[2]), gelu_tanh_f(v1[3])}; }
                    u32x4 w; w.x = cvt_pk_bf16(v0[0], v0[1]); w.y = cvt_pk_bf16(v0[2], v0[3]); w.z = cvt_pk_bf16(v1[0], v1[1]); w.w = cvt_pk_bf16(v1[2], v1[3]);
                    *(u32x4*)(rowp + bj * HALF) = w; } }
    }
};
struct EpiMoeDown {
    static constexpr bool PERM = false, AFTER_DRAIN = false;
    float* out; int ldc; const int* tok; const float* gatev;
    __device__ __forceinline__ void operator()(const f32x4 (&acc)[2][2][4][2], const Unit& u, int wr, int wc, int fr, int fq) const {
        const int row0 = u.pm * BM + wr * 64 + fr, col0 = u.pn * BM + wc * 32 + 4 * fq;
#pragma unroll
        for (int ai = 0; ai < 2; ++ai)
#pragma unroll
            for (int m = 0; m < 4; ++m) { const int r = row0 + ai * HALF + m * 16; const int t = tok[r]; const float g = gatev[r];
                if (t >= 0) { float* o = out + (size_t)t * ldc + col0; f32x4 b[2][2];
#pragma unroll
                    for (int bj = 0; bj < 2; ++bj)
#pragma unroll
                        for (int n = 0; n < 2; ++n) b[bj][n] = *(const f32x4*)(o + bj * HALF + n * 16);
#pragma unroll
                    for (int bj = 0; bj < 2; ++bj)
#pragma unroll
                        for (int n = 0; n < 2; ++n) *(f32x4*)(o + bj * HALF + n * 16) = b[bj][n] + acc[ai][bj][m][n] * g; }
                asm volatile("" ::: "memory"); }
    }
};
struct MoeOrder : StaticOrder {
    const int* tok; int gb[8]; int nNe;
    __device__ void init_moe(int rows, int N, int G_, int c_, const int* tok_, const int* base) { init(rows, N, G_, c_); tok = tok_; nNe = N / BM;
#pragma unroll
        for (int j = 0; j < 8; ++j) gb[j] = base[j]; }
    __device__ __forceinline__ bool next(int i, Unit& u) const {
        if (!StaticOrder::next(i, u)) return false;
        int e = 0;
#pragma unroll
        for (int j = 1; j < 8; ++j) e += (u.pm * BM >= gb[j]) ? 1 : 0;
        u.pb = e * nNe + u.pn; return true; }
    __device__ __forceinline__ int arow(int r) const { const int t = tok[r]; return t < 0 ? 0 : t; }
};

template <class Epi, class Sched, bool ALIGN_EPI = false, bool SP2 = false, bool GATHER = false>
__device__ __forceinline__ void gemm_phase(PG8_LAS unsigned char* lds, const Gemm g, const Sched& S, const Epi& E) {
    int tid_ = threadIdx.x; asm volatile("" : "+v"(tid_));
    const int tid = tid_, wid = __builtin_amdgcn_readfirstlane(tid >> 6), lane = tid & 63, wr = wid >> 2, wc = wid & 3, fr = lane & 15, fq = lane >> 4;
    static_assert(!GATHER || SP2, "GATHER is written for the SP2 loop");
    const int K = g.K, nt = K / BK;
    unsigned voffA[2], voffB[2];
#pragma unroll
    for (int i = 0; i < 2; ++i) { int R, C; stage_rc(tid * 16 + i * 8192, R, C); const int Rb = Epi::PERM ? ((R & ~31) + perm32(R & 31)) : R;
        voffA[i] = (unsigned)(R * K + C) * 2u; voffB[i] = (unsigned)(Rb * K + C) * 2u; }
    unsigned tk[2], tn[2]; unsigned cC2 = 0; int gR0 = 0;
    if constexpr (GATHER) { int R_, C_; stage_rc(tid * 16, R_, C_); gR0 = R_; cC2 = (unsigned)C_ * 2u; }
#define PG8_GTOK(dst, u) do { _Pragma("unroll") for (int _h = 0; _h < 2; ++_h) dst[_h] = (unsigned)S.arow((u).pm * BM + _h * HALF + gR0) | ((unsigned)S.arow((u).pm * BM + _h * HALF + gR0 + 64) << 16); } while (0)
    const size_t kstep = (size_t)(BK * 2);
    const size_t hstep = (size_t)HALF * K * 2;
    const size_t tstep = 2 * hstep;
    const unsigned ldsw = (unsigned)wid * 1024u;
    const int aoff = lds_byte(wr * 64 + fr, fq * 8), boff = lds_byte(wc * 32 + fr, fq * 8);
#define PG8_SA(b, h) (((b) * 2 + (h)) * HTB)
#define PG8_SB(b, h) ((4 + (b) * 2 + (h)) * HTB)
#define PG8_STAGE(bufoff, gbase, voff) do { _Pragma("unroll") for (int _i = 0; _i < 2; ++_i) \
        __builtin_amdgcn_global_load_lds((const unsigned*)((const char*)(gbase) + (voff)[_i]), (PG8_LAS unsigned*)(lds + (bufoff) + ldsw + _i * 8192), 16, 0, 0); } while (0)
#define PG8_STAGEG(bufoff, gbase, tkw) do { _Pragma("unroll") for (int _i = 0; _i < 2; ++_i) { const unsigned _o = (((tkw) >> (16 * _i)) & 0xffffu) * (unsigned)(K * 2) + cC2; \
        __builtin_amdgcn_global_load_lds((const unsigned*)((const char*)(gbase) + _o), (PG8_LAS unsigned*)(lds + (bufoff) + ldsw + _i * 8192), 16, 0, 0); } } while (0)
#define PG8_STA(bufoff, ptr, h, nx) do { if constexpr (GATHER) { if (nx) PG8_STAGEG(bufoff, ptr, tn[h]); else PG8_STAGEG(bufoff, ptr, tk[h]); } else PG8_STAGE(bufoff, (ptr) + (h) * hstep, voffA); } while (0)
#define PG8_LDA(dst, b, h) do { _Pragma("unroll") for (int m = 0; m < 4; ++m) _Pragma("unroll") for (int k = 0; k < 2; ++k) dst[m][k] = *(const PG8_LAS bf16x8*)(lds + PG8_SA(b, h) + aoff + m * 2048 + k * 1024); } while (0)
#define PG8_LDB(dst, b, h) do { _Pragma("unroll") for (int n = 0; n < 2; ++n) _Pragma("unroll") for (int k = 0; k < 2; ++k) dst[n][k] = *(const PG8_LAS bf16x8*)(lds + PG8_SB(b, h) + boff + n * 2048 + k * 1024); } while (0)
#define PG8_MMA(ai, bj, At, Bt) do { __builtin_amdgcn_s_setprio(1); _Pragma("unroll") for (int m = 0; m < 4; ++m) _Pragma("unroll") for (int n = 0; n < 2; ++n) _Pragma("unroll") for (int k = 0; k < 2; ++k) \
        acc[ai][bj][m][n] = __builtin_amdgcn_mfma_f32_16x16x32_bf16(Bt[n][k], At[m][k], acc[ai][bj][m][n], 0, 0, 0); __builtin_amdgcn_s_setprio(0); } while (0)
#define PG8_WAIT_V(n) asm volatile("s_waitcnt vmcnt(" #n ")" ::: "memory")
#define PG8_WAIT_L(n) asm volatile("s_waitcnt lgkmcnt(" #n ")" ::: "memory")
#define PG8_BAR __builtin_amdgcn_s_barrier()
#define PG8_SCHED __builtin_amdgcn_sched_barrier(0)
    Unit cur, nxt; int ui = 0;
    if (!S.next(0, cur)) return;
    f32x4 acc[2][2][4][2];
#pragma unroll
    for (int a = 0; a < 2; ++a)
#pragma unroll
        for (int b = 0; b < 2; ++b)
#pragma unroll
            for (int m = 0; m < 4; ++m)
#pragma unroll
                for (int n = 0; n < 2; ++n) acc[a][b][m][n] = (f32x4){0.f, 0.f, 0.f, 0.f};
    bf16x8 At[4][2], B0[2][2], B1[2][2];
    const char* cA = GATHER ? (const char*)g.A : (const char*)g.A + (size_t)cur.pm * tstep; const char* cB = (const char*)g.Bt + (size_t)cur.pb * tstep;
    if constexpr (GATHER) { PG8_GTOK(tk, cur); }
    S.a_ready(cur);
    if constexpr (SP2) {
        PG8_STAGE(PG8_SB(0, 0), cB, voffB); PG8_STAGE(PG8_SB(0, 1), cB + hstep, voffB); PG8_STA(PG8_SA(0, 0), cA, 0, false); PG8_STA(PG8_SA(0, 1), cA, 1, false);
        if (wr == 1) PG8_BAR;
        PG8_WAIT_V(2); PG8_BAR;
        PG8_STAGE(PG8_SB(1, 0), cB + kstep, voffB); PG8_STA(PG8_SA(1, 0), cA + kstep, 0, false); PG8_STAGE(PG8_SB(1, 1), cB + hstep + kstep, voffB);
        PG8_WAIT_V(6); PG8_BAR;
    } else {
        PG8_STAGE(PG8_SB(0, 0), cB, voffB); PG8_STAGE(PG8_SA(0, 0), cA, voffA); PG8_STAGE(PG8_SB(0, 1), cB + hstep, voffB); PG8_STAGE(PG8_SA(0, 1), cA + hstep, voffA);
        if (wr == 1) PG8_BAR;
        PG8_WAIT_V(4); PG8_BAR;
        PG8_STAGE(PG8_SB(1, 0), cB + kstep, voffB); PG8_STAGE(PG8_SA(1, 0), cA + kstep, voffA); PG8_STAGE(PG8_SB(1, 1), cB + hstep + kstep, voffB);
        PG8_WAIT_V(6); PG8_BAR;
    }
    for (;;) {
        const bool has_next = S.next(ui + 1, nxt);
        if constexpr (GATHER) { if (has_next) { PG8_GTOK(tn, nxt); } else { tn[0] = tk[0]; tn[1] = tk[1]; } }
        const char* nA = GATHER ? (const char*)g.A : (has_next ? (const char*)g.A + (size_t)nxt.pm * tstep : cA); const char* nB = has_next ? (const char*)g.Bt + (size_t)nxt.pb * tstep : cB;
        for (int t = 0; t < nt; t += 2) {
            const bool last = (t == nt - 2);
            const char* a1 = cA + (size_t)(t + 1) * kstep;
            const char* a2 = last ? nA : cA + (size_t)(t + 2) * kstep; const char* b2 = last ? nB : cB + (size_t)(t + 2) * kstep;
            const char* a3 = a2 + kstep; const char* b3 = b2 + kstep;
            if (last && has_next) S.a_ready(nxt);
            if constexpr (SP2) {
            PG8_LDB(B0, 0, 0); PG8_LDB(B1, 0, 1); PG8_SCHED; PG8_LDA(At, 0, 0); PG8_STA(PG8_SA(1, 1), a1, 1, false);
            PG8_WAIT_V(8); PG8_WAIT_L(0); PG8_BAR; PG8_MMA(0, 0, At, B0); PG8_MMA(0, 1, At, B1); PG8_BAR; PG8_SCHED;
            PG8_LDA(At, 0, 1); PG8_STAGE(PG8_SB(0, 0), b2, voffB); PG8_STAGE(PG8_SB(0, 1), b2 + hstep, voffB); PG8_STA(PG8_SA(0, 0), a2, 0, last);
            PG8_WAIT_V(8); PG8_WAIT_L(0); PG8_BAR; PG8_MMA(1, 0, At, B0); PG8_MMA(1, 1, At, B1); PG8_BAR; PG8_SCHED;
            PG8_LDB(B0, 1, 0); PG8_LDB(B1, 1, 1); PG8_SCHED; PG8_LDA(At, 1, 0); PG8_STA(PG8_SA(0, 1), a2, 1, last);
            PG8_WAIT_V(8); PG8_WAIT_L(0); PG8_BAR; PG8_MMA(0, 0, At, B0); PG8_MMA(0, 1, At, B1); PG8_BAR; PG8_SCHED;
            PG8_LDA(At, 1, 1); PG8_STAGE(PG8_SB(1, 0), b3, voffB); PG8_STAGE(PG8_SB(1, 1), b3 + hstep, voffB); PG8_STA(PG8_SA(1, 0), a3, 0, last);
            PG8_WAIT_V(8); PG8_WAIT_L(0); PG8_BAR; PG8_MMA(1, 0, At, B0); PG8_MMA(1, 1, At, B1); PG8_BAR; PG8_SCHED;
            } else {
            PG8_LDB(B0, 0, 0); PG8_SCHED; PG8_LDA(At, 0, 0); PG8_STAGE(PG8_SA(1, 1), a1 + hstep, voffA);
            PG8_WAIT_L(8); PG8_BAR; PG8_WAIT_L(0); PG8_MMA(0, 0, At, B0); PG8_BAR; PG8_SCHED;
            PG8_LDB(B1, 0, 1); PG8_STAGE(PG8_SB(0, 0), b2, voffB);
            PG8_BAR; PG8_WAIT_L(0); PG8_MMA(0, 1, At, B1); PG8_BAR;
            PG8_LDA(At, 0, 1); PG8_STAGE(PG8_SA(0, 0), a2, voffA);
            PG8_BAR; PG8_WAIT_L(0); PG8_MMA(1, 0, At, B0); PG8_BAR; PG8_SCHED;
            PG8_STAGE(PG8_SB(0, 1), b2 + hstep, voffB);
            PG8_WAIT_V(6); PG8_BAR; PG8_MMA(1, 1, At, B1); PG8_BAR;
            PG8_LDB(B0, 1, 0); PG8_SCHED; PG8_LDA(At, 1, 0); PG8_STAGE(PG8_SA(0, 1), a2 + hstep, voffA);
            PG8_WAIT_L(8); PG8_BAR; PG8_WAIT_L(0); PG8_MMA(0, 0, At, B0); PG8_BAR; PG8_SCHED;
            PG8_LDB(B1, 1, 1); PG8_STAGE(PG8_SB(1, 0), b3, voffB);
            PG8_BAR; PG8_WAIT_L(0); PG8_MMA(0, 1, At, B1); PG8_BAR;
            PG8_LDA(At, 1, 1); PG8_STAGE(PG8_SA(1, 0), a3, voffA);
            PG8_BAR; PG8_WAIT_L(0); PG8_MMA(1, 0, At, B0); PG8_BAR; PG8_SCHED;
            PG8_STAGE(PG8_SB(1, 1), b3 + hstep, voffB);
            PG8_WAIT_V(6); PG8_BAR; PG8_MMA(1, 1, At, B1); PG8_BAR;
            }
        }
        if constexpr (ALIGN_EPI) { if (wr == 0) PG8_BAR; }
        if constexpr (!Epi::AFTER_DRAIN) { E(acc, cur, wr, wc, fr, fq); S.done(cur); }
        if (!has_next) break;
#pragma unroll
        for (int a = 0; a < 2; ++a)
#pragma unroll
            for (int b = 0; b < 2; ++b)
#pragma unroll
                for (int m = 0; m < 4; ++m)
#pragma unroll
                    for (int n = 0; n < 2; ++n) acc[a][b][m][n] = (f32x4){0.f, 0.f, 0.f, 0.f};
        cur = nxt; cA = nA; cB = nB; ++ui;
        if constexpr (GATHER) { tk[0] = tn[0]; tk[1] = tn[1]; }
        if constexpr (ALIGN_EPI) { if (wr == 1) PG8_BAR; }
    }
    PG8_WAIT_V(0);
    if constexpr (!ALIGN_EPI) { if (wr == 0) PG8_BAR; }
    PG8_BAR;
    if constexpr (Epi::AFTER_DRAIN) { E.fused(acc, cur, wr, wc, fr, fq, lds, wid, lane); S.done(cur); }
#undef PG8_SA
#undef PG8_SB
#undef PG8_STAGE
#undef PG8_STA
#undef PG8_STAGEG
#undef PG8_GTOK
#undef PG8_LDA
#undef PG8_LDB
#undef PG8_MMA
#undef PG8_WAIT_V
#undef PG8_WAIT_L
#undef PG8_BAR
#undef PG8_SCHED
}
}

#include <hip/hip_bf16.h>
#include <cmath>
namespace attn_body {
using bf16=__hip_bfloat16;
using bf16x8=__attribute__((ext_vector_type(8)))short;
using s16x4=__attribute__((ext_vector_type(4)))short;
using f32x16=__attribute__((ext_vector_type(16)))float;
using u32x4=__attribute__((ext_vector_type(4)))unsigned;
constexpr int BATCH=4,NHEAD=16,SEQ=8192,D=64,DM=NHEAD*D;
constexpr int NW=8,QBLK=32,QB=QBLK*NW,KVBLK=64,NQB=SEQ/QB;
constexpr int ATTN_PITCH=DM, ATTN_UNIT_ROWS=QB;
__device__ __forceinline__ int crow(int r,int hi){return (r&3)+8*(r>>2)+4*hi;}
#define SBAR() __builtin_amdgcn_sched_barrier(0)
typedef __attribute__((address_space(3))) const float* lds_cfptr;
__device__ __forceinline__ void cmask(f32x16&p0,f32x16&p1,int jb,int qrel,int hi,lds_cfptr tabd){
  const float NEG=-INFINITY; const int d0=qrel-(64*jb+4*hi);
  #pragma unroll
  for(int r=0;r<16;++r){const int dA=d0-((r&3)+8*(r>>2)),dB=dA-32;
    const float tA=tabd[dA<0?0:(dA>127?127:dA)],tB=tabd[dB<0?0:(dB>127?127:dB)];
    p0[r]=dA<0?NEG:p0[r]+tA; p1[r]=dB<0?NEG:p1[r]+tB;}
}

constexpr int NSLOT=3, SLOTB=8192;
constexpr int LDS_K=0, LDS_V=NSLOT*SLOTB, LDS_WS=2*NSLOT*SLOTB, LDS_OST=LDS_WS+NW*64*4, LDS_BYTES=LDS_OST+NW*4096;
constexpr float C2=0.125f*1.4426950408889634f;
__device__ __forceinline__ void glds16(const void*sbase,unsigned voff,unsigned lds_dst){unsigned keep;
  asm volatile("s_mov_b32 %0, m0\n\ts_mov_b32 m0, %3\n\ts_nop 0\n\tglobal_load_lds_dwordx4 %1, %2\n\ts_mov_b32 m0, %0":"=&s"(keep):"v"(voff),"s"(sbase),"s"(lds_dst):"memory");}
__device__ __forceinline__ float max3f(float a,float b,float c){float r;asm("v_max3_f32 %0, %1, %2, %3":"=v"(r):"v"(a),"v"(b),"v"(c));return r;}
__device__ __forceinline__ float max2f(float a,float b){float r;asm("v_max_f32_e32 %0, %1, %2":"=v"(r):"v"(a),"v"(b));return r;}
__device__ __forceinline__ float fadd_s(float a,float b){float r;asm("v_add_f32_e32 %0, %1, %2":"=v"(r):"v"(a),"v"(b));return r;}
__device__ __forceinline__ float fsub_s(float a,float b){float r;asm("v_sub_f32_e32 %0, %1, %2":"=v"(r):"v"(a),"v"(b));return r;}
typedef float f32x2_t __attribute__((ext_vector_type(2))); typedef __bf16 bf16x2_t __attribute__((ext_vector_type(2)));
__device__ __forceinline__ unsigned cvtpk_s(float lo,float hi){f32x2_t v={lo,hi};bf16x2_t b=__builtin_convertvector(v,bf16x2_t);return __builtin_bit_cast(unsigned,b);}
#define WAIT_BAR(N) asm volatile("s_waitcnt vmcnt(" #N ") lgkmcnt(0)\n\ts_barrier":::"memory")

__device__ __forceinline__ void qkt(f32x16&p0,f32x16&p1,const char*Kslot,const bf16x8*qr,const f32x16&negm,int r32,int hi){
  const char*kb=Kslot+hi*1024+r32*16;
  #pragma unroll
  for(int d0=0;d0<4;++d0){
    const bf16x8 b0=*reinterpret_cast<const bf16x8*>(kb+d0*2048);
    const bf16x8 b1=*reinterpret_cast<const bf16x8*>(kb+d0*2048+512);
    if(d0==0){p0=__builtin_amdgcn_mfma_f32_32x32x16_bf16(b0,qr[0],negm,0,0,0);p1=__builtin_amdgcn_mfma_f32_32x32x16_bf16(b1,qr[0],negm,0,0,0);}
    else{p0=__builtin_amdgcn_mfma_f32_32x32x16_bf16(b0,qr[d0],p0,0,0,0);p1=__builtin_amdgcn_mfma_f32_32x32x16_bf16(b1,qr[d0],p1,0,0,0);}}
}
typedef __attribute__((address_space(3))) const char* lds_cptr;
typedef short v4i16_t __attribute__((ext_vector_type(4)));
__device__ __forceinline__ void kload8(bf16x8*kf,lds_cptr kp){
  kf[0]=*(const __attribute__((address_space(3))) bf16x8*)(kp);      kf[1]=*(const __attribute__((address_space(3))) bf16x8*)(kp+512);
  kf[2]=*(const __attribute__((address_space(3))) bf16x8*)(kp+2048); kf[3]=*(const __attribute__((address_space(3))) bf16x8*)(kp+2560);
  kf[4]=*(const __attribute__((address_space(3))) bf16x8*)(kp+4096); kf[5]=*(const __attribute__((address_space(3))) bf16x8*)(kp+4608);
  kf[6]=*(const __attribute__((address_space(3))) bf16x8*)(kp+6144); kf[7]=*(const __attribute__((address_space(3))) bf16x8*)(kp+6656);
}
__device__ __forceinline__ void kload2(bf16x8*kf,lds_cptr kp,int j){ kf[2*j]=*(const __attribute__((address_space(3))) bf16x8*)(kp+j*2048); kf[2*j+1]=*(const __attribute__((address_space(3))) bf16x8*)(kp+j*2048+512); }
__device__ __forceinline__ s16x4 vtr(lds_cptr p){ return __builtin_bit_cast(s16x4,__builtin_amdgcn_ds_read_tr16_b64_v4i16((__attribute__((address_space(3))) v4i16_t*)p)); }
__device__ __forceinline__ float rowmax(const f32x16&p0,const f32x16&p1){
  float a=max3f(p0[0],p0[1],p1[0]),b=max3f(p0[2],p0[3],p1[1]);a=max3f(a,p1[2],p1[3]);
  #pragma unroll
  for(int r=4;r<16;r+=4){a=max3f(a,p0[r],p0[r+1]);b=max3f(b,p0[r+2],p0[r+3]);a=max3f(a,p1[r],p1[r+1]);b=max3f(b,p1[r+2],p1[r+3]);}
  const float m=max2f(a,b);
  auto rr=__builtin_amdgcn_permlane32_swap(__float_as_uint(m),__float_as_uint(m),false,false);
  return max2f(__uint_as_float(rr[0]),__uint_as_float(rr[1]));
}
__device__ __forceinline__ void pv(f32x16*o,int vb,bf16x8 pa0,bf16x8 pa1,bf16x8 pa2,bf16x8 pa3){
  #pragma unroll
  for(int d0=0;d0<2;++d0){s16x4 lo[4],hi[4];
    #pragma unroll
    for(int ks=0;ks<4;++ks){
      asm volatile("ds_read_b64_tr_b16 %0,%1 offset:%c2":"=&v"(lo[ks]):"v"(vb),"i"(d0*4096+ks*1024):"memory");
      asm volatile("ds_read_b64_tr_b16 %0,%1 offset:%c2":"=&v"(hi[ks]):"v"(vb),"i"(d0*4096+ks*1024+512):"memory");}
    asm volatile("s_waitcnt lgkmcnt(0)":::"memory");SBAR();
    #define PK(k) (bf16x8){lo[k][0],lo[k][1],lo[k][2],lo[k][3],hi[k][0],hi[k][1],hi[k][2],hi[k][3]}
    o[d0]=__builtin_amdgcn_mfma_f32_32x32x16_bf16(pa0,PK(0),o[d0],0,0,0);
    o[d0]=__builtin_amdgcn_mfma_f32_32x32x16_bf16(pa1,PK(1),o[d0],0,0,0);
    o[d0]=__builtin_amdgcn_mfma_f32_32x32x16_bf16(pa2,PK(2),o[d0],0,0,0);
    o[d0]=__builtin_amdgcn_mfma_f32_32x32x16_bf16(pa3,PK(3),o[d0],0,0,0);
    #undef PK
  }
}

#ifndef ATTN_STORE16
#define ATTN_STORE16(p,v) (*(u32x4*)(p)=(v))
#endif
template<int THRL> __device__ __forceinline__ void attn_unit(int b,int hq,int hv,int qb,const bf16*Q,const bf16*__restrict__ K,const bf16*__restrict__ V,bf16*O,char*shm,float b31s,lds_cfptr tabd){
  const int tid=threadIdx.x,lane=tid&63,r32=lane&31,hi=lane>>5; const int wid=__builtin_amdgcn_readfirstlane(tid>>6);
  const long rowbase=(long)b*SEQ; const int q0=qb*QB;
  const bf16*Qw=Q+(rowbase+q0+wid*QBLK)*DM+hq*D;
  const bf16*Kh=K+rowbase*DM+hq*D,*Vh=V+rowbase*DM+hv*D;
  const unsigned lds0=(unsigned)(uintptr_t)shm;
  float*wsf=(float*)(shm+LDS_WS)+wid*64;
  const unsigned koff=(unsigned)(lane*DM+wid*8)*2u;
  const unsigned voff=(unsigned)((16*(wid&3)+(lane>>2))*DM+(wid>>2)*32+(lane&3)*8)*2u;
  const unsigned kdst=lds0+LDS_K+wid*1024, vdst=lds0+LDS_V+wid*1024;
  #define DMA_K(t,slot) glds16(Kh+(long)(t)*KVBLK*DM,koff,(unsigned)__builtin_amdgcn_readfirstlane(kdst+(slot)))
  #define DMA_V(t,slot) glds16(Vh+(long)(t)*KVBLK*DM,voff,(unsigned)__builtin_amdgcn_readfirstlane(vdst+(slot)))
  const int vb0=(int)(lds0+LDS_V)+((lane>>4)&1)*32+(lane&3)*8+(4*hi+((lane&15)>>2))*64;
  const char*Kbase=shm+LDS_K; bf16x8 kf[8];
  const lds_cptr shm3=(lds_cptr)shm; const lds_cptr kp0=shm3+LDS_K+hi*1024+r32*16; const lds_cptr vp0=shm3+LDS_V+((lane>>4)&1)*32+(lane&3)*8+(4*hi+((lane&15)>>2))*64;
  const int NT=(q0+QB)/KVBLK;
  DMA_K(0,0);DMA_V(0,0);DMA_K(1,SLOTB);
  bf16x8 qr[4];
  { int lq=lane; asm volatile("":"+v"(lq));
  #pragma unroll
  for(int d0=0;d0<4;++d0)qr[d0]=*reinterpret_cast<const bf16x8*>(&Qw[(long)(lq&31)*DM+d0*16+(lq>>5)*8]); }
  float mhat=0.f,l_reg=0.f;f32x16 o[2];o[0]=f32x16{};o[1]=f32x16{};f32x16 negm;
  #pragma unroll
  for(int r=0;r<16;++r)negm[r]=b31s;
  asm volatile("":"+v"(negm));
  const int qrel=wid*QBLK+r32;
  #define CMASK(P0,P1,t) do{int jb_=(t)-(NT-4); if(jb_>=-2)cmask(P0,P1,jb_,qrel,hi,tabd);}while(0)
  bool resc=false;
  #define START(P0,P1) do{ const float rm=rowmax(P0,P1); resc=false; \
    { const float dl=rm; mhat=fadd_s(mhat,dl); \
      _Pragma("unroll") for(int r=0;r<16;++r){P0[r]=fsub_s(P0[r],dl);P1[r]=fsub_s(P1[r],dl);} \
      _Pragma("unroll") for(int r=0;r<16;++r)negm[r]=b31s-mhat; asm volatile("":"+v"(negm)); } \
    _Pragma("unroll") for(int r=0;r<16;++r)P0[r]=__builtin_amdgcn_exp2f(P0[r]); }while(0)
  #define RESC() do{ if(resc){ asm volatile("s_waitcnt lgkmcnt(0)":::"memory"); \
      _Pragma("unroll") for(int d_=0;d_<2;++d_) _Pragma("unroll") for(int r=0;r<16;++r)o[d_][r]*=wsf[crow(r,hi)]; } }while(0)
  f32x16 pA0,pA1,pB0,pB1;
  int sl_prev=0,sl_cur=0,sl_next=SLOTB;
  #define ROT() do{sl_prev=sl_cur;sl_cur=sl_next;sl_next=(sl_next==(NSLOT-1)*SLOTB)?0:sl_next+SLOTB;}while(0)
  DMA_K(2,2*SLOTB);
  WAIT_BAR(3);
  qkt(pA0,pA1,Kbase,qr,negm,r32,hi);asm volatile("s_nop 15\n\ts_nop 7":"+v"(pA0),"+v"(pA1));CMASK(pA0,pA1,0);
  START(pA0,pA1);
  _Pragma("unroll") for(int r=0;r<16;++r)pA1[r]=__builtin_amdgcn_exp2f(pA1[r]);
  WAIT_BAR(0);
  DMA_K(3,0);DMA_V(1,SLOTB);
  ROT();
  kload8(kf,kp0+sl_cur);
  WAIT_BAR(2);
  s16x4 vlo[8],vhi[8]; u32x4 pw0,pw1,pw2,pw3;
  #define PKW(P,B) cvtpk_s(P[B],P[B+1])
  #define PAF(k) __builtin_bit_cast(bf16x8,pw##k)
  #define VFR(i) (bf16x8){vlo[i][0],vlo[i][1],vlo[i][2],vlo[i][3],vhi[i][0],vhi[i][1],vhi[i][2],vhi[i][3]}
  #define PIN(x) asm volatile("":"+v"(x))
  #define MX3(a,b,c) __builtin_fmaxf(__builtin_fmaxf((a),(b)),(c))
  #define GAPA(MF,A0,A1,A2,A3,W0,W1,PW) do{ MF; sacc+=A0; sacc+=A1; sacc+=A2; sacc+=A3; PIN(sacc); W0; W1; PIN(PW); SBAR(); }while(0)
  #define EX(v) __builtin_amdgcn_exp2f(v)
  #define GAPB(MF,X,B) do{ MF; X[B]=EX(X[B]); X[B+1]=EX(X[B+1]); X[B+2]=EX(X[B+2]); X[B+3]=EX(X[B+3]); PIN(X); SBAR(); }while(0)
  #define VRD(i) do{ vlo[i]=vtr(vp_+(((i)>>2)*4096+((i)&3)*1024)); vhi[i]=vtr(vp_+(((i)>>2)*4096+((i)&3)*1024+512)); }while(0)
  #define KRD(G,j) do{ if(G){ kload2(kf,kp0+sl_next,j); SBAR(); } }while(0)
  #define STEP(C0,C1,P0,P1,t,GK,GV,GL) do{ SBAR(); \
    const lds_cptr vp_=vp0+sl_prev; \
    VRD(0); SBAR(); float sacc=(P0[0]+P0[1]); \
    GAPA(C0=__builtin_amdgcn_mfma_f32_32x32x16_bf16(kf[0],qr[0],negm,0,0,0), P0[2],P0[3],P0[4],P0[5],     pw0[0]=PKW(P0,0), pw0[1]=PKW(P0,2), pw0); \
    VRD(4); SBAR(); GAPA(C1=__builtin_amdgcn_mfma_f32_32x32x16_bf16(kf[1],qr[0],negm,0,0,0), P0[6],P0[7],P0[8],P0[9],     pw0[2]=PKW(P0,4), pw0[3]=PKW(P0,6), pw0); \
    VRD(1); SBAR(); GAPA(C0=__builtin_amdgcn_mfma_f32_32x32x16_bf16(kf[2],qr[1],C0,0,0,0),   P0[10],P0[11],P0[12],P0[13], pw1[0]=PKW(P0,8), pw1[1]=PKW(P0,10), pw1); \
    VRD(5); SBAR(); GAPA(C1=__builtin_amdgcn_mfma_f32_32x32x16_bf16(kf[3],qr[1],C1,0,0,0),   P0[14],P0[15],P1[0],P1[1],   pw1[2]=PKW(P0,12),pw1[3]=PKW(P0,14), pw1); \
    VRD(2); SBAR(); GAPA(C0=__builtin_amdgcn_mfma_f32_32x32x16_bf16(kf[4],qr[2],C0,0,0,0),   P1[2],P1[3],P1[4],P1[5],     pw2[0]=PKW(P1,0), pw2[1]=PKW(P1,2), pw2); \
    VRD(6); SBAR(); GAPA(C1=__builtin_amdgcn_mfma_f32_32x32x16_bf16(kf[5],qr[2],C1,0,0,0),   P1[6],P1[7],P1[8],P1[9],     pw2[2]=PKW(P1,4), pw2[3]=PKW(P1,6), pw2); \
    VRD(3); SBAR(); GAPA(C0=__builtin_amdgcn_mfma_f32_32x32x16_bf16(kf[6],qr[3],C0,0,0,0),   P1[10],P1[11],P1[12],P1[13], pw3[0]=PKW(P1,8), pw3[1]=PKW(P1,10), pw3); \
    VRD(7); SBAR(); GAPA(C1=__builtin_amdgcn_mfma_f32_32x32x16_bf16(kf[7],qr[3],C1,0,0,0),   P1[14],P1[15],0.f,0.f,       pw3[2]=PKW(P1,12),pw3[3]=PKW(P1,14), pw3); \
    l_reg+=sacc; \
    if(GK){DMA_K((t)+3,sl_cur);} if(GV){DMA_V((t)+1,sl_next);} \
    CMASK(C0,C1,t); \
    { float a=MX3(C0[0],C0[1],C1[0]),b=MX3(C0[2],C0[3],C1[1]); a=MX3(a,C1[2],C1[3]); \
      _Pragma("unroll") for(int r=4;r<16;r+=4){a=MX3(a,C0[r],C0[r+1]);b=MX3(b,C0[r+2],C0[r+3]);a=MX3(a,C1[r],C1[r+1]);b=MX3(b,C1[r+2],C1[r+3]);} \
      float rm=__builtin_fmaxf(a,b); { auto rr=__builtin_amdgcn_permlane32_swap(__float_as_uint(rm),__float_as_uint(rm),false,false); rm=__builtin_fmaxf(__uint_as_float(rr[0]),__uint_as_float(rr[1])); } \
      resc=false; \
      if(__builtin_expect(__any(rm>(float)THRL),0)){ const float dl=__builtin_fmaxf(rm,0.f); mhat+=dl; \
        _Pragma("unroll") for(int r=0;r<16;++r){C0[r]-=dl;C1[r]-=dl;} \
        _Pragma("unroll") for(int r=0;r<16;++r)negm[r]=b31s-mhat; asm volatile("":"+v"(negm)); \
        const float f=__builtin_amdgcn_exp2f(-dl); l_reg*=f; if(hi==0)wsf[r32]=f; resc=true; } } \
    SBAR(); \
    GAPB(o[0]=__builtin_amdgcn_mfma_f32_32x32x16_bf16(PAF(0),VFR(0),o[0],0,0,0), C0,0); \
    GAPB(o[1]=__builtin_amdgcn_mfma_f32_32x32x16_bf16(PAF(0),VFR(4),o[1],0,0,0), C0,4); \
    KRD(GL,0); GAPB(o[0]=__builtin_amdgcn_mfma_f32_32x32x16_bf16(PAF(1),VFR(1),o[0],0,0,0), C0,8); \
    KRD(GL,1); GAPB(o[1]=__builtin_amdgcn_mfma_f32_32x32x16_bf16(PAF(1),VFR(5),o[1],0,0,0), C0,12); \
    KRD(GL,2); GAPB(o[0]=__builtin_amdgcn_mfma_f32_32x32x16_bf16(PAF(2),VFR(2),o[0],0,0,0), C1,0); \
    KRD(GL,3); GAPB(o[1]=__builtin_amdgcn_mfma_f32_32x32x16_bf16(PAF(2),VFR(6),o[1],0,0,0), C1,4); \
    GAPB(o[0]=__builtin_amdgcn_mfma_f32_32x32x16_bf16(PAF(3),VFR(3),o[0],0,0,0), C1,8); \
    GAPB(o[1]=__builtin_amdgcn_mfma_f32_32x32x16_bf16(PAF(3),VFR(7),o[1],0,0,0), C1,12); \
    }while(0)
  int t=1;
  #undef CMASK
  #define CMASK(P0,P1,t) do{}while(0)
  for(;t+7<NT;t+=2){
    STEP(pB0,pB1,pA0,pA1,t,true,true,true);     WAIT_BAR(2); RESC(); ROT();
    STEP(pA0,pA1,pB0,pB1,t+1,true,true,true);   WAIT_BAR(2); RESC(); ROT();
  }
  #undef CMASK
  #define CMASK(P0,P1,t) do{int jb_=(t)-(NT-4); if(jb_>=-2)cmask(P0,P1,jb_,qrel,hi,tabd);}while(0)
  #define ENDW(tt) do{ if((tt)+3<NT){WAIT_BAR(2);} else if((tt)+2<NT){WAIT_BAR(1);} else {WAIT_BAR(0);} }while(0)
  for(;t+1<NT;t+=2){
    STEP(pB0,pB1,pA0,pA1,t,(t+3<NT),(t+1<NT),(t+1<NT));       ENDW(t);   RESC(); ROT();
    STEP(pA0,pA1,pB0,pB1,t+1,(t+4<NT),(t+2<NT),(t+2<NT));     ENDW(t+1); RESC(); ROT();
  }
  STEP(pB0,pB1,pA0,pA1,NT-1,false,false,false); RESC();
  { float sacc=pB0[0]+pB0[1]; _Pragma("unroll") for(int r=2;r<16;++r)sacc+=pB0[r]; _Pragma("unroll") for(int r=0;r<16;++r)sacc+=pB1[r]; l_reg+=sacc;
    pw0=(u32x4){PKW(pB0,0),PKW(pB0,2),PKW(pB0,4),PKW(pB0,6)};pw1=(u32x4){PKW(pB0,8),PKW(pB0,10),PKW(pB0,12),PKW(pB0,14)};pw2=(u32x4){PKW(pB1,0),PKW(pB1,2),PKW(pB1,4),PKW(pB1,6)};pw3=(u32x4){PKW(pB1,8),PKW(pB1,10),PKW(pB1,12),PKW(pB1,14)};
    SBAR(); pv(o,vb0+sl_cur,PAF(0),PAF(1),PAF(2),PAF(3)); }
  #undef PKW
  #undef PAF
  #undef VFR
  #undef PIN
  #undef MX3
  #undef GAPA
  #undef GAPB
  #undef EX
  #undef VRD
  #undef KRD
  #undef STEP
  #undef ENDW
  {auto rr=__builtin_amdgcn_permlane32_swap(__float_as_uint(l_reg),__float_as_uint(l_reg),false,false);l_reg=__uint_as_float(rr[0])+__uint_as_float(rr[1]);}
  if(hi==0)wsf[32+r32]=l_reg;asm volatile("s_waitcnt lgkmcnt(0)":::"memory");
  float rli[16];
  #pragma unroll
  for(int r=0;r<16;++r)rli[r]=__builtin_amdgcn_rcpf(wsf[32+crow(r,hi)]);
  bf16*Ow=O+(rowbase+q0+wid*QBLK)*DM+hv*D;
  { bf16*stg=(bf16*)(shm+LDS_OST)+wid*2048;
    #pragma unroll
    for(int r=0;r<16;++r){const int orow=crow(r,hi);
      #pragma unroll
      for(int d0=0;d0<2;++d0)stg[orow*64+d0*32+r32]=__float2bfloat16(o[d0][r]*rli[r]);}
    asm volatile("s_waitcnt lgkmcnt(0)":::"memory");
    int le=lane; asm volatile("":"+v"(le));
    #pragma unroll
    for(int i=0;i<4;++i){const int row=i*8+(le>>3),ch=le&7; const u32x4 v=*(const u32x4*)(stg+row*64+ch*8); ATTN_STORE16(Ow+(long)row*DM+ch*8,v);} }
  asm volatile("s_waitcnt lgkmcnt(0)\n\ts_barrier":::"memory");
  #undef DMA_K
  #undef DMA_V
  #undef CMASK
  #undef START
  #undef RESC
  #undef ROT
}
constexpr int ATTN_LDS_BYTES=LDS_BYTES, LDS_TAB=LDS_BYTES;
struct AttnTensors { const bf16* Q; const bf16* K; const bf16* V; bf16* O0; bf16* O1; const float* TB; };
template<int THRL=8> __device__ __forceinline__ void attn_phase(char*lds,const AttnTensors&T,int grid,int block){
  const int vcu=(grid%8==0)?(block%8)*(grid/8)+block/8:block;
  lds_cfptr tab=(lds_cfptr)((__attribute__((address_space(3))) const char*)lds+LDS_TAB);
  { __attribute__((address_space(3))) float* tw=(__attribute__((address_space(3))) float*)((__attribute__((address_space(3))) char*)lds+LDS_TAB);
    for(int i=threadIdx.x;i<8*128;i+=512){const int h=i>>7; tw[i]=T.TB[i]-T.TB[h*128+127];}
    asm volatile("s_waitcnt vmcnt(0) lgkmcnt(0)\n\ts_barrier":::"memory"); }
  for(int bh=vcu>>3;bh<BATCH*8;bh+=grid>>3){ const int b=bh>>3,h=bh&7,s=vcu&7; const float b31s=T.TB[h*128+127];
    for(int j=0;j<4;++j){ const int c=j>>1,vh=j&1;
      for(int i=0;i<4;++i){ const int qb=(i==0)?s:(i==1)?15-s:(i==2)?16+s:31-s;
        attn_unit<THRL>(b,h*2+c,h*2+vh,qb,T.Q,T.K,T.V,c?T.O1:T.O0,lds,b31s,tab+h*128); } } }
}
#undef SBAR
#undef WAIT_BAR
}

constexpr int RING_BYTES = 131072;
constexpr int LDSCTL_OFF = RING_BYTES, MISC_OFF = LDSCTL_OFF + 320;
constexpr int LDS_BYTES = 147456;

struct Args { const float* in[28]; float* out; unsigned char* ws; int ph_lo, ph_hi; };

__device__ __forceinline__ void rms_rows_bf16(const float* X, const float* g, bf16* H, int bid, int nb) {
    const int tid_ = fresh_tid(); const int lane = tid_ & 63, wave = tid_ >> 6;
    f32x4 gv[4];
#pragma unroll
    for (int j = 0; j < 4; ++j) gv[j] = *(const f32x4*)(g + 4 * lane + 256 * j);
    for (int m = bid * NWAVES + wave; m < NT; m += nb * NWAVES) {
        const f32x4* xr = (const f32x4*)(X + (size_t)m * DM) + lane;
        f32x4 v[4]; float s = 0.f;
#pragma unroll
        for (int j = 0; j < 4; ++j) { v[j] = xr[64 * j]; s += (v[j].x * v[j].x + v[j].y * v[j].y) + (v[j].z * v[j].z + v[j].w * v[j].w); }
        const float r = 1.f / sqrtf(wave_sum(s) * (1.f / DM) + NORM_EPS);
        unsigned long long* o8 = (unsigned long long*)(H + (size_t)m * DM) + lane;
#pragma unroll
        for (int j = 0; j < 4; ++j) { const f32x4 y = v[j] * r * gv[j]; o8[64 * j] = (unsigned long long)pk2(y.x, y.y) | ((unsigned long long)pk2(y.z, y.w) << 32); }
    }
}
__device__ __forceinline__ void rms_rows_f32_inplace(float* X, const float* g, int bid, int nb) {
    const int tid_ = fresh_tid(); const int lane = tid_ & 63, wave = tid_ >> 6;
    f32x4 gv[4];
#pragma unroll
    for (int j = 0; j < 4; ++j) gv[j] = *(const f32x4*)(g + 4 * lane + 256 * j);
    for (int m = bid * NWAVES + wave; m < NT; m += nb * NWAVES) {
        f32x4* xr = (f32x4*)(X + (size_t)m * DM) + lane;
        f32x4 v[4]; float s = 0.f;
#pragma unroll
        for (int j = 0; j < 4; ++j) { v[j] = xr[64 * j]; s += (v[j].x * v[j].x + v[j].y * v[j].y) + (v[j].z * v[j].z + v[j].w * v[j].w); }
        const float r = 1.f / sqrtf(wave_sum(s) * (1.f / DM) + NORM_EPS);
#pragma unroll
        for (int j = 0; j < 4; ++j) xr[64 * j] = v[j] * r * gv[j];
    }
}

template <int NB, class P>
__device__ __forceinline__ void ref_gemm(const P& p, LAS float* sm, int bid, int nb) {
    constexpr int LDP = 132;
    LAS float* As = sm; LAS float* Bs = sm + 16 * LDP;
    const int tid = fresh_tid(), ty = tid >> 4, tx = tid & 15;
    const int nt = p.ntiles();
    for (int it = bid; it < nt; it += nb) {
        int m0, n0; const float* W[2]; p.tile(it, m0, n0, W[0], W[1]);
        float acc[NB][4][8];
#pragma unroll
        for (int b = 0; b < NB; ++b)
#pragma unroll
            for (int i = 0; i < 4; ++i)
#pragma unroll
                for (int j = 0; j < 8; ++j) acc[b][i][j] = 0.f;
        const bf16* ap = p.arow(m0 + (tid >> 2)) + (tid & 3) * 4;
        for (int k0 = 0; k0 < p.K; k0 += 16) {
            { const v2u v = *(const v2u*)(ap + k0); const int r = tid >> 2, kq = (tid & 3) * 4;
              As[(kq + 0) * LDP + r] = bflo(v.x); As[(kq + 1) * LDP + r] = bfhi(v.x); As[(kq + 2) * LDP + r] = bflo(v.y); As[(kq + 3) * LDP + r] = bfhi(v.y); }
#pragma unroll
            for (int b = 0; b < NB; ++b) { const int k = tid >> 5, n4 = (tid & 31) * 4;
                const f32x4 v = *(const f32x4*)(W[b] + (size_t)(k0 + k) * p.ldw + n0 + n4);
                *(LAS f32x4*)(Bs + (b * 16 + k) * LDP + n4) = v; }
            __syncthreads();
#pragma unroll 2
            for (int kk = 0; kk < 16; ++kk) {
                const f32x4 a = *(const LAS f32x4*)(As + kk * LDP + ty * 4);
#pragma unroll
                for (int b = 0; b < NB; ++b) {
                    const f32x4 b0 = *(const LAS f32x4*)(Bs + (b * 16 + kk) * LDP + tx * 8), b1 = *(const LAS f32x4*)(Bs + (b * 16 + kk) * LDP + tx * 8 + 4);
#pragma unroll
                    for (int i = 0; i < 4; ++i) {
                        acc[b][i][0] += a[i] * b0.x; acc[b][i][1] += a[i] * b0.y; acc[b][i][2] += a[i] * b0.z; acc[b][i][3] += a[i] * b0.w;
                        acc[b][i][4] += a[i] * b1.x; acc[b][i][5] += a[i] * b1.y; acc[b][i][6] += a[i] * b1.z; acc[b][i][7] += a[i] * b1.w; }
                }
            }
            __syncthreads();
        }
#pragma unroll
        for (int i = 0; i < 4; ++i) {
            float a[NB][8];
#pragma unroll
            for (int b = 0; b < NB; ++b)
#pragma unroll
                for (int j = 0; j < 8; ++j) a[b][j] = acc[b][i][j];
            p.epi(m0 + ty * 4 + i, n0 + tx * 8, a);
        }
    }
}
__device__ __forceinline__ void st_bf16x8(bf16* p, const float* v) { v4u w; w.x = pk2(v[0], v[1]); w.y = pk2(v[2], v[3]); w.z = pk2(v[4], v[5]); w.w = pk2(v[6], v[7]); *(v4u*)p = w; }
__device__ __forceinline__ float silu_(float x) { return x / (1.f + __expf(-x)); }
__device__ __forceinline__ float gelu_tanh_(float x) { const float u = 0.7978845608028654f * (x + 0.044715f * x * x * x); return 0.5f * x * (1.f + tanhf(u)); }

struct PQkv {
    int K, ldw; const bf16* H; const float* W; bf16 *Q, *Kb, *V;
    __device__ int ntiles() const { return (NT / 128) * (3 * DM / 128); }
    __device__ void tile(int i, int& m0, int& n0, const float*& W0, const float*& W1) const { m0 = (i / 24) * 128; n0 = (i % 24) * 128; W0 = W; W1 = W; }
    __device__ const bf16* arow(int r) const { return H + (size_t)r * DM; }
    __device__ void epi(int r, int c0, const float (&a)[1][8]) const {
        const int t = c0 >> 10, c = c0 & 1023; float v[8]; const float sc = (t == 0) ? C2 : 1.f;
#pragma unroll
        for (int j = 0; j < 8; ++j) v[j] = a[0][j] * sc;
        st_bf16x8(Q + (size_t)t * (size_t)(32u << 20) + (size_t)r * DM + c, v); }
};
struct PResid {
    int K, ldw; const bf16* A; int lda; const float* W; const float* base; float* out;
    __device__ int ntiles() const { return (NT / 128) * (DM / 128); }
    __device__ void tile(int i, int& m0, int& n0, const float*& W0, const float*& W1) const { m0 = (i / 8) * 128; n0 = (i % 8) * 128; W0 = W; W1 = W; }
    __device__ const bf16* arow(int r) const { return A + (size_t)r * lda; }
    __device__ void epi(int r, int c0, const float (&a)[1][8]) const {
        const f32x4 b0 = *(const f32x4*)(base + (size_t)r * DM + c0), b1 = *(const f32x4*)(base + (size_t)r * DM + c0 + 4);
        *(f32x4*)(out + (size_t)r * DM + c0) = (f32x4){b0.x + a[0][0], b0.y + a[0][1], b0.z + a[0][2], b0.w + a[0][3]};
        *(f32x4*)(out + (size_t)r * DM + c0 + 4) = (f32x4){b1.x + a[0][4], b1.y + a[0][5], b1.z + a[0][6], b1.w + a[0][7]}; }
};
struct PSwiglu {
    int K, ldw; const bf16* H; const float *Wg, *Wu; bf16* ACT;
    __device__ int ntiles() const { return (NT / 128) * (DFF / 128); }
    __device__ void tile(int i, int& m0, int& n0, const float*& W0, const float*& W1) const { m0 = (i / 22) * 128; n0 = (i % 22) * 128; W0 = Wg; W1 = Wu; }
    __device__ const bf16* arow(int r) const { return H + (size_t)r * DM; }
    __device__ void epi(int r, int c0, const float (&a)[2][8]) const { float v[8];
#pragma unroll
        for (int j = 0; j < 8; ++j) v[j] = silu_(a[0][j]) * a[1][j];
        st_bf16x8(ACT + (size_t)r * DFF + c0, v); }
};
struct PWin {
    int K, ldw; const bf16* H; const float* W; bf16 *G, *XB;
    __device__ int ntiles() const { return (NT / 128) * (2 * DRNN / 128); }
    __device__ void tile(int i, int& m0, int& n0, const float*& W0, const float*& W1) const { m0 = (i / 20) * 128; n0 = (i % 20) * 128; W0 = W; W1 = W; }
    __device__ const bf16* arow(int r) const { return H + (size_t)r * DM; }
    __device__ void epi(int r, int c0, const float (&a)[1][8]) const { float v[8];
        if (c0 < DRNN) {
#pragma unroll
            for (int j = 0; j < 8; ++j) v[j] = gelu_tanh_(a[0][j]);
            st_bf16x8(G + (size_t)r * DRNN + c0, v);
        } else {
#pragma unroll
            for (int j = 0; j < 8; ++j) v[j] = a[0][j];
            st_bf16x8(XB + (size_t)r * DRNN + (c0 - DRNN), v); } }
};
struct PMoeGU {
    int K, ldw; const bf16* H; const float *Wg, *Wu; bf16* ACT; const int* tok; const int* base;
    __device__ int ntiles() const { return (base[8] / 128) * (DFE / 128); }
    __device__ void tile(int i, int& m0, int& n0, const float*& W0, const float*& W1) const {
        m0 = (i / 28) * 128; n0 = (i % 28) * 128; int e = 0;
#pragma unroll
        for (int j = 1; j < 8; ++j) e += (m0 >= base[j]) ? 1 : 0;
        W0 = Wg + (size_t)e * DM * DFE; W1 = Wu + (size_t)e * DM * DFE; }
    __device__ const bf16* arow(int r) const { int t = tok[r]; if (t < 0) t = 0; return H + (size_t)t * DM; }
    __device__ void epi(int r, int c0, const float (&a)[2][8]) const { float v[8];
#pragma unroll
        for (int j = 0; j < 8; ++j) v[j] = silu_(a[0][j]) * a[1][j];
        st_bf16x8(ACT + (size_t)r * DFE + c0, v); }
};
struct PMoeDown {
    int K, ldw; const bf16* ACT; const float* Wd; float* out; const int* tok; const float* gatev; const int* base;
    __device__ int ntiles() const { return (base[8] / 128) * (DM / 128); }
    __device__ void tile(int i, int& m0, int& n0, const float*& W0, const float*& W1) const {
        m0 = (i / 8) * 128; n0 = (i % 8) * 128; int e = 0;
#pragma unroll
        for (int j = 1; j < 8; ++j) e += (m0 >= base[j]) ? 1 : 0;
        W0 = Wd + (size_t)e * DFE * DM; W1 = W0; }
    __device__ const bf16* arow(int r) const { return ACT + (size_t)r * DFE; }
    __device__ void epi(int r, int c0, const float (&a)[1][8]) const {
        const int t = tok[r]; if (t < 0) return; const float g = gatev[r];
        float* o = out + (size_t)t * DM + c0; const f32x4 b0 = *(const f32x4*)o, b1 = *(const f32x4*)(o + 4);
        *(f32x4*)o = (f32x4){b0.x + g * a[0][0], b0.y + g * a[0][1], b0.z + g * a[0][2], b0.w + g * a[0][3]};
        *(f32x4*)(o + 4) = (f32x4){b1.x + g * a[0][4], b1.y + g * a[0][5], b1.z + g * a[0][6], b1.w + g * a[0][7]}; }
};

__device__ __forceinline__ int t5_bucket(int n) {
    const float nf = (float)(n < 1 ? 1 : n);
    int large = 16 + (int)(logf(nf / 16.0f) / 2.0794415416798357f * 16.0f);
    large = large < 31 ? large : 31;
    return n < 16 ? n : large;
}
__device__ __forceinline__ void build_tables(const float* rel_bias, float* TB) {
    for (int i = fresh_tid(); i < NH * 128; i += NTHR) { const int h = i >> 7, n = i & 127; TB[i] = rel_bias[t5_bucket(n) * NH + h] * LOG2E; }
}
__device__ __forceinline__ float compute_lam(const float* lq1, const float* lk1, const float* lq2, const float* lk2) {
    const int lane = fresh_tid() & 63;
    const float s1 = wave_sum(lq1[lane] * lk1[lane]), s2 = wave_sum(lq2[lane] * lk2[lane]);
    return expf(s1) - expf(s2) + LAM_INIT;
}

__device__ __forceinline__ void ref_attention(const bf16* Q, const bf16* Kb, const bf16* V, bf16* O0, bf16* O1, const float* TB, LAS float* sm, int bid, int nb) {
    LAS float* Ks = sm; LAS float* Vs = sm + 32 * 128; LAS float* tb = sm + 2 * 32 * 128;
    const int tid = fresh_tid(), qr = tid & 127, cv = tid >> 7, c = cv >> 1, vh = cv & 1;
    const int NU = NB_ * NH * (SEQ / 128);
    for (int u = bid; u < NU; u += nb) {
        const int uu = NU - 1 - u;
        const int qblk = uu / (NB_ * NH), bh = uu % (NB_ * NH), b = bh / NH, h = bh % NH;
        const int q0 = qblk * 128, q = q0 + qr; const size_t rb = (size_t)b * SEQ;
        __syncthreads();
        if (tid < 128) tb[tid] = TB[h * 128 + tid];
        float qv[64];
        { const v4u* qp = (const v4u*)(Q + (rb + q) * DM + h * 128 + c * 64);
#pragma unroll
          for (int i = 0; i < 8; ++i) { const v4u w = qp[i]; qv[8 * i] = bflo(w.x); qv[8 * i + 1] = bfhi(w.x); qv[8 * i + 2] = bflo(w.y); qv[8 * i + 3] = bfhi(w.y); qv[8 * i + 4] = bflo(w.z); qv[8 * i + 5] = bfhi(w.z); qv[8 * i + 6] = bflo(w.w); qv[8 * i + 7] = bfhi(w.w); } }
        float o[64]; float m = -INFINITY, l = 0.f;
#pragma unroll
        for (int d = 0; d < 64; ++d) o[d] = 0.f;
        const int nkt = (q0 + 127) / 32 + 1;
        for (int kt = 0; kt < nkt; ++kt) {
            __syncthreads();
            { const int r = tid >> 4, c8 = (tid & 15) * 8; const size_t g = (rb + kt * 32 + r) * DM + h * 128 + c8;
              const v4u kw = *(const v4u*)(Kb + g), vw = *(const v4u*)(V + g);
              LAS float* kd = Ks + r * 128 + c8; LAS float* vd = Vs + r * 128 + c8;
              kd[0] = bflo(kw.x); kd[1] = bfhi(kw.x); kd[2] = bflo(kw.y); kd[3] = bfhi(kw.y); kd[4] = bflo(kw.z); kd[5] = bfhi(kw.z); kd[6] = bflo(kw.w); kd[7] = bfhi(kw.w);
              vd[0] = bflo(vw.x); vd[1] = bfhi(vw.x); vd[2] = bflo(vw.y); vd[3] = bfhi(vw.y); vd[4] = bflo(vw.z); vd[5] = bfhi(vw.z); vd[6] = bflo(vw.w); vd[7] = bfhi(vw.w); }
            __syncthreads();
            if (kt * 32 <= q) {
#pragma unroll 1
                for (int j = 0; j < 32; ++j) {
                    const int dist = q - (kt * 32 + j);
                    if (dist >= 0) {
                        const LAS float* kr = Ks + j * 128 + c * 64; float a = 0.f;
#pragma unroll
                        for (int d = 0; d < 64; d += 4) { const f32x4 kv = *(const LAS f32x4*)(kr + d); a += qv[d] * kv.x + qv[d + 1] * kv.y + qv[d + 2] * kv.z + qv[d + 3] * kv.w; }
                        a += tb[dist > 127 ? 127 : dist];
                        const float mn = fmaxf(m, a), al = exp2f(m - mn), pj = exp2f(a - mn); m = mn; l = l * al + pj;
                        const LAS float* vr = Vs + j * 128 + vh * 64;
#pragma unroll
                        for (int d = 0; d < 64; d += 4) { const f32x4 vv = *(const LAS f32x4*)(vr + d);
                            o[d] = o[d] * al + pj * vv.x; o[d + 1] = o[d + 1] * al + pj * vv.y; o[d + 2] = o[d + 2] * al + pj * vv.z; o[d + 3] = o[d + 3] * al + pj * vv.w; }
                    }
                }
            }
        }
        const float rl = 1.f / l;
        bf16* op = (c == 0 ? O0 : O1) + (rb + q) * DM + h * 128 + vh * 64;
#pragma unroll
        for (int i = 0; i < 8; ++i) { float v[8];
#pragma unroll
            for (int j = 0; j < 8; ++j) v[j] = o[8 * i + j] * rl;
            st_bf16x8(op + 8 * i, v); }
    }
}
__device__ __forceinline__ void combine_rows(const bf16* O0, const bf16* O1, bf16* OC, const float* subg, float lam, int bid, int nb) {
    const int tid_ = fresh_tid(); const int lane = tid_ & 63, wave = tid_ >> 6;
    const float g0 = subg[2 * lane], g1 = subg[2 * lane + 1];
    for (long it = (long)bid * NWAVES + wave; it < (long)NT * NH; it += (long)nb * NWAVES) {
        const size_t off = (size_t)it * 128 + 2 * lane;
        const unsigned a = *(const unsigned*)(O0 + off), b = *(const unsigned*)(O1 + off);
        const float x0 = bflo(a) - lam * bflo(b), x1 = bfhi(a) - lam * bfhi(b);
        const float r = 1.f / sqrtf(wave_sum(x0 * x0 + x1 * x1) * (1.f / 128.f) + SUBLN_EPS) * (1.f - LAM_INIT);
        *(unsigned*)(OC + off) = pk2(x0 * r * g0, x1 * r * g1);
    }
}

__device__ __forceinline__ void ref_lru_local(const bf16* XB, const float* convw, const float* convb, const float* gaw, const float* gab, const float* gxw, const float* gxb,
                                              const float* lamp, bf16* HL, bf16* CA, float* AEND, float* HEND, LAS float* sm, int bid, int nb) {
    LAS float* xc = sm;
    LAS float* av = sm + 64 * 128;
    LAS float* bv = sm + 2 * 64 * 128;
    const int tid = fresh_tid();
    const int NU = NB_ * NCH * NLB;
    for (int u = bid; u < NU; u += nb) {
        const int n = u % NLB, ch = (u / NLB) % NCH, b = u / (NLB * NCH);
        const int t0 = ch * LCH; const size_t rb = (size_t)b * SEQ;
        __syncthreads();
        for (int i = tid; i < LCH * 128; i += NTHR) { const int t = i >> 7, c = i & 127, cg = n * 128 + c; float a = convb[cg];
#pragma unroll
            for (int j = 0; j < CW; ++j) { const int tt = t0 + t + j - (CW - 1); if (tt >= 0) a += bf2f(XB[(rb + tt) * DRNN + cg]) * convw[j * DRNN + cg]; }
            xc[i] = a; }
        __syncthreads();
        { const int e = tid & 127, tq = tid >> 7, cg = n * 128 + e;
          const float* wa = gaw + (size_t)n * 128 * 128 + e; const float* wx = gxw + (size_t)n * 128 * 128 + e;
          const float ba = gab[cg], bx = gxb[cg]; const float sp = log1pf(expf(-lamp[cg]));
          for (int tb4 = 0; tb4 < 4; ++tb4) {
              float ar[4] = {0.f, 0.f, 0.f, 0.f}, ai[4] = {0.f, 0.f, 0.f, 0.f};
              const int tbase = tq * 16 + tb4 * 4;
              for (int d = 0; d < 128; ++d) { const float w1 = wa[d * 128], w2 = wx[d * 128];
#pragma unroll
                  for (int k = 0; k < 4; ++k) { const float xv = xc[(tbase + k) * 128 + d]; ar[k] += xv * w1; ai[k] += xv * w2; } }
#pragma unroll
              for (int k = 0; k < 4; ++k) { const int t = tbase + k; const float r = sigmoidf_(ar[k] + ba), ig = sigmoidf_(ai[k] + bx);
                  const float la = -8.0f * r * sp, a = expf(la), mult = sqrtf(-expm1f(2.0f * la));
                  av[t * 128 + e] = a; bv[t * 128 + e] = mult * (ig * xc[t * 128 + e]); }
          } }
        __syncthreads();
        if (tid < 128) { const int cg = n * 128 + tid; float hh = 0.f, cp = 1.f;
            for (int t = 0; t < LCH; ++t) { const float a = av[t * 128 + tid]; hh = a * hh + bv[t * 128 + tid]; cp *= a;
                HL[(rb + t0 + t) * DRNN + cg] = (bf16)f2bf(hh); CA[(rb + t0 + t) * DRNN + cg] = (bf16)f2bf(cp); }
            AEND[((size_t)b * NCH + ch) * DRNN + cg] = cp; HEND[((size_t)b * NCH + ch) * DRNN + cg] = hh; }
    }
}
__device__ __forceinline__ void lru_carry(const float* AEND, const float* HEND, float* CIN, int bid, int nb) {
    for (int i = bid * NTHR + fresh_tid(); i < NB_ * DRNN; i += nb * NTHR) { const int b = i / DRNN, c = i % DRNN; float cin = 0.f;
        for (int ch = 0; ch < NCH; ++ch) { const size_t o = ((size_t)b * NCH + ch) * DRNN + c; CIN[o] = cin; cin = AEND[o] * cin + HEND[o]; } }
}
__device__ __forceinline__ void lru_fixup(const bf16* HL, const bf16* CA, const bf16* G, const float* CIN, bf16* Y, int bid, int nb) {
    const size_t total = (size_t)NT * DRNN / 2;
    for (size_t i = (size_t)bid * NTHR + fresh_tid(); i < total; i += (size_t)nb * NTHR) {
        const size_t el = 2 * i; const int row = (int)(el / DRNN), c = (int)(el % DRNN); const int b = row / SEQ, ch = (row % SEQ) / LCH;
        const unsigned hl = *(const unsigned*)(HL + el), ca = *(const unsigned*)(CA + el), g = *(const unsigned*)(G + el);
        const float* ci = CIN + ((size_t)b * NCH + ch) * DRNN + c;
        const float h0 = bflo(hl) + bflo(ca) * ci[0], h1 = bfhi(hl) + bfhi(ca) * ci[1];
        *(unsigned*)(Y + el) = pk2(h0 * bflo(g), h1 * bfhi(g));
    }
}

__device__ __forceinline__ void moe_route(const float* X, const float* g, const float* router, bf16* H, int* RE, float* RG, int* RR, int* CNT, LAS float* sm, int bid, int nb) {
    LAS int* e_s = (LAS int*)sm;
    const int tid = fresh_tid(), lane = tid & 63, wave = tid >> 6;
    f32x4 gv[4];
#pragma unroll
    for (int j = 0; j < 4; ++j) gv[j] = *(const f32x4*)(g + 4 * lane + 256 * j);
    for (int tile = bid; tile < NT / 256; tile += nb) {
        __syncthreads();
        for (int rr = 0; rr < 32; ++rr) {
            const int lr = wave * 32 + rr, m = tile * 256 + lr;
            const f32x4* xr = (const f32x4*)(X + (size_t)m * DM) + lane;
            f32x4 v[4]; float s = 0.f;
#pragma unroll
            for (int j = 0; j < 4; ++j) { v[j] = xr[64 * j]; s += (v[j].x * v[j].x + v[j].y * v[j].y) + (v[j].z * v[j].z + v[j].w * v[j].w); }
            const float r = 1.f / sqrtf(wave_sum(s) * (1.f / DM) + NORM_EPS);
            unsigned long long* o8 = (unsigned long long*)(H + (size_t)m * DM) + lane;
            float lg[NE];
#pragma unroll
            for (int e = 0; e < NE; ++e) lg[e] = 0.f;
#pragma unroll
            for (int j = 0; j < 4; ++j) { const f32x4 y = v[j] * r * gv[j]; o8[64 * j] = (unsigned long long)pk2(y.x, y.y) | ((unsigned long long)pk2(y.z, y.w) << 32);
                const float* rp = router + (size_t)(4 * lane + 256 * j) * NE;
#pragma unroll
                for (int q = 0; q < 4; ++q) { const f32x4 r0 = *(const f32x4*)(rp + q * NE), r1 = *(const f32x4*)(rp + q * NE + 4); const float yy = y[q];
                    lg[0] += yy * r0.x; lg[1] += yy * r0.y; lg[2] += yy * r0.z; lg[3] += yy * r0.w; lg[4] += yy * r1.x; lg[5] += yy * r1.y; lg[6] += yy * r1.z; lg[7] += yy * r1.w; } }
#pragma unroll
            for (int e = 0; e < NE; ++e) lg[e] = wave_sum(lg[e]);
            int i0 = 0; float v0 = lg[0];
#pragma unroll
            for (int e = 1; e < NE; ++e) if (lg[e] > v0) { v0 = lg[e]; i0 = e; }
            int i1 = -1; float v1 = -INFINITY;
#pragma unroll
            for (int e = 0; e < NE; ++e) if (e != i0 && lg[e] > v1) { v1 = lg[e]; i1 = e; }
            const float g1 = 1.f / (1.f + expf(v0 - v1)), g0 = 1.f - g1;
            if (lane == 0) { e_s[lr] = i0; e_s[256 + lr] = i1; RE[m] = i0; RE[NT + m] = i1; RG[m] = g0; RG[NT + m] = g1; }
        }
        __syncthreads();
        { const int s = tid >> 8, i = tid & 255; const int me = e_s[s * 256 + i]; int rk = 0;
          for (int j = 0; j < i; ++j) rk += (e_s[s * 256 + j] == me) ? 1 : 0;
          RR[s * NT + tile * 256 + i] = rk; }
        if (tid < 16) { const int s = tid >> 3, e = tid & 7; int c = 0; for (int j = 0; j < 256; ++j) c += (e_s[s * 256 + j] == e) ? 1 : 0; CNT[tile * 16 + tid] = c; }
    }
}
__device__ __forceinline__ void moe_scatter(const int* RE, const float* RG, const int* RR, const int* CNT, int* BASE, int* TOK, float* GATEV, LAS float* sm, int bid, int nb) {
    LAS int* tbase = (LAS int*)sm;
    LAS int* gbase = tbase + 128 * 16;
    LAS int* tot = gbase + 32;
    const int tid = fresh_tid();
    __syncthreads();
    if (tid < 16) { int run = 0; for (int t = 0; t < NT / 256; ++t) { tbase[t * 16 + tid] = run; run += CNT[t * 16 + tid]; } tot[tid] = run; }
    __syncthreads();
    if (tid < 2) { int run = 0; for (int e = 0; e < NE; ++e) { gbase[tid * 9 + e] = run; run += (tot[tid * 8 + e] + 255) & ~255; } gbase[tid * 9 + 8] = run; }
    __syncthreads();
    if (bid == 0 && tid < 18) BASE[tid] = gbase[tid];
    for (int i = bid * NTHR + tid; i < 2 * NT; i += nb * NTHR) { const int s = i / NT, m = i % NT; const int e = RE[i];
        const int pos = gbase[s * 9 + e] + tbase[(m >> 8) * 16 + s * 8 + e] + RR[i];
        TOK[s * SLOT_ROWS + pos] = m; GATEV[s * SLOT_ROWS + pos] = RG[i]; }
    for (int gi = bid; gi < 16; gi += nb) { const int s = gi >> 3, e = gi & 7; const int lo = gbase[s * 9 + e] + tot[gi], hi = gbase[s * 9 + e + 1];
        for (int p = lo + tid; p < hi; p += NTHR) { TOK[s * SLOT_ROWS + p] = -1; GATEV[s * SLOT_ROWS + p] = 0.f; } }
}

#define LDS_WAIT() asm volatile("s_waitcnt lgkmcnt(0)" ::: "memory")
__device__ __forceinline__ void transpose_item(const float* W, int N, bf16* WT, int K, int k0, int n0, int drow0, LAS float* scr, int lane) {
#pragma unroll 8
    for (int i = 0; i < 32; ++i) { const int kk = 2 * i + (lane >> 5); scr[kk * 33 + (lane & 31)] = W[(size_t)(k0 + kk) * N + n0 + (lane & 31)]; }
    LDS_WAIT(); asm volatile("" ::: "memory");
    const int c = lane & 7;
#pragma unroll
    for (int j = 0; j < 4; ++j) { const int n = (lane >> 3) + 8 * j; const LAS float* sp = scr + (8 * c) * 33 + n;
        v4u o; o.x = pk2(sp[0 * 33], sp[1 * 33]); o.y = pk2(sp[2 * 33], sp[3 * 33]); o.z = pk2(sp[4 * 33], sp[5 * 33]); o.w = pk2(sp[6 * 33], sp[7 * 33]);
        *(v4u*)(WT + (size_t)(drow0 + n) * K + k0 + 8 * c) = o; }
    LDS_WAIT(); asm volatile("" ::: "memory");
}
__device__ __forceinline__ void convert_matrix(const float* W, int K, int N, bf16* WT, int mode, LAS float* scr, int gw, int ngw, int lane) {
    const int nblk = N / 32, nitems = (K / 64) * nblk;
    for (int it = gw; it < nitems; it += ngw) { const int kb = it / nblk, nbk = it % nblk, n0 = 32 * nbk;
        const int drow0 = mode == 0 ? n0 : ((n0 >> 7) * 256 + (mode == 2 ? 128 : 0) + (n0 & 127));
        transpose_item(W, N, WT, K, 64 * kb, n0, drow0, scr, lane); }
}
constexpr size_t WA_QKV = 0, WA_O = 6 * MiB, WA_GU = 8 * MiB, WA_D = 19 * MiB, WA_IN = 19 * MiB + 5632 * 1024, WA_OUT = WA_IN + 5 * MiB, WA_GATES = WA_OUT + 2560 * 1024;
static_assert(WA_GATES + 2 * NLB * 128 * 128 * 2 <= 33 * MiB, "weights map");
__device__ __forceinline__ void convert_weights_a(const __attribute__((address_space(4))) Args* args, unsigned char* ws, LAS unsigned char* L, int bid, int nb) {
    const int tid = fresh_tid(), lane = tid & 63, wave = tid >> 6; LAS float* scr = (LAS float*)(L + wave * 16384);
    const int gw = bid * NWAVES + wave, ngw = nb * NWAVES; unsigned char* wa = ws + WS_WA;
    convert_matrix(args->in[5], DM, 3 * DM, (bf16*)(wa + WA_QKV), 0, scr, gw, ngw, lane);
    convert_matrix(args->in[6], DM, DM, (bf16*)(wa + WA_O), 0, scr, gw, ngw, lane);
    convert_matrix(args->in[21], DM, DFF, (bf16*)(wa + WA_GU), 1, scr, gw, ngw, lane);
    convert_matrix(args->in[22], DM, DFF, (bf16*)(wa + WA_GU), 2, scr, gw, ngw, lane);
    convert_matrix(args->in[23], DFF, DM, (bf16*)(wa + WA_D), 0, scr, gw, ngw, lane);
    convert_matrix(args->in[12], DM, 2 * DRNN, (bf16*)(wa + WA_IN), 0, scr, gw, ngw, lane);
    convert_matrix(args->in[20], DRNN, DM, (bf16*)(wa + WA_OUT), 0, scr, gw, ngw, lane);
}
constexpr size_t WM_GU = 0, WM_D = 112 * MiB;
__device__ __forceinline__ void convert_weights_moe(const __attribute__((address_space(4))) Args* args, unsigned char* ws, LAS unsigned char* L, int bid, int nb) {
    const int tid = fresh_tid(), lane = tid & 63, wave = tid >> 6; LAS float* scr = (LAS float*)(L + wave * 16384);
    const int gw = bid * NWAVES + wave, ngw = nb * NWAVES; unsigned char* wm = ws + WS_WM;
    for (int e = 0; e < NE; ++e) {
        convert_matrix(args->in[25] + (size_t)e * DM * DFE, DM, DFE, (bf16*)(wm + WM_GU) + (size_t)e * 2 * DFE * DM, 1, scr, gw, ngw, lane);
        convert_matrix(args->in[26] + (size_t)e * DM * DFE, DM, DFE, (bf16*)(wm + WM_GU) + (size_t)e * 2 * DFE * DM, 2, scr, gw, ngw, lane);
        convert_matrix(args->in[27] + (size_t)e * DFE * DM, DFE, DM, (bf16*)(wm + WM_D) + (size_t)e * DM * DFE, 0, scr, gw, ngw, lane);
    }
}
namespace lru {
typedef short bf16x8 __attribute__((ext_vector_type(8)));
typedef float f32x16 __attribute__((ext_vector_type(16)));
__device__ __forceinline__ unsigned cvtpk(float lo, float hi) { unsigned r; asm volatile("v_cvt_pk_bf16_f32 %0, %1, %2" : "=v"(r) : "v"(lo), "v"(hi)); return r; }
__device__ __forceinline__ float sigm(float x) { return __builtin_amdgcn_rcpf(1.0f + __builtin_amdgcn_exp2f(-1.4426950408889634f * x)); }
constexpr int NITEMS = NB_ * NLB * 4, CHUNK = 256, NCHK = SEQ / CHUNK;
__device__ __forceinline__ void lru_items(const bf16* XB, const bf16* G, bf16* Y, const float* convw, const float* convb, const float* gaw, const float* gab, const float* gxw, const float* gxb,
                                          const float* lamp, LAS unsigned char* L, int bid, int nb) {
    const int tid = fresh_tid(), lane = tid & 63, wave = __builtin_amdgcn_readfirstlane(tid >> 6), e = lane & 31, hi = lane >> 5;
    LAS float* cwl = (LAS float*)L;
    LAS float* xch = (LAS float*)(L + 4096);
    for (int item = bid; item < NITEMS; item += nb) {
        const int q = item & 3, n = (item >> 2) % NLB, b = item / (4 * NLB);
        const int cb0 = n * 128, cg = cb0 + 32 * q + e;
        __syncthreads();
        for (int i = tid; i < 5 * 128; i += NTHR) cwl[i] = (i < 512) ? convw[(i >> 7) * DRNN + cb0 + (i & 127)] : convb[cb0 + (i & 127)];
        __syncthreads();
        bf16x8 Ba[8], Bx[8];
#pragma unroll
        for (int ks = 0; ks < 8; ++ks) { float wa[8], wx[8];
#pragma unroll
            for (int j = 0; j < 8; ++j) { const size_t o = ((size_t)n * 128 + 16 * ks + 8 * hi + j) * 128 + 32 * q + e; wa[j] = gaw[o]; wx[j] = gxw[o]; }
            unsigned pa[4], px[4];
#pragma unroll
            for (int j = 0; j < 4; ++j) { pa[j] = cvtpk(wa[2 * j], wa[2 * j + 1]); px[j] = cvtpk(wx[2 * j], wx[2 * j + 1]); }
            Ba[ks] = __builtin_bit_cast(bf16x8, (v4u){pa[0], pa[1], pa[2], pa[3]}); Bx[ks] = __builtin_bit_cast(bf16x8, (v4u){px[0], px[1], px[2], px[3]}); }
        const float ba = gab[cg], bx = gxb[cg], sp8 = -8.0f * log1pf(expf(-lamp[cg]));
        const float cw0 = cwl[0 * 128 + 32 * q + e], cw1 = cwl[1 * 128 + 32 * q + e], cw2 = cwl[2 * 128 + 32 * q + e], cw3 = cwl[3 * 128 + 32 * q + e], cbv = cwl[4 * 128 + 32 * q + e];
        float hprev = 0.f;
        const bf16* XBb = XB + (size_t)b * SEQ * DRNN; const bf16* Gb = G + (size_t)b * SEQ * DRNN; bf16* Yb = Y + (size_t)b * SEQ * DRNN;
        for (int ch = 0; ch < NCHK; ++ch) {
            const int tb = ch * CHUNK + wave * 32;
            bf16x8 Af[8];
            const int ta = tb + e;
#pragma unroll
            for (int ks = 0; ks < 8; ++ks) { const int c0 = 16 * ks + 8 * hi; float acc[8];
                { const f32x4 b0 = *(const LAS f32x4*)(cwl + 4 * 128 + c0), b1 = *(const LAS f32x4*)(cwl + 4 * 128 + c0 + 4);
                  acc[0] = b0.x; acc[1] = b0.y; acc[2] = b0.z; acc[3] = b0.w; acc[4] = b1.x; acc[5] = b1.y; acc[6] = b1.z; acc[7] = b1.w; }
#pragma unroll
                for (int tp = 0; tp < 4; ++tp) { const int tt = ta - 3 + tp;
                    v4u xv = (v4u){0u, 0u, 0u, 0u}; if (tt >= 0) xv = *(const v4u*)(XBb + (size_t)tt * DRNN + cb0 + c0);
                    const f32x4 w0 = *(const LAS f32x4*)(cwl + tp * 128 + c0), w1 = *(const LAS f32x4*)(cwl + tp * 128 + c0 + 4);
                    acc[0] += w0.x * bflo(xv.x); acc[1] += w0.y * bfhi(xv.x); acc[2] += w0.z * bflo(xv.y); acc[3] += w0.w * bfhi(xv.y);
                    acc[4] += w1.x * bflo(xv.z); acc[5] += w1.y * bfhi(xv.z); acc[6] += w1.z * bflo(xv.w); acc[7] += w1.w * bfhi(xv.w); }
                Af[ks] = __builtin_bit_cast(bf16x8, (v4u){cvtpk(acc[0], acc[1]), cvtpk(acc[2], acc[3]), cvtpk(acc[4], acc[5]), cvtpk(acc[6], acc[7])}); }
            f32x16 ar = {}, ai = {};
#pragma unroll
            for (int ks = 0; ks < 8; ++ks) { ar = __builtin_amdgcn_mfma_f32_32x32x16_bf16(Af[ks], Ba[ks], ar, 0, 0, 0); ai = __builtin_amdgcn_mfma_f32_32x32x16_bf16(Af[ks], Bx[ks], ai, 0, 0, 0); }
            float av[16], hl[16];
#pragma unroll
            for (int g = 0; g < 4; ++g) { const int t0 = tb + 8 * g + 4 * hi; float xr[7];
#pragma unroll
                for (int k = 0; k < 7; ++k) { const int tt = t0 - 3 + k; xr[k] = (tt >= 0) ? bf2f(XBb[(size_t)tt * DRNN + cg]) : 0.f; }
#pragma unroll
                for (int i = 0; i < 4; ++i) { const int r = 4 * g + i;
                    const float xc = cbv + cw0 * xr[i] + cw1 * xr[i + 1] + cw2 * xr[i + 2] + cw3 * xr[i + 3];
                    const float rg = sigm(ar[r] + ba), ig = sigm(ai[r] + bx);
                    const float la = sp8 * rg, a = __expf(la), mult = sqrtf(-expm1f(2.0f * la));
                    av[r] = a; hl[r] = mult * (ig * xc); } }
#pragma unroll
            for (int g = 0; g < 4; ++g) {
#pragma unroll
                for (int i = 1; i < 4; ++i) { const int r = 4 * g + i; hl[r] = av[r] * hl[r - 1] + hl[r]; av[r] = av[r] * av[r - 1]; } }
            float PA = 1.f, PH = 0.f;
#pragma unroll
            for (int g = 0; g < 4; ++g) { const float As = av[4 * g + 3], Hs = hl[4 * g + 3];
                const float Ap = __shfl_xor(As, 32), Hp = __shfl_xor(Hs, 32);
                const float Alo = hi ? Ap : As, Hlo = hi ? Hp : Hs, Ahi = hi ? As : Ap, Hhi = hi ? Hs : Hp;
                const float PA1 = PA * Alo, PH1 = Alo * PH + Hlo;
                const float EA = hi ? PA1 : PA, EH = hi ? PH1 : PH;
#pragma unroll
                for (int i = 0; i < 4; ++i) { const int r = 4 * g + i; hl[r] = hl[r] + av[r] * EH; av[r] = av[r] * EA; }
                PH = Ahi * PH1 + Hhi; PA = PA1 * Ahi; }
            LAS float* xb = xch + (ch & 1) * 512;
            if (hi == 0) { xb[wave * 64 + e] = PA; xb[wave * 64 + 32 + e] = PH; }
            __syncthreads();
            float hin = 0.f, h = hprev;
#pragma unroll
            for (int w = 0; w < 8; ++w) { if (w == wave) hin = h; h = xb[w * 64 + e] * h + xb[w * 64 + 32 + e]; }
            hprev = h;
#pragma unroll
            for (int r = 0; r < 16; ++r) { const int t = tb + (r & 3) + 8 * (r >> 2) + 4 * hi; const size_t o = (size_t)t * DRNN + cg;
                const float hv = hl[r] + av[r] * hin; Yb[o] = (bf16)f2bf(hv * bf2f(Gb[o])); }
        }
    }
}
constexpr int CONV_PER_MAT = (DM / 64) * (DFE / 32), CONV_PER_E = 3 * CONV_PER_MAT, CONV_TOTAL = NE * CONV_PER_E;
__device__ __forceinline__ void convert_moe_queue(const float* wg, const float* wu, const float* wd, bf16* WGU, bf16* WD, unsigned* ticket, LAS unsigned char* L) {
    const int tid = fresh_tid(), lane = tid & 63, wave = __builtin_amdgcn_readfirstlane(tid >> 6); LAS float* scr = (LAS float*)(L + wave * 16384);
    for (;;) {
        unsigned it = 0; if (lane == 0) it = __hip_atomic_fetch_add(ticket, 1u, __ATOMIC_RELAXED, __HIP_MEMORY_SCOPE_AGENT);
        it = (unsigned)__builtin_amdgcn_readfirstlane((int)it);
        if (it >= (unsigned)CONV_TOTAL) break;
        const int ex = it / CONV_PER_E, r = it % CONV_PER_E, m = r / CONV_PER_MAT, idx = r % CONV_PER_MAT;
        if (m < 2) { const int nblk = DFE / 32, kb = idx / nblk, n0 = 32 * (idx % nblk); const int drow0 = (n0 >> 7) * 256 + (m == 1 ? 128 : 0) + (n0 & 127);
            transpose_item((m == 0 ? wg : wu) + (size_t)ex * DM * DFE, DFE, WGU + (size_t)ex * 2 * DFE * DM, DM, 64 * kb, n0, drow0, scr, lane); }
        else { const int nblk = DM / 32, kb = idx / nblk, n0 = 32 * (idx % nblk);
            transpose_item(wd + (size_t)ex * DFE * DM, DM, WD + (size_t)ex * DM * DFE, DFE, 64 * kb, n0, n0, scr, lane); }
    }
}
}
constexpr int N_PHASES = 21;
typedef const __attribute__((address_space(4))) Args* KArgs;
__device__ __forceinline__ KArgs fresh_args() { KArgs k = (KArgs)__builtin_amdgcn_kernarg_segment_ptr(); asm volatile("" : "+s"(k)); return k; }
#define WSP(T, off) ((T*)(ws + (off)))
__global__ void __launch_bounds__(NTHR, 2) fwd(Args args_unused) {
    extern __shared__ __attribute__((aligned(16))) unsigned char lds[];
    LAS unsigned char* L = (LAS unsigned char*)lds;
    LAS float* sm = (LAS float*)L;
    volatile LAS unsigned* MISC = (volatile LAS unsigned*)(L + MISC_OFF);
    const int bid = blockIdx.x, nb = gridDim.x;
    { const int tid = threadIdx.x; for (int u = tid; u < (LDS_BYTES - LDSCTL_OFF) / 4; u += NTHR) ((LAS unsigned*)(L + LDSCTL_OFF))[u] = 0u; }
    __syncthreads();
    int lo, hi;
    XcdBarrier bar;
    { KArgs ka = fresh_args(); lo = ka->ph_lo; hi = ka->ph_hi; bar.bar = (unsigned*)(ka->ws + WS_CTL) + CW_BAR; bar.x = 0; bar.st = nullptr; }
#if MK_ONE_LAUNCH
    bar = xcd_barrier_post(bar.bar, MISC + 8);
#endif
#ifndef PH_MASK
#define PH_MASK 0x1FFFFF
#endif
#define IN(k) (((PH_MASK >> (k)) & 1) && lo <= (k) && (k) < hi)
#if MK_ONE_LAUNCH
#define SEAM(k) do { if (IN(k) && IN((k) + 1)) xcd_barrier(bar); } while (0)
#else
#define SEAM(k) do { } while (0)
#endif
#define PH_BEGIN KArgs ka = fresh_args(); unsigned char* ws = ka->ws; (void)ws;
#define SMALLP(T, off) WSP(T, WS_SMALL + (off))
#define WAT(off) WSP(const pg8::bf16_t, WS_WA + (off))

    if (IN(0)) { PH_BEGIN if (bid == 0) build_tables(ka->in[4], SMALLP(float, SM_TB));
        convert_weights_a(ka, ws, L, bid, nb); __syncthreads();
        rms_rows_bf16(ka->in[0], ka->in[1], WSP(bf16, WS_H), bid, nb); } SEAM(0);
    if (IN(1)) { PH_BEGIN pg8::Gemm g{WSP(bf16, WS_H), WAT(WA_QKV), NT, 3 * DM, DM}; pg8::StaticOrder S; S.init(NT, 3 * DM, nb, bid);
        pg8::EpiBf16<0> E{WSP(bf16, WS_Q), DM, nullptr, DM, (size_t)(WS_K - WS_Q) / 2, C2};
        pg8::gemm_phase<pg8::EpiBf16<0>, pg8::StaticOrder, true, true>(L, g, S, E); } SEAM(1);
#if FAST_ATTN
    if (IN(2)) { PH_BEGIN const attn_body::AttnTensors AT{WSP(const attn_body::bf16, WS_Q), WSP(const attn_body::bf16, WS_K), WSP(const attn_body::bf16, WS_V), WSP(attn_body::bf16, WS_O0), WSP(attn_body::bf16, WS_O1), SMALLP(const float, SM_TB)};
        attn_body::attn_phase<8>((char*)lds, AT, nb, bid); } SEAM(2);
#else
    if (IN(2)) { PH_BEGIN ref_attention(WSP(bf16, WS_Q), WSP(bf16, WS_K), WSP(bf16, WS_V), WSP(bf16, WS_O0), WSP(bf16, WS_O1), SMALLP(float, SM_TB), sm, bid, nb); } SEAM(2);
#endif
    if (IN(3)) { PH_BEGIN const float lam = compute_lam(ka->in[7], ka->in[8], ka->in[9], ka->in[10]); combine_rows(WSP(bf16, WS_O0), WSP(bf16, WS_O1), WSP(bf16, WS_H), ka->in[11], lam, bid, nb); } SEAM(3);
    if (IN(4)) { PH_BEGIN pg8::Gemm g{WSP(bf16, WS_H), WAT(WA_O), NT, DM, DM}; pg8::StaticOrder S; S.init(NT, DM, nb, bid);
        pg8::EpiResF32 E{ka->in[0], ka->out, DM};
        pg8::gemm_phase<pg8::EpiResF32, pg8::StaticOrder, true, true>(L, g, S, E); } SEAM(4);
    if (IN(5)) { PH_BEGIN rms_rows_bf16(ka->out, ka->in[2], WSP(bf16, WS_H), bid, nb); } SEAM(5);
    if (IN(6)) { PH_BEGIN pg8::Gemm g{WSP(bf16, WS_H), WAT(WA_GU), NT, 2 * DFF, DM}; pg8::StaticOrder S; S.init(NT, 2 * DFF, nb, bid);
        pg8::EpiSwiglu E{WSP(bf16, WS_ACT), DFF};
        pg8::gemm_phase<pg8::EpiSwiglu, pg8::StaticOrder, true, true>(L, g, S, E); } SEAM(6);
    if (IN(7)) { PH_BEGIN pg8::Gemm g{WSP(bf16, WS_ACT), WAT(WA_D), NT, DM, DFF}; pg8::StaticOrder S; S.init(NT, DM, nb, bid);
        pg8::EpiResF32 E{ka->out, ka->out, DM};
        pg8::gemm_phase<pg8::EpiResF32, pg8::StaticOrder, true, true>(L, g, S, E); } SEAM(7);
    if (IN(8)) { PH_BEGIN rms_rows_bf16(ka->out, ka->in[1] + DM, WSP(bf16, WS_H), bid, nb); } SEAM(8);
    if (IN(9)) { PH_BEGIN pg8::Gemm g{WSP(bf16, WS_H), WAT(WA_IN), NT, 2 * DRNN, DM}; pg8::StaticOrder S; S.init(NT, 2 * DRNN, nb, bid);
        pg8::EpiWin E{WSP(bf16, WS_G), WSP(bf16, WS_XB), DRNN, DRNN / 256};
        pg8::gemm_phase<pg8::EpiWin, pg8::StaticOrder, true, true>(L, g, S, E); } SEAM(9);
#if FAST_LRU
    if (IN(10)) { PH_BEGIN lru::lru_items(WSP(bf16, WS_XB), WSP(bf16, WS_G), WSP(bf16, WS_Y), ka->in[13], ka->in[14], ka->in[15], ka->in[16], ka->in[17], ka->in[18], ka->in[19], L, bid, nb);
        __syncthreads();
        lru::convert_moe_queue(ka->in[25], ka->in[26], ka->in[27], WSP(bf16, WS_WM + WM_GU), WSP(bf16, WS_WM + WM_D), (unsigned*)(ws + WS_CTL) + CW_TICKET, L); } SEAM(12);
#else
    if (IN(10)) { PH_BEGIN ref_lru_local(WSP(bf16, WS_XB), ka->in[13], ka->in[14], ka->in[15], ka->in[16], ka->in[17], ka->in[18], ka->in[19], WSP(bf16, WS_HL), WSP(bf16, WS_CA), SMALLP(float, SM_AEND), SMALLP(float, SM_HEND), sm, bid, nb); } SEAM(10);
    if (IN(11)) { PH_BEGIN lru_carry(SMALLP(float, SM_AEND), SMALLP(float, SM_HEND), SMALLP(float, SM_CIN), bid, nb); } SEAM(11);
    if (IN(12)) { PH_BEGIN lru_fixup(WSP(bf16, WS_HL), WSP(bf16, WS_CA), WSP(bf16, WS_G), SMALLP(float, SM_CIN), WSP(bf16, WS_Y), bid, nb); } SEAM(12);
#endif
    if (IN(13)) { PH_BEGIN pg8::Gemm g{WSP(bf16, WS_Y), WAT(WA_OUT), NT, DM, DRNN}; pg8::StaticOrder S; S.init(NT, DM, nb, bid);
        pg8::EpiResF32 E{ka->out, ka->out, DM};
        pg8::gemm_phase<pg8::EpiResF32, pg8::StaticOrder, true, true>(L, g, S, E); } SEAM(13);
    if (IN(14)) { PH_BEGIN int* RE = SMALLP(int, SM_ROUTE); moe_route(ka->out, ka->in[2] + DM, ka->in[24], WSP(bf16, WS_H), RE, (float*)(RE + 2 * NT), RE + 4 * NT, SMALLP(int, SM_CNT), sm, bid, nb); } SEAM(14);
    if (IN(15)) { PH_BEGIN int* RE = SMALLP(int, SM_ROUTE); moe_scatter(RE, (float*)(RE + 2 * NT), RE + 4 * NT, SMALLP(int, SM_CNT), SMALLP(int, SM_BASE), SMALLP(int, SM_TOK), SMALLP(float, SM_GATEV), sm, bid, nb);
#if !FAST_LRU
        __syncthreads(); convert_weights_moe(ka, ws, L, bid, nb);
#endif
    } SEAM(15);
    for (int sl = 0; sl < 2; ++sl) {
        if (IN(16 + 2 * sl)) { PH_BEGIN const int* tok_s = SMALLP(int, SM_TOK) + sl * SLOT_ROWS; const int* base_s = SMALLP(int, SM_BASE) + sl * 9; const int rows = base_s[8];
            pg8::Gemm g{WSP(bf16, WS_H), WSP(const pg8::bf16_t, WS_WM + WM_GU), rows, 2 * DFE, DM}; pg8::MoeOrder S; S.init_moe(rows, 2 * DFE, nb, bid, tok_s, base_s);
            pg8::EpiSwiglu E{WSP(bf16, WS_ACTM), DFE};
            pg8::gemm_phase<pg8::EpiSwiglu, pg8::MoeOrder, true, true, true>(L, g, S, E); } SEAM(16 + 2 * sl);
        if (IN(17 + 2 * sl)) { PH_BEGIN const int* tok_s = SMALLP(int, SM_TOK) + sl * SLOT_ROWS; const float* gate_s = SMALLP(float, SM_GATEV) + sl * SLOT_ROWS; const int* base_s = SMALLP(int, SM_BASE) + sl * 9; const int rows = base_s[8];
            pg8::Gemm g{WSP(bf16, WS_ACTM), WSP(const pg8::bf16_t, WS_WM + WM_D), rows, DM, DFE}; pg8::MoeOrder S; S.init_moe(rows, DM, nb, bid, tok_s, base_s);
            pg8::EpiMoeDown E{ka->out, DM, tok_s, gate_s};
            pg8::gemm_phase<pg8::EpiMoeDown, pg8::MoeOrder, true, true, false>(L, g, S, E); } SEAM(17 + 2 * sl);
    }
    if (IN(20)) { PH_BEGIN rms_rows_f32_inplace(ka->out, ka->in[3], bid, nb); }
#undef IN
#undef SEAM
}

extern "C" void kernel_launch(void* const* d_in, const int* in_sizes, int n_in, void* d_out, int out_size, void* d_ws, size_t ws_size, hipStream_t stream) {
    static int grid = 0;
    if (grid == 0) {
        if (n_in != 28 || in_sizes[0] != NT * DM || out_size != NT * DM || ws_size < WS_END) { fprintf(stderr, "kernel_launch: unexpected shapes (n_in %d, in0 %d, out %d, ws %zu); nothing launched\n", n_in, n_in > 0 ? in_sizes[0] : -1, out_size, ws_size); grid = -1; return; }
        int dev = 0, cus = 0, per_cu = 0;
        if (hipGetDevice(&dev) != hipSuccess || hipDeviceGetAttribute(&cus, hipDeviceAttributeMultiprocessorCount, dev) != hipSuccess) { grid = -1; return; }
        if (hipFuncSetAttribute((const void*)fwd, hipFuncAttributeMaxDynamicSharedMemorySize, LDS_BYTES) != hipSuccess) { fprintf(stderr, "kernel_launch: hipFuncSetAttribute failed\n"); grid = -1; return; }
        if (hipOccupancyMaxActiveBlocksPerMultiprocessor(&per_cu, (const void*)fwd, NTHR, LDS_BYTES) != hipSuccess || per_cu < 1) { fprintf(stderr, "kernel_launch: occupancy query reports %d\n", per_cu); }
        (void)hipGetLastError();
        grid = cus & ~7;
    }
    if (grid < 0) return;
    if (hipMemsetAsync((char*)d_ws + WS_CTL, 0, CTL_ZERO_BYTES, stream) != hipSuccess) return;
    Args a{};
    for (int i = 0; i < 28; ++i) a.in[i] = (const float*)d_in[i];
    a.out = (float*)d_out; a.ws = (unsigned char*)d_ws;
#if MK_ONE_LAUNCH
    a.ph_lo = 0; a.ph_hi = N_PHASES;
    hipLaunchKernelGGL(fwd, dim3(grid), dim3(NTHR), LDS_BYTES, stream, a);
#else
    for (int p = 0; p < N_PHASES; ++p) { a.ph_lo = p; a.ph_hi = p + 1; hipLaunchKernelGGL(fwd, dim3(grid), dim3(NTHR), LDS_BYTES, stream, a); }
#endif
}
```

```cpp
#include <hip/hip_runtime.h>
#include <cstdio>
#include <cstdint>

#ifndef FAST_GEMM
#define FAST_GEMM 1
#endif
#ifndef FAST_ATTN
#define FAST_ATTN 1
#endif
#ifndef I8_QKV
#define I8_QKV 1
#endif
#ifndef I8_FFN
#define I8_FFN 1
#endif
#ifndef I8_WIN
#define I8_WIN 1
#endif
#ifndef I8_MOE
#define I8_MOE 1
#endif
#ifndef XS_BF16
#define XS_BF16 1
#endif
#ifndef FAST_LRU
#define FAST_LRU 1
#endif
#ifndef ATTN_PC
#define ATTN_PC 3
#endif
#ifndef FAST_MOE
#define FAST_MOE 1
#endif
#ifndef MK_ONE_LAUNCH
#define MK_ONE_LAUNCH 1
#endif

#define GAS __attribute__((address_space(1)))
#define LAS __attribute__((address_space(3)))
typedef unsigned short bf16;
typedef unsigned v4u __attribute__((ext_vector_type(4)));
typedef unsigned v2u __attribute__((ext_vector_type(2)));
typedef float f32x4 __attribute__((ext_vector_type(4)));
typedef GAS unsigned gu32;
#define RLX_AGENT __ATOMIC_RELAXED, __HIP_MEMORY_SCOPE_AGENT

constexpr int NB_ = 4, SEQ = 8192, DM = 1024, NT = NB_ * SEQ;
constexpr int NH = 8, HD = 64, VD = 128;
constexpr int DRNN = 1280, NLB = 10, LBK = 128, CW = 4;
constexpr int DFF = 2816, NE = 8, DFE = 3584;
constexpr float NORM_EPS = 1e-6f, SUBLN_EPS = 1e-5f, LOG2E = 1.4426950408889634f;
constexpr float C2 = 0.125f * LOG2E;
constexpr float LAM_INIT = 0.2f;
constexpr int NWAVES = 8, NTHR = 512;
constexpr int LCH = 64, NCH = SEQ / LCH;
constexpr int SLOT_ROWS = NT + NE * 256;

constexpr size_t MiB = 1u << 20;
constexpr size_t WS_CTL = 0, CTL_ZERO_BYTES = 1 * MiB;
constexpr size_t WS_SMALL = 1 * MiB;
constexpr size_t SM_TB = 0;
constexpr size_t SM_ROUTE = 64 * 1024;
constexpr size_t SM_CNT = 1 * MiB;
constexpr size_t SM_BASE = 1 * MiB + 16 * 1024;
constexpr size_t SM_TOK = 2 * MiB;
constexpr size_t SM_GATEV = 2 * MiB + 512 * 1024;
constexpr size_t SM_AEND = 4 * MiB;
constexpr size_t SM_HEND = 7 * MiB;
constexpr size_t SM_CIN = 10 * MiB;
constexpr size_t SM_SB = 13 * MiB;
constexpr size_t SB_QKV = 0, SB_GU = 3072, SB_IN = SB_GU + 2 * DFF, SB_MOE = SB_IN + 2 * DRNN;
constexpr size_t SM_SAS = 14 * MiB + 256 * 1024;
constexpr size_t SM_TOK16 = 14 * MiB + 768 * 1024;
constexpr size_t SM_SA = 14 * MiB;
constexpr size_t WS_WA = 17 * MiB;
constexpr size_t WS_O0 = 50 * MiB, WS_O1 = 114 * MiB;
constexpr size_t WS_HL = 50 * MiB, WS_CA = 130 * MiB;
constexpr size_t WS_WM = 50 * MiB;
constexpr size_t WS_XS = 162 * MiB;
constexpr size_t WS_HB = WS_XS;
constexpr size_t WS_H = 250 * MiB;
constexpr size_t WS_SCR = 282 * MiB;
constexpr size_t WS_Q = WS_SCR, WS_K = WS_SCR + 64 * MiB, WS_V = WS_SCR + 128 * MiB;
constexpr size_t WS_OC = WS_Q;
constexpr size_t WS_ACT = WS_SCR;
constexpr size_t WS_G = WS_SCR, WS_XB = WS_SCR + 80 * MiB, WS_Y = WS_SCR + 160 * MiB;
constexpr size_t WS_XC = WS_Y, WS_YF = WS_XB;
constexpr size_t WS_ACTM = WS_SCR;
constexpr size_t WS_END = 522 * MiB;
static_assert(WS_ACTM + (size_t)SLOT_ROWS * DFE * 2 <= WS_END && WS_XC + (size_t)NT * DRNN * 2 <= WS_END && WS_XS + (size_t)NT * DM * 2 <= WS_H && WS_H + (size_t)NT * DM <= WS_SCR, "ws map");
static_assert(SM_CIN + (size_t)NB_ * NCH * DRNN * 4 <= 16 * MiB, "small map");
constexpr int CW_BAR = 4096, CW_TICKET = 8192;

__device__ __forceinline__ int fresh_tid() { int t = threadIdx.x; asm volatile("" : "+v"(t)); return t; }
__device__ __forceinline__ unsigned f2bf(float f) { unsigned u = __builtin_bit_cast(unsigned, f); return (u + 0x7fffu + ((u >> 16) & 1u)) >> 16; }
__device__ __forceinline__ unsigned pk2(float lo, float hi) { return f2bf(lo) | (f2bf(hi) << 16); }
__device__ __forceinline__ float bflo(unsigned u) { return __builtin_bit_cast(float, u << 16); }
__device__ __forceinline__ float bfhi(unsigned u) { return __builtin_bit_cast(float, u & 0xffff0000u); }
__device__ __forceinline__ float bf2f(bf16 v) { return __builtin_bit_cast(float, (unsigned)v << 16); }
__device__ __forceinline__ float wave_sum(float v) {
#pragma unroll
    for (int o = 1; o < 64; o <<= 1) v += __shfl_xor(v, o);
    return v;
}
__device__ __forceinline__ float sigmoidf_(float x) { return 1.f / (1.f + __expf(-x)); }

#define XB_TMO      128
#define XB_XCNT(j)  (256  + 64 * (j))
#define XB_XSUB(j)  (1280 + 64 * (j))
#define XB_XGEN(j)  (2304 + 64 * (j))
#define XB_TOP      3328
#define XB_TOPGEN   3392
#define XCD_BAR_WORDS 3456
#define XB_SPIN_CAP (1u << 18)
__device__ __forceinline__ unsigned xb_ld(unsigned* p)              { return __hip_atomic_load(p, __ATOMIC_RELAXED, __HIP_MEMORY_SCOPE_AGENT); }
__device__ __forceinline__ unsigned xb_add(unsigned* p, unsigned v) { return __hip_atomic_fetch_add(p, v, __ATOMIC_RELAXED, __HIP_MEMORY_SCOPE_AGENT); }
__device__ __forceinline__ unsigned xb_xcc_id() { return (unsigned)__builtin_amdgcn_s_getreg((3 << 11) | 20) & 0xFu; }
#define XB_SPIN(cond, bar) do { unsigned _sp = 0; while (cond) { __builtin_amdgcn_s_sleep(1); \
    if ((++_sp & 255u) == 0u) { if (xb_ld(&(bar)[XB_TMO])) break; if (_sp > XB_SPIN_CAP) { atomicAdd(&(bar)[XB_TMO], 1u); break; } } } } while (0)
struct XcdBarrier { unsigned* bar; unsigned x; volatile LAS unsigned* st; };
__device__ __forceinline__ XcdBarrier xcd_barrier_post(unsigned* bar, volatile LAS unsigned* st) {
    XcdBarrier b; b.bar = bar; b.x = xb_xcc_id(); b.st = st;
    if (threadIdx.x == 0) (void)xb_add(&bar[XB_XCNT(b.x)], 1u);
    return b;
}
__device__ __forceinline__ void xcd_barrier_complete(unsigned* bar, unsigned x, unsigned& nloc, unsigned& nx) {
    const unsigned G = gridDim.x * gridDim.y * gridDim.z;
    unsigned sum, cnt, mine, sp = 0u;
    for (;;) {
        sum = 0u; cnt = 0u; mine = 0u;
#pragma unroll
        for (unsigned j = 0; j < 16; ++j) { const unsigned c = xb_ld(&bar[XB_XCNT(j)]); sum += c; cnt += (c > 0u) ? 1u : 0u; mine = (j == x) ? c : mine; }
        if (sum == G) break;
        __builtin_amdgcn_s_sleep(1);
        if ((++sp & 255u) == 0u) { if (xb_ld(&bar[XB_TMO])) break; if (sp > XB_SPIN_CAP) { atomicAdd(&bar[XB_TMO], 1u); break; } }
    }
    nloc = mine > 0u ? mine : 1u; nx = cnt > 0u ? cnt : 1u;
}
__device__ __forceinline__ void xcd_barrier(const XcdBarrier& b) {
    asm volatile("s_waitcnt vmcnt(0)" ::: "memory");
    __syncthreads();
    if (threadIdx.x == 0) {
        unsigned* bar = b.bar;
        __builtin_amdgcn_s_waitcnt(0);
        unsigned nloc = b.st[0], nx = b.st[1];
        if (nloc == 0u) { xcd_barrier_complete(bar, b.x, nloc, nx); b.st[0] = nloc; b.st[1] = nx; }
        const unsigned old = xb_add(&bar[XB_XSUB(b.x)], 1u);
        const unsigned gen = old / nloc;
        if (old + 1u == (gen + 1u) * nloc) {
            __builtin_amdgcn_fence(__ATOMIC_RELEASE, "agent");
            asm volatile("s_waitcnt vmcnt(0)" ::: "memory");
            const unsigned og = xb_add(&bar[XB_TOP], 1u);
            const unsigned tg = og / nx;
            if (og + 1u == (tg + 1u) * nx) xb_add(&bar[XB_TOPGEN], 1u);
            else XB_SPIN(xb_ld(&bar[XB_TOPGEN]) == tg, bar);
            __builtin_amdgcn_fence(__ATOMIC_ACQUIRE, "agent");
            xb_add(&bar[XB_XGEN(b.x)], 1u);
            asm volatile("s_waitcnt vmcnt(0)" ::: "memory");
        } else {
            XB_SPIN(xb_ld(&bar[XB_XGEN(b.x)]) == gen, bar);
            __builtin_amdgcn_fence(__ATOMIC_ACQUIRE, "agent");
            asm volatile("s_waitcnt vmcnt(0)" ::: "memory");
        }
    }
    __syncthreads();
}

namespace pg8 {
#define PG8_LAS __attribute__((address_space(3)))
typedef unsigned short bf16_t;
typedef short bf16x8 __attribute__((ext_vector_type(8)));
typedef float f32x4 __attribute__((ext_vector_type(4)));
typedef unsigned u32x4 __attribute__((ext_vector_type(4)));
typedef int i32x4 __attribute__((ext_vector_type(4)));
constexpr int BM = 256, BK = 64, HALF = 128, HTB = HALF * BK * 2  , STAGE_BYTES = 8 * HTB, NXCD = 8, WGM = 8;

__host__ __device__ __forceinline__ int lds_byte(int r, int c) { const int st = (r >> 4) * 2 + (c >> 5), rr = r & 15, cc = c & 31, ob = rr * 64 + cc * 2; return st * 1024 + (ob ^ (((ob >> 9) & 1) << 5)); }
__host__ __device__ __forceinline__ void stage_rc(int b, int& R, int& C) { const int st = b / 1024, sb = b % 1024, swz = sb ^ (((sb >> 9) & 1) << 5); R = (st >> 1) * 16 + swz / 64; C = (st & 1) * 32 + (swz % 64) / 2; }
__host__ __device__ __forceinline__ int perm32(int rho) { const int n = rho >> 4, i = rho & 15; return 8 * (i >> 2) + 4 * n + (i & 3); }

struct Unit { int pm, pn, pb; };
struct Gemm { const bf16_t* A; const bf16_t* Bt; int M, N, K; };

struct StaticOrder {
    int nM, nN, nwg, G, c, nlim;
    __host__ __device__ void init(int M, int N, int G_, int c_) { nM = M / BM; nN = N / BM; nwg = nM * nN; G = G_; c = c_; nlim = nwg; }
    __host__ __device__ bool next(int i, Unit& u) const { const long L = (long)i * G + c; if (L >= nlim) return false; unit_at((int)L, u); return true; }
    __host__ __device__ void unit_at(int Lu, Unit& u) const {
        int wgid = Lu; { const int q = nwg / NXCD, r = nwg % NXCD, xcd = wgid % NXCD, off = wgid / NXCD; wgid = (xcd < r ? xcd * (q + 1) : r * (q + 1) + (xcd - r) * q) + off; }
        const int nig = WGM * nN, gid = wgid / nig, fm = gid * WGM, gsz = (nM - fm) < WGM ? (nM - fm) : WGM;
        u.pm = fm + ((wgid % nig) % gsz); u.pn = (wgid % nig) / gsz; u.pb = u.pn;
    }
    __device__ __forceinline__ void a_ready(const Unit&) const {}
    __device__ __forceinline__ void done(const Unit&) const {}
};

typedef float f32x2c __attribute__((ext_vector_type(2))); typedef __bf16 bf16x2c __attribute__((ext_vector_type(2)));
__device__ __forceinline__ unsigned cvt_pk_bf16(float lo, float hi) { f32x2c v = {lo, hi}; bf16x2c b = __builtin_convertvector(v, bf16x2c); return __builtin_bit_cast(unsigned, b); }
typedef float f32x2 __attribute__((ext_vector_type(2)));

template <int ACT  > struct EpiBf16 {
    static constexpr bool PERM = true, AFTER_DRAIN = false; static_assert(ACT == 0, "EpiBf16: only ACT 0 here");
    bf16_t* O; int ldc; const float* bias; int split_cols; size_t split_stride; float scale0;
    __device__ __forceinline__ void operator()(const f32x4 (&acc)[2][2][4][2], const Unit& u, int wr, int wc, int fr, int fq) const {
        const int row0 = u.pm * BM + wr * 64 + fr; int colt = u.pn * BM; bf16_t* base = O;
        float sc = 1.f; if (split_cols) { const int t = colt / split_cols; base += (size_t)t * split_stride; colt -= t * split_cols; if (t == 0) sc = scale0; }
        const int col0 = colt + wc * 32 + 8 * fq, bcol0 = u.pn * BM + wc * 32 + 8 * fq;
        f32x4 bv[2][2];
#pragma unroll
        for (int bj = 0; bj < 2; ++bj)
#pragma unroll
            for (int n = 0; n < 2; ++n) bv[bj][n] = bias ? *(const f32x4*)(bias + bcol0 + bj * HALF + 4 * n) : (f32x4){0.f, 0.f, 0.f, 0.f};
#pragma unroll
        for (int ai = 0; ai < 2; ++ai)
#pragma unroll
            for (int m = 0; m < 4; ++m) { bf16_t* rowp = base + (size_t)(row0 + ai * HALF + m * 16) * ldc + col0;
#pragma unroll
                for (int bj = 0; bj < 2; ++bj) { f32x4 v0 = acc[ai][bj][m][0] + bv[bj][0], v1 = acc[ai][bj][m][1] + bv[bj][1];
                    v0 = v0 * sc; v1 = v1 * sc; u32x4 w; w.x = cvt_pk_bf16(v0[0], v0[1]); w.y = cvt_pk_bf16(v0[2], v0[3]); w.z = cvt_pk_bf16(v1[0], v1[1]); w.w = cvt_pk_bf16(v1[2], v1[3]);
                    *(u32x4*)(rowp + bj * HALF) = w; } }
    }
};

__device__ __forceinline__ float silu_f(float x) { return x * __builtin_amdgcn_rcpf(1.0f + __builtin_amdgcn_exp2f(-1.4426950408889634f * x)); }
__device__ __forceinline__ float gelu_tanh_f(float x) { const float u = x * (0.7978845608028654f + 0.035677408136300125f * x * x);
    return x * __builtin_amdgcn_rcpf(1.0f + __builtin_amdgcn_exp2f(-2.0f * 1.4426950408889634f * u)); }
struct EpiResF32 {
    static constexpr bool PERM = false, AFTER_DRAIN = false;
    const float* base; float* out; int ldc;
    __device__ __forceinline__ void operator()(const f32x4 (&acc)[2][2][4][2], const Unit& u, int wr, int wc, int fr, int fq) const {
        const int row0 = u.pm * BM + wr * 64 + fr, col0 = u.pn * BM + wc * 32 + 4 * fq;
#pragma unroll
        for (int ai = 0; ai < 2; ++ai)
#pragma unroll
            for (int m = 0; m < 4; ++m) { const size_t off = (size_t)(row0 + ai * HALF + m * 16) * ldc + col0;
                f32x4 b[2][2];
#pragma unroll
                for (int bj = 0; bj < 2; ++bj)
#pragma unroll
                    for (int n = 0; n < 2; ++n) b[bj][n] = *(const f32x4*)(base + off + bj * HALF + n * 16);
#pragma unroll
                for (int bj = 0; bj < 2; ++bj)
#pragma unroll
                    for (int n = 0; n < 2; ++n) *(f32x4*)(out + off + bj * HALF + n * 16) = b[bj][n] + acc[ai][bj][m][n];
                asm volatile("" ::: "memory"); }
    }
};
__device__ __forceinline__ unsigned dpp_xor8(unsigned x) { return (unsigned)__builtin_amdgcn_update_dpp(0, (int)x, 0x128  , 0xf, 0xf, true); }
__device__ __forceinline__ u32x4 dpp_xor8(const u32x4 v) { return (u32x4){dpp_xor8(v.x), dpp_xor8(v.y), dpp_xor8(v.z), dpp_xor8(v.w)}; }
__device__ __forceinline__ void p2_to_rows(const u32x4 w0, const u32x4 w1, bool lo, u32x4& a, u32x4& b) { const u32x4 x = lo ? w1 : w0; const u32x4 r = dpp_xor8(x); a = lo ? w0 : r; b = lo ? r : w1; }
__device__ __forceinline__ void p2_from_rows(const u32x4 a, const u32x4 b, bool lo, u32x4& w0, u32x4& w1) { const u32x4 x = lo ? b : a; const u32x4 r = dpp_xor8(x); w0 = lo ? a : r; w1 = lo ? r : b; }
template <class BaseT> struct EpiResX {
    static constexpr bool PERM = true, AFTER_DRAIN = false, PERM2 = sizeof(BaseT) == 2;
    const BaseT* base; bf16_t* out; int ldc;
    __device__ __forceinline__ void operator()(const f32x4 (&acc)[2][2][4][2], const Unit& u, int wr, int wc, int fr_, int fq_) const {
        int fr = fr_, fq = fq_; asm volatile("" : "+v"(fr), "+v"(fq));
        if constexpr (PERM2) {
            const bool lo = (fr & 8) == 0;
            const int row0 = u.pm * BM + wr * 64 + (fr & 7), col0 = u.pn * BM + wc * 64 + (lo ? 0 : 32) + 8 * fq;
#pragma unroll
            for (int ai = 0; ai < 2; ++ai) { u32x4 ra[4], rb[4];
#pragma unroll
                for (int m = 0; m < 4; ++m) { const bf16_t* bp = (const bf16_t*)base + (size_t)(row0 + ai * HALF + m * 16) * ldc + col0; ra[m] = *(const u32x4*)bp; rb[m] = *(const u32x4*)(bp + (size_t)8 * ldc); }
#pragma unroll
                for (int m = 0; m < 4; ++m) { u32x4 x[2]; p2_from_rows(ra[m], rb[m], lo, x[0], x[1]); u32x4 w[2];
#pragma unroll
                    for (int bj = 0; bj < 2; ++bj) { const f32x4 a0 = acc[ai][bj][m][0], a1 = acc[ai][bj][m][1]; const u32x4 xx = x[bj];
                        w[bj].x = cvt_pk_bf16(__builtin_bit_cast(float, xx.x << 16) + a0[0], __builtin_bit_cast(float, xx.x & 0xffff0000u) + a0[1]); w[bj].y = cvt_pk_bf16(__builtin_bit_cast(float, xx.y << 16) + a0[2], __builtin_bit_cast(float, xx.y & 0xffff0000u) + a0[3]);
                        w[bj].z = cvt_pk_bf16(__builtin_bit_cast(float, xx.z << 16) + a1[0], __builtin_bit_cast(float, xx.z & 0xffff0000u) + a1[1]); w[bj].w = cvt_pk_bf16(__builtin_bit_cast(float, xx.w << 16) + a1[2], __builtin_bit_cast(float, xx.w & 0xffff0000u) + a1[3]); }
                    u32x4 a, b; p2_to_rows(w[0], w[1], lo, a, b);
                    bf16_t* op = out + (size_t)(row0 + ai * HALF + m * 16) * ldc + col0; *(u32x4*)op = a; *(u32x4*)(op + (size_t)8 * ldc) = b; }
                asm volatile("" ::: "memory"); }
        } else {
        const int row0 = u.pm * BM + wr * 64 + fr, col0 = u.pn * BM + wc * 32 + 8 * fq;
#pragma unroll
        for (int ai = 0; ai < 2; ++ai) {
            f32x4 b0[4][2], b1[4][2];
#pragma unroll
            for (int m = 0; m < 4; ++m) { const size_t off = (size_t)(row0 + ai * HALF + m * 16) * ldc + col0;
#pragma unroll
                for (int bj = 0; bj < 2; ++bj) { b0[m][bj] = *(const f32x4*)((const float*)base + off + bj * HALF); b1[m][bj] = *(const f32x4*)((const float*)base + off + bj * HALF + 4); } }
#pragma unroll
            for (int m = 0; m < 4; ++m) { const size_t off = (size_t)(row0 + ai * HALF + m * 16) * ldc + col0;
#pragma unroll
                for (int bj = 0; bj < 2; ++bj) { const f32x4 v0 = b0[m][bj] + acc[ai][bj][m][0], v1 = b1[m][bj] + acc[ai][bj][m][1];
                    u32x4 w; w.x = cvt_pk_bf16(v0[0], v0[1]); w.y = cvt_pk_bf16(v0[2], v0[3]); w.z = cvt_pk_bf16(v1[0], v1[1]); w.w = cvt_pk_bf16(v1[2], v1[3]);
                    *(u32x4*)(out + off + bj * HALF) = w; } }
            asm volatile("" ::: "memory"); }
        }
    }
};
struct EpiMoeDownX {
    static constexpr bool PERM = true, AFTER_DRAIN = false, PERM2 = true;
    bf16_t* out; int ldc; const int* tok; const float* gatev;
    __device__ __forceinline__ void operator()(const f32x4 (&acc)[2][2][4][2], const Unit& u, int wr, int wc, int fr_, int fq_) const {
        int fr = fr_, fq = fq_; asm volatile("" : "+v"(fr), "+v"(fq));
        const bool lo = (fr & 8) == 0;
        const int row0 = u.pm * BM + wr * 64, col0 = u.pn * BM + wc * 64 + (lo ? 0 : 32) + 8 * fq;
        int ta[2][4], tb[2][4]; float gr[2][4];
#pragma unroll
        for (int ai = 0; ai < 2; ++ai)
#pragma unroll
            for (int m = 0; m < 4; ++m) { const int r = row0 + ai * HALF + m * 16; ta[ai][m] = tok[r + (fr & 7)]; tb[ai][m] = tok[r + 8 + (fr & 7)]; gr[ai][m] = gatev[r + fr]; }
#pragma unroll
        for (int ai = 0; ai < 2; ++ai) { u32x4 ra[4], rb[4];
#pragma unroll
            for (int m = 0; m < 4; ++m) { const int t0 = ta[ai][m] < 0 ? 0 : ta[ai][m], t1 = tb[ai][m] < 0 ? 0 : tb[ai][m];
                ra[m] = *(const u32x4*)(out + (size_t)t0 * ldc + col0); rb[m] = *(const u32x4*)(out + (size_t)t1 * ldc + col0); }
#pragma unroll
            for (int m = 0; m < 4; ++m) { const float g = gr[ai][m]; u32x4 x[2]; p2_from_rows(ra[m], rb[m], lo, x[0], x[1]); u32x4 w[2];
#pragma unroll
                for (int bj = 0; bj < 2; ++bj) { const f32x4 a0 = acc[ai][bj][m][0] * g, a1 = acc[ai][bj][m][1] * g; const u32x4 xx = x[bj];
                    w[bj].x = cvt_pk_bf16(__builtin_bit_cast(float, xx.x << 16) + a0[0], __builtin_bit_cast(float, xx.x & 0xffff0000u) + a0[1]); w[bj].y = cvt_pk_bf16(__builtin_bit_cast(float, xx.y << 16) + a0[2], __builtin_bit_cast(float, xx.y & 0xffff0000u) + a0[3]);
                    w[bj].z = cvt_pk_bf16(__builtin_bit_cast(float, xx.z << 16) + a1[0], __builtin_bit_cast(float, xx.z & 0xffff0000u) + a1[1]); w[bj].w = cvt_pk_bf16(__builtin_bit_cast(float, xx.w << 16) + a1[2], __builtin_bit_cast(float, xx.w & 0xffff0000u) + a1[3]); }
                u32x4 a, b; p2_to_rows(w[0], w[1], lo, a, b);
                if (ta[ai][m] >= 0) *(u32x4*)(out + (size_t)ta[ai][m] * ldc + col0) = a;
                if (tb[ai][m] >= 0) *(u32x4*)(out + (size_t)tb[ai][m] * ldc + col0) = b; }
            asm volatile("" ::: "memory"); }
    }
};
struct EpiSwiglu {
    static constexpr bool PERM = true, AFTER_DRAIN = false;
    bf16_t* O; int ldc;
    __device__ __forceinline__ void operator()(const f32x4 (&acc)[2][2][4][2], const Unit& u, int wr, int wc, int fr, int fq) const {
        const int row0 = u.pm * BM + wr * 64 + fr, col0 = u.pn * HALF + wc * 32 + 8 * fq;
#pragma unroll
        for (int ai = 0; ai < 2; ++ai)
#pragma unroll
            for (int m = 0; m < 4; ++m) { bf16_t* rowp = O + (size_t)(row0 + ai * HALF + m * 16) * ldc + col0;
                const f32x4 g0 = acc[ai][0][m][0], g1 = acc[ai][0][m][1], u0 = acc[ai][1][m][0], u1 = acc[ai][1][m][1];
                u32x4 w; w.x = cvt_pk_bf16(silu_f(g0[0]) * u0[0], silu_f(g0[1]) * u0[1]); w.y = cvt_pk_bf16(silu_f(g0[2]) * u0[2], silu_f(g0[3]) * u0[3]);
                w.z = cvt_pk_bf16(silu_f(g1[0]) * u1[0], silu_f(g1[1]) * u1[1]); w.w = cvt_pk_bf16(silu_f(g1[2]) * u1[2], silu_f(g1[3]) * u1[3]);
                *(u32x4*)rowp = w; }
    }
};
struct EpiWin {
    static constexpr bool PERM = true, AFTER_DRAIN = false;
    bf16_t* G; bf16_t* XB; int ldc; int nsplit;
    __device__ __forceinline__ void operator()(const f32x4 (&acc)[2][2][4][2], const Unit& u, int wr, int wc, int fr, int fq) const {
        const bool isg = u.pn < nsplit; bf16_t* base = isg ? G : XB; const int colt = (isg ? u.pn : u.pn - nsplit) * BM;
        const int row0 = u.pm * BM + wr * 64 + fr, col0 = colt + wc * 32 + 8 * fq;
#pragma unroll
        for (int ai = 0; ai < 2; ++ai)
#pragma unroll
            for (int m = 0; m < 4; ++m) { bf16_t* rowp = base + (size_t)(row0 + ai * HALF + m * 16) * ldc + col0;
#pragma unroll
                for (int bj = 0; bj < 2; ++bj) { f32x4 v0 = acc[ai][bj][m][0], v1 = acc[ai][bj][m][1];
                    if (isg) { v0 = (f32x4){gelu_tanh_f(v0[0]), gelu_tanh_f(v0[1]), gelu_tanh_f(v0[2]), gelu_tanh_f(v0[3])}; v1 = (f32x4){gelu_tanh_f(v1[0]), gelu_tanh_f(v1[1]), gelu_tanh_f(v1[2]), gelu_tanh_f(v1[3])}; }
                    u32x4 w; w.x = cvt_pk_bf16(v0[0], v0[1]); w.y = cvt_pk_bf16(v0[2], v0[3]); w.z = cvt_pk_bf16(v1[0], v1[1]); w.w = cvt_pk_bf16(v1[2], v1[3]);
                    *(u32x4*)(rowp + bj * HALF) = w; } }
    }
};
struct EpiMoeDown {
    static constexpr bool PERM = false, AFTER_DRAIN = false;
    float* out; int ldc; const int* tok; const float* gatev;
    __device__ __forceinline__ void operator()(const f32x4 (&acc)[2][2][4][2], const Unit& u, int wr, int wc, int fr, int fq) const {
        const int row0 = u.pm * BM + wr * 64 + fr, col0 = u.pn * BM + wc * 32 + 4 * fq;
#pragma unroll
        for (int ai = 0; ai < 2; ++ai)
#pragma unroll
            for (int m = 0; m < 4; ++m) { const int r = row0 + ai * HALF + m * 16; const int t = tok[r]; const float g = gatev[r];
                if (t >= 0) { float* o = out + (size_t)t * ldc + col0; f32x4 b[2][2];
#pragma unroll
                    for (int bj = 0; bj < 2; ++bj)
#pragma unroll
                        for (int n = 0; n < 2; ++n) b[bj][n] = *(const f32x4*)(o + bj * HALF + n * 16);
#pragma unroll
                    for (int bj = 0; bj < 2; ++bj)
#pragma unroll
                        for (int n = 0; n < 2; ++n) *(f32x4*)(o + bj * HALF + n * 16) = b[bj][n] + acc[ai][bj][m][n] * g; }
                asm volatile("" ::: "memory"); }
    }
};
__device__ __forceinline__ f32x4 cvt4(const i32x4 a, const f32x4 s) { return (f32x4){(float)a[0] * s[0], (float)a[1] * s[1], (float)a[2] * s[2], (float)a[3] * s[3]}; }
struct EpiBf16Q {
    static constexpr bool PERM = true, AFTER_DRAIN = false, PERM2 = true;
    bf16_t* O; int ldc; int split_cols; size_t split_stride; float scale0; const float* sa; const float* sb;
    __device__ __forceinline__ void operator()(const i32x4 (&acc)[2][2][4][2], const Unit& u, int wr, int wc, int fr, int fq) const {
        const int row0 = u.pm * BM + wr * 64; int colt = u.pn * BM; bf16_t* base = O;
        float sc = 1.f; if (split_cols) { const int t = colt / split_cols; base += (size_t)t * split_stride; colt -= t * split_cols; if (t == 0) sc = scale0; }
        const bool lo = (fr & 8) == 0;
        const int col0 = colt + wc * 64 + (lo ? 0 : 32) + 8 * fq, bcol0 = u.pb * BM + wc * 64 + 8 * fq;
        f32x4 sv[2][2];
#pragma unroll
        for (int bj = 0; bj < 2; ++bj)
#pragma unroll
            for (int n = 0; n < 2; ++n) sv[bj][n] = *(const f32x4*)(sb + bcol0 + bj * 32 + 4 * n) * sc;
        float sar[2][4];
#pragma unroll
        for (int ai = 0; ai < 2; ++ai)
#pragma unroll
            for (int m = 0; m < 4; ++m) sar[ai][m] = sa[row0 + fr + ai * HALF + m * 16];
#pragma unroll
        for (int ai = 0; ai < 2; ++ai)
#pragma unroll
            for (int m = 0; m < 4; ++m) { const float s = sar[ai][m]; u32x4 w[2];
#pragma unroll
                for (int bj = 0; bj < 2; ++bj) { const f32x4 v0 = cvt4(acc[ai][bj][m][0], sv[bj][0] * s), v1 = cvt4(acc[ai][bj][m][1], sv[bj][1] * s);
                    w[bj].x = cvt_pk_bf16(v0[0], v0[1]); w[bj].y = cvt_pk_bf16(v0[2], v0[3]); w[bj].z = cvt_pk_bf16(v1[0], v1[1]); w[bj].w = cvt_pk_bf16(v1[2], v1[3]); }
                u32x4 a, b; p2_to_rows(w[0], w[1], lo, a, b);
                bf16_t* rowp = base + (size_t)(row0 + ai * HALF + m * 16 + (fr & 7)) * ldc + col0;
                *(u32x4*)rowp = a; *(u32x4*)(rowp + (size_t)8 * ldc) = b; }
    }
};
struct EpiSwigluQ {
    static constexpr bool PERM = true, AFTER_DRAIN = false;
    bf16_t* O; int ldc; const float* sa; const float* sb; const int* tok;
    __device__ __forceinline__ void operator()(const i32x4 (&acc)[2][2][4][2], const Unit& u, int wr, int wc, int fr_, int fq_) const {
        int fr = fr_, fq = fq_; asm volatile("" : "+v"(fr), "+v"(fq));
        const int row0 = u.pm * BM + wr * 64 + fr, col0 = u.pn * HALF + wc * 32 + 8 * fq, bcol0 = u.pb * BM + wc * 32 + 8 * fq;
        f32x4 sv[2][2];
#pragma unroll
        for (int bj = 0; bj < 2; ++bj)
#pragma unroll
            for (int n = 0; n < 2; ++n) sv[bj][n] = *(const f32x4*)(sb + bcol0 + bj * HALF + 4 * n);
        float sar[2][4];
#pragma unroll
        for (int ai = 0; ai < 2; ++ai)
#pragma unroll
            for (int m = 0; m < 4; ++m) { const int r = row0 + ai * HALF + m * 16; int t = r; if (tok) { t = tok[r]; t = t < 0 ? 0 : t; } sar[ai][m] = sa[t]; }
#pragma unroll
        for (int ai = 0; ai < 2; ++ai)
#pragma unroll
            for (int m = 0; m < 4; ++m) { const int r = row0 + ai * HALF + m * 16; const float s = sar[ai][m];
                bf16_t* rowp = O + (size_t)r * ldc + col0;
                const f32x4 g0 = cvt4(acc[ai][0][m][0], sv[0][0] * s), g1 = cvt4(acc[ai][0][m][1], sv[0][1] * s), u0 = cvt4(acc[ai][1][m][0], sv[1][0] * s), u1 = cvt4(acc[ai][1][m][1], sv[1][1] * s);
                u32x4 w; w.x = cvt_pk_bf16(silu_f(g0[0]) * u0[0], silu_f(g0[1]) * u0[1]); w.y = cvt_pk_bf16(silu_f(g0[2]) * u0[2], silu_f(g0[3]) * u0[3]);
                w.z = cvt_pk_bf16(silu_f(g1[0]) * u1[0], silu_f(g1[1]) * u1[1]); w.w = cvt_pk_bf16(silu_f(g1[2]) * u1[2], silu_f(g1[3]) * u1[3]);
                *(u32x4*)rowp = w; }
    }
};
struct EpiWinQ {
    static constexpr bool PERM = true, AFTER_DRAIN = false, PERM2 = true;
    bf16_t* G; bf16_t* XB; int ldc; int nsplit; const float* sa; const float* sb;
    __device__ __forceinline__ void operator()(const i32x4 (&acc)[2][2][4][2], const Unit& u, int wr, int wc, int fr, int fq) const {
        const bool isg = u.pn < nsplit; bf16_t* base = isg ? G : XB; const int colt = (isg ? u.pn : u.pn - nsplit) * BM;
        const bool lo = (fr & 8) == 0;
        const int row0 = u.pm * BM + wr * 64, col0 = colt + wc * 64 + (lo ? 0 : 32) + 8 * fq, bcol0 = u.pb * BM + wc * 64 + 8 * fq;
        f32x4 sv[2][2];
#pragma unroll
        for (int bj = 0; bj < 2; ++bj)
#pragma unroll
            for (int n = 0; n < 2; ++n) sv[bj][n] = *(const f32x4*)(sb + bcol0 + bj * 32 + 4 * n);
        float sar[2][4];
#pragma unroll
        for (int ai = 0; ai < 2; ++ai)
#pragma unroll
            for (int m = 0; m < 4; ++m) sar[ai][m] = sa[row0 + fr + ai * HALF + m * 16];
#pragma unroll
        for (int ai = 0; ai < 2; ++ai)
#pragma unroll
            for (int m = 0; m < 4; ++m) { const float s = sar[ai][m]; u32x4 w[2];
#pragma unroll
                for (int bj = 0; bj < 2; ++bj) { f32x4 v0 = cvt4(acc[ai][bj][m][0], sv[bj][0] * s), v1 = cvt4(acc[ai][bj][m][1], sv[bj][1] * s);
                    if (isg) { v0 = (f32x4){gelu_tanh_f(v0[0]), gelu_tanh_f(v0[1]), gelu_tanh_f(v0[2]), gelu_tanh_f(v0[3])}; v1 = (f32x4){gelu_tanh_f(v1[0]), gelu_tanh_f(v1[1]), gelu_tanh_f(v1[2]), gelu_tanh_f(v1[3])}; }
                    w[bj].x = cvt_pk_bf16(v0[0], v0[1]); w[bj].y = cvt_pk_bf16(v0[2], v0[3]); w[bj].z = cvt_pk_bf16(v1[0], v1[1]); w[bj].w = cvt_pk_bf16(v1[2], v1[3]); }
                u32x4 a, b; p2_to_rows(w[0], w[1], lo, a, b);
                bf16_t* rowp = base + (size_t)(row0 + ai * HALF + m * 16 + (fr & 7)) * ldc + col0;
                *(u32x4*)rowp = a; *(u32x4*)(rowp + (size_t)8 * ldc) = b; }
    }
};
struct MoeOrder : StaticOrder {
    const unsigned short* tok16; const PG8_LAS int* pexp; int nNe;
    __device__ void init_moe(int rows, int N, int G_, int c_, const unsigned short* tok16_, const PG8_LAS int* pexp_) { init(rows, N, G_, c_); tok16 = tok16_; pexp = pexp_; nNe = N / BM; }
    __device__ __forceinline__ bool next(int i, Unit& u) const {
        if (!StaticOrder::next(i, u)) return false;
        u.pm = __builtin_amdgcn_readfirstlane(u.pm); u.pn = __builtin_amdgcn_readfirstlane(u.pn);
        const int e = __builtin_amdgcn_readfirstlane(pexp[u.pm]);
        u.pb = __builtin_amdgcn_readfirstlane(e * nNe + u.pn); return true; }
};


template <bool I8> struct AccT { typedef f32x4 type; };
template <> struct AccT<true> { typedef i32x4 type; };
template <class E, class = void> struct EpiPerm2 { static constexpr bool value = false; };
template <class E> struct EpiPerm2<E, decltype((void)E::PERM2)> { static constexpr bool value = E::PERM2; };
template <class Epi, class Sched, bool ALIGN_EPI = false, bool SP2 = false, bool GATHER = false, bool I8 = false>
__device__ __forceinline__ void gemm_phase(PG8_LAS unsigned char* lds, const Gemm g, const Sched& S, const Epi& E) {
    int tid_ = threadIdx.x; asm volatile("" : "+v"(tid_));
    const int tid = tid_, wid = __builtin_amdgcn_readfirstlane(tid >> 6), lane = tid & 63, wr = wid >> 2, wc = wid & 3, fr = lane & 15, fq = lane >> 4;
    static_assert(!GATHER || SP2, "GATHER is written for the SP2 loop");
    const int K = g.K, nt = K / BK;
    unsigned voffA[1], voffB[1]; const unsigned k128 = (unsigned)K * 128u;
    constexpr bool P2 = EpiPerm2<Epi>::value;
    { int R, C; stage_rc(tid * 16, R, C); const int Rb = P2 ? (64 * (R >> 5) + perm32(R & 31)) : (Epi::PERM ? ((R & ~31) + perm32(R & 31)) : R);
        voffA[0] = (unsigned)(R * K + C) * 2u; voffB[0] = (unsigned)(Rb * K + C) * 2u; }
    const unsigned kB128 = P2 ? 2u * k128 : k128;
    unsigned tk[2] = {0u, 0u}, tn[2] = {0u, 0u}; unsigned cC2 = 0; int gR0 = 0;
    if constexpr (GATHER) { int R_, C_; stage_rc(tid * 16, R_, C_); gR0 = R_; cC2 = (unsigned)C_ * 2u; }
#define PG8_GTOK(dst, u) do { _Pragma("unroll") for (int _h = 0; _h < 2; ++_h) { const unsigned* p_ = (const unsigned*)S.tok16 + (((u).pm * 2 + _h) * 64 + gR0); \
        asm volatile("global_load_dword %0, %1, off" : "=v"(dst[_h]) : "v"(p_) : "memory"); } } while (0)
#define PG8_TQ(x) ({ unsigned q_ = (x); asm volatile("" : "+v"(q_)); q_; })
    const size_t kstep = (size_t)(BK * 2);
    const size_t hstep = (size_t)HALF * K * 2;
    const size_t tstep = 2 * hstep;
    const size_t hstepB = P2 ? (size_t)32 * K * 2 : hstep;
    const unsigned ldsw = (unsigned)wid * 1024u;
    const int aoff = lds_byte(wr * 64 + fr, fq * 8), boff = lds_byte(wc * 32 + fr, fq * 8);
#define PG8_SA(b, h) (((b) * 2 + (h)) * HTB)
#define PG8_SB(b, h) ((4 + (b) * 2 + (h)) * HTB)
#define PG8_STAGE(bufoff, gbase, voff) do { _Pragma("unroll") for (int _i = 0; _i < 2; ++_i) \
        __builtin_amdgcn_global_load_lds((const unsigned*)((const char*)(gbase) + ((voff)[0] + _i * k128)), (PG8_LAS unsigned*)(lds + (bufoff) + ldsw + _i * 8192), 16, 0, 0); } while (0)
#define PG8_STAGEB(bufoff, gbase) do { _Pragma("unroll") for (int _i = 0; _i < 2; ++_i) \
        __builtin_amdgcn_global_load_lds((const unsigned*)((const char*)(gbase) + (voffB[0] + _i * kB128)), (PG8_LAS unsigned*)(lds + (bufoff) + ldsw + _i * 8192), 16, 0, 0); } while (0)
#define PG8_STAGEG(bufoff, gbase, tkw) do { _Pragma("unroll") for (int _i = 0; _i < 2; ++_i) { const unsigned _o = (((tkw) >> (16 * _i)) & 0xffffu) * (unsigned)(K * 2) + cC2; \
        __builtin_amdgcn_global_load_lds((const unsigned*)((const char*)(gbase) + _o), (PG8_LAS unsigned*)(lds + (bufoff) + ldsw + _i * 8192), 16, 0, 0); } } while (0)
#define PG8_STA(bufoff, ptr, h, nx) do { if constexpr (GATHER) { if (nx) { const unsigned tq_ = PG8_TQ(tn[h]); PG8_STAGEG(bufoff, ptr, tq_); } else PG8_STAGEG(bufoff, ptr, tk[h]); } else PG8_STAGE(bufoff, (ptr) + (h) * hstep, voffA); } while (0)
#define PG8_LDA(dst, b, h) do { _Pragma("unroll") for (int m = 0; m < 4; ++m) _Pragma("unroll") for (int k = 0; k < 2; ++k) dst[m][k] = *(const PG8_LAS bf16x8*)(lds + PG8_SA(b, h) + aoff + m * 2048 + k * 1024); } while (0)
#define PG8_LDB(dst, b, h) do { _Pragma("unroll") for (int n = 0; n < 2; ++n) _Pragma("unroll") for (int k = 0; k < 2; ++k) dst[n][k] = *(const PG8_LAS bf16x8*)(lds + PG8_SB(b, h) + boff + n * 2048 + k * 1024); } while (0)
#define PG8_MMA(ai, bj, At, Bt) do { __builtin_amdgcn_s_setprio(1); _Pragma("unroll") for (int m = 0; m < 4; ++m) _Pragma("unroll") for (int n = 0; n < 2; ++n) _Pragma("unroll") for (int k = 0; k < 2; ++k) \
        { if constexpr (I8) acc[ai][bj][m][n] = __builtin_amdgcn_mfma_i32_16x16x64_i8(__builtin_bit_cast(i32x4, Bt[n][k]), __builtin_bit_cast(i32x4, At[m][k]), acc[ai][bj][m][n], 0, 0, 0); \
          else acc[ai][bj][m][n] = __builtin_amdgcn_mfma_f32_16x16x32_bf16(Bt[n][k], At[m][k], acc[ai][bj][m][n], 0, 0, 0); } __builtin_amdgcn_s_setprio(0); } while (0)
#define PG8_WAIT_V(n) asm volatile("s_waitcnt vmcnt(" #n ")" ::: "memory")
#define PG8_WAIT_L(n) asm volatile("s_waitcnt lgkmcnt(" #n ")" ::: "memory")
#define PG8_BAR __builtin_amdgcn_s_barrier()
#define PG8_SCHED __builtin_amdgcn_sched_barrier(0)
    Unit cur, nxt; int ui = 0;
    if (!S.next(0, cur)) return;
    typedef typename AccT<I8>::type acc_t;
    acc_t acc[2][2][4][2];
#pragma unroll
    for (int a = 0; a < 2; ++a)
#pragma unroll
        for (int b = 0; b < 2; ++b)
#pragma unroll
            for (int m = 0; m < 4; ++m)
#pragma unroll
                for (int n = 0; n < 2; ++n) acc[a][b][m][n] = (acc_t){0, 0, 0, 0};
    bf16x8 At[4][2], B0[2][2], B1[2][2];
    const char* cA = GATHER ? (const char*)g.A : (const char*)g.A + (size_t)cur.pm * tstep; const char* cB = (const char*)g.Bt + (size_t)cur.pb * tstep;
    if constexpr (GATHER) { PG8_GTOK(tk, cur); asm volatile("s_waitcnt vmcnt(0)" ::: "memory"); tk[0] = PG8_TQ(tk[0]); tk[1] = PG8_TQ(tk[1]); }
    S.a_ready(cur);
    if constexpr (SP2) {
        PG8_STAGEB(PG8_SB(0, 0), cB); PG8_STAGEB(PG8_SB(0, 1), cB + hstepB); PG8_STA(PG8_SA(0, 0), cA, 0, false); PG8_STA(PG8_SA(0, 1), cA, 1, false);
        if (wr == 1) PG8_BAR;
        PG8_WAIT_V(2); PG8_BAR;
        PG8_STAGEB(PG8_SB(1, 0), cB + kstep); PG8_STA(PG8_SA(1, 0), cA + kstep, 0, false); PG8_STAGEB(PG8_SB(1, 1), cB + hstepB + kstep);
        PG8_WAIT_V(6); PG8_BAR;
    } else {
        PG8_STAGEB(PG8_SB(0, 0), cB); PG8_STAGE(PG8_SA(0, 0), cA, voffA); PG8_STAGEB(PG8_SB(0, 1), cB + hstepB); PG8_STAGE(PG8_SA(0, 1), cA + hstep, voffA);
        if (wr == 1) PG8_BAR;
        PG8_WAIT_V(4); PG8_BAR;
        PG8_STAGEB(PG8_SB(1, 0), cB + kstep); PG8_STAGE(PG8_SA(1, 0), cA + kstep, voffA); PG8_STAGEB(PG8_SB(1, 1), cB + hstepB + kstep);
        PG8_WAIT_V(6); PG8_BAR;
    }
    for (;;) {
        const bool has_next = S.next(ui + 1, nxt);
        if constexpr (GATHER) { Unit un_; un_.pm = has_next ? nxt.pm : cur.pm; un_.pn = 0; un_.pb = 0; PG8_GTOK(tn, un_); }
        const char* nA = GATHER ? (const char*)g.A : (has_next ? (const char*)g.A + (size_t)nxt.pm * tstep : cA); const char* nB = has_next ? (const char*)g.Bt + (size_t)nxt.pb * tstep : cB;
        for (int t = 0; t < nt; t += 2) {
            const bool last = (t == nt - 2);
            const char* a1 = cA + (size_t)(t + 1) * kstep;
            const char* a2 = last ? nA : cA + (size_t)(t + 2) * kstep; const char* b2 = last ? nB : cB + (size_t)(t + 2) * kstep;
            const char* a3 = a2 + kstep; const char* b3 = b2 + kstep;
            if (last && has_next) S.a_ready(nxt);
            if constexpr (SP2) {
            PG8_LDB(B0, 0, 0); PG8_LDB(B1, 0, 1); PG8_SCHED; PG8_LDA(At, 0, 0); PG8_STA(PG8_SA(1, 1), a1, 1, false);
            PG8_WAIT_V(8); PG8_WAIT_L(0); PG8_BAR; PG8_MMA(0, 0, At, B0); PG8_MMA(0, 1, At, B1); PG8_BAR; PG8_SCHED;
            PG8_LDA(At, 0, 1); PG8_STAGEB(PG8_SB(0, 0), b2); PG8_STAGEB(PG8_SB(0, 1), b2 + hstepB); PG8_STA(PG8_SA(0, 0), a2, 0, last);
            PG8_WAIT_V(8); PG8_WAIT_L(0); PG8_BAR; PG8_MMA(1, 0, At, B0); PG8_MMA(1, 1, At, B1); PG8_BAR; PG8_SCHED;
            PG8_LDB(B0, 1, 0); PG8_LDB(B1, 1, 1); PG8_SCHED; PG8_LDA(At, 1, 0); PG8_STA(PG8_SA(0, 1), a2, 1, last);
            PG8_WAIT_V(8); PG8_WAIT_L(0); PG8_BAR; PG8_MMA(0, 0, At, B0); PG8_MMA(0, 1, At, B1); PG8_BAR; PG8_SCHED;
            PG8_LDA(At, 1, 1); PG8_STAGEB(PG8_SB(1, 0), b3); PG8_STAGEB(PG8_SB(1, 1), b3 + hstepB); PG8_STA(PG8_SA(1, 0), a3, 0, last);
            PG8_WAIT_V(8); PG8_WAIT_L(0); PG8_BAR; PG8_MMA(1, 0, At, B0); PG8_MMA(1, 1, At, B1); PG8_BAR; PG8_SCHED;
            } else {
            PG8_LDB(B0, 0, 0); PG8_SCHED; PG8_LDA(At, 0, 0); PG8_STAGE(PG8_SA(1, 1), a1 + hstep, voffA);
            PG8_WAIT_L(8); PG8_BAR; PG8_WAIT_L(0); PG8_MMA(0, 0, At, B0); PG8_BAR; PG8_SCHED;
            PG8_LDB(B1, 0, 1); PG8_STAGEB(PG8_SB(0, 0), b2);
            PG8_BAR; PG8_WAIT_L(0); PG8_MMA(0, 1, At, B1); PG8_BAR;
            PG8_LDA(At, 0, 1); PG8_STAGE(PG8_SA(0, 0), a2, voffA);
            PG8_BAR; PG8_WAIT_L(0); PG8_MMA(1, 0, At, B0); PG8_BAR; PG8_SCHED;
            PG8_STAGEB(PG8_SB(0, 1), b2 + hstepB);
            PG8_WAIT_V(6); PG8_BAR; PG8_MMA(1, 1, At, B1); PG8_BAR;
            PG8_LDB(B0, 1, 0); PG8_SCHED; PG8_LDA(At, 1, 0); PG8_STAGE(PG8_SA(0, 1), a2 + hstep, voffA);
            PG8_WAIT_L(8); PG8_BAR; PG8_WAIT_L(0); PG8_MMA(0, 0, At, B0); PG8_BAR; PG8_SCHED;
            PG8_LDB(B1, 1, 1); PG8_STAGEB(PG8_SB(1, 0), b3);
            PG8_BAR; PG8_WAIT_L(0); PG8_MMA(0, 1, At, B1); PG8_BAR;
            PG8_LDA(At, 1, 1); PG8_STAGE(PG8_SA(1, 0), a3, voffA);
            PG8_BAR; PG8_WAIT_L(0); PG8_MMA(1, 0, At, B0); PG8_BAR; PG8_SCHED;
            PG8_STAGEB(PG8_SB(1, 1), b3 + hstepB);
            PG8_WAIT_V(6); PG8_BAR; PG8_MMA(1, 1, At, B1); PG8_BAR;
            }
        }
        if constexpr (ALIGN_EPI) { if (wr == 0) PG8_BAR; }
        if constexpr (!Epi::AFTER_DRAIN) { E(acc, cur, wr, wc, fr, fq); S.done(cur); }
        if (!has_next) break;
#pragma unroll
        for (int a = 0; a < 2; ++a)
#pragma unroll
            for (int b = 0; b < 2; ++b)
#pragma unroll
                for (int m = 0; m < 4; ++m)
#pragma unroll
                    for (int n = 0; n < 2; ++n) acc[a][b][m][n] = (acc_t){0, 0, 0, 0};
        cur = nxt; cA = nA; cB = nB; ++ui;
        if constexpr (GATHER) { tk[0] = PG8_TQ(tn[0]); tk[1] = PG8_TQ(tn[1]); }
        if constexpr (ALIGN_EPI) { if (wr == 1) PG8_BAR; }
    }
    PG8_WAIT_V(0);
    if constexpr (!ALIGN_EPI) { if (wr == 0) PG8_BAR; }
    PG8_BAR;
    if constexpr (Epi::AFTER_DRAIN) { E.fused(acc, cur, wr, wc, fr, fq, lds, wid, lane); S.done(cur); }
#undef PG8_SA
#undef PG8_SB
#undef PG8_STAGE
#undef PG8_STA
#undef PG8_STAGEG
#undef PG8_STAGEB
#undef PG8_GTOK
#undef PG8_TQ
#undef PG8_LDA
#undef PG8_LDB
#undef PG8_MMA
#undef PG8_WAIT_V
#undef PG8_WAIT_L
#undef PG8_BAR
#undef PG8_SCHED
}
}

#include <hip/hip_bf16.h>
#include <cmath>
namespace attn_body {
using bf16=__hip_bfloat16;
using bf16x8=__attribute__((ext_vector_type(8)))short;
using s16x4=__attribute__((ext_vector_type(4)))short;
using f32x16=__attribute__((ext_vector_type(16)))float;
using u32x4=__attribute__((ext_vector_type(4)))unsigned;
constexpr int BATCH=4,NHEAD=16,SEQ=8192,D=64,DM=NHEAD*D;
constexpr int NW=8,QBLK=32,QB=QBLK*NW,KVBLK=64,NQB=SEQ/QB;
constexpr int ATTN_PITCH=DM, ATTN_UNIT_ROWS=QB;
__device__ __forceinline__ int crow(int r,int hi){return (r&3)+8*(r>>2)+4*hi;}
#define SBAR() __builtin_amdgcn_sched_barrier(0)
typedef __attribute__((address_space(3))) const float* lds_cfptr;
__device__ __forceinline__ void cmask(f32x16&p0,f32x16&p1,int jb,int qrel,int hi,lds_cfptr tabd){
  const float NEG=-INFINITY; const int d0=qrel-(64*jb+4*hi);
  #pragma unroll
  for(int r=0;r<16;++r){const int dA=d0-((r&3)+8*(r>>2)),dB=dA-32;
    const float tA=tabd[dA<0?0:(dA>127?127:dA)],tB=tabd[dB<0?0:(dB>127?127:dB)];
    p0[r]=dA<0?NEG:p0[r]+tA; p1[r]=dB<0?NEG:p1[r]+tB;}
}

constexpr int NSLOT=3, SLOTB=8192;
constexpr int LDS_K=0, LDS_V=NSLOT*SLOTB, LDS_WS=2*NSLOT*SLOTB, LDS_OST=LDS_WS+NW*64*4, LDS_BYTES=LDS_OST+NW*4096;
constexpr float C2=0.125f*1.4426950408889634f;
__device__ __forceinline__ void glds16(const void*sbase,unsigned voff,unsigned lds_dst){unsigned keep;
  asm volatile("s_mov_b32 %0, m0\n\ts_mov_b32 m0, %3\n\ts_nop 0\n\tglobal_load_lds_dwordx4 %1, %2\n\ts_mov_b32 m0, %0":"=&s"(keep):"v"(voff),"s"(sbase),"s"(lds_dst):"memory");}
__device__ __forceinline__ float max3f(float a,float b,float c){float r;asm("v_max3_f32 %0, %1, %2, %3":"=v"(r):"v"(a),"v"(b),"v"(c));return r;}
__device__ __forceinline__ float max2f(float a,float b){float r;asm("v_max_f32_e32 %0, %1, %2":"=v"(r):"v"(a),"v"(b));return r;}
__device__ __forceinline__ float fadd_s(float a,float b){float r;asm("v_add_f32_e32 %0, %1, %2":"=v"(r):"v"(a),"v"(b));return r;}
__device__ __forceinline__ float fsub_s(float a,float b){float r;asm("v_sub_f32_e32 %0, %1, %2":"=v"(r):"v"(a),"v"(b));return r;}
typedef float f32x2_t __attribute__((ext_vector_type(2))); typedef __bf16 bf16x2_t __attribute__((ext_vector_type(2)));
__device__ __forceinline__ unsigned cvtpk_s(float lo,float hi){f32x2_t v={lo,hi};bf16x2_t b=__builtin_convertvector(v,bf16x2_t);return __builtin_bit_cast(unsigned,b);}
#define WAIT_BAR(N) asm volatile("s_waitcnt vmcnt(" #N ") lgkmcnt(0)\n\ts_barrier":::"memory")

__device__ __forceinline__ void qkt(f32x16&p0,f32x16&p1,const char*Kslot,const bf16x8*qr,const f32x16&negm,int r32,int hi){
  const char*kb=Kslot+hi*1024+r32*16;
  #pragma unroll
  for(int d0=0;d0<4;++d0){
    const bf16x8 b0=*reinterpret_cast<const bf16x8*>(kb+d0*2048);
    const bf16x8 b1=*reinterpret_cast<const bf16x8*>(kb+d0*2048+512);
    if(d0==0){p0=__builtin_amdgcn_mfma_f32_32x32x16_bf16(b0,qr[0],negm,0,0,0);p1=__builtin_amdgcn_mfma_f32_32x32x16_bf16(b1,qr[0],negm,0,0,0);}
    else{p0=__builtin_amdgcn_mfma_f32_32x32x16_bf16(b0,qr[d0],p0,0,0,0);p1=__builtin_amdgcn_mfma_f32_32x32x16_bf16(b1,qr[d0],p1,0,0,0);}}
}
typedef __attribute__((address_space(3))) const char* lds_cptr;
typedef short v4i16_t __attribute__((ext_vector_type(4)));
__device__ __forceinline__ void kload8(bf16x8*kf,lds_cptr kp){
  kf[0]=*(const __attribute__((address_space(3))) bf16x8*)(kp);      kf[1]=*(const __attribute__((address_space(3))) bf16x8*)(kp+512);
  kf[2]=*(const __attribute__((address_space(3))) bf16x8*)(kp+2048); kf[3]=*(const __attribute__((address_space(3))) bf16x8*)(kp+2560);
  kf[4]=*(const __attribute__((address_space(3))) bf16x8*)(kp+4096); kf[5]=*(const __attribute__((address_space(3))) bf16x8*)(kp+4608);
  kf[6]=*(const __attribute__((address_space(3))) bf16x8*)(kp+6144); kf[7]=*(const __attribute__((address_space(3))) bf16x8*)(kp+6656);
}
__device__ __forceinline__ void kload2(bf16x8*kf,lds_cptr kp,int j){ kf[2*j]=*(const __attribute__((address_space(3))) bf16x8*)(kp+j*2048); kf[2*j+1]=*(const __attribute__((address_space(3))) bf16x8*)(kp+j*2048+512); }
__device__ __forceinline__ s16x4 vtr(lds_cptr p){ return __builtin_bit_cast(s16x4,__builtin_amdgcn_ds_read_tr16_b64_v4i16((__attribute__((address_space(3))) v4i16_t*)p)); }
__device__ __forceinline__ float rowmax(const f32x16&p0,const f32x16&p1){
  float a=max3f(p0[0],p0[1],p1[0]),b=max3f(p0[2],p0[3],p1[1]);a=max3f(a,p1[2],p1[3]);
  #pragma unroll
  for(int r=4;r<16;r+=4){a=max3f(a,p0[r],p0[r+1]);b=max3f(b,p0[r+2],p0[r+3]);a=max3f(a,p1[r],p1[r+1]);b=max3f(b,p1[r+2],p1[r+3]);}
  const float m=max2f(a,b);
  auto rr=__builtin_amdgcn_permlane32_swap(__float_as_uint(m),__float_as_uint(m),false,false);
  return max2f(__uint_as_float(rr[0]),__uint_as_float(rr[1]));
}
__device__ __forceinline__ void pv(f32x16*o,int vb,bf16x8 pa0,bf16x8 pa1,bf16x8 pa2,bf16x8 pa3){
  #pragma unroll
  for(int d0=0;d0<2;++d0){s16x4 lo[4],hi[4];
    #pragma unroll
    for(int ks=0;ks<4;++ks){
      asm volatile("ds_read_b64_tr_b16 %0,%1 offset:%c2":"=&v"(lo[ks]):"v"(vb),"i"(d0*4096+ks*1024):"memory");
      asm volatile("ds_read_b64_tr_b16 %0,%1 offset:%c2":"=&v"(hi[ks]):"v"(vb),"i"(d0*4096+ks*1024+512):"memory");}
    asm volatile("s_waitcnt lgkmcnt(0)":::"memory");SBAR();
    #define PK(k) (bf16x8){lo[k][0],lo[k][1],lo[k][2],lo[k][3],hi[k][0],hi[k][1],hi[k][2],hi[k][3]}
    o[d0]=__builtin_amdgcn_mfma_f32_32x32x16_bf16(pa0,PK(0),o[d0],0,0,0);
    o[d0]=__builtin_amdgcn_mfma_f32_32x32x16_bf16(pa1,PK(1),o[d0],0,0,0);
    o[d0]=__builtin_amdgcn_mfma_f32_32x32x16_bf16(pa2,PK(2),o[d0],0,0,0);
    o[d0]=__builtin_amdgcn_mfma_f32_32x32x16_bf16(pa3,PK(3),o[d0],0,0,0);
    #undef PK
  }
}

#ifndef ATTN_STORE16
#define ATTN_STORE16(p,v) (*(u32x4*)(p)=(v))
#endif
template<int THRL> __device__ __forceinline__ void attn_unit(int b,int hq,int hv,int qb,const bf16*Q,const bf16*__restrict__ K,const bf16*__restrict__ V,bf16*O,char*shm,float b31s,lds_cfptr tabd){
  const int tid=threadIdx.x,lane=tid&63,r32=lane&31,hi=lane>>5; const int wid=__builtin_amdgcn_readfirstlane(tid>>6);
  const long rowbase=(long)b*SEQ; const int q0=qb*QB;
  const bf16*Qw=Q+(rowbase+q0+wid*QBLK)*DM+hq*D;
  const bf16*Kh=K+rowbase*DM+hq*D,*Vh=V+rowbase*DM+hv*D;
  const unsigned lds0=(unsigned)(uintptr_t)shm;
  float*wsf=(float*)(shm+LDS_WS)+wid*64;
  const unsigned koff=(unsigned)(lane*DM+wid*8)*2u;
  const unsigned voff=(unsigned)((16*(wid&3)+(lane>>2))*DM+(wid>>2)*32+(lane&3)*8)*2u;
  const unsigned kdst=lds0+LDS_K+wid*1024, vdst=lds0+LDS_V+wid*1024;
  #define DMA_K(t,slot) glds16(Kh+(long)(t)*KVBLK*DM,koff,(unsigned)__builtin_amdgcn_readfirstlane(kdst+(slot)))
  #define DMA_V(t,slot) glds16(Vh+(long)(t)*KVBLK*DM,voff,(unsigned)__builtin_amdgcn_readfirstlane(vdst+(slot)))
  const int vb0=(int)(lds0+LDS_V)+((lane>>4)&1)*32+(lane&3)*8+(4*hi+((lane&15)>>2))*64;
  const char*Kbase=shm+LDS_K; bf16x8 kf[8];
  const lds_cptr shm3=(lds_cptr)shm; const lds_cptr kp0=shm3+LDS_K+hi*1024+r32*16; const lds_cptr vp0=shm3+LDS_V+((lane>>4)&1)*32+(lane&3)*8+(4*hi+((lane&15)>>2))*64;
  const int NT=(q0+QB)/KVBLK;
  DMA_K(0,0);DMA_V(0,0);DMA_K(1,SLOTB);
  bf16x8 qr[4];
  { int lq=lane; asm volatile("":"+v"(lq));
  #pragma unroll
  for(int d0=0;d0<4;++d0)qr[d0]=*reinterpret_cast<const bf16x8*>(&Qw[(long)(lq&31)*DM+d0*16+(lq>>5)*8]); }
  float mhat=0.f,l_reg=0.f;f32x16 o[2];o[0]=f32x16{};o[1]=f32x16{};f32x16 negm;
  #pragma unroll
  for(int r=0;r<16;++r)negm[r]=b31s;
  asm volatile("":"+v"(negm));
  const int qrel=wid*QBLK+r32;
  #define CMASK(P0,P1,t) do{int jb_=(t)-(NT-4); if(jb_>=-2)cmask(P0,P1,jb_,qrel,hi,tabd);}while(0)
  bool resc=false;
  #define START(P0,P1) do{ const float rm=rowmax(P0,P1); resc=false; \
    { const float dl=rm; mhat=fadd_s(mhat,dl); \
      _Pragma("unroll") for(int r=0;r<16;++r){P0[r]=fsub_s(P0[r],dl);P1[r]=fsub_s(P1[r],dl);} \
      _Pragma("unroll") for(int r=0;r<16;++r)negm[r]=b31s-mhat; asm volatile("":"+v"(negm)); } \
    _Pragma("unroll") for(int r=0;r<16;++r)P0[r]=__builtin_amdgcn_exp2f(P0[r]); }while(0)
  #define RESC() do{ if(resc){ asm volatile("s_waitcnt lgkmcnt(0)":::"memory"); \
      _Pragma("unroll") for(int d_=0;d_<2;++d_) _Pragma("unroll") for(int r=0;r<16;++r)o[d_][r]*=wsf[crow(r,hi)]; } }while(0)
  f32x16 pA0,pA1,pB0,pB1;
  int sl_prev=0,sl_cur=0,sl_next=SLOTB;
  #define ROT() do{sl_prev=sl_cur;sl_cur=sl_next;sl_next=(sl_next==(NSLOT-1)*SLOTB)?0:sl_next+SLOTB;}while(0)
  DMA_K(2,2*SLOTB);
  WAIT_BAR(3);
  qkt(pA0,pA1,Kbase,qr,negm,r32,hi);asm volatile("s_nop 15\n\ts_nop 7":"+v"(pA0),"+v"(pA1));CMASK(pA0,pA1,0);
  START(pA0,pA1);
  _Pragma("unroll") for(int r=0;r<16;++r)pA1[r]=__builtin_amdgcn_exp2f(pA1[r]);
  WAIT_BAR(0);
  DMA_K(3,0);DMA_V(1,SLOTB);
  ROT();
  kload8(kf,kp0+sl_cur);
  WAIT_BAR(2);
  s16x4 vlo[8],vhi[8]; u32x4 pw0,pw1,pw2,pw3;
  #define PKW(P,B) cvtpk_s(P[B],P[B+1])
  #define PAF(k) __builtin_bit_cast(bf16x8,pw##k)
  #define VFR(i) (bf16x8){vlo[i][0],vlo[i][1],vlo[i][2],vlo[i][3],vhi[i][0],vhi[i][1],vhi[i][2],vhi[i][3]}
  #define PIN(x) asm volatile("":"+v"(x))
  #define MX3(a,b,c) __builtin_fmaxf(__builtin_fmaxf((a),(b)),(c))
  #define GAPA(MF,A0,A1,A2,A3,W0,W1,PW) do{ MF; sacc+=A0; sacc+=A1; sacc+=A2; sacc+=A3; PIN(sacc); W0; W1; PIN(PW); SBAR(); }while(0)
  #define EX(v) __builtin_amdgcn_exp2f(v)
  #define GAPB(MF,X,B) do{ MF; X[B]=EX(X[B]); X[B+1]=EX(X[B+1]); X[B+2]=EX(X[B+2]); X[B+3]=EX(X[B+3]); PIN(X); SBAR(); }while(0)
  #define VRD(i) do{ vlo[i]=vtr(vp_+(((i)>>2)*4096+((i)&3)*1024)); vhi[i]=vtr(vp_+(((i)>>2)*4096+((i)&3)*1024+512)); }while(0)
  #define KRD(G,j) do{ if(G){ kload2(kf,kp0+sl_next,j); SBAR(); } }while(0)
  #define STEP(C0,C1,P0,P1,t,GK,GV,GL) do{ SBAR(); \
    const lds_cptr vp_=vp0+sl_prev; \
    VRD(0); SBAR(); float sacc=(P0[0]+P0[1]); \
    GAPA(C0=__builtin_amdgcn_mfma_f32_32x32x16_bf16(kf[0],qr[0],negm,0,0,0), P0[2],P0[3],P0[4],P0[5],     pw0[0]=PKW(P0,0), pw0[1]=PKW(P0,2), pw0); \
    VRD(4); SBAR(); GAPA(C1=__builtin_amdgcn_mfma_f32_32x32x16_bf16(kf[1],qr[0],negm,0,0,0), P0[6],P0[7],P0[8],P0[9],     pw0[2]=PKW(P0,4), pw0[3]=PKW(P0,6), pw0); \
    VRD(1); SBAR(); GAPA(C0=__builtin_amdgcn_mfma_f32_32x32x16_bf16(kf[2],qr[1],C0,0,0,0),   P0[10],P0[11],P0[12],P0[13], pw1[0]=PKW(P0,8), pw1[1]=PKW(P0,10), pw1); \
    VRD(5); SBAR(); GAPA(C1=__builtin_amdgcn_mfma_f32_32x32x16_bf16(kf[3],qr[1],C1,0,0,0),   P0[14],P0[15],P1[0],P1[1],   pw1[2]=PKW(P0,12),pw1[3]=PKW(P0,14), pw1); \
    VRD(2); SBAR(); GAPA(C0=__builtin_amdgcn_mfma_f32_32x32x16_bf16(kf[4],qr[2],C0,0,0,0),   P1[2],P1[3],P1[4],P1[5],     pw2[0]=PKW(P1,0), pw2[1]=PKW(P1,2), pw2); \
    VRD(6); SBAR(); GAPA(C1=__builtin_amdgcn_mfma_f32_32x32x16_bf16(kf[5],qr[2],C1,0,0,0),   P1[6],P1[7],P1[8],P1[9],     pw2[2]=PKW(P1,4), pw2[3]=PKW(P1,6), pw2); \
    VRD(3); SBAR(); GAPA(C0=__builtin_amdgcn_mfma_f32_32x32x16_bf16(kf[6],qr[3],C0,0,0,0),   P1[10],P1[11],P1[12],P1[13], pw3[0]=PKW(P1,8), pw3[1]=PKW(P1,10), pw3); \
    VRD(7); SBAR(); GAPA(C1=__builtin_amdgcn_mfma_f32_32x32x16_bf16(kf[7],qr[3],C1,0,0,0),   P1[14],P1[15],0.f,0.f,       pw3[2]=PKW(P1,12),pw3[3]=PKW(P1,14), pw3); \
    l_reg+=sacc; \
    if(GK){DMA_K((t)+3,sl_cur);} if(GV){DMA_V((t)+1,sl_next);} \
    CMASK(C0,C1,t); \
    { float a=MX3(C0[0],C0[1],C1[0]),b=MX3(C0[2],C0[3],C1[1]); a=MX3(a,C1[2],C1[3]); \
      _Pragma("unroll") for(int r=4;r<16;r+=4){a=MX3(a,C0[r],C0[r+1]);b=MX3(b,C0[r+2],C0[r+3]);a=MX3(a,C1[r],C1[r+1]);b=MX3(b,C1[r+2],C1[r+3]);} \
      float rm=__builtin_fmaxf(a,b); { auto rr=__builtin_amdgcn_permlane32_swap(__float_as_uint(rm),__float_as_uint(rm),false,false); rm=__builtin_fmaxf(__uint_as_float(rr[0]),__uint_as_float(rr[1])); } \
      resc=false; \
      if(__builtin_expect(__any(rm>(float)THRL),0)){ const float dl=__builtin_fmaxf(rm,0.f); mhat+=dl; \
        _Pragma("unroll") for(int r=0;r<16;++r){C0[r]-=dl;C1[r]-=dl;} \
        _Pragma("unroll") for(int r=0;r<16;++r)negm[r]=b31s-mhat; asm volatile("":"+v"(negm)); \
        const float f=__builtin_amdgcn_exp2f(-dl); l_reg*=f; if(hi==0)wsf[r32]=f; resc=true; } } \
    SBAR(); \
    GAPB(o[0]=__builtin_amdgcn_mfma_f32_32x32x16_bf16(PAF(0),VFR(0),o[0],0,0,0), C0,0); \
    GAPB(o[1]=__builtin_amdgcn_mfma_f32_32x32x16_bf16(PAF(0),VFR(4),o[1],0,0,0), C0,4); \
    KRD(GL,0); GAPB(o[0]=__builtin_amdgcn_mfma_f32_32x32x16_bf16(PAF(1),VFR(1),o[0],0,0,0), C0,8); \
    KRD(GL,1); GAPB(o[1]=__builtin_amdgcn_mfma_f32_32x32x16_bf16(PAF(1),VFR(5),o[1],0,0,0), C0,12); \
    KRD(GL,2); GAPB(o[0]=__builtin_amdgcn_mfma_f32_32x32x16_bf16(PAF(2),VFR(2),o[0],0,0,0), C1,0); \
    KRD(GL,3); GAPB(o[1]=__builtin_amdgcn_mfma_f32_32x32x16_bf16(PAF(2),VFR(6),o[1],0,0,0), C1,4); \
    GAPB(o[0]=__builtin_amdgcn_mfma_f32_32x32x16_bf16(PAF(3),VFR(3),o[0],0,0,0), C1,8); \
    GAPB(o[1]=__builtin_amdgcn_mfma_f32_32x32x16_bf16(PAF(3),VFR(7),o[1],0,0,0), C1,12); \
    }while(0)
  int t=1;
  #undef CMASK
  #define CMASK(P0,P1,t) do{}while(0)
  for(;t+7<NT;t+=2){
    STEP(pB0,pB1,pA0,pA1,t,true,true,true);     WAIT_BAR(2); RESC(); ROT();
    STEP(pA0,pA1,pB0,pB1,t+1,true,true,true);   WAIT_BAR(2); RESC(); ROT();
  }
  #undef CMASK
  #define CMASK(P0,P1,t) do{int jb_=(t)-(NT-4); if(jb_>=-2)cmask(P0,P1,jb_,qrel,hi,tabd);}while(0)
  #define ENDW(tt) do{ if((tt)+3<NT){WAIT_BAR(2);} else if((tt)+2<NT){WAIT_BAR(1);} else {WAIT_BAR(0);} }while(0)
  for(;t+1<NT;t+=2){
    STEP(pB0,pB1,pA0,pA1,t,(t+3<NT),(t+1<NT),(t+1<NT));       ENDW(t);   RESC(); ROT();
    STEP(pA0,pA1,pB0,pB1,t+1,(t+4<NT),(t+2<NT),(t+2<NT));     ENDW(t+1); RESC(); ROT();
  }
  STEP(pB0,pB1,pA0,pA1,NT-1,false,false,false); RESC();
  { float sacc=pB0[0]+pB0[1]; _Pragma("unroll") for(int r=2;r<16;++r)sacc+=pB0[r]; _Pragma("unroll") for(int r=0;r<16;++r)sacc+=pB1[r]; l_reg+=sacc;
    pw0=(u32x4){PKW(pB0,0),PKW(pB0,2),PKW(pB0,4),PKW(pB0,6)};pw1=(u32x4){PKW(pB0,8),PKW(pB0,10),PKW(pB0,12),PKW(pB0,14)};pw2=(u32x4){PKW(pB1,0),PKW(pB1,2),PKW(pB1,4),PKW(pB1,6)};pw3=(u32x4){PKW(pB1,8),PKW(pB1,10),PKW(pB1,12),PKW(pB1,14)};
    SBAR(); pv(o,vb0+sl_cur,PAF(0),PAF(1),PAF(2),PAF(3)); }
  #undef PKW
  #undef PAF
  #undef VFR
  #undef PIN
  #undef MX3
  #undef GAPA
  #undef GAPB
  #undef EX
  #undef VRD
  #undef KRD
  #undef STEP
  #undef ENDW
  {auto rr=__builtin_amdgcn_permlane32_swap(__float_as_uint(l_reg),__float_as_uint(l_reg),false,false);l_reg=__uint_as_float(rr[0])+__uint_as_float(rr[1]);}
  if(hi==0)wsf[32+r32]=l_reg;asm volatile("s_waitcnt lgkmcnt(0)":::"memory");
  float rli[16];
  #pragma unroll
  for(int r=0;r<16;++r)rli[r]=__builtin_amdgcn_rcpf(wsf[32+crow(r,hi)]);
  bf16*Ow=O+(rowbase+q0+wid*QBLK)*DM+hv*D;
  { bf16*stg=(bf16*)(shm+LDS_OST)+wid*2048;
    #pragma unroll
    for(int r=0;r<16;++r){const int orow=crow(r,hi);
      #pragma unroll
      for(int d0=0;d0<2;++d0)stg[orow*64+d0*32+r32]=__float2bfloat16(o[d0][r]*rli[r]);}
    asm volatile("s_waitcnt lgkmcnt(0)":::"memory");
    int le=lane; asm volatile("":"+v"(le));
    #pragma unroll
    for(int i=0;i<4;++i){const int row=i*8+(le>>3),ch=le&7; const u32x4 v=*(const u32x4*)(stg+row*64+ch*8); ATTN_STORE16(Ow+(long)row*DM+ch*8,v);} }
  asm volatile("s_waitcnt lgkmcnt(0)\n\ts_barrier":::"memory");
  #undef DMA_K
  #undef DMA_V
  #undef CMASK
  #undef START
  #undef RESC
  #undef ROT
}
constexpr int ATTN_LDS_BYTES=LDS_BYTES, LDS_TAB=LDS_BYTES;
struct AttnTensors { const bf16* Q; const bf16* K; const bf16* V; bf16* O0; bf16* O1; const float* TB; const float* subg; float lam; };
template<int THRL=8> __device__ __forceinline__ void attn_phase(char*lds,const AttnTensors&T,int grid,int block){
  const int vcu=(grid%8==0)?(block%8)*(grid/8)+block/8:block;
  lds_cfptr tab=(lds_cfptr)((__attribute__((address_space(3))) const char*)lds+LDS_TAB);
  { __attribute__((address_space(3))) float* tw=(__attribute__((address_space(3))) float*)((__attribute__((address_space(3))) char*)lds+LDS_TAB);
    for(int i=threadIdx.x;i<8*128;i+=512){const int h=i>>7; tw[i]=T.TB[i]-T.TB[h*128+127];}
    asm volatile("s_waitcnt vmcnt(0) lgkmcnt(0)\n\ts_barrier":::"memory"); }
  for(int bh=vcu>>3;bh<BATCH*8;bh+=grid>>3){ const int b=bh>>3,h=bh&7,s=vcu&7; const float b31s=T.TB[h*128+127];
    for(int j=0;j<4;++j){ const int c=j>>1,vh=j&1;
      for(int i=0;i<4;++i){ const int qb=(i==0)?s:(i==1)?15-s:(i==2)?16+s:31-s;
        attn_unit<THRL>(b,h*2+c,h*2+vh,qb,T.Q,T.K,T.V,c?T.O1:T.O0,lds,b31s,tab+h*128); } } }
}
constexpr int L2_K=0, L2_VA=3*SLOTB, L2_VB=6*SLOTB, L2_P=10*SLOTB, L2_WS=14*SLOTB, L2_FAC=L2_WS+2048, L2_FLG=L2_FAC+1024, L2_LB=L2_FLG+64, L2_TAB=L2_LB+512, L2_BYTES=L2_TAB+4096;
template<int THRL> __device__ __forceinline__ void attn_unit2(int b,int h,int c,int q128,const bf16*Q,const bf16*__restrict__ K,const bf16*__restrict__ V,bf16*O,char*shm,float b31s,lds_cfptr tabd){
  const int tid=threadIdx.x,lane=tid&63,r32=lane&31,hi=lane>>5; const int wid=__builtin_amdgcn_readfirstlane(tid>>6); const int w4=wid&3; const bool roleA=wid<4;
  const long rowbase=(long)b*SEQ; const int q0=q128*128; const int hq=h*2+c;
  const bf16*Qw=Q+(rowbase+q0+w4*QBLK)*DM+hq*D;
  const bf16*Kh=K+rowbase*DM+hq*D,*Vh=V+rowbase*DM+(h*2)*D;
  const unsigned lds0=(unsigned)(uintptr_t)shm;
  float*wsf=(float*)(shm+L2_WS)+wid*64;
  float*fac=(float*)(shm+L2_FAC)+w4*64;
  volatile __attribute__((address_space(3))) unsigned*flg=(volatile __attribute__((address_space(3))) unsigned*)((__attribute__((address_space(3))) char*)shm+L2_FLG)+w4*2;
  float*lbuf=(float*)(shm+L2_LB)+w4*32;
  char*pbuf=shm+L2_P+w4*8192;
  const unsigned koff=(unsigned)(lane*DM+wid*8)*2u;
  const unsigned voff=(unsigned)((16*(wid&3)+(lane>>2))*DM+(wid>>2)*32+(lane&3)*8)*2u;
  const unsigned kdst=lds0+L2_K+wid*1024, vdst=lds0+L2_VA+wid*1024, vbdst=lds0+L2_VB+wid*1024;
  #define DMA_K(t,slot) glds16(Kh+(long)(t)*KVBLK*DM,koff,(unsigned)__builtin_amdgcn_readfirstlane(kdst+(slot)))
  #define DMA_V(t,slot) do{ glds16(Vh+(long)(t)*KVBLK*DM,voff,(unsigned)__builtin_amdgcn_readfirstlane(vdst+(slot))); \
    glds16(Vh+(long)(t)*KVBLK*DM+64,voff,(unsigned)__builtin_amdgcn_readfirstlane(vbdst+(((t)&3)*SLOTB))); }while(0)
  const int vb0=(int)(lds0+L2_VA)+((lane>>4)&1)*32+(lane&3)*8+(4*hi+((lane&15)>>2))*64;
  const int vbB=(int)(lds0+L2_VB)+((lane>>4)&1)*32+(lane&3)*8+(4*hi+((lane&15)>>2))*64;
  const char*Kbase=shm+L2_K; bf16x8 kf[8];
  const lds_cptr shm3=(lds_cptr)shm; const lds_cptr kp0=shm3+L2_K+hi*1024+r32*16; const lds_cptr vp0=shm3+L2_VA+((lane>>4)&1)*32+(lane&3)*8+(4*hi+((lane&15)>>2))*64;
  const int NTr=2*q128+2, NT=NTr<4?4:NTr;
  DMA_K(0,0);DMA_V(0,0);DMA_K(1,SLOTB);
  int sl_prev=0,sl_cur=0,sl_next=SLOTB;
  #define ROT() do{sl_prev=sl_cur;sl_cur=sl_next;sl_next=(sl_next==(NSLOT-1)*SLOTB)?0:sl_next+SLOTB;}while(0)
  #define ENDW(tt) do{ if((tt)+3<NT){WAIT_BAR(3);} else if((tt)+2<NT){WAIT_BAR(2);} else {WAIT_BAR(0);} }while(0)
  if(roleA){
  bf16x8 qr[4];
  { int lq=lane; asm volatile("":"+v"(lq));
  #pragma unroll
  for(int d0=0;d0<4;++d0)qr[d0]=*reinterpret_cast<const bf16x8*>(&Qw[(long)(lq&31)*DM+d0*16+(lq>>5)*8]); }
  float mhat=0.f,l_reg=0.f;f32x16 o[2];o[0]=f32x16{};o[1]=f32x16{};f32x16 negm;
  #pragma unroll
  for(int r=0;r<16;++r)negm[r]=b31s;
  asm volatile("":"+v"(negm));
  const int qrel=w4*QBLK+r32;
  #define CMASK(P0,P1,t) do{int jb_=(t)-(NTr-2); if(jb_>=-2)cmask(P0,P1,jb_,qrel,hi,tabd);}while(0)
  bool resc=false;
  #define START(P0,P1) do{ const float rm=rowmax(P0,P1); resc=false; \
    { const float dl=rm; mhat=fadd_s(mhat,dl); \
      _Pragma("unroll") for(int r=0;r<16;++r){P0[r]=fsub_s(P0[r],dl);P1[r]=fsub_s(P1[r],dl);} \
      _Pragma("unroll") for(int r=0;r<16;++r)negm[r]=b31s-mhat; asm volatile("":"+v"(negm)); } \
    _Pragma("unroll") for(int r=0;r<16;++r)P0[r]=__builtin_amdgcn_exp2f(P0[r]); }while(0)
  #define RESC(t) do{ const float*facp_=fac+((t)&1)*32; if(resc){ asm volatile("s_waitcnt lgkmcnt(0)":::"memory"); \
      _Pragma("unroll") for(int d_=0;d_<2;++d_) _Pragma("unroll") for(int r=0;r<16;++r)o[d_][r]*=facp_[crow(r,hi)]; } }while(0)
  f32x16 pA0,pA1,pB0,pB1;
  DMA_K(2,2*SLOTB);
  WAIT_BAR(4);
  qkt(pA0,pA1,Kbase,qr,negm,r32,hi);asm volatile("s_nop 15\n\ts_nop 7":"+v"(pA0),"+v"(pA1));CMASK(pA0,pA1,0);
  START(pA0,pA1);
  _Pragma("unroll") for(int r=0;r<16;++r)pA1[r]=__builtin_amdgcn_exp2f(pA1[r]);
  WAIT_BAR(0);
  DMA_K(3,0);DMA_V(1,SLOTB);
  ROT();
  kload8(kf,kp0+sl_cur);
  WAIT_BAR(3);
  s16x4 vlo[8],vhi[8]; u32x4 pw0,pw1,pw2,pw3;
  #define PKW(P,B) cvtpk_s(P[B],P[B+1])
  #define PAF(k) __builtin_bit_cast(bf16x8,pw##k)
  #define VFR(i) (bf16x8){vlo[i][0],vlo[i][1],vlo[i][2],vlo[i][3],vhi[i][0],vhi[i][1],vhi[i][2],vhi[i][3]}
  #define PIN(x) asm volatile("":"+v"(x))
  #define MX3(a,b,c) __builtin_fmaxf(__builtin_fmaxf((a),(b)),(c))
  #define GAPA(MF,A0,A1,A2,A3,W0,W1,PW) do{ MF; sacc+=A0; sacc+=A1; sacc+=A2; sacc+=A3; PIN(sacc); W0; W1; PIN(PW); SBAR(); }while(0)
  #define EX(v) __builtin_amdgcn_exp2f(v)
  #define GAPB(MF,X,B) do{ MF; X[B]=EX(X[B]); X[B+1]=EX(X[B+1]); X[B+2]=EX(X[B+2]); X[B+3]=EX(X[B+3]); PIN(X); SBAR(); }while(0)
  #define VRD(i) do{ vlo[i]=vtr(vp_+(((i)>>2)*4096+((i)&3)*1024)); vhi[i]=vtr(vp_+(((i)>>2)*4096+((i)&3)*1024+512)); }while(0)
  #define KRD(G,j) do{ if(G){ kload2(kf,kp0+sl_next,j); SBAR(); } }while(0)
  #define STEP(C0,C1,P0,P1,t,GK,GV,GL) do{ SBAR(); \
    const lds_cptr vp_=vp0+sl_prev; \
    VRD(0); SBAR(); float sacc=(P0[0]+P0[1]); \
    GAPA(C0=__builtin_amdgcn_mfma_f32_32x32x16_bf16(kf[0],qr[0],negm,0,0,0), P0[2],P0[3],P0[4],P0[5],     pw0[0]=PKW(P0,0), pw0[1]=PKW(P0,2), pw0); \
    VRD(4); SBAR(); GAPA(C1=__builtin_amdgcn_mfma_f32_32x32x16_bf16(kf[1],qr[0],negm,0,0,0), P0[6],P0[7],P0[8],P0[9],     pw0[2]=PKW(P0,4), pw0[3]=PKW(P0,6), pw0); \
    VRD(1); SBAR(); GAPA(C0=__builtin_amdgcn_mfma_f32_32x32x16_bf16(kf[2],qr[1],C0,0,0,0),   P0[10],P0[11],P0[12],P0[13], pw1[0]=PKW(P0,8), pw1[1]=PKW(P0,10), pw1); \
    VRD(5); SBAR(); GAPA(C1=__builtin_amdgcn_mfma_f32_32x32x16_bf16(kf[3],qr[1],C1,0,0,0),   P0[14],P0[15],P1[0],P1[1],   pw1[2]=PKW(P0,12),pw1[3]=PKW(P0,14), pw1); \
    VRD(2); SBAR(); GAPA(C0=__builtin_amdgcn_mfma_f32_32x32x16_bf16(kf[4],qr[2],C0,0,0,0),   P1[2],P1[3],P1[4],P1[5],     pw2[0]=PKW(P1,0), pw2[1]=PKW(P1,2), pw2); \
    VRD(6); SBAR(); GAPA(C1=__builtin_amdgcn_mfma_f32_32x32x16_bf16(kf[5],qr[2],C1,0,0,0),   P1[6],P1[7],P1[8],P1[9],     pw2[2]=PKW(P1,4), pw2[3]=PKW(P1,6), pw2); \
    VRD(3); SBAR(); GAPA(C0=__builtin_amdgcn_mfma_f32_32x32x16_bf16(kf[6],qr[3],C0,0,0,0),   P1[10],P1[11],P1[12],P1[13], pw3[0]=PKW(P1,8), pw3[1]=PKW(P1,10), pw3); \
    VRD(7); SBAR(); GAPA(C1=__builtin_amdgcn_mfma_f32_32x32x16_bf16(kf[7],qr[3],C1,0,0,0),   P1[14],P1[15],0.f,0.f,       pw3[2]=PKW(P1,12),pw3[3]=PKW(P1,14), pw3); \
    l_reg+=sacc; \
    { char*pb_=pbuf+(((t)-1)&1)*4096+lane*16; *(u32x4*)(pb_)=pw0; *(u32x4*)(pb_+1024)=pw1; *(u32x4*)(pb_+2048)=pw2; *(u32x4*)(pb_+3072)=pw3; }     \
    if(GK){DMA_K((t)+3,sl_cur);} if(GV){DMA_V((t)+1,sl_next);} \
    CMASK(C0,C1,t); \
    { float a=MX3(C0[0],C0[1],C1[0]),b=MX3(C0[2],C0[3],C1[1]); a=MX3(a,C1[2],C1[3]); \
      _Pragma("unroll") for(int r=4;r<16;r+=4){a=MX3(a,C0[r],C0[r+1]);b=MX3(b,C0[r+2],C0[r+3]);a=MX3(a,C1[r],C1[r+1]);b=MX3(b,C1[r+2],C1[r+3]);} \
      float rm=__builtin_fmaxf(a,b); { auto rr=__builtin_amdgcn_permlane32_swap(__float_as_uint(rm),__float_as_uint(rm),false,false); rm=__builtin_fmaxf(__uint_as_float(rr[0]),__uint_as_float(rr[1])); } \
      resc=false; \
      if(__builtin_expect(__any(rm>(float)THRL),0)){ const float dl=__builtin_fmaxf(rm,0.f); mhat+=dl; \
        _Pragma("unroll") for(int r=0;r<16;++r){C0[r]-=dl;C1[r]-=dl;} \
        _Pragma("unroll") for(int r=0;r<16;++r)negm[r]=b31s-mhat; asm volatile("":"+v"(negm)); \
        const float f=__builtin_amdgcn_exp2f(-dl); l_reg*=f; if(hi==0)fac[((t)&1)*32+r32]=f; resc=true; } \
      if(lane==0)flg[(t)&1]=resc?1u:0u; } \
    SBAR(); \
    GAPB(o[0]=__builtin_amdgcn_mfma_f32_32x32x16_bf16(PAF(0),VFR(0),o[0],0,0,0), C0,0); \
    GAPB(o[1]=__builtin_amdgcn_mfma_f32_32x32x16_bf16(PAF(0),VFR(4),o[1],0,0,0), C0,4); \
    KRD(GL,0); GAPB(o[0]=__builtin_amdgcn_mfma_f32_32x32x16_bf16(PAF(1),VFR(1),o[0],0,0,0), C0,8); \
    KRD(GL,1); GAPB(o[1]=__builtin_amdgcn_mfma_f32_32x32x16_bf16(PAF(1),VFR(5),o[1],0,0,0), C0,12); \
    KRD(GL,2); GAPB(o[0]=__builtin_amdgcn_mfma_f32_32x32x16_bf16(PAF(2),VFR(2),o[0],0,0,0), C1,0); \
    KRD(GL,3); GAPB(o[1]=__builtin_amdgcn_mfma_f32_32x32x16_bf16(PAF(2),VFR(6),o[1],0,0,0), C1,4); \
    GAPB(o[0]=__builtin_amdgcn_mfma_f32_32x32x16_bf16(PAF(3),VFR(3),o[0],0,0,0), C1,8); \
    GAPB(o[1]=__builtin_amdgcn_mfma_f32_32x32x16_bf16(PAF(3),VFR(7),o[1],0,0,0), C1,12); \
    }while(0)
  int t=1;
  #undef CMASK
  #define CMASK(P0,P1,t) do{}while(0)
  for(;t+7<NT;t+=2){
    STEP(pB0,pB1,pA0,pA1,t,true,true,true);     WAIT_BAR(3); RESC(t); ROT();
    STEP(pA0,pA1,pB0,pB1,t+1,true,true,true);   WAIT_BAR(3); RESC(t+1); ROT();
  }
  #undef CMASK
  #define CMASK(P0,P1,t) do{int jb_=(t)-(NTr-2); if(jb_>=-2)cmask(P0,P1,jb_,qrel,hi,tabd);}while(0)
  for(;t+1<NT;t+=2){
    STEP(pB0,pB1,pA0,pA1,t,(t+3<NT),(t+1<NT),(t+1<NT));       ENDW(t);   RESC(t); ROT();
    STEP(pA0,pA1,pB0,pB1,t+1,(t+4<NT),(t+2<NT),(t+2<NT));     ENDW(t+1); RESC(t+1); ROT();
  }
  STEP(pB0,pB1,pA0,pA1,NT-1,false,false,false); RESC(NT-1);
  WAIT_BAR(0);
  { float sacc=pB0[0]+pB0[1]; _Pragma("unroll") for(int r=2;r<16;++r)sacc+=pB0[r]; _Pragma("unroll") for(int r=0;r<16;++r)sacc+=pB1[r]; l_reg+=sacc;
    pw0=(u32x4){PKW(pB0,0),PKW(pB0,2),PKW(pB0,4),PKW(pB0,6)};pw1=(u32x4){PKW(pB0,8),PKW(pB0,10),PKW(pB0,12),PKW(pB0,14)};pw2=(u32x4){PKW(pB1,0),PKW(pB1,2),PKW(pB1,4),PKW(pB1,6)};pw3=(u32x4){PKW(pB1,8),PKW(pB1,10),PKW(pB1,12),PKW(pB1,14)};
    { char*pb_=pbuf+((NT-1)&1)*4096+lane*16; *(u32x4*)(pb_)=pw0; *(u32x4*)(pb_+1024)=pw1; *(u32x4*)(pb_+2048)=pw2; *(u32x4*)(pb_+3072)=pw3; }
    SBAR(); pv(o,vb0+sl_cur,PAF(0),PAF(1),PAF(2),PAF(3)); }
  #undef PKW
  #undef PAF
  #undef VFR
  #undef PIN
  #undef MX3
  #undef GAPA
  #undef GAPB
  #undef EX
  #undef VRD
  #undef KRD
  #undef STEP
  {auto rr=__builtin_amdgcn_permlane32_swap(__float_as_uint(l_reg),__float_as_uint(l_reg),false,false);l_reg=__uint_as_float(rr[0])+__uint_as_float(rr[1]);}
  if(hi==0)lbuf[r32]=l_reg;
  WAIT_BAR(0);
  float rli[16];
  #pragma unroll
  for(int r=0;r<16;++r)rli[r]=__builtin_amdgcn_rcpf(lbuf[crow(r,hi)]);
  bf16*Ow=O+(rowbase+q0+w4*QBLK)*DM+(h*2)*D;
  { bf16*stg=(bf16*)(shm+L2_VA)+w4*2048;
    #pragma unroll
    for(int r=0;r<16;++r){const int orow=crow(r,hi);
      #pragma unroll
      for(int d0=0;d0<2;++d0)stg[orow*64+d0*32+r32]=__float2bfloat16(o[d0][r]*rli[r]);}
    asm volatile("s_waitcnt lgkmcnt(0)":::"memory");
    int le=lane; asm volatile("":"+v"(le));
    #pragma unroll
    for(int i=0;i<4;++i){const int row=i*8+(le>>3),ch=le&7; const u32x4 v=*(const u32x4*)(stg+row*64+ch*8); ATTN_STORE16(Ow+(long)row*DM+ch*8,v);} }
  } else {
  f32x16 o[2];o[0]=f32x16{};o[1]=f32x16{};
  #define LDP(k,par) (*(const bf16x8*)(pbuf+(par)*4096+(k)*1024+lane*16))
  #define PVB(tt) do{ const int par_=(tt)&1; asm volatile("s_waitcnt lgkmcnt(0)":::"memory"); pv(o,vbB+(((tt)&3)*SLOTB),LDP(0,par_),LDP(1,par_),LDP(2,par_),LDP(3,par_)); }while(0)
  #define RESCB(tt) do{ if(flg[(tt)&1]){ const float*facp_=fac+((tt)&1)*32; _Pragma("unroll") for(int d_=0;d_<2;++d_) _Pragma("unroll") for(int r=0;r<16;++r)o[d_][r]*=facp_[crow(r,hi)]; } }while(0)
  DMA_K(2,2*SLOTB);
  WAIT_BAR(4);
  WAIT_BAR(0);
  DMA_K(3,0);DMA_V(1,SLOTB);
  ROT();
  WAIT_BAR(3);
  for(int t=1;t<NT;++t){
    if(t>=2){ PVB(t-2); RESCB(t-1); }
    if(t+3<NT){DMA_K(t+3,sl_cur);} if(t+1<NT){DMA_V(t+1,sl_next);}
    if(t+1<NT){ ENDW(t); } else { WAIT_BAR(0); }
    ROT();
  }
  WAIT_BAR(0);
  PVB(NT-2); RESCB(NT-1); PVB(NT-1);
  float rli[16];
  #pragma unroll
  for(int r=0;r<16;++r)rli[r]=__builtin_amdgcn_rcpf(lbuf[crow(r,hi)]);
  bf16*Ow=O+(rowbase+q0+w4*QBLK)*DM+(h*2+1)*D;
  { bf16*stg=(bf16*)(shm+L2_K)+w4*2048;
    #pragma unroll
    for(int r=0;r<16;++r){const int orow=crow(r,hi);
      #pragma unroll
      for(int d0=0;d0<2;++d0)stg[orow*64+d0*32+r32]=__float2bfloat16(o[d0][r]*rli[r]);}
    asm volatile("s_waitcnt lgkmcnt(0)":::"memory");
    int le=lane; asm volatile("":"+v"(le));
    #pragma unroll
    for(int i=0;i<4;++i){const int row=i*8+(le>>3),ch=le&7; const u32x4 v=*(const u32x4*)(stg+row*64+ch*8); ATTN_STORE16(Ow+(long)row*DM+ch*8,v);} }
  #undef LDP
  #undef PVB
  #undef RESCB
  }
  asm volatile("s_waitcnt lgkmcnt(0)\n\ts_barrier":::"memory");
  #undef ENDW
  #undef DMA_K
  #undef DMA_V
  #undef CMASK
  #undef START
  #undef RESC
  #undef ROT
}
constexpr int ATTN2_LDS_BYTES=L2_BYTES;
template<int THRL=8> __device__ __forceinline__ void attn_phase2(char*lds,const AttnTensors&T,int grid,int block){
  const int vcu=(grid%8==0)?(block%8)*(grid/8)+block/8:block;
  lds_cfptr tab=(lds_cfptr)((__attribute__((address_space(3))) const char*)lds+L2_TAB);
  { __attribute__((address_space(3))) float* tw=(__attribute__((address_space(3))) float*)((__attribute__((address_space(3))) char*)lds+L2_TAB);
    for(int i=threadIdx.x;i<8*128;i+=512){const int h=i>>7; tw[i]=T.TB[i]-T.TB[h*128+127];}
    asm volatile("s_waitcnt vmcnt(0) lgkmcnt(0)\n\ts_barrier":::"memory"); }
  for(int bh=vcu>>3;bh<BATCH*8;bh+=grid>>3){ const int b=bh>>3,h=bh&7,s=vcu&7; const float b31s=T.TB[h*128+127];
    for(int c=0;c<2;++c){
      for(int i=0;i<8;++i){ const int q=(i&1)?(16*(i>>1)+15-s):(16*(i>>1)+s);
        attn_unit2<THRL>(b,h,c,q,T.Q,T.K,T.V,c?T.O1:T.O0,lds,b31s,tab+h*128); } } }
}
constexpr int L3_K=0, L3_V=3*SLOTB, L3_P=11*SLOTB, L3_WS=15*SLOTB, L3_FAC=L3_WS+2048, L3_FLG=L3_FAC+1024, L3_LB=L3_FLG+64, L3_TAB=L3_LB+512, L3_BYTES=L3_TAB+4096;
template<int THRL> __device__ __forceinline__ void attn_unit3(int b,int h,int c,int q128,const bf16*Q,const bf16*__restrict__ K,const bf16*__restrict__ V,bf16*O,char*shm,float b31s,lds_cfptr tabd){
  const int tid=threadIdx.x,lane=tid&63,r32=lane&31,hi=lane>>5; const int wid=__builtin_amdgcn_readfirstlane(tid>>6); const int w4=wid&3; const bool roleA=wid<4;
  const long rowbase=(long)b*SEQ; const int q0=q128*128; const int hq=h*2+c;
  const bf16*Qw=Q+(rowbase+q0+w4*QBLK)*DM+hq*D;
  const bf16*Kh=K+rowbase*DM+hq*D,*Vh=V+rowbase*DM+(h*2)*D;
  const unsigned lds0=(unsigned)(uintptr_t)shm;
  float*wsf=(float*)(shm+L3_WS)+wid*64;
  float*fac=(float*)(shm+L3_FAC)+w4*64;
  volatile __attribute__((address_space(3))) unsigned*flg=(volatile __attribute__((address_space(3))) unsigned*)((__attribute__((address_space(3))) char*)shm+L3_FLG)+w4*2;
  float*lbuf=(float*)(shm+L3_LB)+w4*32;
  char*pbuf=shm+L3_P+w4*8192;
  const unsigned koff=(unsigned)(lane*DM+wid*8)*2u;
  const unsigned voff=(unsigned)((16*(wid&3)+(lane>>2))*DM+(wid>>2)*32+(lane&3)*8)*2u;
  const unsigned kdst=lds0+L3_K+wid*1024, vbdst=lds0+L3_V+wid*1024;
  #define DMA_K(t,slot) glds16(Kh+(long)(t)*KVBLK*DM,koff,(unsigned)__builtin_amdgcn_readfirstlane(kdst+(slot)))
  #define DMA_V(t,slot) do{ glds16(Vh+(long)(t)*KVBLK*DM,voff,(unsigned)__builtin_amdgcn_readfirstlane(vbdst+(((t)&3)*2*SLOTB))); \
    glds16(Vh+(long)(t)*KVBLK*DM+64,voff,(unsigned)__builtin_amdgcn_readfirstlane(vbdst+(((t)&3)*2*SLOTB+SLOTB))); }while(0)
  const int vbB=(int)(lds0+L3_V)+((lane>>4)&1)*32+(lane&3)*8+(4*hi+((lane&15)>>2))*64;
  const char*Kbase=shm+L3_K; bf16x8 kf[8];
  const lds_cptr shm3=(lds_cptr)shm; const lds_cptr kp0=shm3+L3_K+hi*1024+r32*16;
  const int NTr=2*q128+2, NT=NTr<4?4:NTr;
  DMA_K(0,0);DMA_V(0,0);DMA_K(1,SLOTB);
  int sl_prev=0,sl_cur=0,sl_next=SLOTB;
  #define ROT() do{sl_prev=sl_cur;sl_cur=sl_next;sl_next=(sl_next==(NSLOT-1)*SLOTB)?0:sl_next+SLOTB;}while(0)
  #define ENDW(tt) do{ if((tt)+3<NT){WAIT_BAR(3);} else if((tt)+2<NT){WAIT_BAR(2);} else {WAIT_BAR(0);} }while(0)
  if(roleA){
  bf16x8 qr[4];
  { int lq=lane; asm volatile("":"+v"(lq));
  #pragma unroll
  for(int d0=0;d0<4;++d0)qr[d0]=*reinterpret_cast<const bf16x8*>(&Qw[(long)(lq&31)*DM+d0*16+(lq>>5)*8]); }
  float mhat=0.f,l_reg=0.f;f32x16 negm;
  #pragma unroll
  for(int r=0;r<16;++r)negm[r]=b31s;
  asm volatile("":"+v"(negm));
  const int qrel=w4*QBLK+r32;
  #define CMASK(P0,P1,t) do{int jb_=(t)-(NTr-2); if(jb_>=-2)cmask(P0,P1,jb_,qrel,hi,tabd);}while(0)
  bool resc=false;
  #define START(P0,P1) do{ const float rm=rowmax(P0,P1); resc=false; \
    { const float dl=rm; mhat=fadd_s(mhat,dl); \
      _Pragma("unroll") for(int r=0;r<16;++r){P0[r]=fsub_s(P0[r],dl);P1[r]=fsub_s(P1[r],dl);} \
      _Pragma("unroll") for(int r=0;r<16;++r)negm[r]=b31s-mhat; asm volatile("":"+v"(negm)); } \
    _Pragma("unroll") for(int r=0;r<16;++r)P0[r]=__builtin_amdgcn_exp2f(P0[r]); }while(0)
  #define RESC(t) do{}while(0)
  f32x16 pA0,pA1,pB0,pB1;
  DMA_K(2,2*SLOTB);
  WAIT_BAR(4);
  qkt(pA0,pA1,Kbase,qr,negm,r32,hi);asm volatile("s_nop 15\n\ts_nop 7":"+v"(pA0),"+v"(pA1));CMASK(pA0,pA1,0);
  START(pA0,pA1);
  _Pragma("unroll") for(int r=0;r<16;++r)pA1[r]=__builtin_amdgcn_exp2f(pA1[r]);
  WAIT_BAR(0);
  DMA_K(3,0);DMA_V(1,SLOTB);
  ROT();
  kload8(kf,kp0+sl_cur);
  WAIT_BAR(3);
  u32x4 pw0,pw1,pw2,pw3;
  #define PKW(P,B) cvtpk_s(P[B],P[B+1])
  #define PAF(k) __builtin_bit_cast(bf16x8,pw##k)
  #define PIN(x) asm volatile("":"+v"(x))
  #define MX3(a,b,c) __builtin_fmaxf(__builtin_fmaxf((a),(b)),(c))
  #define GAPA(MF,A0,A1,A2,A3,W0,W1,PW) do{ MF; sacc+=A0; sacc+=A1; sacc+=A2; sacc+=A3; PIN(sacc); W0; W1; PIN(PW); SBAR(); }while(0)
  #define EX(v) __builtin_amdgcn_exp2f(v)
  #define GAPX(X,B) do{ X[B]=EX(X[B]); X[B+1]=EX(X[B+1]); X[B+2]=EX(X[B+2]); X[B+3]=EX(X[B+3]); PIN(X); SBAR(); }while(0)
  #define KRD(G,j) do{ if(G){ kload2(kf,kp0+sl_next,j); SBAR(); } }while(0)
  #define STEP(C0,C1,P0,P1,t,GK,GV,GL) do{ SBAR(); \
    float sacc=(P0[0]+P0[1]); \
    GAPA(C0=__builtin_amdgcn_mfma_f32_32x32x16_bf16(kf[0],qr[0],negm,0,0,0), P0[2],P0[3],P0[4],P0[5],     pw0[0]=PKW(P0,0), pw0[1]=PKW(P0,2), pw0); \
    GAPA(C1=__builtin_amdgcn_mfma_f32_32x32x16_bf16(kf[1],qr[0],negm,0,0,0), P0[6],P0[7],P0[8],P0[9],     pw0[2]=PKW(P0,4), pw0[3]=PKW(P0,6), pw0); \
    GAPA(C0=__builtin_amdgcn_mfma_f32_32x32x16_bf16(kf[2],qr[1],C0,0,0,0),   P0[10],P0[11],P0[12],P0[13], pw1[0]=PKW(P0,8), pw1[1]=PKW(P0,10), pw1); \
    GAPA(C1=__builtin_amdgcn_mfma_f32_32x32x16_bf16(kf[3],qr[1],C1,0,0,0),   P0[14],P0[15],P1[0],P1[1],   pw1[2]=PKW(P0,12),pw1[3]=PKW(P0,14), pw1); \
    GAPA(C0=__builtin_amdgcn_mfma_f32_32x32x16_bf16(kf[4],qr[2],C0,0,0,0),   P1[2],P1[3],P1[4],P1[5],     pw2[0]=PKW(P1,0), pw2[1]=PKW(P1,2), pw2); \
    GAPA(C1=__builtin_amdgcn_mfma_f32_32x32x16_bf16(kf[5],qr[2],C1,0,0,0),   P1[6],P1[7],P1[8],P1[9],     pw2[2]=PKW(P1,4), pw2[3]=PKW(P1,6), pw2); \
    GAPA(C0=__builtin_amdgcn_mfma_f32_32x32x16_bf16(kf[6],qr[3],C0,0,0,0),   P1[10],P1[11],P1[12],P1[13], pw3[0]=PKW(P1,8), pw3[1]=PKW(P1,10), pw3); \
    GAPA(C1=__builtin_amdgcn_mfma_f32_32x32x16_bf16(kf[7],qr[3],C1,0,0,0),   P1[14],P1[15],0.f,0.f,       pw3[2]=PKW(P1,12),pw3[3]=PKW(P1,14), pw3); \
    l_reg+=sacc; \
    { char*pb_=pbuf+(((t)-1)&1)*4096+lane*16; *(u32x4*)(pb_)=pw0; *(u32x4*)(pb_+1024)=pw1; *(u32x4*)(pb_+2048)=pw2; *(u32x4*)(pb_+3072)=pw3; }     \
    if(GK){DMA_K((t)+3,sl_cur);} if(GV){DMA_V((t)+1,sl_next);} \
    CMASK(C0,C1,t); \
    { float a=MX3(C0[0],C0[1],C1[0]),b=MX3(C0[2],C0[3],C1[1]); a=MX3(a,C1[2],C1[3]); \
      _Pragma("unroll") for(int r=4;r<16;r+=4){a=MX3(a,C0[r],C0[r+1]);b=MX3(b,C0[r+2],C0[r+3]);a=MX3(a,C1[r],C1[r+1]);b=MX3(b,C1[r+2],C1[r+3]);} \
      float rm=__builtin_fmaxf(a,b); { auto rr=__builtin_amdgcn_permlane32_swap(__float_as_uint(rm),__float_as_uint(rm),false,false); rm=__builtin_fmaxf(__uint_as_float(rr[0]),__uint_as_float(rr[1])); } \
      resc=false; \
      if(__builtin_expect(__any(rm>(float)THRL),0)){ const float dl=__builtin_fmaxf(rm,0.f); mhat+=dl; \
        _Pragma("unroll") for(int r=0;r<16;++r){C0[r]-=dl;C1[r]-=dl;} \
        _Pragma("unroll") for(int r=0;r<16;++r)negm[r]=b31s-mhat; asm volatile("":"+v"(negm)); \
        const float f=__builtin_amdgcn_exp2f(-dl); l_reg*=f; if(hi==0)fac[((t)&1)*32+r32]=f; resc=true; } \
      if(lane==0)flg[(t)&1]=resc?1u:0u; } \
    SBAR(); \
    GAPX(C0,0); \
    GAPX(C0,4); \
    KRD(GL,0); GAPX(C0,8); \
    KRD(GL,1); GAPX(C0,12); \
    KRD(GL,2); GAPX(C1,0); \
    KRD(GL,3); GAPX(C1,4); \
    GAPX(C1,8); \
    GAPX(C1,12); \
    }while(0)
  int t=1;
  #undef CMASK
  #define CMASK(P0,P1,t) do{}while(0)
  for(;t+7<NT;t+=2){
    STEP(pB0,pB1,pA0,pA1,t,true,true,true);     WAIT_BAR(3); RESC(t); ROT();
    STEP(pA0,pA1,pB0,pB1,t+1,true,true,true);   WAIT_BAR(3); RESC(t+1); ROT();
  }
  #undef CMASK
  #define CMASK(P0,P1,t) do{int jb_=(t)-(NTr-2); if(jb_>=-2)cmask(P0,P1,jb_,qrel,hi,tabd);}while(0)
  for(;t+1<NT;t+=2){
    STEP(pB0,pB1,pA0,pA1,t,(t+3<NT),(t+1<NT),(t+1<NT));       ENDW(t);   RESC(t); ROT();
    STEP(pA0,pA1,pB0,pB1,t+1,(t+4<NT),(t+2<NT),(t+2<NT));     ENDW(t+1); RESC(t+1); ROT();
  }
  STEP(pB0,pB1,pA0,pA1,NT-1,false,false,false); RESC(NT-1);
  WAIT_BAR(0);
  { float sacc=pB0[0]+pB0[1]; _Pragma("unroll") for(int r=2;r<16;++r)sacc+=pB0[r]; _Pragma("unroll") for(int r=0;r<16;++r)sacc+=pB1[r]; l_reg+=sacc;
    pw0=(u32x4){PKW(pB0,0),PKW(pB0,2),PKW(pB0,4),PKW(pB0,6)};pw1=(u32x4){PKW(pB0,8),PKW(pB0,10),PKW(pB0,12),PKW(pB0,14)};pw2=(u32x4){PKW(pB1,0),PKW(pB1,2),PKW(pB1,4),PKW(pB1,6)};pw3=(u32x4){PKW(pB1,8),PKW(pB1,10),PKW(pB1,12),PKW(pB1,14)};
    { char*pb_=pbuf+((NT-1)&1)*4096+lane*16; *(u32x4*)(pb_)=pw0; *(u32x4*)(pb_+1024)=pw1; *(u32x4*)(pb_+2048)=pw2; *(u32x4*)(pb_+3072)=pw3; }
    }
  #undef PKW
  #undef PAF
  #undef PIN
  #undef MX3
  #undef GAPA
  #undef GAPX
  #undef EX
  #undef KRD
  #undef STEP
  {auto rr=__builtin_amdgcn_permlane32_swap(__float_as_uint(l_reg),__float_as_uint(l_reg),false,false);l_reg=__uint_as_float(rr[0])+__uint_as_float(rr[1]);}
  if(hi==0)lbuf[r32]=l_reg;
  WAIT_BAR(0);
  } else {
  f32x16 o[4];o[0]=f32x16{};o[1]=f32x16{};o[2]=f32x16{};o[3]=f32x16{};
  #define LDP(k,par) (*(const bf16x8*)(pbuf+(par)*4096+(k)*1024+lane*16))
  #define PVB(tt) do{ const int par_=(tt)&1; asm volatile("s_waitcnt lgkmcnt(0)":::"memory"); const bf16x8 p0_=LDP(0,par_),p1_=LDP(1,par_),p2_=LDP(2,par_),p3_=LDP(3,par_); pv(o,vbB+(((tt)&3)*2*SLOTB),p0_,p1_,p2_,p3_); pv(o+2,vbB+(((tt)&3)*2*SLOTB+SLOTB),p0_,p1_,p2_,p3_); }while(0)
  #define RESCB(tt) do{ if(flg[(tt)&1]){ const float*facp_=fac+((tt)&1)*32; _Pragma("unroll") for(int d_=0;d_<4;++d_) _Pragma("unroll") for(int r=0;r<16;++r)o[d_][r]*=facp_[crow(r,hi)]; } }while(0)
  DMA_K(2,2*SLOTB);
  WAIT_BAR(4);
  WAIT_BAR(0);
  DMA_K(3,0);DMA_V(1,SLOTB);
  ROT();
  WAIT_BAR(3);
  for(int t=1;t<NT;++t){
    if(t>=2){ PVB(t-2); RESCB(t-1); }
    if(t+3<NT){DMA_K(t+3,sl_cur);} if(t+1<NT){DMA_V(t+1,sl_next);}
    if(t+1<NT){ ENDW(t); } else { WAIT_BAR(0); }
    ROT();
  }
  WAIT_BAR(0);
  PVB(NT-2); RESCB(NT-1); PVB(NT-1);
  float rli[16];
  #pragma unroll
  for(int r=0;r<16;++r)rli[r]=__builtin_amdgcn_rcpf(lbuf[crow(r,hi)]);
  bf16*Ow=O+(rowbase+q0+w4*QBLK)*DM+(h*2)*D;
  { bf16*stg=(bf16*)(pbuf);
    #pragma unroll
    for(int r=0;r<16;++r){const int orow=crow(r,hi);
      #pragma unroll
      for(int d0=0;d0<4;++d0)stg[orow*128+d0*32+r32]=__float2bfloat16(o[d0][r]*rli[r]);}
    asm volatile("s_waitcnt lgkmcnt(0)":::"memory");
    int le=lane; asm volatile("":"+v"(le));
    #pragma unroll
    for(int i=0;i<8;++i){const int row=i*4+(le>>4),ch=le&15; const u32x4 v=*(const u32x4*)(stg+row*128+ch*8); ATTN_STORE16(Ow+(long)row*DM+ch*8,v);} }
  #undef LDP
  #undef PVB
  #undef RESCB
  }
  asm volatile("s_waitcnt lgkmcnt(0)\n\ts_barrier":::"memory");
  #undef ENDW
  #undef DMA_K
  #undef DMA_V
  #undef CMASK
  #undef START
  #undef RESC
  #undef ROT
}
constexpr int ATTN3_LDS_BYTES=L3_BYTES;
template<int THRL=8> __device__ __forceinline__ void attn_phase3(char*lds,const AttnTensors&T,int grid,int block){
  const int vcu=(grid%8==0)?(block%8)*(grid/8)+block/8:block;
  lds_cfptr tab=(lds_cfptr)((__attribute__((address_space(3))) const char*)lds+L3_TAB);
  { __attribute__((address_space(3))) float* tw=(__attribute__((address_space(3))) float*)((__attribute__((address_space(3))) char*)lds+L3_TAB);
    for(int i=threadIdx.x;i<8*128;i+=512){const int h=i>>7; tw[i]=T.TB[i]-T.TB[h*128+127];}
    asm volatile("s_waitcnt vmcnt(0) lgkmcnt(0)\n\ts_barrier":::"memory"); }
  for(int bh=vcu>>3;bh<BATCH*8;bh+=grid>>3){ const int b=bh>>3,h=bh&7,s=vcu&7; const float b31s=T.TB[h*128+127];
    for(int c=0;c<2;++c){
      for(int i=0;i<8;++i){ const int q=(i&1)?(16*(i>>1)+15-s):(16*(i>>1)+s);
        attn_unit3<THRL>(b,h,c,q,T.Q,T.K,T.V,c?T.O1:T.O0,lds,b31s,tab+h*128); } } }
}
constexpr int L4_K=0, L4_V=3*SLOTB, L4_WS=9*SLOTB, L4_TAB=L4_WS+2048, L4_BYTES=L4_TAB+4096;
template<int THRL> __device__ __forceinline__ void attn_unit4(int b,int h,int c,int qb,const bf16*Q,const bf16*__restrict__ K,const bf16*__restrict__ V,bf16*O,bf16*OC,const float*subg,float lam,char*shm,float b31s,lds_cfptr tabd){
  const int tid=threadIdx.x,lane=tid&63,r32=lane&31,hi=lane>>5; const int wid=__builtin_amdgcn_readfirstlane(tid>>6);
  const long rowbase=(long)b*SEQ; const int q0=qb*QB; const int hq=h*2+c;
  const bf16*Qw=Q+(rowbase+q0+wid*QBLK)*DM+hq*D;
  const bf16*Kh=K+rowbase*DM+hq*D,*Vh=V+rowbase*DM+(h*2)*D;
  const unsigned lds0=(unsigned)(uintptr_t)shm;
  float*wsf=(float*)(shm+L4_WS)+wid*64;
  const unsigned koff=(unsigned)(lane*DM+wid*8)*2u;
  const unsigned voff=(unsigned)((16*(wid&3)+(lane>>2))*DM+(wid>>2)*32+(lane&3)*8)*2u;
  const unsigned kdst=lds0+L4_K+wid*1024, vdst=lds0+L4_V+wid*1024;
  #define DMA_K(t,slot) glds16(Kh+(long)(t)*KVBLK*DM,koff,(unsigned)__builtin_amdgcn_readfirstlane(kdst+(slot)))
  #define DMA_V(t,slot) do{ glds16(Vh+(long)(t)*KVBLK*DM,voff,(unsigned)__builtin_amdgcn_readfirstlane(vdst+2*(slot))); \
    glds16(Vh+(long)(t)*KVBLK*DM+64,voff,(unsigned)__builtin_amdgcn_readfirstlane(vdst+2*(slot)+SLOTB)); }while(0)
  const int vb0=(int)(lds0+L4_V)+((lane>>4)&1)*32+(lane&3)*8+(4*hi+((lane&15)>>2))*64;
  const char*Kbase=shm+L4_K; bf16x8 kf[8];
  const lds_cptr shm3=(lds_cptr)shm; const lds_cptr kp0=shm3+L4_K+hi*1024+r32*16; const lds_cptr vp0=shm3+L4_V+((lane>>4)&1)*32+(lane&3)*8+(4*hi+((lane&15)>>2))*64;
  const int NT=(q0+QB)/KVBLK, NTr=NT-2;
  DMA_K(0,0);DMA_V(0,0);DMA_K(1,SLOTB);
  int sl_prev=0,sl_cur=0,sl_next=SLOTB;
  #define ROT() do{sl_prev=sl_cur;sl_cur=sl_next;sl_next=(sl_next==(NSLOT-1)*SLOTB)?0:sl_next+SLOTB;}while(0)
  #define ENDW(tt) do{ if((tt)+3<NT){WAIT_BAR(3);} else if((tt)+2<NT){WAIT_BAR(2);} else {WAIT_BAR(0);} }while(0)
  bf16x8 qr[4];
  { int lq=lane; asm volatile("":"+v"(lq));
  #pragma unroll
  for(int d0=0;d0<4;++d0)qr[d0]=*reinterpret_cast<const bf16x8*>(&Qw[(long)(lq&31)*DM+d0*16+(lq>>5)*8]); }
  float mhat=0.f,l_reg=0.f;f32x16 o[4];o[0]=f32x16{};o[1]=f32x16{};o[2]=f32x16{};o[3]=f32x16{};float nm=b31s; const f32x16 zc=f32x16{};
  const int qrel=wid*QBLK+r32;
  #define CMASK(P0,P1,t) do{int jb_=(t)-(NTr-2); if(jb_>=-2)cmask(P0,P1,jb_,qrel,hi,tabd);}while(0)
  bool resc=false;
  #define START(P0,P1) do{ const float rm=rowmax(P0,P1); resc=false; \
    { const float dl=rm; mhat=fadd_s(mhat,dl); \
      _Pragma("unroll") for(int r=0;r<16;++r){P0[r]=fsub_s(P0[r],dl);P1[r]=fsub_s(P1[r],dl);} \
      nm=b31s-mhat; } \
    _Pragma("unroll") for(int r=0;r<16;++r)P0[r]=__builtin_amdgcn_exp2f(P0[r]); }while(0)
  #define RESC(t) do{ if(resc){ asm volatile("s_waitcnt lgkmcnt(0)":::"memory"); \
      _Pragma("unroll") for(int d_=0;d_<4;++d_) _Pragma("unroll") for(int r=0;r<16;++r)o[d_][r]*=wsf[crow(r,hi)]; } }while(0)
  f32x16 pA0,pA1,pB0,pB1;
  DMA_K(2,2*SLOTB);
  WAIT_BAR(4);
  qkt(pA0,pA1,Kbase,qr,zc,r32,hi);asm volatile("s_nop 15\n\ts_nop 7":"+v"(pA0),"+v"(pA1));
  _Pragma("unroll") for(int r=0;r<16;++r){pA0[r]=fadd_s(pA0[r],nm);pA1[r]=fadd_s(pA1[r],nm);}
  CMASK(pA0,pA1,0);
  START(pA0,pA1);
  _Pragma("unroll") for(int r=0;r<16;++r)pA1[r]=__builtin_amdgcn_exp2f(pA1[r]);
  WAIT_BAR(0);
  DMA_K(3,0);DMA_V(1,SLOTB);
  ROT();
  kload8(kf,kp0+sl_cur);
  WAIT_BAR(3);
  u32x4 pw0,pw1,pw2,pw3;
  #define PKW(P,B) cvtpk_s(P[B],P[B+1])
  #define PAF(k) __builtin_bit_cast(bf16x8,pw##k)
  #define PIN(x) asm volatile("":"+v"(x))
  #define MX3(a,b,c) __builtin_fmaxf(__builtin_fmaxf((a),(b)),(c))
  #define GAPA(MF,A0,A1,A2,A3,W0,W1,PW) do{ MF; sacc+=A0; sacc+=A1; sacc+=A2; sacc+=A3; PIN(sacc); W0; W1; PIN(PW); SBAR(); }while(0)
  #define EX(v) __builtin_amdgcn_exp2f(v)
    \
  #define VF(lo,hi,k,d) do{ lo=vtr(vp_+(((d)>>1)*SLOTB+((d)&1)*4096+(k)*1024)); hi=vtr(vp_+(((d)>>1)*SLOTB+((d)&1)*4096+(k)*1024+512)); }while(0)
  #define VFRG(lo,hi) (bf16x8){lo[0],lo[1],lo[2],lo[3],hi[0],hi[1],hi[2],hi[3]}
  #define GAPY(g,cl0,ch0,cl1,ch1,nl0,nh0,nl1,nh1,X,B) do{ if((g)<7){ VF(nl0,nh0,((g)+1)>>1,2*(((g)+1)&1)); VF(nl1,nh1,((g)+1)>>1,2*(((g)+1)&1)+1); } \
    o[2*((g)&1)]=__builtin_amdgcn_mfma_f32_32x32x16_bf16(PAFK((g)>>1),VFRG(cl0,ch0),o[2*((g)&1)],0,0,0); o[2*((g)&1)+1]=__builtin_amdgcn_mfma_f32_32x32x16_bf16(PAFK((g)>>1),VFRG(cl1,ch1),o[2*((g)&1)+1],0,0,0); \
    X[B]=EX(X[B]); X[B+1]=EX(X[B+1]); X[B+2]=EX(X[B+2]); X[B+3]=EX(X[B+3]); PIN(X); SBAR(); }while(0)
  #define PAFK(k) ((k)==0?PAF(0):(k)==1?PAF(1):(k)==2?PAF(2):PAF(3))
  #define KRD(G,j) do{ if(G){ kload2(kf,kp0+sl_next,j); SBAR(); } }while(0)
  #define STEP(C0,C1,P0,P1,t,GK,GV,GL) do{ SBAR(); \
    float sacc=(P0[0]+P0[1]); \
    GAPA(C0=__builtin_amdgcn_mfma_f32_32x32x16_bf16(kf[0],qr[0],zc,0,0,0), P0[2],P0[3],P0[4],P0[5],     pw0[0]=PKW(P0,0), pw0[1]=PKW(P0,2), pw0); \
    GAPA(C1=__builtin_amdgcn_mfma_f32_32x32x16_bf16(kf[1],qr[0],zc,0,0,0), P0[6],P0[7],P0[8],P0[9],     pw0[2]=PKW(P0,4), pw0[3]=PKW(P0,6), pw0); \
    GAPA(C0=__builtin_amdgcn_mfma_f32_32x32x16_bf16(kf[2],qr[1],C0,0,0,0),   P0[10],P0[11],P0[12],P0[13], pw1[0]=PKW(P0,8), pw1[1]=PKW(P0,10), pw1); \
    GAPA(C1=__builtin_amdgcn_mfma_f32_32x32x16_bf16(kf[3],qr[1],C1,0,0,0),   P0[14],P0[15],P1[0],P1[1],   pw1[2]=PKW(P0,12),pw1[3]=PKW(P0,14), pw1); \
    GAPA(C0=__builtin_amdgcn_mfma_f32_32x32x16_bf16(kf[4],qr[2],C0,0,0,0),   P1[2],P1[3],P1[4],P1[5],     pw2[0]=PKW(P1,0), pw2[1]=PKW(P1,2), pw2); \
    GAPA(C1=__builtin_amdgcn_mfma_f32_32x32x16_bf16(kf[5],qr[2],C1,0,0,0),   P1[6],P1[7],P1[8],P1[9],     pw2[2]=PKW(P1,4), pw2[3]=PKW(P1,6), pw2); \
    GAPA(C0=__builtin_amdgcn_mfma_f32_32x32x16_bf16(kf[6],qr[3],C0,0,0,0),   P1[10],P1[11],P1[12],P1[13], pw3[0]=PKW(P1,8), pw3[1]=PKW(P1,10), pw3); \
    GAPA(C1=__builtin_amdgcn_mfma_f32_32x32x16_bf16(kf[7],qr[3],C1,0,0,0),   P1[14],P1[15],0.f,0.f,       pw3[2]=PKW(P1,12),pw3[3]=PKW(P1,14), pw3); \
    l_reg+=sacc; \
    if(GK){DMA_K((t)+3,sl_cur);} if(GV){DMA_V((t)+1,sl_next);} \
    _Pragma("unroll") for(int r=0;r<16;++r){C0[r]+=nm;C1[r]+=nm;} \
    CMASK(C0,C1,t); \
    { float a=MX3(C0[0],C0[1],C1[0]),b=MX3(C0[2],C0[3],C1[1]); a=MX3(a,C1[2],C1[3]); \
      _Pragma("unroll") for(int r=4;r<16;r+=4){a=MX3(a,C0[r],C0[r+1]);b=MX3(b,C0[r+2],C0[r+3]);a=MX3(a,C1[r],C1[r+1]);b=MX3(b,C1[r+2],C1[r+3]);} \
      float rm=__builtin_fmaxf(a,b); { auto rr=__builtin_amdgcn_permlane32_swap(__float_as_uint(rm),__float_as_uint(rm),false,false); rm=__builtin_fmaxf(__uint_as_float(rr[0]),__uint_as_float(rr[1])); } \
      resc=false; \
      if(__builtin_expect(__any(rm>(float)THRL),0)){ const float dl=__builtin_fmaxf(rm,0.f); mhat+=dl; \
        _Pragma("unroll") for(int r=0;r<16;++r){C0[r]-=dl;C1[r]-=dl;} \
        nm=b31s-mhat; \
        const float f=__builtin_amdgcn_exp2f(-dl); l_reg*=f; if(hi==0)wsf[r32]=f; resc=true; } } \
    SBAR(); \
    const lds_cptr vp_=vp0+2*sl_prev; s16x4 fl0,fh0,fl1,fh1,gl0,gh0,gl1,gh1; \
    VF(fl0,fh0,0,0); VF(fl1,fh1,0,1); SBAR(); \
    GAPY(0,fl0,fh0,fl1,fh1,gl0,gh0,gl1,gh1,C0,0); \
    GAPY(1,gl0,gh0,gl1,gh1,fl0,fh0,fl1,fh1,C0,4); \
    KRD(GL,0); GAPY(2,fl0,fh0,fl1,fh1,gl0,gh0,gl1,gh1,C0,8); \
    KRD(GL,1); GAPY(3,gl0,gh0,gl1,gh1,fl0,fh0,fl1,fh1,C0,12); \
    KRD(GL,2); GAPY(4,fl0,fh0,fl1,fh1,gl0,gh0,gl1,gh1,C1,0); \
    KRD(GL,3); GAPY(5,gl0,gh0,gl1,gh1,fl0,fh0,fl1,fh1,C1,4); \
    GAPY(6,fl0,fh0,fl1,fh1,gl0,gh0,gl1,gh1,C1,8); \
    GAPY(7,gl0,gh0,gl1,gh1,fl0,fh0,fl1,fh1,C1,12); \
    }while(0)
  int t=1;
  #undef CMASK
  #define CMASK(P0,P1,t) do{}while(0)
  for(;t+7<NT;t+=2){
    STEP(pB0,pB1,pA0,pA1,t,true,true,true);     WAIT_BAR(3); RESC(t); ROT();
    STEP(pA0,pA1,pB0,pB1,t+1,true,true,true);   WAIT_BAR(3); RESC(t+1); ROT();
  }
  #undef CMASK
  #define CMASK(P0,P1,t) do{int jb_=(t)-(NTr-2); if(jb_>=-2)cmask(P0,P1,jb_,qrel,hi,tabd);}while(0)
  for(;t+1<NT;t+=2){
    STEP(pB0,pB1,pA0,pA1,t,(t+3<NT),(t+1<NT),(t+1<NT));       ENDW(t);   RESC(t); ROT();
    STEP(pA0,pA1,pB0,pB1,t+1,(t+4<NT),(t+2<NT),(t+2<NT));     ENDW(t+1); RESC(t+1); ROT();
  }
  STEP(pB0,pB1,pA0,pA1,NT-1,false,false,false); RESC(NT-1);
  { float sacc=pB0[0]+pB0[1]; _Pragma("unroll") for(int r=2;r<16;++r)sacc+=pB0[r]; _Pragma("unroll") for(int r=0;r<16;++r)sacc+=pB1[r]; l_reg+=sacc;
    pw0=(u32x4){PKW(pB0,0),PKW(pB0,2),PKW(pB0,4),PKW(pB0,6)};pw1=(u32x4){PKW(pB0,8),PKW(pB0,10),PKW(pB0,12),PKW(pB0,14)};pw2=(u32x4){PKW(pB1,0),PKW(pB1,2),PKW(pB1,4),PKW(pB1,6)};pw3=(u32x4){PKW(pB1,8),PKW(pB1,10),PKW(pB1,12),PKW(pB1,14)};
    SBAR(); pv(o,vb0+2*sl_cur,PAF(0),PAF(1),PAF(2),PAF(3)); pv(o+2,vb0+2*sl_cur+SLOTB,PAF(0),PAF(1),PAF(2),PAF(3)); }
  #undef PKW
  #undef PAF
  #undef PIN
  #undef MX3
  #undef GAPA
  #undef GAPY
  #undef VF
  #undef VFRG
  #undef PAFK
  #undef EX
  #undef KRD
  #undef STEP
  {auto rr=__builtin_amdgcn_permlane32_swap(__float_as_uint(l_reg),__float_as_uint(l_reg),false,false);l_reg=__uint_as_float(rr[0])+__uint_as_float(rr[1]);}
  if(hi==0)wsf[32+r32]=l_reg;asm volatile("s_waitcnt lgkmcnt(0)":::"memory");
  float rli[16];
  #pragma unroll
  for(int r=0;r<16;++r)rli[r]=__builtin_amdgcn_rcpf(wsf[32+crow(r,hi)]);
  WAIT_BAR(0);
  bf16*Ow=O+(rowbase+q0+wid*QBLK)*DM+(h*2)*D;
  { bf16*stg=(bf16*)(shm+L4_K)+wid*4096;
    #pragma unroll
    for(int r=0;r<16;++r){const int orow=crow(r,hi);
      #pragma unroll
      for(int d0=0;d0<4;++d0)stg[orow*128+d0*32+r32]=__float2bfloat16(o[d0][r]*rli[r]);}
    asm volatile("s_waitcnt lgkmcnt(0)":::"memory");
    int le=lane; asm volatile("":"+v"(le));
    if(c==0){
    #pragma unroll
    for(int i=0;i<8;++i){const int row=i*4+(le>>4),ch=le&15; const u32x4 v=*(const u32x4*)(stg+row*128+ch*8); ATTN_STORE16(Ow+(long)row*DM+ch*8,v);}
    } else {
    asm volatile("s_waitcnt vmcnt(0)":::"memory");
    bf16*OCw=OC+(rowbase+q0+wid*QBLK)*DM+(h*2)*D; const int ch=le&15;
    const float4 g0=*(const float4*)(subg+ch*8), g1=*(const float4*)(subg+ch*8+4);
    #pragma unroll
    for(int i=0;i<8;++i){const int row=i*4+(le>>4); const u32x4 v1=*(const u32x4*)(stg+row*128+ch*8); const u32x4 v0=*(const u32x4*)(Ow+(long)row*DM+ch*8);
      float x[8];
      #define BLO(u_) __builtin_bit_cast(float,(u_)<<16)
      #define BHI(u_) __builtin_bit_cast(float,(u_)&0xffff0000u)
      x[0]=BLO(v0[0])-lam*BLO(v1[0]); x[1]=BHI(v0[0])-lam*BHI(v1[0]); x[2]=BLO(v0[1])-lam*BLO(v1[1]); x[3]=BHI(v0[1])-lam*BHI(v1[1]);
      x[4]=BLO(v0[2])-lam*BLO(v1[2]); x[5]=BHI(v0[2])-lam*BHI(v1[2]); x[6]=BLO(v0[3])-lam*BLO(v1[3]); x[7]=BHI(v0[3])-lam*BHI(v1[3]);
      #undef BLO
      #undef BHI
      float ss=(x[0]*x[0]+x[1]*x[1])+(x[2]*x[2]+x[3]*x[3])+(x[4]*x[4]+x[5]*x[5])+(x[6]*x[6]+x[7]*x[7]);
      ss+=__shfl_xor(ss,1); ss+=__shfl_xor(ss,2); ss+=__shfl_xor(ss,4); ss+=__shfl_xor(ss,8);
      const float rn=(1.0f/sqrtf(ss*(1.0f/128.0f)+1e-5f))*0.8f;
      u32x4 w; w[0]=cvtpk_s(x[0]*rn*g0.x,x[1]*rn*g0.y); w[1]=cvtpk_s(x[2]*rn*g0.z,x[3]*rn*g0.w); w[2]=cvtpk_s(x[4]*rn*g1.x,x[5]*rn*g1.y); w[3]=cvtpk_s(x[6]*rn*g1.z,x[7]*rn*g1.w);
      ATTN_STORE16(OCw+(long)row*DM+ch*8,w);}
    } }
  asm volatile("s_waitcnt lgkmcnt(0)\n\ts_barrier":::"memory");
  #undef ENDW
  #undef DMA_K
  #undef DMA_V
  #undef CMASK
  #undef START
  #undef RESC
  #undef ROT
}
constexpr int ATTN4_LDS_BYTES=L4_BYTES;
template<int THRL=8> __device__ __forceinline__ void attn_phase4(char*lds,const AttnTensors&T,int grid,int block){
  const int vcu=(grid%8==0)?(block%8)*(grid/8)+block/8:block;
  lds_cfptr tab=(lds_cfptr)((__attribute__((address_space(3))) const char*)lds+L4_TAB);
  { __attribute__((address_space(3))) float* tw=(__attribute__((address_space(3))) float*)((__attribute__((address_space(3))) char*)lds+L4_TAB);
    for(int i=threadIdx.x;i<8*128;i+=512){const int h=i>>7; tw[i]=T.TB[i]-T.TB[h*128+127];}
    asm volatile("s_waitcnt vmcnt(0) lgkmcnt(0)\n\ts_barrier":::"memory"); }
  for(int bh=vcu>>3;bh<BATCH*8;bh+=grid>>3){ const int b=bh>>3,h=bh&7,s=vcu&7; const float b31s=T.TB[h*128+127];
    for(int i=0;i<4;++i){ const int qb=(i==0)?s:(i==1)?15-s:(i==2)?16+s:31-s;
      for(int c=0;c<2;++c)
        attn_unit4<THRL>(b,h,c,qb,T.Q,T.K,T.V,T.O0,T.O1,T.subg,T.lam,lds,b31s,tab+h*128); } }
}
#undef SBAR
#undef WAIT_BAR
}

constexpr int RING_BYTES = 135168;
constexpr int LDSCTL_OFF = RING_BYTES, MISC_OFF = LDSCTL_OFF + 320;
constexpr int LDS_BYTES = 147456;

struct Args { const float* in[28]; float* out; unsigned char* ws; int ph_lo, ph_hi; };

template <class XT> __device__ __forceinline__ f32x4 ld_row4(const XT* X, int m, int lane, int j) {
    if constexpr (sizeof(XT) == 4) return ((const f32x4*)((const float*)X + (size_t)m * DM))[lane + 64 * j];
    else { const unsigned long long w = ((const unsigned long long*)((const bf16*)X + (size_t)m * DM))[lane + 64 * j]; const unsigned lo = (unsigned)w, hi = (unsigned)(w >> 32);
        return (f32x4){bflo(lo), bfhi(lo), bflo(hi), bfhi(hi)}; }
}
template <class XT> __device__ __forceinline__ void rms_rows_bf16(const XT* X, const float* g, bf16* H, int bid, int nb) {
    const int tid_ = fresh_tid(); const int lane = tid_ & 63, wave = tid_ >> 6;
    f32x4 gv[4];
#pragma unroll
    for (int j = 0; j < 4; ++j) gv[j] = *(const f32x4*)(g + 4 * lane + 256 * j);
    for (int m = bid * NWAVES + wave; m < NT; m += nb * NWAVES) {
        f32x4 v[4]; float s = 0.f;
#pragma unroll
        for (int j = 0; j < 4; ++j) { v[j] = ld_row4(X, m, lane, j); s += (v[j].x * v[j].x + v[j].y * v[j].y) + (v[j].z * v[j].z + v[j].w * v[j].w); }
        const float r = 1.f / sqrtf(wave_sum(s) * (1.f / DM) + NORM_EPS);
        unsigned long long* o8 = (unsigned long long*)(H + (size_t)m * DM) + lane;
#pragma unroll
        for (int j = 0; j < 4; ++j) { const f32x4 y = v[j] * r * gv[j]; o8[64 * j] = (unsigned long long)pk2(y.x, y.y) | ((unsigned long long)pk2(y.z, y.w) << 32); }
    }
}
template <class XT> __device__ __forceinline__ void rms_rows_final(const XT* X, const float* g, float* OUT, int bid, int nb) {
    const int tid_ = fresh_tid(); const int lane = tid_ & 63, wave = tid_ >> 6;
    f32x4 gv[4];
#pragma unroll
    for (int j = 0; j < 4; ++j) gv[j] = *(const f32x4*)(g + 4 * lane + 256 * j);
    for (int m = bid * NWAVES + wave; m < NT; m += nb * NWAVES) {
        f32x4* orow = (f32x4*)(OUT + (size_t)m * DM) + lane;
        f32x4 v[4]; float s = 0.f;
#pragma unroll
        for (int j = 0; j < 4; ++j) { v[j] = ld_row4(X, m, lane, j); s += (v[j].x * v[j].x + v[j].y * v[j].y) + (v[j].z * v[j].z + v[j].w * v[j].w); }
        const float r = 1.f / sqrtf(wave_sum(s) * (1.f / DM) + NORM_EPS);
#pragma unroll
        for (int j = 0; j < 4; ++j) orow[64 * j] = v[j] * r * gv[j];
    }
}

template <int NB, class P>
__device__ __forceinline__ void ref_gemm(const P& p, LAS float* sm, int bid, int nb) {
    constexpr int LDP = 132;
    LAS float* As = sm; LAS float* Bs = sm + 16 * LDP;
    const int tid = fresh_tid(), ty = tid >> 4, tx = tid & 15;
    const int nt = p.ntiles();
    for (int it = bid; it < nt; it += nb) {
        int m0, n0; const float* W[2]; p.tile(it, m0, n0, W[0], W[1]);
        float acc[NB][4][8];
#pragma unroll
        for (int b = 0; b < NB; ++b)
#pragma unroll
            for (int i = 0; i < 4; ++i)
#pragma unroll
                for (int j = 0; j < 8; ++j) acc[b][i][j] = 0.f;
        const bf16* ap = p.arow(m0 + (tid >> 2)) + (tid & 3) * 4;
        for (int k0 = 0; k0 < p.K; k0 += 16) {
            { const v2u v = *(const v2u*)(ap + k0); const int r = tid >> 2, kq = (tid & 3) * 4;
              As[(kq + 0) * LDP + r] = bflo(v.x); As[(kq + 1) * LDP + r] = bfhi(v.x); As[(kq + 2) * LDP + r] = bflo(v.y); As[(kq + 3) * LDP + r] = bfhi(v.y); }
#pragma unroll
            for (int b = 0; b < NB; ++b) { const int k = tid >> 5, n4 = (tid & 31) * 4;
                const f32x4 v = *(const f32x4*)(W[b] + (size_t)(k0 + k) * p.ldw + n0 + n4);
                *(LAS f32x4*)(Bs + (b * 16 + k) * LDP + n4) = v; }
            __syncthreads();
#pragma unroll 2
            for (int kk = 0; kk < 16; ++kk) {
                const f32x4 a = *(const LAS f32x4*)(As + kk * LDP + ty * 4);
#pragma unroll
                for (int b = 0; b < NB; ++b) {
                    const f32x4 b0 = *(const LAS f32x4*)(Bs + (b * 16 + kk) * LDP + tx * 8), b1 = *(const LAS f32x4*)(Bs + (b * 16 + kk) * LDP + tx * 8 + 4);
#pragma unroll
                    for (int i = 0; i < 4; ++i) {
                        acc[b][i][0] += a[i] * b0.x; acc[b][i][1] += a[i] * b0.y; acc[b][i][2] += a[i] * b0.z; acc[b][i][3] += a[i] * b0.w;
                        acc[b][i][4] += a[i] * b1.x; acc[b][i][5] += a[i] * b1.y; acc[b][i][6] += a[i] * b1.z; acc[b][i][7] += a[i] * b1.w; }
                }
            }
            __syncthreads();
        }
#pragma unroll
        for (int i = 0; i < 4; ++i) {
            float a[NB][8];
#pragma unroll
            for (int b = 0; b < NB; ++b)
#pragma unroll
                for (int j = 0; j < 8; ++j) a[b][j] = acc[b][i][j];
            p.epi(m0 + ty * 4 + i, n0 + tx * 8, a);
        }
    }
}
__device__ __forceinline__ void st_bf16x8(bf16* p, const float* v) { v4u w; w.x = pk2(v[0], v[1]); w.y = pk2(v[2], v[3]); w.z = pk2(v[4], v[5]); w.w = pk2(v[6], v[7]); *(v4u*)p = w; }
__device__ __forceinline__ float silu_(float x) { return x / (1.f + __expf(-x)); }
__device__ __forceinline__ float gelu_tanh_(float x) { const float u = 0.7978845608028654f * (x + 0.044715f * x * x * x); return 0.5f * x * (1.f + tanhf(u)); }

struct PQkv {
    int K, ldw; const bf16* H; const float* W; bf16 *Q, *Kb, *V;
    __device__ int ntiles() const { return (NT / 128) * (3 * DM / 128); }
    __device__ void tile(int i, int& m0, int& n0, const float*& W0, const float*& W1) const { m0 = (i / 24) * 128; n0 = (i % 24) * 128; W0 = W; W1 = W; }
    __device__ const bf16* arow(int r) const { return H + (size_t)r * DM; }
    __device__ void epi(int r, int c0, const float (&a)[1][8]) const {
        const int t = c0 >> 10, c = c0 & 1023; float v[8]; const float sc = (t == 0) ? C2 : 1.f;
#pragma unroll
        for (int j = 0; j < 8; ++j) v[j] = a[0][j] * sc;
        st_bf16x8(Q + (size_t)t * (size_t)(32u << 20) + (size_t)r * DM + c, v); }
};
struct PResid {
    int K, ldw; const bf16* A; int lda; const float* W; const float* base; float* out;
    __device__ int ntiles() const { return (NT / 128) * (DM / 128); }
    __device__ void tile(int i, int& m0, int& n0, const float*& W0, const float*& W1) const { m0 = (i / 8) * 128; n0 = (i % 8) * 128; W0 = W; W1 = W; }
    __device__ const bf16* arow(int r) const { return A + (size_t)r * lda; }
    __device__ void epi(int r, int c0, const float (&a)[1][8]) const {
        const f32x4 b0 = *(const f32x4*)(base + (size_t)r * DM + c0), b1 = *(const f32x4*)(base + (size_t)r * DM + c0 + 4);
        *(f32x4*)(out + (size_t)r * DM + c0) = (f32x4){b0.x + a[0][0], b0.y + a[0][1], b0.z + a[0][2], b0.w + a[0][3]};
        *(f32x4*)(out + (size_t)r * DM + c0 + 4) = (f32x4){b1.x + a[0][4], b1.y + a[0][5], b1.z + a[0][6], b1.w + a[0][7]}; }
};
struct PSwiglu {
    int K, ldw; const bf16* H; const float *Wg, *Wu; bf16* ACT;
    __device__ int ntiles() const { return (NT / 128) * (DFF / 128); }
    __device__ void tile(int i, int& m0, int& n0, const float*& W0, const float*& W1) const { m0 = (i / 22) * 128; n0 = (i % 22) * 128; W0 = Wg; W1 = Wu; }
    __device__ const bf16* arow(int r) const { return H + (size_t)r * DM; }
    __device__ void epi(int r, int c0, const float (&a)[2][8]) const { float v[8];
#pragma unroll
        for (int j = 0; j < 8; ++j) v[j] = silu_(a[0][j]) * a[1][j];
        st_bf16x8(ACT + (size_t)r * DFF + c0, v); }
};
struct PWin {
    int K, ldw; const bf16* H; const float* W; bf16 *G, *XB;
    __device__ int ntiles() const { return (NT / 128) * (2 * DRNN / 128); }
    __device__ void tile(int i, int& m0, int& n0, const float*& W0, const float*& W1) const { m0 = (i / 20) * 128; n0 = (i % 20) * 128; W0 = W; W1 = W; }
    __device__ const bf16* arow(int r) const { return H + (size_t)r * DM; }
    __device__ void epi(int r, int c0, const float (&a)[1][8]) const { float v[8];
        if (c0 < DRNN) {
#pragma unroll
            for (int j = 0; j < 8; ++j) v[j] = gelu_tanh_(a[0][j]);
            st_bf16x8(G + (size_t)r * DRNN + c0, v);
        } else {
#pragma unroll
            for (int j = 0; j < 8; ++j) v[j] = a[0][j];
            st_bf16x8(XB + (size_t)r * DRNN + (c0 - DRNN), v); } }
};
struct PMoeGU {
    int K, ldw; const bf16* H; const float *Wg, *Wu; bf16* ACT; const int* tok; const int* base;
    __device__ int ntiles() const { return (base[8] / 128) * (DFE / 128); }
    __device__ void tile(int i, int& m0, int& n0, const float*& W0, const float*& W1) const {
        m0 = (i / 28) * 128; n0 = (i % 28) * 128; int e = 0;
#pragma unroll
        for (int j = 1; j < 8; ++j) e += (m0 >= base[j]) ? 1 : 0;
        W0 = Wg + (size_t)e * DM * DFE; W1 = Wu + (size_t)e * DM * DFE; }
    __device__ const bf16* arow(int r) const { int t = tok[r]; if (t < 0) t = 0; return H + (size_t)t * DM; }
    __device__ void epi(int r, int c0, const float (&a)[2][8]) const { float v[8];
#pragma unroll
        for (int j = 0; j < 8; ++j) v[j] = silu_(a[0][j]) * a[1][j];
        st_bf16x8(ACT + (size_t)r * DFE + c0, v); }
};
struct PMoeDown {
    int K, ldw; const bf16* ACT; const float* Wd; float* out; const int* tok; const float* gatev; const int* base;
    __device__ int ntiles() const { return (base[8] / 128) * (DM / 128); }
    __device__ void tile(int i, int& m0, int& n0, const float*& W0, const float*& W1) const {
        m0 = (i / 8) * 128; n0 = (i % 8) * 128; int e = 0;
#pragma unroll
        for (int j = 1; j < 8; ++j) e += (m0 >= base[j]) ? 1 : 0;
        W0 = Wd + (size_t)e * DFE * DM; W1 = W0; }
    __device__ const bf16* arow(int r) const { return ACT + (size_t)r * DFE; }
    __device__ void epi(int r, int c0, const float (&a)[1][8]) const {
        const int t = tok[r]; if (t < 0) return; const float g = gatev[r];
        float* o = out + (size_t)t * DM + c0; const f32x4 b0 = *(const f32x4*)o, b1 = *(const f32x4*)(o + 4);
        *(f32x4*)o = (f32x4){b0.x + g * a[0][0], b0.y + g * a[0][1], b0.z + g * a[0][2], b0.w + g * a[0][3]};
        *(f32x4*)(o + 4) = (f32x4){b1.x + g * a[0][4], b1.y + g * a[0][5], b1.z + g * a[0][6], b1.w + g * a[0][7]}; }
};

__device__ __forceinline__ int t5_bucket(int n) {
    const float nf = (float)(n < 1 ? 1 : n);
    int large = 16 + (int)(logf(nf / 16.0f) / 2.0794415416798357f * 16.0f);
    large = large < 31 ? large : 31;
    return n < 16 ? n : large;
}
__device__ __forceinline__ void build_tables(const float* rel_bias, float* TB) {
    for (int i = fresh_tid(); i < NH * 128; i += NTHR) { const int h = i >> 7, n = i & 127; TB[i] = rel_bias[t5_bucket(n) * NH + h] * LOG2E; }
}
__device__ __forceinline__ float compute_lam(const float* lq1, const float* lk1, const float* lq2, const float* lk2) {
    const int lane = fresh_tid() & 63;
    const float s1 = wave_sum(lq1[lane] * lk1[lane]), s2 = wave_sum(lq2[lane] * lk2[lane]);
    return expf(s1) - expf(s2) + LAM_INIT;
}

__device__ __forceinline__ void ref_attention(const bf16* Q, const bf16* Kb, const bf16* V, bf16* O0, bf16* O1, const float* TB, LAS float* sm, int bid, int nb) {
    LAS float* Ks = sm; LAS float* Vs = sm + 32 * 128; LAS float* tb = sm + 2 * 32 * 128;
    const int tid = fresh_tid(), qr = tid & 127, cv = tid >> 7, c = cv >> 1, vh = cv & 1;
    const int NU = NB_ * NH * (SEQ / 128);
    for (int u = bid; u < NU; u += nb) {
        const int uu = NU - 1 - u;
        const int qblk = uu / (NB_ * NH), bh = uu % (NB_ * NH), b = bh / NH, h = bh % NH;
        const int q0 = qblk * 128, q = q0 + qr; const size_t rb = (size_t)b * SEQ;
        __syncthreads();
        if (tid < 128) tb[tid] = TB[h * 128 + tid];
        float qv[64];
        { const v4u* qp = (const v4u*)(Q + (rb + q) * DM + h * 128 + c * 64);
#pragma unroll
          for (int i = 0; i < 8; ++i) { const v4u w = qp[i]; qv[8 * i] = bflo(w.x); qv[8 * i + 1] = bfhi(w.x); qv[8 * i + 2] = bflo(w.y); qv[8 * i + 3] = bfhi(w.y); qv[8 * i + 4] = bflo(w.z); qv[8 * i + 5] = bfhi(w.z); qv[8 * i + 6] = bflo(w.w); qv[8 * i + 7] = bfhi(w.w); } }
        float o[64]; float m = -INFINITY, l = 0.f;
#pragma unroll
        for (int d = 0; d < 64; ++d) o[d] = 0.f;
        const int nkt = (q0 + 127) / 32 + 1;
        for (int kt = 0; kt < nkt; ++kt) {
            __syncthreads();
            { const int r = tid >> 4, c8 = (tid & 15) * 8; const size_t g = (rb + kt * 32 + r) * DM + h * 128 + c8;
              const v4u kw = *(const v4u*)(Kb + g), vw = *(const v4u*)(V + g);
              LAS float* kd = Ks + r * 128 + c8; LAS float* vd = Vs + r * 128 + c8;
              kd[0] = bflo(kw.x); kd[1] = bfhi(kw.x); kd[2] = bflo(kw.y); kd[3] = bfhi(kw.y); kd[4] = bflo(kw.z); kd[5] = bfhi(kw.z); kd[6] = bflo(kw.w); kd[7] = bfhi(kw.w);
              vd[0] = bflo(vw.x); vd[1] = bfhi(vw.x); vd[2] = bflo(vw.y); vd[3] = bfhi(vw.y); vd[4] = bflo(vw.z); vd[5] = bfhi(vw.z); vd[6] = bflo(vw.w); vd[7] = bfhi(vw.w); }
            __syncthreads();
            if (kt * 32 <= q) {
#pragma unroll 1
                for (int j = 0; j < 32; ++j) {
                    const int dist = q - (kt * 32 + j);
                    if (dist >= 0) {
                        const LAS float* kr = Ks + j * 128 + c * 64; float a = 0.f;
#pragma unroll
                        for (int d = 0; d < 64; d += 4) { const f32x4 kv = *(const LAS f32x4*)(kr + d); a += qv[d] * kv.x + qv[d + 1] * kv.y + qv[d + 2] * kv.z + qv[d + 3] * kv.w; }
                        a += tb[dist > 127 ? 127 : dist];
                        const float mn = fmaxf(m, a), al = exp2f(m - mn), pj = exp2f(a - mn); m = mn; l = l * al + pj;
                        const LAS float* vr = Vs + j * 128 + vh * 64;
#pragma unroll
                        for (int d = 0; d < 64; d += 4) { const f32x4 vv = *(const LAS f32x4*)(vr + d);
                            o[d] = o[d] * al + pj * vv.x; o[d + 1] = o[d + 1] * al + pj * vv.y; o[d + 2] = o[d + 2] * al + pj * vv.z; o[d + 3] = o[d + 3] * al + pj * vv.w; }
                    }
                }
            }
        }
        const float rl = 1.f / l;
        bf16* op = (c == 0 ? O0 : O1) + (rb + q) * DM + h * 128 + vh * 64;
#pragma unroll
        for (int i = 0; i < 8; ++i) { float v[8];
#pragma unroll
            for (int j = 0; j < 8; ++j) v[j] = o[8 * i + j] * rl;
            st_bf16x8(op + 8 * i, v); }
    }
}
__device__ __forceinline__ void combine_rows(const bf16* O0, const bf16* O1, bf16* OC, const float* subg, float lam, int bid, int nb) {
    const int tid_ = fresh_tid(); const int lane = tid_ & 63, wave = tid_ >> 6;
    const float g0 = subg[2 * lane], g1 = subg[2 * lane + 1];
    for (long it = (long)bid * NWAVES + wave; it < (long)NT * NH; it += (long)nb * NWAVES) {
        const size_t off = (size_t)it * 128 + 2 * lane;
        const unsigned a = *(const unsigned*)(O0 + off), b = *(const unsigned*)(O1 + off);
        const float x0 = bflo(a) - lam * bflo(b), x1 = bfhi(a) - lam * bfhi(b);
        const float r = 1.f / sqrtf(wave_sum(x0 * x0 + x1 * x1) * (1.f / 128.f) + SUBLN_EPS) * (1.f - LAM_INIT);
        *(unsigned*)(OC + off) = pk2(x0 * r * g0, x1 * r * g1);
    }
}

__device__ __forceinline__ void ref_lru_local(const bf16* XB, const float* convw, const float* convb, const float* gaw, const float* gab, const float* gxw, const float* gxb,
                                              const float* lamp, bf16* HL, bf16* CA, float* AEND, float* HEND, LAS float* sm, int bid, int nb) {
    LAS float* xc = sm;
    LAS float* av = sm + 64 * 128;
    LAS float* bv = sm + 2 * 64 * 128;
    const int tid = fresh_tid();
    const int NU = NB_ * NCH * NLB;
    for (int u = bid; u < NU; u += nb) {
        const int n = u % NLB, ch = (u / NLB) % NCH, b = u / (NLB * NCH);
        const int t0 = ch * LCH; const size_t rb = (size_t)b * SEQ;
        __syncthreads();
        for (int i = tid; i < LCH * 128; i += NTHR) { const int t = i >> 7, c = i & 127, cg = n * 128 + c; float a = convb[cg];
#pragma unroll
            for (int j = 0; j < CW; ++j) { const int tt = t0 + t + j - (CW - 1); if (tt >= 0) a += bf2f(XB[(rb + tt) * DRNN + cg]) * convw[j * DRNN + cg]; }
            xc[i] = a; }
        __syncthreads();
        { const int e = tid & 127, tq = tid >> 7, cg = n * 128 + e;
          const float* wa = gaw + (size_t)n * 128 * 128 + e; const float* wx = gxw + (size_t)n * 128 * 128 + e;
          const float ba = gab[cg], bx = gxb[cg]; const float sp = log1pf(expf(-lamp[cg]));
          for (int tb4 = 0; tb4 < 4; ++tb4) {
              float ar[4] = {0.f, 0.f, 0.f, 0.f}, ai[4] = {0.f, 0.f, 0.f, 0.f};
              const int tbase = tq * 16 + tb4 * 4;
              for (int d = 0; d < 128; ++d) { const float w1 = wa[d * 128], w2 = wx[d * 128];
#pragma unroll
                  for (int k = 0; k < 4; ++k) { const float xv = xc[(tbase + k) * 128 + d]; ar[k] += xv * w1; ai[k] += xv * w2; } }
#pragma unroll
              for (int k = 0; k < 4; ++k) { const int t = tbase + k; const float r = sigmoidf_(ar[k] + ba), ig = sigmoidf_(ai[k] + bx);
                  const float la = -8.0f * r * sp, a = expf(la), mult = sqrtf(-expm1f(2.0f * la));
                  av[t * 128 + e] = a; bv[t * 128 + e] = mult * (ig * xc[t * 128 + e]); }
          } }
        __syncthreads();
        if (tid < 128) { const int cg = n * 128 + tid; float hh = 0.f, cp = 1.f;
            for (int t = 0; t < LCH; ++t) { const float a = av[t * 128 + tid]; hh = a * hh + bv[t * 128 + tid]; cp *= a;
                HL[(rb + t0 + t) * DRNN + cg] = (bf16)f2bf(hh); CA[(rb + t0 + t) * DRNN + cg] = (bf16)f2bf(cp); }
            AEND[((size_t)b * NCH + ch) * DRNN + cg] = cp; HEND[((size_t)b * NCH + ch) * DRNN + cg] = hh; }
    }
}
__device__ __forceinline__ void lru_carry(const float* AEND, const float* HEND, float* CIN, int bid, int nb) {
    for (int i = bid * NTHR + fresh_tid(); i < NB_ * DRNN; i += nb * NTHR) { const int b = i / DRNN, c = i % DRNN; float cin = 0.f;
        for (int ch = 0; ch < NCH; ++ch) { const size_t o = ((size_t)b * NCH + ch) * DRNN + c; CIN[o] = cin; cin = AEND[o] * cin + HEND[o]; } }
}
__device__ __forceinline__ void lru_fixup(const bf16* HL, const bf16* CA, const bf16* G, const float* CIN, bf16* Y, int bid, int nb) {
    const size_t total = (size_t)NT * DRNN / 2;
    for (size_t i = (size_t)bid * NTHR + fresh_tid(); i < total; i += (size_t)nb * NTHR) {
        const size_t el = 2 * i; const int row = (int)(el / DRNN), c = (int)(el % DRNN); const int b = row / SEQ, ch = (row % SEQ) / LCH;
        const unsigned hl = *(const unsigned*)(HL + el), ca = *(const unsigned*)(CA + el), g = *(const unsigned*)(G + el);
        const float* ci = CIN + ((size_t)b * NCH + ch) * DRNN + c;
        const float h0 = bflo(hl) + bflo(ca) * ci[0], h1 = bfhi(hl) + bfhi(ca) * ci[1];
        *(unsigned*)(Y + el) = pk2(h0 * bflo(g), h1 * bfhi(g));
    }
}

__device__ __forceinline__ float wave_max(float v) {
#pragma unroll
    for (int o = 1; o < 64; o <<= 1) v = fmaxf(v, __shfl_xor(v, o));
    return v;
}
__device__ __forceinline__ unsigned pack_i8x4(float a, float b, float c, float d) {
    const int ia = (int)rintf(a), ib = (int)rintf(b), ic = (int)rintf(c), id = (int)rintf(d);
    return (unsigned)(ia & 0xff) | ((unsigned)(ib & 0xff) << 8) | ((unsigned)(ic & 0xff) << 16) | ((unsigned)(id & 0xff) << 24);
}
constexpr int RT = 128, NRT = NT / RT;
template <class XT> __device__ __forceinline__ void moe_route(const XT* X, const float* g, const float* router, bf16* H, signed char* HQ, float* SA, int* RE, float* RG, int* RR, int* CNT, LAS float* sm, int bid, int nb) {
    LAS int* e_s = (LAS int*)sm;
    const int tid = fresh_tid(), lane = tid & 63, wave = tid >> 6;
    f32x4 gv[4];
#pragma unroll
    for (int j = 0; j < 4; ++j) gv[j] = *(const f32x4*)(g + 4 * lane + 256 * j);
    const int b0 = lane & 1, b1 = (lane >> 1) & 1, b2 = (lane >> 2) & 1;
    f32x4 rw[4][4][2];
#pragma unroll
    for (int j = 0; j < 4; ++j)
#pragma unroll
        for (int q = 0; q < 4; ++q) { const float* rp = router + (size_t)(4 * lane + 256 * j + q) * NE; rw[j][q][0] = *(const f32x4*)rp; rw[j][q][1] = *(const f32x4*)(rp + 4); }
    for (int tile = bid; tile < NRT; tile += nb) {
        __syncthreads();
#pragma unroll 2
        for (int rr = 0; rr < RT / NWAVES; ++rr) {
            const int lr = wave * (RT / NWAVES) + rr, m = tile * RT + lr;
            f32x4 v[4]; float s = 0.f;
#pragma unroll
            for (int j = 0; j < 4; ++j) { v[j] = ld_row4(X, m, lane, j); s += (v[j].x * v[j].x + v[j].y * v[j].y) + (v[j].z * v[j].z + v[j].w * v[j].w); }
            const float r = 1.f / sqrtf(wave_sum(s) * (1.f / DM) + NORM_EPS);
            unsigned long long* o8 = (unsigned long long*)(H + (size_t)m * DM) + lane;
            float lg[NE];
#pragma unroll
            for (int e = 0; e < NE; ++e) lg[e] = 0.f;
            if (HQ) { float am = 0.f;
#pragma unroll
                for (int j = 0; j < 4; ++j) { const f32x4 y = v[j] * r * gv[j]; am = fmaxf(am, fmaxf(fmaxf(fabsf(y.x), fabsf(y.y)), fmaxf(fabsf(y.z), fabsf(y.w)))); }
                am = wave_max(am); const float inv = am > 0.f ? 127.f / am : 0.f; unsigned* o4 = (unsigned*)(HQ + (size_t)m * DM) + lane;
#pragma unroll
                for (int j = 0; j < 4; ++j) { const f32x4 y = v[j] * r * gv[j]; o4[64 * j] = pack_i8x4(y.x * inv, y.y * inv, y.z * inv, y.w * inv); }
                if (lane == 0) SA[m] = am * (1.f / 127.f); }
#pragma unroll
            for (int j = 0; j < 4; ++j) { const f32x4 y = v[j] * r * gv[j]; if (!HQ) o8[64 * j] = (unsigned long long)pk2(y.x, y.y) | ((unsigned long long)pk2(y.z, y.w) << 32);
#pragma unroll
                for (int q = 0; q < 4; ++q) { const f32x4 r0 = rw[j][q][0], r1 = rw[j][q][1]; const float yy = y[q];
                    lg[0] += yy * r0.x; lg[1] += yy * r0.y; lg[2] += yy * r0.z; lg[3] += yy * r0.w; lg[4] += yy * r1.x; lg[5] += yy * r1.y; lg[6] += yy * r1.z; lg[7] += yy * r1.w; } }
            float k4[4], k2[2], k1;
#pragma unroll
            for (int i = 0; i < 4; ++i) { const float snd = b0 ? lg[i] : lg[4 + i]; const float rcv = __shfl_xor(snd, 1); k4[i] = (b0 ? lg[4 + i] : lg[i]) + rcv; }
#pragma unroll
            for (int i = 0; i < 2; ++i) { const float snd = b1 ? k4[i] : k4[2 + i]; const float rcv = __shfl_xor(snd, 2); k2[i] = (b1 ? k4[2 + i] : k4[i]) + rcv; }
            { const float snd = b2 ? k2[0] : k2[1]; const float rcv = __shfl_xor(snd, 4); k1 = (b2 ? k2[1] : k2[0]) + rcv; }
            k1 += __shfl_xor(k1, 8); k1 += __shfl_xor(k1, 16); k1 += __shfl_xor(k1, 32);
            float lt[NE];
#pragma unroll
            for (int e = 0; e < NE; ++e) { const int src = ((e >> 2) & 1) | (((e >> 1) & 1) << 1) | ((e & 1) << 2); lt[e] = __builtin_bit_cast(float, __builtin_amdgcn_readlane(__builtin_bit_cast(int, k1), src)); }
            int i0 = 0; float v0 = lt[0];
#pragma unroll
            for (int e = 1; e < NE; ++e) if (lt[e] > v0) { v0 = lt[e]; i0 = e; }
            int i1 = -1; float v1 = -INFINITY;
#pragma unroll
            for (int e = 0; e < NE; ++e) if (e != i0 && lt[e] > v1) { v1 = lt[e]; i1 = e; }
            const float g1 = 1.f / (1.f + expf(v0 - v1)), g0 = 1.f - g1;
            if (lane == 0) { e_s[lr] = i0; e_s[RT + lr] = i1; RE[m] = i0; RE[NT + m] = i1; RG[m] = g0; RG[NT + m] = g1; }
        }
        __syncthreads();
        if (tid < 2 * RT) { const int s = tid / RT, i = tid % RT; const int me = e_s[s * RT + i]; int rk = 0;
          for (int j = 0; j < i; ++j) rk += (e_s[s * RT + j] == me) ? 1 : 0;
          RR[s * NT + tile * RT + i] = rk; }
        if (tid >= 2 * RT && tid < 2 * RT + 16) { const int k = tid - 2 * RT, s = k >> 3, e = k & 7; int c = 0; for (int j = 0; j < RT; ++j) c += (e_s[s * RT + j] == e) ? 1 : 0; CNT[tile * 16 + k] = c; }
    }
}
__device__ __forceinline__ int tok16_index(int p) { const int rr = p & 127; return (p & ~127) + 2 * (rr & 63) + (rr >> 6); }
__device__ __forceinline__ void moe_scatter(const int* RE, const float* RG, const int* RR, const int* CNT, int* BASE, int* TOK, float* GATEV, const float* SA, float* SAS, bf16* TOK16, LAS float* sm, int bid, int nb) {
    LAS int* tbase = (LAS int*)sm;
    LAS int* segt = tbase + NRT * 16;
    LAS int* gbase = segt + 256;
    LAS int* tot = gbase + 32;
    const int tid = fresh_tid();
    __syncthreads();
    for (int i = tid; i < NRT * 16; i += NTHR) tbase[i] = CNT[i];
    __syncthreads();
    if (tid < 256) { const int k = tid & 15, seg = tid >> 4; int run = 0;
        for (int t = 0; t < 16; ++t) { const int idx = (seg * 16 + t) * 16 + k; const int c = tbase[idx]; tbase[idx] = run; run += c; }
        segt[seg * 16 + k] = run; }
    __syncthreads();
    if (tid < 16) { int run = 0; for (int sg = 0; sg < 16; ++sg) { const int c = segt[sg * 16 + tid]; segt[sg * 16 + tid] = run; run += c; } tot[tid] = run; }
    __syncthreads();
    if (tid < 2) { int run = 0; for (int e = 0; e < NE; ++e) { gbase[tid * 9 + e] = run; run += (tot[tid * 8 + e] + 255) & ~255; } gbase[tid * 9 + 8] = run; }
    __syncthreads();
    if (bid == 0 && tid < 18) BASE[tid] = gbase[tid];
    for (int i = bid * NTHR + tid; i < 2 * NT; i += nb * NTHR) { const int s = i / NT, m = i % NT; const int e = RE[i]; const int tl = m / RT;
        const int pos = gbase[s * 9 + e] + segt[(tl >> 4) * 16 + s * 8 + e] + tbase[tl * 16 + s * 8 + e] + RR[i];
        TOK[s * SLOT_ROWS + pos] = m; GATEV[s * SLOT_ROWS + pos] = RG[i]; SAS[s * SLOT_ROWS + pos] = SA[m]; TOK16[s * SLOT_ROWS + tok16_index(pos)] = (bf16)m; }
    for (int gi = bid; gi < 16; gi += nb) { const int s = gi >> 3, e = gi & 7; const int lo = gbase[s * 9 + e] + tot[gi], hi = gbase[s * 9 + e + 1];
        for (int p = lo + tid; p < hi; p += NTHR) { TOK[s * SLOT_ROWS + p] = -1; GATEV[s * SLOT_ROWS + p] = 0.f; SAS[s * SLOT_ROWS + p] = 0.f; TOK16[s * SLOT_ROWS + tok16_index(p)] = 0; } }
}

template <class XT> __device__ __forceinline__ void rms_rows_q(const XT* X, const float* g, signed char* HQ, float* SA, int bid, int nb) {
    const int tid_ = fresh_tid(); const int lane = tid_ & 63, wave = tid_ >> 6;
    f32x4 gv[4];
#pragma unroll
    for (int j = 0; j < 4; ++j) gv[j] = *(const f32x4*)(g + 4 * lane + 256 * j);
    for (int m = bid * NWAVES + wave; m < NT; m += nb * NWAVES) {
        f32x4 v[4]; float s = 0.f;
#pragma unroll
        for (int j = 0; j < 4; ++j) { v[j] = ld_row4(X, m, lane, j); s += (v[j].x * v[j].x + v[j].y * v[j].y) + (v[j].z * v[j].z + v[j].w * v[j].w); }
        const float r = 1.f / sqrtf(wave_sum(s) * (1.f / DM) + NORM_EPS);
        float am = 0.f;
#pragma unroll
        for (int j = 0; j < 4; ++j) { v[j] = v[j] * r * gv[j]; am = fmaxf(am, fmaxf(fmaxf(fabsf(v[j].x), fabsf(v[j].y)), fmaxf(fabsf(v[j].z), fabsf(v[j].w)))); }
        am = wave_max(am); const float inv = am > 0.f ? 127.f / am : 0.f;
        unsigned* o4 = (unsigned*)(HQ + (size_t)m * DM) + lane;
#pragma unroll
        for (int j = 0; j < 4; ++j) o4[64 * j] = pack_i8x4(v[j].x * inv, v[j].y * inv, v[j].z * inv, v[j].w * inv);
        if (lane == 0) SA[m] = am * (1.f / 127.f);
    }
}
__device__ __forceinline__ void quant_item_wg(const float* W, int N, signed char* WQ, float* SB, int n0, int drow0, LAS unsigned char* L, int tid) {
    const int lane = tid & 63, wave = __builtin_amdgcn_readfirstlane(tid >> 6);
    LAS float* pm = (LAS float*)L;
    LAS unsigned char* tile = L + 2048 + wave * (64 * 144);
    float tv[128]; float am = 0.f;
#pragma unroll
    for (int i = 0; i < 128; ++i) { tv[i] = __builtin_nontemporal_load(W + (size_t)(wave * 128 + i) * N + n0 + lane); am = fmaxf(am, fabsf(tv[i])); }
    pm[wave * 64 + lane] = am;
    __syncthreads();
#pragma unroll
    for (int w = 0; w < 8; ++w) am = fmaxf(am, pm[w * 64 + lane]);
    const float inv = am > 0.f ? 127.f / am : 0.f;
#pragma unroll
    for (int c = 0; c < 8; ++c) { v4u o;
        o.x = pack_i8x4(tv[16 * c + 0] * inv, tv[16 * c + 1] * inv, tv[16 * c + 2] * inv, tv[16 * c + 3] * inv); o.y = pack_i8x4(tv[16 * c + 4] * inv, tv[16 * c + 5] * inv, tv[16 * c + 6] * inv, tv[16 * c + 7] * inv);
        o.z = pack_i8x4(tv[16 * c + 8] * inv, tv[16 * c + 9] * inv, tv[16 * c + 10] * inv, tv[16 * c + 11] * inv); o.w = pack_i8x4(tv[16 * c + 12] * inv, tv[16 * c + 13] * inv, tv[16 * c + 14] * inv, tv[16 * c + 15] * inv);
        *(LAS v4u*)(tile + lane * 144 + 16 * c) = o; }
    asm volatile("s_waitcnt lgkmcnt(0)" ::: "memory");
    { const int c = lane & 7;
#pragma unroll
      for (int j = 0; j < 8; ++j) { const int n = (lane >> 3) + 8 * j; const v4u o = *(const LAS v4u*)(tile + n * 144 + 16 * c);
          *(v4u*)(WQ + (size_t)(drow0 + n) * 1024 + wave * 128 + 16 * c) = o; } }
    if (wave == 0) SB[drow0 + lane] = am * (1.f / 127.f);
    __syncthreads();
}
#define LDS_WAIT() asm volatile("s_waitcnt lgkmcnt(0)" ::: "memory")
__device__ __forceinline__ void transpose_item(const float* W, int N, bf16* WT, int K, int k0, int n0, int drow0, LAS float* scr, int lane) {
    float tv[32];
#pragma unroll
    for (int i = 0; i < 32; ++i) { const int kk = 2 * i + (lane >> 5); tv[i] = W[(size_t)(k0 + kk) * N + n0 + (lane & 31)]; }
#pragma unroll
    for (int i = 0; i < 32; ++i) { const int kk = 2 * i + (lane >> 5); scr[kk * 33 + (lane & 31)] = tv[i]; }
    LDS_WAIT(); asm volatile("" ::: "memory");
    const int c = lane & 7;
#pragma unroll
    for (int j = 0; j < 4; ++j) { const int n = (lane >> 3) + 8 * j; const LAS float* sp = scr + (8 * c) * 33 + n;
        v4u o; o.x = pk2(sp[0 * 33], sp[1 * 33]); o.y = pk2(sp[2 * 33], sp[3 * 33]); o.z = pk2(sp[4 * 33], sp[5 * 33]); o.w = pk2(sp[6 * 33], sp[7 * 33]);
        *(v4u*)(WT + (size_t)(drow0 + n) * K + k0 + 8 * c) = o; }
    LDS_WAIT(); asm volatile("" ::: "memory");
}
__device__ __forceinline__ void convert_matrix(const float* W, int K, int N, bf16* WT, int mode, LAS float* scr, int gw, int ngw, int lane) {
    const int nblk = N / 32, nitems = (K / 64) * nblk;
    for (int it = gw; it < nitems; it += ngw) { const int kb = it / nblk, nbk = it % nblk, n0 = 32 * nbk;
        const int drow0 = mode == 0 ? n0 : ((n0 >> 7) * 256 + (mode == 2 ? 128 : 0) + (n0 & 127));
        transpose_item(W, N, WT, K, 64 * kb, n0, drow0, scr, lane); }
}
constexpr size_t WA_QKV = 0, WA_O = 6 * MiB, WA_GU = 8 * MiB, WA_D = 19 * MiB, WA_IN = 19 * MiB + 5632 * 1024, WA_OUT = WA_IN + 5 * MiB, WA_GATES = WA_OUT + 2560 * 1024;
static_assert(8 * 64 * 65 * 4 <= RING_BYTES, "conversion tiles fit the ring");
static_assert(WA_GATES + 2 * NLB * 128 * 128 * 2 <= 33 * MiB, "weights map");
__device__ __forceinline__ void convert_weights_a(const __attribute__((address_space(4))) Args* args, unsigned char* ws, LAS unsigned char* L, int bid, int nb) {
    const int tid = fresh_tid(), lane = tid & 63, wave = tid >> 6; LAS float* scr = (LAS float*)(L + wave * 16384);
    const int gw = bid * NWAVES + wave, ngw = nb * NWAVES; unsigned char* wa = ws + WS_WA;
    { float* SB = (float*)(ws + WS_SMALL + SM_SB); __syncthreads();
      constexpr int NQ = I8_QKV ? 3 * DM / 64 : 0, NF = I8_FFN ? DFF / 64 : 0, NW = I8_WIN ? 2 * DRNN / 64 : 0;
      for (int it = bid; it < NQ + 2 * NF + NW; it += nb) {
          if (it < NQ) quant_item_wg(args->in[5], 3 * DM, (signed char*)(wa + WA_QKV), SB + SB_QKV, 64 * it, 64 * it, L, tid);
          else if (it >= NQ + 2 * NF) { const int n0 = 64 * (it - NQ - 2 * NF); quant_item_wg(args->in[12], 2 * DRNN, (signed char*)(wa + WA_IN), SB + SB_IN, n0, n0, L, tid); }
          else { const int j = it - NQ, up = j >= NF ? 1 : 0, n0 = 64 * (j - up * NF);
              quant_item_wg(args->in[21 + up], DFF, (signed char*)(wa + WA_GU), SB + SB_GU, n0, (n0 >> 7) * 256 + up * 128 + (n0 & 127), L, tid); } }
      __syncthreads(); }
#if !I8_QKV
    convert_matrix(args->in[5], DM, 3 * DM, (bf16*)(wa + WA_QKV), 0, scr, gw, ngw, lane);
#endif
    convert_matrix(args->in[6], DM, DM, (bf16*)(wa + WA_O), 0, scr, gw, ngw, lane);
#if !I8_FFN
    convert_matrix(args->in[21], DM, DFF, (bf16*)(wa + WA_GU), 1, scr, gw, ngw, lane);
    convert_matrix(args->in[22], DM, DFF, (bf16*)(wa + WA_GU), 2, scr, gw, ngw, lane);
#endif
    convert_matrix(args->in[23], DFF, DM, (bf16*)(wa + WA_D), 0, scr, gw, ngw, lane);
#if !I8_WIN
    convert_matrix(args->in[12], DM, 2 * DRNN, (bf16*)(wa + WA_IN), 0, scr, gw, ngw, lane);
#endif
    convert_matrix(args->in[20], DRNN, DM, (bf16*)(wa + WA_OUT), 0, scr, gw, ngw, lane);
}
constexpr size_t WM_GU = 0, WM_D = 56 * MiB;
static_assert(I8_MOE && I8_FFN && I8_WIN && ATTN_PC == 3 && FAST_LRU && WS_WM + WM_D + (size_t)NE * DM * DFE * 2 <= WS_XS, "this d_ws map holds the int8 gate|up copies (56 MiB) + bf16 down copies (56 MiB)");
__device__ __forceinline__ void convert_weights_moe(const __attribute__((address_space(4))) Args* args, unsigned char* ws, LAS unsigned char* L, int bid, int nb) {
    const int tid = fresh_tid(), lane = tid & 63, wave = tid >> 6; LAS float* scr = (LAS float*)(L + wave * 16384);
    const int gw = bid * NWAVES + wave, ngw = nb * NWAVES; unsigned char* wm = ws + WS_WM;
    for (int e = 0; e < NE; ++e) {
        convert_matrix(args->in[25] + (size_t)e * DM * DFE, DM, DFE, (bf16*)(wm + WM_GU) + (size_t)e * 2 * DFE * DM, 1, scr, gw, ngw, lane);
        convert_matrix(args->in[26] + (size_t)e * DM * DFE, DM, DFE, (bf16*)(wm + WM_GU) + (size_t)e * 2 * DFE * DM, 2, scr, gw, ngw, lane);
        convert_matrix(args->in[27] + (size_t)e * DFE * DM, DFE, DM, (bf16*)(wm + WM_D) + (size_t)e * DM * DFE, 0, scr, gw, ngw, lane);
    }
}
namespace lru {
typedef short bf16x8 __attribute__((ext_vector_type(8)));
typedef float f32x16 __attribute__((ext_vector_type(16)));
__device__ __forceinline__ unsigned cvtpk(float lo, float hi) { unsigned r; asm volatile("v_cvt_pk_bf16_f32 %0, %1, %2" : "=v"(r) : "v"(lo), "v"(hi)); return r; }
__device__ __forceinline__ float sigm(float x) { return __builtin_amdgcn_rcpf(1.0f + __builtin_amdgcn_exp2f(-1.4426950408889634f * x)); }
constexpr int NITEMS = NB_ * NLB * 4, CHUNK = 256, NCHK = SEQ / CHUNK;
__device__ __forceinline__ void conv_pass(const bf16* XB, bf16* XC, const float* convw, const float* convb, LAS unsigned char* L, int bid, int nb) {
    const int tid = fresh_tid(); LAS float* cw = (LAS float*)L;
    __syncthreads();
    for (int i = tid; i < 5 * DRNN; i += NTHR) cw[i] = (i < 4 * DRNN) ? convw[i] : convb[i - 4 * DRNN];
    __syncthreads();
    constexpr int NG = DRNN / 8; const long total = (long)NT * NG;
    for (long it = (long)bid * NTHR + tid; it < total; it += (long)nb * NTHR) {
        const int row = (int)(it / NG), c0 = (int)(it % NG) * 8, t = row % SEQ;
        float acc[8];
        { const f32x4 b0 = *(const LAS f32x4*)(cw + 4 * DRNN + c0), b1 = *(const LAS f32x4*)(cw + 4 * DRNN + c0 + 4);
          acc[0] = b0.x; acc[1] = b0.y; acc[2] = b0.z; acc[3] = b0.w; acc[4] = b1.x; acc[5] = b1.y; acc[6] = b1.z; acc[7] = b1.w; }
#pragma unroll
        for (int tp = 0; tp < 4; ++tp) { const int dt = 3 - tp;
            v4u xv = (v4u){0u, 0u, 0u, 0u}; if (t - dt >= 0) xv = *(const v4u*)(XB + (size_t)(row - dt) * DRNN + c0);
            const f32x4 w0 = *(const LAS f32x4*)(cw + tp * DRNN + c0), w1 = *(const LAS f32x4*)(cw + tp * DRNN + c0 + 4);
            acc[0] += w0.x * bflo(xv.x); acc[1] += w0.y * bfhi(xv.x); acc[2] += w0.z * bflo(xv.y); acc[3] += w0.w * bfhi(xv.y);
            acc[4] += w1.x * bflo(xv.z); acc[5] += w1.y * bfhi(xv.z); acc[6] += w1.z * bflo(xv.w); acc[7] += w1.w * bfhi(xv.w); }
        *(v4u*)(XC + (size_t)row * DRNN + c0) = (v4u){cvtpk(acc[0], acc[1]), cvtpk(acc[2], acc[3]), cvtpk(acc[4], acc[5]), cvtpk(acc[6], acc[7])};
    }
}
__device__ __forceinline__ void lru_items(const bf16* XC, const bf16* G, bf16* Y, const float* gaw, const float* gab, const float* gxw, const float* gxb,
                                          const float* lamp, LAS unsigned char* L, int bid, int nb) {
    const int tid = fresh_tid(), lane = tid & 63, wave = __builtin_amdgcn_readfirstlane(tid >> 6), e = lane & 31, hi = lane >> 5;
    LAS float* xch = (LAS float*)(L + 4096);
    for (int item = bid; item < NITEMS; item += nb) {
        const int q = item & 3, n = (item >> 2) % NLB, b = item / (4 * NLB);
        const int cb0 = n * 128, cg = cb0 + 32 * q + e;
        __syncthreads();
        bf16x8 Ba[8], Bx[8];
#pragma unroll
        for (int ks = 0; ks < 8; ++ks) { float wa[8], wx[8];
#pragma unroll
            for (int j = 0; j < 8; ++j) { const size_t o = ((size_t)n * 128 + 16 * ks + 8 * hi + j) * 128 + 32 * q + e; wa[j] = gaw[o]; wx[j] = gxw[o]; }
            unsigned pa[4], px[4];
#pragma unroll
            for (int j = 0; j < 4; ++j) { pa[j] = cvtpk(wa[2 * j], wa[2 * j + 1]); px[j] = cvtpk(wx[2 * j], wx[2 * j + 1]); }
            Ba[ks] = __builtin_bit_cast(bf16x8, (v4u){pa[0], pa[1], pa[2], pa[3]}); Bx[ks] = __builtin_bit_cast(bf16x8, (v4u){px[0], px[1], px[2], px[3]}); }
        const float ba = gab[cg], bx = gxb[cg], sp8 = -8.0f * 1.4426950408889634f * log1pf(expf(-lamp[cg]));
        float hprev = 0.f;
        const bf16* XCb = XC + (size_t)b * SEQ * DRNN; const bf16* Gb = G + (size_t)b * SEQ * DRNN; bf16* Yb = Y + (size_t)b * SEQ * DRNN;
        v4u Ag[8], Gg[2];
        LAS unsigned char* atile = L + 8192 + wave * 8192; const int arow = lane >> 4, acol = lane & 15;
        LAS unsigned char* gtile = L + 73728 + wave * 4096; LAS unsigned char* ytile = gtile + 2048;
        const int grow = lane >> 2, gcol = lane & 3;
#define LRU_LD_A(chn) do { const bf16* p_ = XCb + (size_t)((chn) * CHUNK + wave * 32 + arow) * DRNN + cb0 + 8 * acol; _Pragma("unroll") for (int i = 0; i < 8; ++i) Ag[i] = *(const v4u*)(p_ + (size_t)(4 * i) * DRNN); } while (0)
#define LRU_ROWOF(r) (((r) & 3) + 8 * ((r) >> 2) + 4 * hi)
#define LRU_LD_G(chn) do { const bf16* p_ = Gb + (size_t)((chn) * CHUNK + wave * 32 + grow) * DRNN + cb0 + 32 * q + 8 * gcol; Gg[0] = *(const v4u*)p_; Gg[1] = *(const v4u*)(p_ + (size_t)16 * DRNN); } while (0)
        LRU_LD_A(0); LRU_LD_G(0);
        for (int ch = 0; ch < NCHK; ++ch) {
            const int tb = ch * CHUNK + wave * 32;
            const int chn = ch + 1 < NCHK ? ch + 1 : ch;
            f32x16 ar = {}, ai = {};
            bf16x8 Af[8];
#pragma unroll
            for (int i = 0; i < 8; ++i) { const int row = 4 * i + arow; *(LAS v4u*)(atile + row * 256 + ((acol ^ (row & 15)) << 4)) = Ag[i]; }
#pragma unroll
            for (int ks = 0; ks < 8; ++ks) Af[ks] = *(const LAS bf16x8*)(atile + e * 256 + (((2 * ks + hi) ^ (e & 15)) << 4));
#pragma unroll
            for (int ks = 0; ks < 8; ++ks) { ar = __builtin_amdgcn_mfma_f32_32x32x16_bf16(Af[ks], Ba[ks], ar, 0, 0, 0); ai = __builtin_amdgcn_mfma_f32_32x32x16_bf16(Af[ks], Bx[ks], ai, 0, 0, 0); }
            LRU_LD_A(chn);
            float av[16], hl[16];
#pragma unroll
            for (int r = 0; r < 16; ++r) {
                const int xrow = LRU_ROWOF(r), xch_ = 32 * q + e;
                const float xc = bf2f(*(const LAS bf16*)(atile + xrow * 256 + ((((xch_ >> 3) ^ (xrow & 15))) << 4) + (xch_ & 7) * 2));
                const float rg = sigm(ar[r] + ba), ig = sigm(ai[r] + bx);
                const float la2 = sp8 * rg, a = __builtin_amdgcn_exp2f(la2), x2 = la2 * (2.0f * 0.6931471805599453f);
                const float em = x2 > -0.02f ? -x2 * (1.0f + x2 * (0.5f + x2 * (1.0f / 6.0f))) : 1.0f - a * a;
                av[r] = a; hl[r] = __builtin_amdgcn_sqrtf(em) * (ig * xc); }
#pragma unroll
            for (int g = 0; g < 4; ++g) {
#pragma unroll
                for (int i = 1; i < 4; ++i) { const int r = 4 * g + i; hl[r] = av[r] * hl[r - 1] + hl[r]; av[r] = av[r] * av[r - 1]; } }
            float PA = 1.f, PH = 0.f;
#pragma unroll
            for (int g = 0; g < 4; ++g) { const float As = av[4 * g + 3], Hs = hl[4 * g + 3];
                const float Ap = __shfl_xor(As, 32), Hp = __shfl_xor(Hs, 32);
                const float Alo = hi ? Ap : As, Hlo = hi ? Hp : Hs, Ahi = hi ? As : Ap, Hhi = hi ? Hs : Hp;
                const float PA1 = PA * Alo, PH1 = Alo * PH + Hlo;
                const float EA = hi ? PA1 : PA, EH = hi ? PH1 : PH;
#pragma unroll
                for (int i = 0; i < 4; ++i) { const int r = 4 * g + i; hl[r] = hl[r] + av[r] * EH; av[r] = av[r] * EA; }
                PH = Ahi * PH1 + Hhi; PA = PA1 * Ahi; }
            LAS float* xb = xch + (ch & 1) * 512;
            if (hi == 0) { xb[wave * 64 + e] = PA; xb[wave * 64 + 32 + e] = PH; }
            __syncthreads();
            float hin = 0.f, h = hprev;
#pragma unroll
            for (int w = 0; w < 8; ++w) { if (w == wave) hin = h; h = xb[w * 64 + e] * h + xb[w * 64 + 32 + e]; }
            hprev = h;
            *(LAS v4u*)(gtile + grow * 64 + gcol * 16) = Gg[0]; *(LAS v4u*)(gtile + (grow + 16) * 64 + gcol * 16) = Gg[1];
            LRU_LD_G(chn);
#pragma unroll
            for (int r = 0; r < 16; ++r) { const int yrow = LRU_ROWOF(r);
                const float hv = hl[r] + av[r] * hin; *(LAS bf16*)(ytile + yrow * 64 + e * 2) = (bf16)f2bf(hv * bf2f(*(const LAS bf16*)(gtile + yrow * 64 + e * 2))); }
            { bf16* yp = Yb + (size_t)(tb + grow) * DRNN + cb0 + 32 * q + 8 * gcol;
              const v4u y0 = *(const LAS v4u*)(ytile + grow * 64 + gcol * 16), y1 = *(const LAS v4u*)(ytile + (grow + 16) * 64 + gcol * 16);
              *(v4u*)yp = y0; *(v4u*)(yp + (size_t)16 * DRNN) = y1; }
        }
#undef LRU_LD_A
#undef LRU_LD_G
#undef LRU_ROWOF
    }
}
constexpr int CV_LD = 65, CV_WAVE_BYTES = 64 * CV_LD * 4;
__device__ __forceinline__ void transpose_item64(const float* W, int N, bf16* WT, int K, int k0, int n0, int drow0, LAS float* scr, int lane) {
    { float tv[64];
#pragma unroll
      for (int i = 0; i < 64; ++i) tv[i] = __builtin_nontemporal_load(W + (size_t)(k0 + i) * N + n0 + lane);
#pragma unroll
      for (int i = 0; i < 64; ++i) scr[i * CV_LD + lane] = tv[i]; }
    LDS_WAIT(); asm volatile("" ::: "memory");
    const int c = lane & 7;
#pragma unroll
    for (int j = 0; j < 8; ++j) { const int n = (lane >> 3) + 8 * j; const LAS float* sp = scr + (8 * c) * CV_LD + n;
        v4u o; o.x = pk2(sp[0 * CV_LD], sp[1 * CV_LD]); o.y = pk2(sp[2 * CV_LD], sp[3 * CV_LD]); o.z = pk2(sp[4 * CV_LD], sp[5 * CV_LD]); o.w = pk2(sp[6 * CV_LD], sp[7 * CV_LD]);
        *(v4u*)(WT + (size_t)(drow0 + n) * K + k0 + 8 * c) = o; }
    LDS_WAIT(); asm volatile("" ::: "memory");
}
constexpr int CONV_PER_MAT = (DM / 64) * (DFE / 64), CONV_PER_E = 3 * CONV_PER_MAT, CONV_TOTAL = NE * CONV_PER_E;
constexpr int QWG_PER_E = 2 * (DFE / 64), QWG_TOTAL = NE * QWG_PER_E;
__device__ __forceinline__ void convert_moe_queue(const float* wg, const float* wu, const float* wd, bf16* WGU, bf16* WD, float* SBM, unsigned* ticket, LAS unsigned char* L) {
    const int tid = fresh_tid(), lane = tid & 63, wave = __builtin_amdgcn_readfirstlane(tid >> 6); LAS float* scr = (LAS float*)(L + wave * CV_WAVE_BYTES);
#if I8_MOE
    { LAS unsigned* tk = (LAS unsigned*)(L + 81920); int par = 0;
      __syncthreads();
      if (tid == 0) tk[0] = __hip_atomic_fetch_add(ticket + 64, 1u, __ATOMIC_RELAXED, __HIP_MEMORY_SCOPE_AGENT);
      for (;;) { __syncthreads();
          const unsigned it = tk[par];
          if (it >= (unsigned)QWG_TOTAL) break;
          unsigned nxt = 0u; if (tid == 0) nxt = __hip_atomic_fetch_add(ticket + 64, 1u, __ATOMIC_RELAXED, __HIP_MEMORY_SCOPE_AGENT);
          const int ex = it / QWG_PER_E, r = it % QWG_PER_E, up = r / (DFE / 64), n0 = 64 * (r % (DFE / 64));
          quant_item_wg((up ? wu : wg) + (size_t)ex * DM * DFE, DFE, (signed char*)WGU + (size_t)ex * 2 * DFE * DM, SBM + (size_t)ex * 2 * DFE, n0, (n0 >> 7) * 256 + up * 128 + (n0 & 127), L, tid);
          par ^= 1; if (tid == 0) tk[par] = nxt; }
      __syncthreads(); }
#endif
    unsigned it = 0; if (lane == 0) it = __hip_atomic_fetch_add(ticket, 1u, __ATOMIC_RELAXED, __HIP_MEMORY_SCOPE_AGENT);
    it = (unsigned)__builtin_amdgcn_readfirstlane((int)it);
    for (;; ) {
        unsigned nxt = 0;
#if I8_MOE
        if (it >= (unsigned)(NE * CONV_PER_MAT)) break;
        if (lane == 0) nxt = __hip_atomic_fetch_add(ticket, 1u, __ATOMIC_RELAXED, __HIP_MEMORY_SCOPE_AGENT);
        const int ex = it / CONV_PER_MAT, m = 2, idx = it % CONV_PER_MAT;
#else
        if (it >= (unsigned)CONV_TOTAL) break;
        if (lane == 0) nxt = __hip_atomic_fetch_add(ticket, 1u, __ATOMIC_RELAXED, __HIP_MEMORY_SCOPE_AGENT);
        const int ex = it / CONV_PER_E, r = it % CONV_PER_E, m = r / CONV_PER_MAT, idx = r % CONV_PER_MAT;
#endif
        if (m < 2) { const int nblk = DFE / 64, kb = idx / nblk, n0 = 64 * (idx % nblk); const int drow0 = (n0 >> 7) * 256 + (m == 1 ? 128 : 0) + (n0 & 127);
            transpose_item64((m == 0 ? wg : wu) + (size_t)ex * DM * DFE, DFE, WGU + (size_t)ex * 2 * DFE * DM, DM, 64 * kb, n0, drow0, scr, lane); }
        else { const int nblk = DM / 64, kb = idx / nblk, n0 = 64 * (idx % nblk);
            transpose_item64(wd + (size_t)ex * DFE * DM, DM, WD + (size_t)ex * DM * DFE, DFE, 64 * kb, n0, n0, scr, lane); }
        it = (unsigned)__builtin_amdgcn_readfirstlane((int)nxt);
    }
}
}
template <class OT> __device__ __forceinline__ void moe_down_tail(const bf16* ACTM, const bf16* WD, OT* out, const int* tok, const float* gatev, const LAS int* pexp, int rows, LAS unsigned char* L, int bid, int nb) {
    typedef short bf16x8 __attribute__((ext_vector_type(8)));
    const int tid = fresh_tid(), lane = tid & 63, wave = __builtin_amdgcn_readfirstlane(tid >> 6), fr = lane & 15, fq = lane >> 4;
    pg8::StaticOrder S; S.init(rows, DM, nb, 0);
    const int first = (S.nwg / nb) * nb, ntask = (S.nwg - first) * 16;
    LAS f32x4* red = (LAS f32x4*)L;
    constexpr int KW = DFE / 8, NPR = KW / 64;
    LAS unsigned char* tile = L + wave * 16384;
    const int lr = lane >> 3, lc = lane & 7;
    for (int task = bid; task < ntask; task += nb) {
        pg8::Unit u; S.unit_at(first + (task >> 4), u); const int sub = task & 15;
        const int rowbase = u.pm * 256 + 64 * (sub >> 2), colbase = u.pn * 256 + 64 * (sub & 3), ex = pexp[u.pm];
        const bf16* Ag = ACTM + (size_t)(rowbase + lr) * DFE + wave * KW + 8 * lc;
        const bf16* Bg = WD + ((size_t)ex * DM + colbase + lr) * DFE + wave * KW + 8 * lc;
        f32x4 acc[4][4];
#pragma unroll
        for (int m = 0; m < 4; ++m)
#pragma unroll
            for (int n = 0; n < 4; ++n) acc[m][n] = (f32x4){0.f, 0.f, 0.f, 0.f};
        __syncthreads();
        v4u g[16];
#define TAIL_GLD(pr) do { _Pragma("unroll") for (int i = 0; i < 8; ++i) { g[i] = *(const v4u*)(Ag + (size_t)(8 * i) * DFE + 64 * (pr)); g[8 + i] = *(const v4u*)(Bg + (size_t)(8 * i) * DFE + 64 * (pr)); } } while (0)
        TAIL_GLD(0);
#pragma unroll 1
        for (int pr = 0; pr < NPR; ++pr) {
#pragma unroll
            for (int i = 0; i < 16; ++i) { const int row = 8 * i + lr; *(LAS v4u*)(tile + row * 128 + ((lc ^ ((row >> 1) & 7)) << 4)) = g[i]; }
            __builtin_amdgcn_sched_barrier(0);
            if (pr + 1 < NPR) TAIL_GLD(pr + 1);
            __builtin_amdgcn_sched_barrier(0);
            bf16x8 a[2][4], b[2][4];
#pragma unroll
            for (int h = 0; h < 2; ++h)
#pragma unroll
                for (int m = 0; m < 4; ++m) { const int ra = 16 * m + fr, rb = 64 + 16 * m + fr, ch = 4 * h + fq;
                    a[h][m] = *(const LAS bf16x8*)(tile + ra * 128 + ((ch ^ ((ra >> 1) & 7)) << 4)); b[h][m] = *(const LAS bf16x8*)(tile + rb * 128 + ((ch ^ ((rb >> 1) & 7)) << 4)); }
#pragma unroll
            for (int h = 0; h < 2; ++h)
#pragma unroll
                for (int m = 0; m < 4; ++m)
#pragma unroll
                    for (int n = 0; n < 4; ++n) acc[m][n] = __builtin_amdgcn_mfma_f32_16x16x32_bf16(b[h][n], a[h][m], acc[m][n], 0, 0, 0);
            __builtin_amdgcn_sched_barrier(0);
        }
#undef TAIL_GLD
        __syncthreads();
#pragma unroll
        for (int m = 0; m < 4; ++m)
#pragma unroll
            for (int n = 0; n < 4; ++n) red[(wave * 16 + m * 4 + n) * 64 + lane] = acc[m][n];
        __syncthreads();
        { const int id = tid >> 5, m = id >> 2, n = id & 3;
#pragma unroll
          for (int k = 0; k < 2; ++k) { const int ls = (tid & 31) * 2 + k; f32x4 v = red[id * 64 + ls];
#pragma unroll
              for (int w = 1; w < 8; ++w) v = v + red[(w * 16 + id) * 64 + ls];
              const int r = rowbase + 16 * m + (ls & 15), cc = colbase + 16 * n + 4 * (ls >> 4); const int t = tok[r];
              if (t >= 0) { OT* o = out + (size_t)t * DM + cc; const f32x4 av = v * gatev[r];
                  if constexpr (sizeof(OT) == 4) { *(f32x4*)o = *(const f32x4*)o + av; }
                  else { const v2u w = *(const v2u*)o; v2u y; y.x = pk2(bflo(w.x) + av[0], bfhi(w.x) + av[1]); y.y = pk2(bflo(w.y) + av[2], bfhi(w.y) + av[3]); *(v2u*)o = y; } } } }
    }
    __syncthreads();
}
constexpr int PEXP_OFF = LDSCTL_OFF + 1024;
__device__ __forceinline__ const LAS int* moe_panel_table(const int* base, int rows, LAS unsigned char* L) {
    LAS int* t = (LAS int*)(L + PEXP_OFF); const int tid = fresh_tid();
    if (tid < rows / 256) { int e = 0;
#pragma unroll
        for (int j = 1; j < 8; ++j) e += (tid * 256 >= base[j]) ? 1 : 0;
        t[tid] = e; }
    __syncthreads();
    return t;
}
constexpr int N_PHASES = 21;
typedef const __attribute__((address_space(4))) Args* KArgs;
__device__ __forceinline__ KArgs fresh_args() { KArgs k = (KArgs)__builtin_amdgcn_kernarg_segment_ptr(); asm volatile("" : "+s"(k)); return k; }
#define WSP(T, off) ((T*)(ws + (off)))
__global__ void __launch_bounds__(NTHR, 2) fwd(Args args_unused) {
    extern __shared__ __attribute__((aligned(16))) unsigned char lds[];
    LAS unsigned char* L = (LAS unsigned char*)lds;
    LAS float* sm = (LAS float*)L;
    volatile LAS unsigned* MISC = (volatile LAS unsigned*)(L + MISC_OFF);
    const int bid = blockIdx.x, nb = gridDim.x;
    { const int tid = threadIdx.x; for (int u = tid; u < (LDS_BYTES - LDSCTL_OFF) / 4; u += NTHR) ((LAS unsigned*)(L + LDSCTL_OFF))[u] = 0u; }
    __syncthreads();
    int lo, hi;
    XcdBarrier bar;
    { KArgs ka = fresh_args(); lo = ka->ph_lo; hi = ka->ph_hi; bar.bar = (unsigned*)(ka->ws + WS_CTL) + CW_BAR; bar.x = 0; bar.st = nullptr; }
#if MK_ONE_LAUNCH
    bar = xcd_barrier_post(bar.bar, MISC + 8);
#endif
#ifndef PH_MASK
#define PH_MASK 0x1FFFFF
#endif
#define IN(k) (((PH_MASK >> (k)) & 1) && lo <= (k) && (k) < hi)
#if MK_ONE_LAUNCH
#define SEAM(k) do { if (IN(k) && IN((k) + 1)) xcd_barrier(bar); } while (0)
#else
#define SEAM(k) do { } while (0)
#endif
#ifndef PROBE_MASK
#define PROBE_MASK 0
#endif
#if XS_BF16
#define XSTREAM WSP(bf16, WS_XS)
#else
#define XSTREAM (ka->out)
#endif
#define PH_BEGIN KArgs ka = fresh_args(); unsigned char* ws = ka->ws; (void)ws; const unsigned long long t0_ = PROBE_MASK ? __builtin_amdgcn_s_memrealtime() : 0ull; (void)t0_;
#define PH_END(k) if (PROBE_MASK && ((PROBE_MASK >> ((k) > 20 ? 20 : (k))) & 1)) { __syncthreads(); const unsigned long long t1_ = __builtin_amdgcn_s_memrealtime(); while (__builtin_amdgcn_s_memrealtime() - t1_ < t1_ - t0_) __builtin_amdgcn_s_sleep(8); }
#define SMALLP(T, off) WSP(T, WS_SMALL + (off))
#define WAT(off) WSP(const pg8::bf16_t, WS_WA + (off))

    if (IN(0)) { PH_BEGIN if (bid == 0) build_tables(ka->in[4], SMALLP(float, SM_TB));
        convert_weights_a(ka, ws, L, bid, nb); __syncthreads();
#if I8_QKV
        rms_rows_q(ka->in[0], ka->in[1], WSP(signed char, WS_H), SMALLP(float, SM_SA), bid, nb);
#else
        rms_rows_bf16(ka->in[0], ka->in[1], WSP(bf16, WS_HB), bid, nb);
#endif
        PH_END(0) } SEAM(0);
#if I8_QKV
    if (IN(1)) { PH_BEGIN pg8::Gemm g{WSP(bf16, WS_H), WAT(WA_QKV), NT, 3 * DM, DM / 2}; pg8::StaticOrder S; S.init(NT, 3 * DM, nb, bid);
        pg8::EpiBf16Q E{WSP(bf16, WS_Q), DM, DM, (size_t)(WS_K - WS_Q) / 2, C2, SMALLP(const float, SM_SA), SMALLP(const float, SM_SB) + SB_QKV};
        pg8::gemm_phase<pg8::EpiBf16Q, pg8::StaticOrder, true, true, false, true>(L, g, S, E); PH_END(1) } SEAM(1);
#else
    if (IN(1)) { PH_BEGIN pg8::Gemm g{WSP(bf16, WS_HB), WAT(WA_QKV), NT, 3 * DM, DM}; pg8::StaticOrder S; S.init(NT, 3 * DM, nb, bid);
        pg8::EpiBf16<0> E{WSP(bf16, WS_Q), DM, nullptr, DM, (size_t)(WS_K - WS_Q) / 2, C2};
        pg8::gemm_phase<pg8::EpiBf16<0>, pg8::StaticOrder, true, true>(L, g, S, E); PH_END(1) } SEAM(1);
#endif
#if FAST_ATTN
    if (IN(2)) { PH_BEGIN const attn_body::AttnTensors AT{WSP(const attn_body::bf16, WS_Q), WSP(const attn_body::bf16, WS_K), WSP(const attn_body::bf16, WS_V), WSP(attn_body::bf16, WS_O0), ATTN_PC == 3 ? WSP(attn_body::bf16, WS_OC) : WSP(attn_body::bf16, WS_O1), SMALLP(const float, SM_TB), ka->in[11], compute_lam(ka->in[7], ka->in[8], ka->in[9], ka->in[10])};
#if ATTN_PC
        static_assert(attn_body::ATTN2_LDS_BYTES <= RING_BYTES, "attention scratch fits the ring");
#if ATTN_PC == 3
        static_assert(attn_body::ATTN4_LDS_BYTES <= RING_BYTES, "attention scratch fits the ring");
        attn_body::attn_phase4<8>((char*)lds, AT, nb, bid);
#elif ATTN_PC == 2
        static_assert(attn_body::ATTN3_LDS_BYTES <= RING_BYTES, "attention scratch fits the ring");
        attn_body::attn_phase3<8>((char*)lds, AT, nb, bid);
#else
        attn_body::attn_phase2<8>((char*)lds, AT, nb, bid);
#endif
#else
        attn_body::attn_phase<8>((char*)lds, AT, nb, bid);
#endif
        PH_END(2) } SEAM(2);
#else
    if (IN(2)) { PH_BEGIN ref_attention(WSP(bf16, WS_Q), WSP(bf16, WS_K), WSP(bf16, WS_V), WSP(bf16, WS_O0), WSP(bf16, WS_O1), SMALLP(float, SM_TB), sm, bid, nb); PH_END(2) } SEAM(2);
#endif
#if ATTN_PC != 3
    if (IN(3)) { PH_BEGIN const float lam = compute_lam(ka->in[7], ka->in[8], ka->in[9], ka->in[10]); combine_rows(WSP(bf16, WS_O0), WSP(bf16, WS_O1), WSP(bf16, WS_H), ka->in[11], lam, bid, nb); PH_END(3) } SEAM(3);
#endif
    if (IN(4)) { PH_BEGIN pg8::Gemm g{WSP(bf16, WS_OC), WAT(WA_O), NT, DM, DM}; pg8::StaticOrder S; S.init(NT, DM, nb, bid);
#if XS_BF16
        pg8::EpiResX<float> E{ka->in[0], WSP(bf16, WS_XS), DM};
        pg8::gemm_phase<pg8::EpiResX<float>, pg8::StaticOrder, true, true>(L, g, S, E); PH_END(4) } SEAM(4);
#else
        pg8::EpiResF32 E{ka->in[0], ka->out, DM};
        pg8::gemm_phase<pg8::EpiResF32, pg8::StaticOrder, true, true>(L, g, S, E); PH_END(4) } SEAM(4);
#endif
#if I8_FFN
    if (IN(5)) { PH_BEGIN rms_rows_q(XSTREAM, ka->in[2], WSP(signed char, WS_H), SMALLP(float, SM_SA), bid, nb); PH_END(5) } SEAM(5);
#else
    if (IN(5)) { PH_BEGIN rms_rows_bf16(XSTREAM, ka->in[2], WSP(bf16, WS_H), bid, nb); PH_END(5) } SEAM(5);
#endif
#if I8_FFN
    if (IN(6)) { PH_BEGIN pg8::Gemm g{WSP(bf16, WS_H), WAT(WA_GU), NT, 2 * DFF, DM / 2}; pg8::StaticOrder S; S.init(NT, 2 * DFF, nb, bid);
        pg8::EpiSwigluQ E{WSP(bf16, WS_ACT), DFF, SMALLP(const float, SM_SA), SMALLP(const float, SM_SB) + SB_GU, nullptr};
        pg8::gemm_phase<pg8::EpiSwigluQ, pg8::StaticOrder, true, true, false, true>(L, g, S, E); PH_END(6) } SEAM(6);
#else
    if (IN(6)) { PH_BEGIN pg8::Gemm g{WSP(bf16, WS_H), WAT(WA_GU), NT, 2 * DFF, DM}; pg8::StaticOrder S; S.init(NT, 2 * DFF, nb, bid);
        pg8::EpiSwiglu E{WSP(bf16, WS_ACT), DFF};
        pg8::gemm_phase<pg8::EpiSwiglu, pg8::StaticOrder, true, true>(L, g, S, E); PH_END(6) } SEAM(6);
#endif
    if (IN(7)) { PH_BEGIN pg8::Gemm g{WSP(bf16, WS_ACT), WAT(WA_D), NT, DM, DFF}; pg8::StaticOrder S; S.init(NT, DM, nb, bid);
#if XS_BF16
        pg8::EpiResX<pg8::bf16_t> E{WSP(bf16, WS_XS), WSP(bf16, WS_XS), DM};
        pg8::gemm_phase<pg8::EpiResX<pg8::bf16_t>, pg8::StaticOrder, true, true>(L, g, S, E); PH_END(7) } SEAM(7);
#else
        pg8::EpiResF32 E{ka->out, ka->out, DM};
        pg8::gemm_phase<pg8::EpiResF32, pg8::StaticOrder, true, true>(L, g, S, E); PH_END(7) } SEAM(7);
#endif
#if I8_WIN
    if (IN(8)) { PH_BEGIN rms_rows_q(XSTREAM, ka->in[1] + DM, WSP(signed char, WS_H), SMALLP(float, SM_SA), bid, nb); PH_END(8) } SEAM(8);
#else
    if (IN(8)) { PH_BEGIN rms_rows_bf16(XSTREAM, ka->in[1] + DM, WSP(bf16, WS_H), bid, nb); PH_END(8) } SEAM(8);
#endif
#if I8_WIN
    if (IN(9)) { PH_BEGIN pg8::Gemm g{WSP(bf16, WS_H), WAT(WA_IN), NT, 2 * DRNN, DM / 2}; pg8::StaticOrder S; S.init(NT, 2 * DRNN, nb, bid);
        pg8::EpiWinQ E{WSP(bf16, WS_G), WSP(bf16, WS_XB), DRNN, DRNN / 256, SMALLP(const float, SM_SA), SMALLP(const float, SM_SB) + SB_IN};
        pg8::gemm_phase<pg8::EpiWinQ, pg8::StaticOrder, true, true, false, true>(L, g, S, E); PH_END(9) } SEAM(9);
#else
    if (IN(9)) { PH_BEGIN pg8::Gemm g{WSP(bf16, WS_H), WAT(WA_IN), NT, 2 * DRNN, DM}; pg8::StaticOrder S; S.init(NT, 2 * DRNN, nb, bid);
        pg8::EpiWin E{WSP(bf16, WS_G), WSP(bf16, WS_XB), DRNN, DRNN / 256};
        pg8::gemm_phase<pg8::EpiWin, pg8::StaticOrder, true, true>(L, g, S, E); PH_END(9) } SEAM(9);
#endif
#if FAST_LRU
    if (IN(10)) { PH_BEGIN lru::conv_pass(WSP(bf16, WS_XB), WSP(bf16, WS_XC), ka->in[13], ka->in[14], L, bid, nb); PH_END(10) } SEAM(10);
    if (IN(11)) { PH_BEGIN lru::lru_items(WSP(bf16, WS_XC), WSP(bf16, WS_G), WSP(bf16, WS_YF), ka->in[15], ka->in[16], ka->in[17], ka->in[18], ka->in[19], L, bid, nb);
        __syncthreads(); PH_END(11) }
    if (IN(11)) { PH_BEGIN lru::convert_moe_queue(ka->in[25], ka->in[26], ka->in[27], WSP(bf16, WS_WM + WM_GU), WSP(bf16, WS_WM + WM_D), SMALLP(float, SM_SB) + SB_MOE, (unsigned*)(ws + WS_CTL) + CW_TICKET, L); PH_END(12) } SEAM(12);
#else
    if (IN(10)) { PH_BEGIN ref_lru_local(WSP(bf16, WS_XB), ka->in[13], ka->in[14], ka->in[15], ka->in[16], ka->in[17], ka->in[18], ka->in[19], WSP(bf16, WS_HL), WSP(bf16, WS_CA), SMALLP(float, SM_AEND), SMALLP(float, SM_HEND), sm, bid, nb); PH_END(10) } SEAM(10);
    if (IN(11)) { PH_BEGIN lru_carry(SMALLP(float, SM_AEND), SMALLP(float, SM_HEND), SMALLP(float, SM_CIN), bid, nb); PH_END(11) } SEAM(11);
    if (IN(12)) { PH_BEGIN lru_fixup(WSP(bf16, WS_HL), WSP(bf16, WS_CA), WSP(bf16, WS_G), SMALLP(float, SM_CIN), WSP(bf16, WS_Y), bid, nb); PH_END(12) } SEAM(12);
#endif
    if (IN(13)) { PH_BEGIN pg8::Gemm g{WSP(bf16, FAST_LRU ? WS_YF : WS_Y), WAT(WA_OUT), NT, DM, DRNN}; pg8::StaticOrder S; S.init(NT, DM, nb, bid);
#if XS_BF16
        pg8::EpiResX<pg8::bf16_t> E{WSP(bf16, WS_XS), WSP(bf16, WS_XS), DM};
        pg8::gemm_phase<pg8::EpiResX<pg8::bf16_t>, pg8::StaticOrder, true, true>(L, g, S, E); PH_END(13) } SEAM(13);
#else
        pg8::EpiResF32 E{ka->out, ka->out, DM};
        pg8::gemm_phase<pg8::EpiResF32, pg8::StaticOrder, true, true>(L, g, S, E); PH_END(13) } SEAM(13);
#endif
    if (IN(14)) { PH_BEGIN int* RE = SMALLP(int, SM_ROUTE); moe_route(XSTREAM, ka->in[2] + DM, ka->in[24], WSP(bf16, WS_H), I8_MOE ? WSP(signed char, WS_H) : nullptr, SMALLP(float, SM_SA), RE, (float*)(RE + 2 * NT), RE + 4 * NT, SMALLP(int, SM_CNT), sm, bid, nb); PH_END(14) } SEAM(14);
    if (IN(15)) { PH_BEGIN int* RE = SMALLP(int, SM_ROUTE); moe_scatter(RE, (float*)(RE + 2 * NT), RE + 4 * NT, SMALLP(int, SM_CNT), SMALLP(int, SM_BASE), SMALLP(int, SM_TOK), SMALLP(float, SM_GATEV), SMALLP(const float, SM_SA), SMALLP(float, SM_SAS), SMALLP(bf16, SM_TOK16), sm, bid, nb);
#if !FAST_LRU
        __syncthreads(); convert_weights_moe(ka, ws, L, bid, nb);
#endif
    PH_END(15) } SEAM(15);
        if (IN(16 + 2 * 0)) { PH_BEGIN const int* tok_s = SMALLP(int, SM_TOK) + 0 * SLOT_ROWS; const int* base_s = SMALLP(int, SM_BASE) + 0 * 9; const int rows = __builtin_amdgcn_readfirstlane(base_s[8]); const unsigned short* tok16_s = SMALLP(const unsigned short, SM_TOK16) + 0 * SLOT_ROWS; const LAS int* pexp = moe_panel_table(base_s, rows, L);
#if I8_MOE
            pg8::Gemm g{WSP(bf16, WS_H), WSP(const pg8::bf16_t, WS_WM + WM_GU), rows, 2 * DFE, DM / 2}; pg8::MoeOrder S; S.init_moe(rows, 2 * DFE, nb, bid, tok16_s, pexp);
            pg8::EpiSwigluQ E{WSP(bf16, WS_ACTM), DFE, SMALLP(const float, SM_SAS) + 0 * SLOT_ROWS, SMALLP(const float, SM_SB) + SB_MOE, nullptr};
            pg8::gemm_phase<pg8::EpiSwigluQ, pg8::MoeOrder, true, true, true, true>(L, g, S, E); PH_END(16 + 2 * 0) } SEAM(16 + 2 * 0);
#else
            pg8::Gemm g{WSP(bf16, WS_H), WSP(const pg8::bf16_t, WS_WM + WM_GU), rows, 2 * DFE, DM}; pg8::MoeOrder S; S.init_moe(rows, 2 * DFE, nb, bid, tok16_s, pexp);
            pg8::EpiSwiglu E{WSP(bf16, WS_ACTM), DFE};
            pg8::gemm_phase<pg8::EpiSwiglu, pg8::MoeOrder, true, true, true>(L, g, S, E); PH_END(16 + 2 * 0) } SEAM(16 + 2 * 0);
#endif
        if (IN(17 + 2 * 0)) { PH_BEGIN const int* tok_s = SMALLP(int, SM_TOK) + 0 * SLOT_ROWS; const float* gate_s = SMALLP(float, SM_GATEV) + 0 * SLOT_ROWS; const int* base_s = SMALLP(int, SM_BASE) + 0 * 9; const int rows = __builtin_amdgcn_readfirstlane(base_s[8]); const unsigned short* tok16_s = SMALLP(const unsigned short, SM_TOK16) + 0 * SLOT_ROWS; const LAS int* pexp = moe_panel_table(base_s, rows, L);
            pg8::Gemm g{WSP(bf16, WS_ACTM), WSP(const pg8::bf16_t, WS_WM + WM_D), rows, DM, DFE}; pg8::MoeOrder S; S.init_moe(rows, DM, nb, bid, tok16_s, pexp); S.nlim = (S.nwg / nb) * nb;
#if XS_BF16
            pg8::EpiMoeDownX E{WSP(bf16, WS_XS), DM, tok_s, gate_s};
            pg8::gemm_phase<pg8::EpiMoeDownX, pg8::MoeOrder, true, true, false>(L, g, S, E);
            __syncthreads(); moe_down_tail(WSP(bf16, WS_ACTM), WSP(const bf16, WS_WM + WM_D), WSP(bf16, WS_XS), tok_s, gate_s, pexp, rows, L, bid, nb); PH_END(17 + 2 * 0) }
#else
            pg8::EpiMoeDown E{ka->out, DM, tok_s, gate_s};
            pg8::gemm_phase<pg8::EpiMoeDown, pg8::MoeOrder, true, true, false>(L, g, S, E);
            __syncthreads(); moe_down_tail(WSP(bf16, WS_ACTM), WSP(const bf16, WS_WM + WM_D), ka->out, tok_s, gate_s, pexp, rows, L, bid, nb); PH_END(17 + 2 * 0) }
#endif
        SEAM(17 + 2 * 0);
        if (IN(16 + 2 * 1)) { PH_BEGIN const int* tok_s = SMALLP(int, SM_TOK) + 1 * SLOT_ROWS; const int* base_s = SMALLP(int, SM_BASE) + 1 * 9; const int rows = __builtin_amdgcn_readfirstlane(base_s[8]); const unsigned short* tok16_s = SMALLP(const unsigned short, SM_TOK16) + 1 * SLOT_ROWS; const LAS int* pexp = moe_panel_table(base_s, rows, L);
#if I8_MOE
            pg8::Gemm g{WSP(bf16, WS_H), WSP(const pg8::bf16_t, WS_WM + WM_GU), rows, 2 * DFE, DM / 2}; pg8::MoeOrder S; S.init_moe(rows, 2 * DFE, nb, bid, tok16_s, pexp);
            pg8::EpiSwigluQ E{WSP(bf16, WS_ACTM), DFE, SMALLP(const float, SM_SAS) + 1 * SLOT_ROWS, SMALLP(const float, SM_SB) + SB_MOE, nullptr};
            pg8::gemm_phase<pg8::EpiSwigluQ, pg8::MoeOrder, true, true, true, true>(L, g, S, E); PH_END(16 + 2 * 1) } SEAM(16 + 2 * 1);
#else
            pg8::Gemm g{WSP(bf16, WS_H), WSP(const pg8::bf16_t, WS_WM + WM_GU), rows, 2 * DFE, DM}; pg8::MoeOrder S; S.init_moe(rows, 2 * DFE, nb, bid, tok16_s, pexp);
            pg8::EpiSwiglu E{WSP(bf16, WS_ACTM), DFE};
            pg8::gemm_phase<pg8::EpiSwiglu, pg8::MoeOrder, true, true, true>(L, g, S, E); PH_END(16 + 2 * 1) } SEAM(16 + 2 * 1);
#endif
        if (IN(17 + 2 * 1)) { PH_BEGIN const int* tok_s = SMALLP(int, SM_TOK) + 1 * SLOT_ROWS; const float* gate_s = SMALLP(float, SM_GATEV) + 1 * SLOT_ROWS; const int* base_s = SMALLP(int, SM_BASE) + 1 * 9; const int rows = __builtin_amdgcn_readfirstlane(base_s[8]); const unsigned short* tok16_s = SMALLP(const unsigned short, SM_TOK16) + 1 * SLOT_ROWS; const LAS int* pexp = moe_panel_table(base_s, rows, L);
            pg8::Gemm g{WSP(bf16, WS_ACTM), WSP(const pg8::bf16_t, WS_WM + WM_D), rows, DM, DFE}; pg8::MoeOrder S; S.init_moe(rows, DM, nb, bid, tok16_s, pexp); S.nlim = (S.nwg / nb) * nb;
#if XS_BF16
            pg8::EpiMoeDownX E{WSP(bf16, WS_XS), DM, tok_s, gate_s};
            pg8::gemm_phase<pg8::EpiMoeDownX, pg8::MoeOrder, true, true, false>(L, g, S, E);
            __syncthreads(); moe_down_tail(WSP(bf16, WS_ACTM), WSP(const bf16, WS_WM + WM_D), WSP(bf16, WS_XS), tok_s, gate_s, pexp, rows, L, bid, nb); PH_END(17 + 2 * 1) }
#else
            pg8::EpiMoeDown E{ka->out, DM, tok_s, gate_s};
            pg8::gemm_phase<pg8::EpiMoeDown, pg8::MoeOrder, true, true, false>(L, g, S, E);
            __syncthreads(); moe_down_tail(WSP(bf16, WS_ACTM), WSP(const bf16, WS_WM + WM_D), ka->out, tok_s, gate_s, pexp, rows, L, bid, nb); PH_END(17 + 2 * 1) }
#endif
        SEAM(17 + 2 * 1);
    if (IN(20)) { PH_BEGIN rms_rows_final(XSTREAM, ka->in[3], ka->out, bid, nb); PH_END(20) }
#undef IN
#undef SEAM
}

extern "C" void kernel_launch(void* const* d_in, const int* in_sizes, int n_in, void* d_out, int out_size, void* d_ws, size_t ws_size, hipStream_t stream) {
    static int grid = 0;
    if (grid == 0) {
        if (n_in != 28 || in_sizes[0] != NT * DM || out_size != NT * DM || ws_size < WS_END) { fprintf(stderr, "kernel_launch: unexpected shapes (n_in %d, in0 %d, out %d, ws %zu); nothing launched\n", n_in, n_in > 0 ? in_sizes[0] : -1, out_size, ws_size); grid = -1; return; }
        int dev = 0, cus = 0, per_cu = 0;
        if (hipGetDevice(&dev) != hipSuccess || hipDeviceGetAttribute(&cus, hipDeviceAttributeMultiprocessorCount, dev) != hipSuccess) { grid = -1; return; }
        if (hipFuncSetAttribute((const void*)fwd, hipFuncAttributeMaxDynamicSharedMemorySize, LDS_BYTES) != hipSuccess) { fprintf(stderr, "kernel_launch: hipFuncSetAttribute failed\n"); grid = -1; return; }
        if (hipOccupancyMaxActiveBlocksPerMultiprocessor(&per_cu, (const void*)fwd, NTHR, LDS_BYTES) != hipSuccess || per_cu < 1) { fprintf(stderr, "kernel_launch: occupancy query reports %d\n", per_cu); }
        (void)hipGetLastError();
        grid = cus & ~7;
    }
    if (grid < 0) return;
    if (hipMemsetAsync((char*)d_ws + WS_CTL, 0, CTL_ZERO_BYTES, stream) != hipSuccess) return;
    Args a{};
    for (int i = 0; i < 28; ++i) a.in[i] = (const float*)d_in[i];
    a.out = (float*)d_out; a.ws = (unsigned char*)d_ws;
#if MK_ONE_LAUNCH
    a.ph_lo = 0; a.ph_hi = N_PHASES;
    hipLaunchKernelGGL(fwd, dim3(grid), dim3(NTHR), LDS_BYTES, stream, a);
#else
    for (int p = 0; p < N_PHASES; ++p) { a.ph_lo = p; a.ph_hi = p + 1; hipLaunchKernelGGL(fwd, dim3(grid), dim3(NTHR), LDS_BYTES, stream, a); }
#endif
}
```

```cpp
#include <hip/hip_runtime.h>
#include <cstdio>
#include <cstdint>

#ifndef FAST_GEMM
#define FAST_GEMM 1
#endif
#ifndef FAST_ATTN
#define FAST_ATTN 1
#endif
#ifndef I8_QKV
#define I8_QKV 1
#endif
#ifndef I8_FFN
#define I8_FFN 1
#endif
#ifndef I8_WIN
#define I8_WIN 1
#endif
#ifndef I8_MOE
#define I8_MOE 1
#endif
#ifndef XS_BF16
#define XS_BF16 1
#endif
#ifndef FAST_LRU
#define FAST_LRU 1
#endif
#ifndef ATTN_PC
#define ATTN_PC 3
#endif
#ifndef FAST_MOE
#define FAST_MOE 1
#endif
#ifndef MK_ONE_LAUNCH
#define MK_ONE_LAUNCH 1
#endif

#define GAS __attribute__((address_space(1)))
#define LAS __attribute__((address_space(3)))
typedef unsigned short bf16;
typedef unsigned v4u __attribute__((ext_vector_type(4)));
typedef unsigned v2u __attribute__((ext_vector_type(2)));
typedef float f32x4 __attribute__((ext_vector_type(4)));
typedef GAS unsigned gu32;
#define RLX_AGENT __ATOMIC_RELAXED, __HIP_MEMORY_SCOPE_AGENT

constexpr int NB_ = 4, SEQ = 8192, DM = 1024, NT = NB_ * SEQ;
constexpr int NH = 8, HD = 64, VD = 128;
constexpr int DRNN = 1280, NLB = 10, LBK = 128, CW = 4;
constexpr int DFF = 2816, NE = 8, DFE = 3584;
constexpr float NORM_EPS = 1e-6f, SUBLN_EPS = 1e-5f, LOG2E = 1.4426950408889634f;
constexpr float C2 = 0.125f * LOG2E;
constexpr float LAM_INIT = 0.2f;
constexpr int NWAVES = 8, NTHR = 512;
constexpr int LCH = 64, NCH = SEQ / LCH;
constexpr int SLOT_ROWS = NT + NE * 256;

constexpr size_t MiB = 1u << 20;
constexpr size_t WS_CTL = 0, CTL_ZERO_BYTES = 64 * 1024;
constexpr size_t WS_SMALL = 1 * MiB;
constexpr size_t SM_TB = 0;
constexpr size_t SM_ROUTE = 64 * 1024;
constexpr size_t SM_CNT = 1 * MiB;
constexpr size_t SM_BASE = 1 * MiB + 16 * 1024;
constexpr size_t SM_TOK = 2 * MiB;
constexpr size_t SM_GATEV = 2 * MiB + 512 * 1024;
constexpr size_t SM_AEND = 4 * MiB;
constexpr size_t SM_HEND = 7 * MiB;
constexpr size_t SM_CIN = 10 * MiB;
constexpr size_t SM_SB = 13 * MiB;
constexpr size_t SB_QKV = 0, SB_GU = 3072, SB_IN = SB_GU + 2 * DFF, SB_MOE = SB_IN + 2 * DRNN;
constexpr size_t SM_SAS = 14 * MiB + 256 * 1024;
constexpr size_t SM_TOK16 = 14 * MiB + 768 * 1024;
constexpr size_t SM_SA = 14 * MiB;
constexpr size_t WS_WA = 17 * MiB;
constexpr size_t WS_O0 = 50 * MiB, WS_O1 = 114 * MiB;
constexpr size_t WS_HL = 50 * MiB, WS_CA = 130 * MiB;
constexpr size_t WS_WM = 50 * MiB;
constexpr size_t WS_XS = 162 * MiB;
constexpr size_t WS_HB = WS_XS;
constexpr size_t WS_H = 250 * MiB;
constexpr size_t WS_SCR = 282 * MiB;
constexpr size_t WS_Q = WS_SCR, WS_K = WS_SCR + 64 * MiB, WS_V = WS_SCR + 128 * MiB;
constexpr size_t WS_OC = WS_Q;
constexpr size_t WS_ACT = WS_SCR;
constexpr size_t WS_G = WS_SCR, WS_XB = WS_SCR + 80 * MiB, WS_Y = WS_SCR + 160 * MiB;
constexpr size_t WS_XC = WS_Y, WS_YF = WS_XB;
constexpr size_t WS_ACTM = WS_SCR;
constexpr size_t WS_END = 522 * MiB;
static_assert(WS_ACTM + (size_t)SLOT_ROWS * DFE * 2 <= WS_END && WS_XC + (size_t)NT * DRNN * 2 <= WS_END && WS_XS + (size_t)NT * DM * 2 <= WS_H && WS_H + (size_t)NT * DM <= WS_SCR, "ws map");
static_assert(SM_CIN + (size_t)NB_ * NCH * DRNN * 4 <= 16 * MiB, "small map");
constexpr int CW_BAR = 4096, CW_TICKET = 8192;

__device__ __forceinline__ int fresh_tid() { int t = threadIdx.x; asm volatile("" : "+v"(t)); return t; }
__device__ __forceinline__ unsigned f2bf(float f) { unsigned u = __builtin_bit_cast(unsigned, f); return (u + 0x7fffu + ((u >> 16) & 1u)) >> 16; }
__device__ __forceinline__ unsigned pk2(float lo, float hi) { return f2bf(lo) | (f2bf(hi) << 16); }
__device__ __forceinline__ float bflo(unsigned u) { return __builtin_bit_cast(float, u << 16); }
__device__ __forceinline__ float bfhi(unsigned u) { return __builtin_bit_cast(float, u & 0xffff0000u); }
__device__ __forceinline__ float bf2f(bf16 v) { return __builtin_bit_cast(float, (unsigned)v << 16); }
__device__ __forceinline__ float wave_sum(float v) {
#pragma unroll
    for (int o = 1; o < 64; o <<= 1) v += __shfl_xor(v, o);
    return v;
}
__device__ __forceinline__ float sigmoidf_(float x) { return 1.f / (1.f + __expf(-x)); }

#define XB_TMO      128
#define XB_XCNT(j)  (256  + 64 * (j))
#define XB_XSUB(j)  (1280 + 64 * (j))
#define XB_XGEN(j)  (2304 + 64 * (j))
#define XB_TOP      3328
#define XB_TOPGEN   3392
#define XCD_BAR_WORDS 3456
#define XB_SPIN_CAP (1u << 18)
__device__ __forceinline__ unsigned xb_ld(unsigned* p)              { return __hip_atomic_load(p, __ATOMIC_RELAXED, __HIP_MEMORY_SCOPE_AGENT); }
__device__ __forceinline__ unsigned xb_add(unsigned* p, unsigned v) { return __hip_atomic_fetch_add(p, v, __ATOMIC_RELAXED, __HIP_MEMORY_SCOPE_AGENT); }
__device__ __forceinline__ unsigned xb_xcc_id() { return (unsigned)__builtin_amdgcn_s_getreg((3 << 11) | 20) & 0xFu; }
#define XB_SPIN(cond, bar) do { unsigned _sp = 0; while (cond) { __builtin_amdgcn_s_sleep(1); \
    if ((++_sp & 255u) == 0u) { if (xb_ld(&(bar)[XB_TMO])) break; if (_sp > XB_SPIN_CAP) { atomicAdd(&(bar)[XB_TMO], 1u); break; } } } } while (0)
struct XcdBarrier { unsigned* bar; unsigned x; volatile LAS unsigned* st; };
__device__ __forceinline__ XcdBarrier xcd_barrier_post(unsigned* bar, volatile LAS unsigned* st) {
    XcdBarrier b; b.bar = bar; b.x = xb_xcc_id(); b.st = st;
    if (threadIdx.x == 0) (void)xb_add(&bar[XB_XCNT(b.x)], 1u);
    return b;
}
__device__ __forceinline__ void xcd_barrier_complete(unsigned* bar, unsigned x, unsigned& nloc, unsigned& nx) {
    const unsigned G = gridDim.x * gridDim.y * gridDim.z;
    unsigned sum, cnt, mine, sp = 0u;
    for (;;) {
        sum = 0u; cnt = 0u; mine = 0u;
#pragma unroll
        for (unsigned j = 0; j < 16; ++j) { const unsigned c = xb_ld(&bar[XB_XCNT(j)]); sum += c; cnt += (c > 0u) ? 1u : 0u; mine = (j == x) ? c : mine; }
        if (sum == G) break;
        __builtin_amdgcn_s_sleep(1);
        if ((++sp & 255u) == 0u) { if (xb_ld(&bar[XB_TMO])) break; if (sp > XB_SPIN_CAP) { atomicAdd(&bar[XB_TMO], 1u); break; } }
    }
    nloc = mine > 0u ? mine : 1u; nx = cnt > 0u ? cnt : 1u;
}
__device__ __forceinline__ void xcd_barrier(const XcdBarrier& b) {
    asm volatile("s_waitcnt vmcnt(0)" ::: "memory");
    __syncthreads();
    if (threadIdx.x == 0) {
        unsigned* bar = b.bar;
        __builtin_amdgcn_s_waitcnt(0);
        unsigned nloc = b.st[0], nx = b.st[1];
        if (nloc == 0u) { xcd_barrier_complete(bar, b.x, nloc, nx); b.st[0] = nloc; b.st[1] = nx; }
        const unsigned old = xb_add(&bar[XB_XSUB(b.x)], 1u);
        const unsigned gen = old / nloc;
        if (old + 1u == (gen + 1u) * nloc) {
            __builtin_amdgcn_fence(__ATOMIC_RELEASE, "agent");
            asm volatile("s_waitcnt vmcnt(0)" ::: "memory");
            const unsigned og = xb_add(&bar[XB_TOP], 1u);
            const unsigned tg = og / nx;
            if (og + 1u == (tg + 1u) * nx) xb_add(&bar[XB_TOPGEN], 1u);
            else XB_SPIN(xb_ld(&bar[XB_TOPGEN]) == tg, bar);
            __builtin_amdgcn_fence(__ATOMIC_ACQUIRE, "agent");
            xb_add(&bar[XB_XGEN(b.x)], 1u);
            asm volatile("s_waitcnt vmcnt(0)" ::: "memory");
        } else {
            XB_SPIN(xb_ld(&bar[XB_XGEN(b.x)]) == gen, bar);
            __builtin_amdgcn_fence(__ATOMIC_ACQUIRE, "agent");
            asm volatile("s_waitcnt vmcnt(0)" ::: "memory");
        }
    }
    __syncthreads();
}

namespace pg8 {
#define PG8_LAS __attribute__((address_space(3)))
typedef unsigned short bf16_t;
typedef short bf16x8 __attribute__((ext_vector_type(8)));
typedef float f32x4 __attribute__((ext_vector_type(4)));
typedef unsigned u32x4 __attribute__((ext_vector_type(4)));
typedef int i32x4 __attribute__((ext_vector_type(4)));
constexpr int BM = 256, BK = 64, HALF = 128, HTB = HALF * BK * 2  , STAGE_BYTES = 8 * HTB, NXCD = 8, WGM = 8;

__host__ __device__ __forceinline__ int lds_byte(int r, int c) { const int st = (r >> 4) * 2 + (c >> 5), rr = r & 15, cc = c & 31, ob = rr * 64 + cc * 2; return st * 1024 + (ob ^ (((ob >> 9) & 1) << 5)); }
__host__ __device__ __forceinline__ void stage_rc(int b, int& R, int& C) { const int st = b / 1024, sb = b % 1024, swz = sb ^ (((sb >> 9) & 1) << 5); R = (st >> 1) * 16 + swz / 64; C = (st & 1) * 32 + (swz % 64) / 2; }
__host__ __device__ __forceinline__ int perm32(int rho) { const int n = rho >> 4, i = rho & 15; return 8 * (i >> 2) + 4 * n + (i & 3); }

struct Unit { int pm, pn, pb; };
struct Gemm { const bf16_t* A; const bf16_t* Bt; int M, N, K; };

struct StaticOrder {
    int nM, nN, nwg, G, c, nlim;
    __host__ __device__ void init(int M, int N, int G_, int c_) { nM = M / BM; nN = N / BM; nwg = nM * nN; G = G_; c = c_; nlim = nwg; }
    __host__ __device__ bool next(int i, Unit& u) const { const long L = (long)i * G + c; if (L >= nlim) return false; unit_at((int)L, u); return true; }
    __host__ __device__ void unit_at(int Lu, Unit& u) const {
        int wgid = Lu; { const int q = nwg / NXCD, r = nwg % NXCD, xcd = wgid % NXCD, off = wgid / NXCD; wgid = (xcd < r ? xcd * (q + 1) : r * (q + 1) + (xcd - r) * q) + off; }
        const int nig = WGM * nN, gid = wgid / nig, fm = gid * WGM, gsz = (nM - fm) < WGM ? (nM - fm) : WGM;
        u.pm = fm + ((wgid % nig) % gsz); u.pn = (wgid % nig) / gsz; u.pb = u.pn;
    }
    __device__ __forceinline__ void a_ready(const Unit&) const {}
    __device__ __forceinline__ void done(const Unit&) const {}
};

typedef float f32x2c __attribute__((ext_vector_type(2))); typedef __bf16 bf16x2c __attribute__((ext_vector_type(2)));
__device__ __forceinline__ unsigned cvt_pk_bf16(float lo, float hi) { f32x2c v = {lo, hi}; bf16x2c b = __builtin_convertvector(v, bf16x2c); return __builtin_bit_cast(unsigned, b); }
typedef float f32x2 __attribute__((ext_vector_type(2)));

template <int ACT  > struct EpiBf16 {
    static constexpr bool PERM = true, AFTER_DRAIN = false; static_assert(ACT == 0, "EpiBf16: only ACT 0 here");
    bf16_t* O; int ldc; const float* bias; int split_cols; size_t split_stride; float scale0;
    __device__ __forceinline__ void operator()(const f32x4 (&acc)[2][2][4][2], const Unit& u, int wr, int wc, int fr, int fq) const {
        const int row0 = u.pm * BM + wr * 64 + fr; int colt = u.pn * BM; bf16_t* base = O;
        float sc = 1.f; if (split_cols) { const int t = colt / split_cols; base += (size_t)t * split_stride; colt -= t * split_cols; if (t == 0) sc = scale0; }
        const int col0 = colt + wc * 32 + 8 * fq, bcol0 = u.pn * BM + wc * 32 + 8 * fq;
        f32x4 bv[2][2];
#pragma unroll
        for (int bj = 0; bj < 2; ++bj)
#pragma unroll
            for (int n = 0; n < 2; ++n) bv[bj][n] = bias ? *(const f32x4*)(bias + bcol0 + bj * HALF + 4 * n) : (f32x4){0.f, 0.f, 0.f, 0.f};
#pragma unroll
        for (int ai = 0; ai < 2; ++ai)
#pragma unroll
            for (int m = 0; m < 4; ++m) { bf16_t* rowp = base + (size_t)(row0 + ai * HALF + m * 16) * ldc + col0;
#pragma unroll
                for (int bj = 0; bj < 2; ++bj) { f32x4 v0 = acc[ai][bj][m][0] + bv[bj][0], v1 = acc[ai][bj][m][1] + bv[bj][1];
                    v0 = v0 * sc; v1 = v1 * sc; u32x4 w; w.x = cvt_pk_bf16(v0[0], v0[1]); w.y = cvt_pk_bf16(v0[2], v0[3]); w.z = cvt_pk_bf16(v1[0], v1[1]); w.w = cvt_pk_bf16(v1[2], v1[3]);
                    *(u32x4*)(rowp + bj * HALF) = w; } }
    }
};

__device__ __forceinline__ float silu_f(float x) { return x * __builtin_amdgcn_rcpf(1.0f + __builtin_amdgcn_exp2f(-1.4426950408889634f * x)); }
__device__ __forceinline__ float gelu_tanh_f(float x) { const float u = x * (0.7978845608028654f + 0.035677408136300125f * x * x);
    return x * __builtin_amdgcn_rcpf(1.0f + __builtin_amdgcn_exp2f(-2.0f * 1.4426950408889634f * u)); }
struct EpiResF32 {
    static constexpr bool PERM = false, AFTER_DRAIN = false;
    const float* base; float* out; int ldc;
    __device__ __forceinline__ void operator()(const f32x4 (&acc)[2][2][4][2], const Unit& u, int wr, int wc, int fr, int fq) const {
        const int row0 = u.pm * BM + wr * 64 + fr, col0 = u.pn * BM + wc * 32 + 4 * fq;
#pragma unroll
        for (int ai = 0; ai < 2; ++ai)
#pragma unroll
            for (int m = 0; m < 4; ++m) { const size_t off = (size_t)(row0 + ai * HALF + m * 16) * ldc + col0;
                f32x4 b[2][2];
#pragma unroll
                for (int bj = 0; bj < 2; ++bj)
#pragma unroll
                    for (int n = 0; n < 2; ++n) b[bj][n] = *(const f32x4*)(base + off + bj * HALF + n * 16);
#pragma unroll
                for (int bj = 0; bj < 2; ++bj)
#pragma unroll
                    for (int n = 0; n < 2; ++n) *(f32x4*)(out + off + bj * HALF + n * 16) = b[bj][n] + acc[ai][bj][m][n];
                asm volatile("" ::: "memory"); }
    }
};
__device__ __forceinline__ unsigned dpp_xor8(unsigned x) { return (unsigned)__builtin_amdgcn_update_dpp(0, (int)x, 0x128  , 0xf, 0xf, true); }
__device__ __forceinline__ u32x4 dpp_xor8(const u32x4 v) { return (u32x4){dpp_xor8(v.x), dpp_xor8(v.y), dpp_xor8(v.z), dpp_xor8(v.w)}; }
__device__ __forceinline__ void p2_to_rows(const u32x4 w0, const u32x4 w1, bool lo, u32x4& a, u32x4& b) { const u32x4 x = lo ? w1 : w0; const u32x4 r = dpp_xor8(x); a = lo ? w0 : r; b = lo ? r : w1; }
__device__ __forceinline__ void p2_from_rows(const u32x4 a, const u32x4 b, bool lo, u32x4& w0, u32x4& w1) { const u32x4 x = lo ? b : a; const u32x4 r = dpp_xor8(x); w0 = lo ? a : r; w1 = lo ? r : b; }
template <class BaseT> struct EpiResX {
    static constexpr bool PERM = true, AFTER_DRAIN = false, PERM2 = sizeof(BaseT) == 2;
    const BaseT* base; bf16_t* out; int ldc;
    __device__ __forceinline__ void operator()(const f32x4 (&acc)[2][2][4][2], const Unit& u, int wr, int wc, int fr_, int fq_) const {
        int fr = fr_, fq = fq_; asm volatile("" : "+v"(fr), "+v"(fq));
        if constexpr (PERM2) {
            const bool lo = (fr & 8) == 0;
            const int row0 = u.pm * BM + wr * 64 + (fr & 7), col0 = u.pn * BM + wc * 64 + (lo ? 0 : 32) + 8 * fq;
#pragma unroll
            for (int ai = 0; ai < 2; ++ai) { u32x4 ra[4], rb[4];
#pragma unroll
                for (int m = 0; m < 4; ++m) { const bf16_t* bp = (const bf16_t*)base + (size_t)(row0 + ai * HALF + m * 16) * ldc + col0; ra[m] = *(const u32x4*)bp; rb[m] = *(const u32x4*)(bp + (size_t)8 * ldc); }
#pragma unroll
                for (int m = 0; m < 4; ++m) { u32x4 x[2]; p2_from_rows(ra[m], rb[m], lo, x[0], x[1]); u32x4 w[2];
#pragma unroll
                    for (int bj = 0; bj < 2; ++bj) { const f32x4 a0 = acc[ai][bj][m][0], a1 = acc[ai][bj][m][1]; const u32x4 xx = x[bj];
                        w[bj].x = cvt_pk_bf16(__builtin_bit_cast(float, xx.x << 16) + a0[0], __builtin_bit_cast(float, xx.x & 0xffff0000u) + a0[1]); w[bj].y = cvt_pk_bf16(__builtin_bit_cast(float, xx.y << 16) + a0[2], __builtin_bit_cast(float, xx.y & 0xffff0000u) + a0[3]);
                        w[bj].z = cvt_pk_bf16(__builtin_bit_cast(float, xx.z << 16) + a1[0], __builtin_bit_cast(float, xx.z & 0xffff0000u) + a1[1]); w[bj].w = cvt_pk_bf16(__builtin_bit_cast(float, xx.w << 16) + a1[2], __builtin_bit_cast(float, xx.w & 0xffff0000u) + a1[3]); }
                    u32x4 a, b; p2_to_rows(w[0], w[1], lo, a, b);
                    bf16_t* op = out + (size_t)(row0 + ai * HALF + m * 16) * ldc + col0; *(u32x4*)op = a; *(u32x4*)(op + (size_t)8 * ldc) = b; }
                asm volatile("" ::: "memory"); }
        } else {
        const int row0 = u.pm * BM + wr * 64 + fr, col0 = u.pn * BM + wc * 32 + 8 * fq;
#pragma unroll
        for (int ai = 0; ai < 2; ++ai) {
            f32x4 b0[4][2], b1[4][2];
#pragma unroll
            for (int m = 0; m < 4; ++m) { const size_t off = (size_t)(row0 + ai * HALF + m * 16) * ldc + col0;
#pragma unroll
                for (int bj = 0; bj < 2; ++bj) { b0[m][bj] = *(const f32x4*)((const float*)base + off + bj * HALF); b1[m][bj] = *(const f32x4*)((const float*)base + off + bj * HALF + 4); } }
#pragma unroll
            for (int m = 0; m < 4; ++m) { const size_t off = (size_t)(row0 + ai * HALF + m * 16) * ldc + col0;
#pragma unroll
                for (int bj = 0; bj < 2; ++bj) { const f32x4 v0 = b0[m][bj] + acc[ai][bj][m][0], v1 = b1[m][bj] + acc[ai][bj][m][1];
                    u32x4 w; w.x = cvt_pk_bf16(v0[0], v0[1]); w.y = cvt_pk_bf16(v0[2], v0[3]); w.z = cvt_pk_bf16(v1[0], v1[1]); w.w = cvt_pk_bf16(v1[2], v1[3]);
                    *(u32x4*)(out + off + bj * HALF) = w; } }
            asm volatile("" ::: "memory"); }
        }
    }
};
struct EpiMoeDownX {
    static constexpr bool PERM = true, AFTER_DRAIN = false, PERM2 = true;
    bf16_t* out; int ldc; const int* tok; const float* gatev;
    __device__ __forceinline__ void operator()(const f32x4 (&acc)[2][2][4][2], const Unit& u, int wr, int wc, int fr_, int fq_) const {
        int fr = fr_, fq = fq_; asm volatile("" : "+v"(fr), "+v"(fq));
        const bool lo = (fr & 8) == 0;
        const int row0 = u.pm * BM + wr * 64, col0 = u.pn * BM + wc * 64 + (lo ? 0 : 32) + 8 * fq;
        int ta[2][4], tb[2][4]; float gr[2][4];
#pragma unroll
        for (int ai = 0; ai < 2; ++ai)
#pragma unroll
            for (int m = 0; m < 4; ++m) { const int r = row0 + ai * HALF + m * 16; ta[ai][m] = tok[r + (fr & 7)]; tb[ai][m] = tok[r + 8 + (fr & 7)]; gr[ai][m] = gatev[r + fr]; }
#pragma unroll
        for (int ai = 0; ai < 2; ++ai) { u32x4 ra[4], rb[4];
#pragma unroll
            for (int m = 0; m < 4; ++m) { const int t0 = ta[ai][m] < 0 ? 0 : ta[ai][m], t1 = tb[ai][m] < 0 ? 0 : tb[ai][m];
                ra[m] = *(const u32x4*)(out + (size_t)t0 * ldc + col0); rb[m] = *(const u32x4*)(out + (size_t)t1 * ldc + col0); }
#pragma unroll
            for (int m = 0; m < 4; ++m) { const float g = gr[ai][m]; u32x4 x[2]; p2_from_rows(ra[m], rb[m], lo, x[0], x[1]); u32x4 w[2];
#pragma unroll
                for (int bj = 0; bj < 2; ++bj) { const f32x4 a0 = acc[ai][bj][m][0] * g, a1 = acc[ai][bj][m][1] * g; const u32x4 xx = x[bj];
                    w[bj].x = cvt_pk_bf16(__builtin_bit_cast(float, xx.x << 16) + a0[0], __builtin_bit_cast(float, xx.x & 0xffff0000u) + a0[1]); w[bj].y = cvt_pk_bf16(__builtin_bit_cast(float, xx.y << 16) + a0[2], __builtin_bit_cast(float, xx.y & 0xffff0000u) + a0[3]);
                    w[bj].z = cvt_pk_bf16(__builtin_bit_cast(float, xx.z << 16) + a1[0], __builtin_bit_cast(float, xx.z & 0xffff0000u) + a1[1]); w[bj].w = cvt_pk_bf16(__builtin_bit_cast(float, xx.w << 16) + a1[2], __builtin_bit_cast(float, xx.w & 0xffff0000u) + a1[3]); }
                u32x4 a, b; p2_to_rows(w[0], w[1], lo, a, b);
                if (ta[ai][m] >= 0) *(u32x4*)(out + (size_t)ta[ai][m] * ldc + col0) = a;
                if (tb[ai][m] >= 0) *(u32x4*)(out + (size_t)tb[ai][m] * ldc + col0) = b; }
            asm volatile("" ::: "memory"); }
    }
};
struct EpiSwiglu {
    static constexpr bool PERM = true, AFTER_DRAIN = false;
    bf16_t* O; int ldc;
    __device__ __forceinline__ void operator()(const f32x4 (&acc)[2][2][4][2], const Unit& u, int wr, int wc, int fr, int fq) const {
        const int row0 = u.pm * BM + wr * 64 + fr, col0 = u.pn * HALF + wc * 32 + 8 * fq;
#pragma unroll
        for (int ai = 0; ai < 2; ++ai)
#pragma unroll
            for (int m = 0; m < 4; ++m) { bf16_t* rowp = O + (size_t)(row0 + ai * HALF + m * 16) * ldc + col0;
                const f32x4 g0 = acc[ai][0][m][0], g1 = acc[ai][0][m][1], u0 = acc[ai][1][m][0], u1 = acc[ai][1][m][1];
                u32x4 w; w.x = cvt_pk_bf16(silu_f(g0[0]) * u0[0], silu_f(g0[1]) * u0[1]); w.y = cvt_pk_bf16(silu_f(g0[2]) * u0[2], silu_f(g0[3]) * u0[3]);
                w.z = cvt_pk_bf16(silu_f(g1[0]) * u1[0], silu_f(g1[1]) * u1[1]); w.w = cvt_pk_bf16(silu_f(g1[2]) * u1[2], silu_f(g1[3]) * u1[3]);
                *(u32x4*)rowp = w; }
    }
};
struct EpiWin {
    static constexpr bool PERM = true, AFTER_DRAIN = false;
    bf16_t* G; bf16_t* XB; int ldc; int nsplit;
    __device__ __forceinline__ void operator()(const f32x4 (&acc)[2][2][4][2], const Unit& u, int wr, int wc, int fr, int fq) const {
        const bool isg = u.pn < nsplit; bf16_t* base = isg ? G : XB; const int colt = (isg ? u.pn : u.pn - nsplit) * BM;
        const int row0 = u.pm * BM + wr * 64 + fr, col0 = colt + wc * 32 + 8 * fq;
#pragma unroll
        for (int ai = 0; ai < 2; ++ai)
#pragma unroll
            for (int m = 0; m < 4; ++m) { bf16_t* rowp = base + (size_t)(row0 + ai * HALF + m * 16) * ldc + col0;
#pragma unroll
                for (int bj = 0; bj < 2; ++bj) { f32x4 v0 = acc[ai][bj][m][0], v1 = acc[ai][bj][m][1];
                    if (isg) { v0 = (f32x4){gelu_tanh_f(v0[0]), gelu_tanh_f(v0[1]), gelu_tanh_f(v0[2]), gelu_tanh_f(v0[3])}; v1 = (f32x4){gelu_tanh_f(v1[0]), gelu_tanh_f(v1[1]), gelu_tanh_f(v1[2]), gelu_tanh_f(v1[3])}; }
                    u32x4 w; w.x = cvt_pk_bf16(v0[0], v0[1]); w.y = cvt_pk_bf16(v0[2], v0[3]); w.z = cvt_pk_bf16(v1[0], v1[1]); w.w = cvt_pk_bf16(v1[2], v1[3]);
                    *(u32x4*)(rowp + bj * HALF) = w; } }
    }
};
struct EpiMoeDown {
    static constexpr bool PERM = false, AFTER_DRAIN = false;
    float* out; int ldc; const int* tok; const float* gatev;
    __device__ __forceinline__ void operator()(const f32x4 (&acc)[2][2][4][2], const Unit& u, int wr, int wc, int fr, int fq) const {
        const int row0 = u.pm * BM + wr * 64 + fr, col0 = u.pn * BM + wc * 32 + 4 * fq;
#pragma unroll
        for (int ai = 0; ai < 2; ++ai)
#pragma unroll
            for (int m = 0; m < 4; ++m) { const int r = row0 + ai * HALF + m * 16; const int t = tok[r]; const float g = gatev[r];
                if (t >= 0) { float* o = out + (size_t)t * ldc + col0; f32x4 b[2][2];
#pragma unroll
                    for (int bj = 0; bj < 2; ++bj)
#pragma unroll
                        for (int n = 0; n < 2; ++n) b[bj][n] = *(const f32x4*)(o + bj * HALF + n * 16);
#pragma unroll
                    for (int bj = 0; bj < 2; ++bj)
#pragma unroll
                        for (int n = 0; n < 2; ++n) *(f32x4*)(o + bj * HALF + n * 16) = b[bj][n] + acc[ai][bj][m][n] * g; }
                asm volatile("" ::: "memory"); }
    }
};
__device__ __forceinline__ f32x4 cvt4(const i32x4 a, const f32x4 s) { return (f32x4){(float)a[0] * s[0], (float)a[1] * s[1], (float)a[2] * s[2], (float)a[3] * s[3]}; }
struct EpiBf16Q {
    static constexpr bool PERM = true, AFTER_DRAIN = false, PERM2 = true;
    bf16_t* O; int ldc; int split_cols; size_t split_stride; float scale0; const float* sa; const float* sb;
    __device__ __forceinline__ void operator()(const i32x4 (&acc)[2][2][4][2], const Unit& u, int wr, int wc, int fr, int fq) const {
        const int row0 = u.pm * BM + wr * 64; int colt = u.pn * BM; bf16_t* base = O;
        float sc = 1.f; if (split_cols) { const int t = colt / split_cols; base += (size_t)t * split_stride; colt -= t * split_cols; if (t == 0) sc = scale0; }
        const bool lo = (fr & 8) == 0;
        const int col0 = colt + wc * 64 + (lo ? 0 : 32) + 8 * fq, bcol0 = u.pb * BM + wc * 64 + 8 * fq;
        f32x4 sv[2][2];
#pragma unroll
        for (int bj = 0; bj < 2; ++bj)
#pragma unroll
            for (int n = 0; n < 2; ++n) sv[bj][n] = *(const f32x4*)(sb + bcol0 + bj * 32 + 4 * n) * sc;
        float sar[2][4];
#pragma unroll
        for (int ai = 0; ai < 2; ++ai)
#pragma unroll
            for (int m = 0; m < 4; ++m) sar[ai][m] = sa[row0 + fr + ai * HALF + m * 16];
#pragma unroll
        for (int ai = 0; ai < 2; ++ai)
#pragma unroll
            for (int m = 0; m < 4; ++m) { const float s = sar[ai][m]; u32x4 w[2];
#pragma unroll
                for (int bj = 0; bj < 2; ++bj) { const f32x4 v0 = cvt4(acc[ai][bj][m][0], sv[bj][0] * s), v1 = cvt4(acc[ai][bj][m][1], sv[bj][1] * s);
                    w[bj].x = cvt_pk_bf16(v0[0], v0[1]); w[bj].y = cvt_pk_bf16(v0[2], v0[3]); w[bj].z = cvt_pk_bf16(v1[0], v1[1]); w[bj].w = cvt_pk_bf16(v1[2], v1[3]); }
                u32x4 a, b; p2_to_rows(w[0], w[1], lo, a, b);
                bf16_t* rowp = base + (size_t)(row0 + ai * HALF + m * 16 + (fr & 7)) * ldc + col0;
                *(u32x4*)rowp = a; *(u32x4*)(rowp + (size_t)8 * ldc) = b; }
    }
};
struct EpiSwigluQ {
    static constexpr bool PERM = true, AFTER_DRAIN = false, LDS_SCALES = true;
    bf16_t* O; int ldc; const float* sa; const float* sb; const int* tok;
    __device__ __forceinline__ const float* sa_ptr(const Unit& u) const { return sa + (size_t)u.pm * BM; }
    __device__ __forceinline__ const float* sb_ptr(const Unit& u) const { return sb + (size_t)u.pb * BM; }
    __device__ __forceinline__ void operator()(const i32x4 (&acc)[2][2][4][2], const Unit& u, int wr, int wc, int fr_, int fq_, const PG8_LAS float* scl) const {
        int fr = fr_, fq = fq_; asm volatile("" : "+v"(fr), "+v"(fq));
        const int row0 = u.pm * BM + wr * 64 + fr, col0 = u.pn * HALF + wc * 32 + 8 * fq, bcol0 = u.pb * BM + wc * 32 + 8 * fq;
        f32x4 sv[2][2];
#pragma unroll
        for (int bj = 0; bj < 2; ++bj)
#pragma unroll
            for (int n = 0; n < 2; ++n) sv[bj][n] = *(const PG8_LAS f32x4*)(scl + 256 + wc * 32 + 8 * fq + bj * HALF + 4 * n);
        float sar[2][4];
#pragma unroll
        for (int ai = 0; ai < 2; ++ai)
#pragma unroll
            for (int m = 0; m < 4; ++m) sar[ai][m] = scl[wr * 64 + fr + ai * HALF + m * 16];
#pragma unroll
        for (int n = 0; n < 2; ++n) { sv[1][n] = sv[0][n] * sv[1][n]; sv[0][n] = sv[0][n] * -1.4426950408889634f; }
#pragma unroll
        for (int ai = 0; ai < 2; ++ai)
#pragma unroll
            for (int m = 0; m < 4; ++m) { const int r = row0 + ai * HALF + m * 16; const float s = sar[ai][m];
                bf16_t* rowp = O + (size_t)r * ldc + col0;
                const float s2 = s * s; f32x4 o4[2];
#pragma unroll
                for (int n = 0; n < 2; ++n) { const i32x4 gi = acc[ai][0][m][n], ui = acc[ai][1][m][n];
                    const f32x4 gf = {(float)gi[0], (float)gi[1], (float)gi[2], (float)gi[3]}, uf = {(float)ui[0], (float)ui[1], (float)ui[2], (float)ui[3]};
                    const f32x4 ea = gf * (sv[0][n] * s), pr = (gf * uf) * (sv[1][n] * s2);
                    const f32x4 ev = {__builtin_amdgcn_exp2f(ea[0]), __builtin_amdgcn_exp2f(ea[1]), __builtin_amdgcn_exp2f(ea[2]), __builtin_amdgcn_exp2f(ea[3])}; const f32x4 dn = ev + 1.0f;
                    o4[n] = pr * (f32x4){__builtin_amdgcn_rcpf(dn[0]), __builtin_amdgcn_rcpf(dn[1]), __builtin_amdgcn_rcpf(dn[2]), __builtin_amdgcn_rcpf(dn[3])}; }
                u32x4 w; w.x = cvt_pk_bf16(o4[0][0], o4[0][1]); w.y = cvt_pk_bf16(o4[0][2], o4[0][3]); w.z = cvt_pk_bf16(o4[1][0], o4[1][1]); w.w = cvt_pk_bf16(o4[1][2], o4[1][3]);
                *(u32x4*)rowp = w; }
    }
};
struct EpiWinQ {
    static constexpr bool PERM = true, AFTER_DRAIN = false, PERM2 = true;
    bf16_t* G; bf16_t* XB; int ldc; int nsplit; const float* sa; const float* sb;
    __device__ __forceinline__ void operator()(const i32x4 (&acc)[2][2][4][2], const Unit& u, int wr, int wc, int fr, int fq) const {
        const bool isg = u.pn < nsplit; bf16_t* base = isg ? G : XB; const int colt = (isg ? u.pn : u.pn - nsplit) * BM;
        const bool lo = (fr & 8) == 0;
        const int row0 = u.pm * BM + wr * 64, col0 = colt + wc * 64 + (lo ? 0 : 32) + 8 * fq, bcol0 = u.pb * BM + wc * 64 + 8 * fq;
        f32x4 sv[2][2];
#pragma unroll
        for (int bj = 0; bj < 2; ++bj)
#pragma unroll
            for (int n = 0; n < 2; ++n) sv[bj][n] = *(const f32x4*)(sb + bcol0 + bj * 32 + 4 * n);
        float sar[2][4];
#pragma unroll
        for (int ai = 0; ai < 2; ++ai)
#pragma unroll
            for (int m = 0; m < 4; ++m) sar[ai][m] = sa[row0 + fr + ai * HALF + m * 16];
#pragma unroll
        for (int ai = 0; ai < 2; ++ai)
#pragma unroll
            for (int m = 0; m < 4; ++m) { const float s = sar[ai][m]; u32x4 w[2];
#pragma unroll
                for (int bj = 0; bj < 2; ++bj) { f32x4 v0 = cvt4(acc[ai][bj][m][0], sv[bj][0] * s), v1 = cvt4(acc[ai][bj][m][1], sv[bj][1] * s);
                    if (isg) { v0 = (f32x4){gelu_tanh_f(v0[0]), gelu_tanh_f(v0[1]), gelu_tanh_f(v0[2]), gelu_tanh_f(v0[3])}; v1 = (f32x4){gelu_tanh_f(v1[0]), gelu_tanh_f(v1[1]), gelu_tanh_f(v1[2]), gelu_tanh_f(v1[3])}; }
                    w[bj].x = cvt_pk_bf16(v0[0], v0[1]); w[bj].y = cvt_pk_bf16(v0[2], v0[3]); w[bj].z = cvt_pk_bf16(v1[0], v1[1]); w[bj].w = cvt_pk_bf16(v1[2], v1[3]); }
                u32x4 a, b; p2_to_rows(w[0], w[1], lo, a, b);
                bf16_t* rowp = base + (size_t)(row0 + ai * HALF + m * 16 + (fr & 7)) * ldc + col0;
                *(u32x4*)rowp = a; *(u32x4*)(rowp + (size_t)8 * ldc) = b; }
    }
};
struct MoeOrder : StaticOrder {
    const unsigned short* tok16; const PG8_LAS int* pexp; int nNe;
    __device__ void init_moe(int rows, int N, int G_, int c_, const unsigned short* tok16_, const PG8_LAS int* pexp_) { init(rows, N, G_, c_); tok16 = tok16_; pexp = pexp_; nNe = N / BM; }
    __device__ __forceinline__ bool next(int i, Unit& u) const {
        if (!StaticOrder::next(i, u)) return false;
        u.pm = __builtin_amdgcn_readfirstlane(u.pm); u.pn = __builtin_amdgcn_readfirstlane(u.pn);
        const int e = __builtin_amdgcn_readfirstlane(pexp[u.pm]);
        u.pb = __builtin_amdgcn_readfirstlane(e * nNe + u.pn); return true; }
};


template <bool I8> struct AccT { typedef f32x4 type; };
template <> struct AccT<true> { typedef i32x4 type; };
template <class E, class = void> struct EpiPerm2 { static constexpr bool value = false; };
template <class E> struct EpiPerm2<E, decltype((void)E::PERM2)> { static constexpr bool value = E::PERM2; };
template <class E, class = void> struct EpiLdsScales { static constexpr bool value = false; };
template <class E> struct EpiLdsScales<E, decltype((void)E::LDS_SCALES)> { static constexpr bool value = E::LDS_SCALES; };
constexpr int SCL_OFF = 135168 + 4096;
template <class Epi, class Sched, bool ALIGN_EPI = false, bool SP2 = false, bool GATHER = false, bool I8 = false>
__device__ __forceinline__ void gemm_phase(PG8_LAS unsigned char* lds, const Gemm g, const Sched& S, const Epi& E) {
    int tid_ = threadIdx.x; asm volatile("" : "+v"(tid_));
    const int tid = tid_, wid = __builtin_amdgcn_readfirstlane(tid >> 6), lane = tid & 63, wr = wid >> 2, wc = wid & 3, fr = lane & 15, fq = lane >> 4;
    static_assert(!GATHER || SP2, "GATHER is written for the SP2 loop");
    const int K = g.K, nt = K / BK;
    unsigned voffA[1], voffB[1]; const unsigned k128 = (unsigned)K * 128u;
    constexpr bool P2 = EpiPerm2<Epi>::value;
    { int R, C; stage_rc(tid * 16, R, C); const int Rb = P2 ? (64 * (R >> 5) + perm32(R & 31)) : (Epi::PERM ? ((R & ~31) + perm32(R & 31)) : R);
        voffA[0] = (unsigned)(R * K + C) * 2u; voffB[0] = (unsigned)(Rb * K + C) * 2u; }
    const unsigned kB128 = P2 ? 2u * k128 : k128;
    unsigned tk[2] = {0u, 0u}, tn[2] = {0u, 0u}; unsigned cC2 = 0; int gR0 = 0;
    if constexpr (GATHER) { int R_, C_; stage_rc(tid * 16, R_, C_); gR0 = R_; cC2 = (unsigned)C_ * 2u; }
#define PG8_GTOK(dst, u) do { _Pragma("unroll") for (int _h = 0; _h < 2; ++_h) { const unsigned* p_ = (const unsigned*)S.tok16 + (((u).pm * 2 + _h) * 64 + gR0); \
        asm volatile("global_load_dword %0, %1, off" : "=v"(dst[_h]) : "v"(p_) : "memory"); } } while (0)
#define PG8_TQ(x) ({ unsigned q_ = (x); asm volatile("" : "+v"(q_)); q_; })
    const size_t kstep = (size_t)(BK * 2);
    const size_t hstep = (size_t)HALF * K * 2;
    const size_t tstep = 2 * hstep;
    const size_t hstepB = P2 ? (size_t)32 * K * 2 : hstep;
    const unsigned ldsw = (unsigned)wid * 1024u;
    const int aoff = lds_byte(wr * 64 + fr, fq * 8), boff = lds_byte(wc * 32 + fr, fq * 8);
#define PG8_SA(b, h) (((b) * 2 + (h)) * HTB)
#define PG8_SB(b, h) ((4 + (b) * 2 + (h)) * HTB)
#define PG8_STAGE(bufoff, gbase, voff) do { _Pragma("unroll") for (int _i = 0; _i < 2; ++_i) \
        __builtin_amdgcn_global_load_lds((const unsigned*)((const char*)(gbase) + ((voff)[0] + _i * k128)), (PG8_LAS unsigned*)(lds + (bufoff) + ldsw + _i * 8192), 16, 0, 0); } while (0)
#define PG8_STAGEB(bufoff, gbase) do { _Pragma("unroll") for (int _i = 0; _i < 2; ++_i) \
        __builtin_amdgcn_global_load_lds((const unsigned*)((const char*)(gbase) + (voffB[0] + _i * kB128)), (PG8_LAS unsigned*)(lds + (bufoff) + ldsw + _i * 8192), 16, 0, 0); } while (0)
#define PG8_SCALES(un, par) do { if constexpr (EpiLdsScales<Epi>::value) { if (wid < 2) { const float* sp_ = (wid == 0 ? E.sa_ptr(un) : E.sb_ptr(un)) + 4 * lane; \
        __builtin_amdgcn_global_load_lds((const unsigned*)sp_, (PG8_LAS unsigned*)(lds + SCL_OFF + (par) * 2048 + wid * 1024), 16, 0, 0); } } } while (0)
#define PG8_STAGEG(bufoff, gbase, tkw) do { _Pragma("unroll") for (int _i = 0; _i < 2; ++_i) { const unsigned _o = (((tkw) >> (16 * _i)) & 0xffffu) * (unsigned)(K * 2) + cC2; \
        __builtin_amdgcn_global_load_lds((const unsigned*)((const char*)(gbase) + _o), (PG8_LAS unsigned*)(lds + (bufoff) + ldsw + _i * 8192), 16, 0, 0); } } while (0)
#define PG8_STA(bufoff, ptr, h, nx) do { if constexpr (GATHER) { if (nx) { const unsigned tq_ = PG8_TQ(tn[h]); PG8_STAGEG(bufoff, ptr, tq_); } else PG8_STAGEG(bufoff, ptr, tk[h]); } else PG8_STAGE(bufoff, (ptr) + (h) * hstep, voffA); } while (0)
#define PG8_LDA(dst, b, h) do { _Pragma("unroll") for (int m = 0; m < 4; ++m) _Pragma("unroll") for (int k = 0; k < 2; ++k) dst[m][k] = *(const PG8_LAS bf16x8*)(lds + PG8_SA(b, h) + aoff + m * 2048 + k * 1024); } while (0)
#define PG8_LDB(dst, b, h) do { _Pragma("unroll") for (int n = 0; n < 2; ++n) _Pragma("unroll") for (int k = 0; k < 2; ++k) dst[n][k] = *(const PG8_LAS bf16x8*)(lds + PG8_SB(b, h) + boff + n * 2048 + k * 1024); } while (0)
#define PG8_MMA(ai, bj, At, Bt) do { __builtin_amdgcn_s_setprio(1); _Pragma("unroll") for (int m = 0; m < 4; ++m) _Pragma("unroll") for (int n = 0; n < 2; ++n) _Pragma("unroll") for (int k = 0; k < 2; ++k) \
        { if constexpr (I8) acc[ai][bj][m][n] = __builtin_amdgcn_mfma_i32_16x16x64_i8(__builtin_bit_cast(i32x4, Bt[n][k]), __builtin_bit_cast(i32x4, At[m][k]), acc[ai][bj][m][n], 0, 0, 0); \
          else acc[ai][bj][m][n] = __builtin_amdgcn_mfma_f32_16x16x32_bf16(Bt[n][k], At[m][k], acc[ai][bj][m][n], 0, 0, 0); } __builtin_amdgcn_s_setprio(0); } while (0)
#define PG8_WAIT_V(n) asm volatile("s_waitcnt vmcnt(" #n ")" ::: "memory")
#define PG8_WAIT_L(n) asm volatile("s_waitcnt lgkmcnt(" #n ")" ::: "memory")
#define PG8_BAR __builtin_amdgcn_s_barrier()
#define PG8_SCHED __builtin_amdgcn_sched_barrier(0)
    Unit cur, nxt; int ui = 0;
    if (!S.next(0, cur)) return;
    typedef typename AccT<I8>::type acc_t;
    acc_t acc[2][2][4][2];
#define PG8_ZERO_ACC() do { bf16x8 z_ = {0, 0, 0, 0, 0, 0, 0, 0}; asm volatile("" : "+v"(z_)); _Pragma("unroll") for (int a = 0; a < 2; ++a) _Pragma("unroll") for (int b = 0; b < 2; ++b) _Pragma("unroll") for (int m = 0; m < 4; ++m) _Pragma("unroll") for (int n = 0; n < 2; ++n) { \
        if constexpr (I8) acc[a][b][m][n] = __builtin_amdgcn_mfma_i32_16x16x64_i8(__builtin_bit_cast(i32x4, z_), __builtin_bit_cast(i32x4, z_), (i32x4){0, 0, 0, 0}, 0, 0, 0); \
        else acc[a][b][m][n] = __builtin_amdgcn_mfma_f32_16x16x32_bf16(z_, z_, (f32x4){0.f, 0.f, 0.f, 0.f}, 0, 0, 0); } } while (0)
    PG8_ZERO_ACC();
    bf16x8 At[4][2], B0[2][2], B1[2][2];
    const char* cA = GATHER ? (const char*)g.A : (const char*)g.A + (size_t)cur.pm * tstep; const char* cB = (const char*)g.Bt + (size_t)cur.pb * tstep;
    if constexpr (GATHER) { PG8_GTOK(tk, cur); asm volatile("s_waitcnt vmcnt(0)" ::: "memory"); tk[0] = PG8_TQ(tk[0]); tk[1] = PG8_TQ(tk[1]); }
    if constexpr (GATHER) { Unit u1_; const bool h1_ = S.next(1, u1_); Unit un_; un_.pm = h1_ ? u1_.pm : cur.pm; un_.pn = 0; un_.pb = 0; PG8_GTOK(tn, un_); }
    PG8_SCALES(cur, 0);
    S.a_ready(cur);
    if constexpr (SP2) {
        PG8_STAGEB(PG8_SB(0, 0), cB); PG8_STAGEB(PG8_SB(0, 1), cB + hstepB); PG8_STA(PG8_SA(0, 0), cA, 0, false); PG8_STA(PG8_SA(0, 1), cA, 1, false);
        if (wr == 1) PG8_BAR;
        PG8_WAIT_V(2); PG8_BAR;
        PG8_STAGEB(PG8_SB(1, 0), cB + kstep); PG8_STA(PG8_SA(1, 0), cA + kstep, 0, false); PG8_STAGEB(PG8_SB(1, 1), cB + hstepB + kstep);
        PG8_WAIT_V(6); PG8_BAR;
    } else {
        PG8_STAGEB(PG8_SB(0, 0), cB); PG8_STAGE(PG8_SA(0, 0), cA, voffA); PG8_STAGEB(PG8_SB(0, 1), cB + hstepB); PG8_STAGE(PG8_SA(0, 1), cA + hstep, voffA);
        if (wr == 1) PG8_BAR;
        PG8_WAIT_V(4); PG8_BAR;
        PG8_STAGEB(PG8_SB(1, 0), cB + kstep); PG8_STAGE(PG8_SA(1, 0), cA + kstep, voffA); PG8_STAGEB(PG8_SB(1, 1), cB + hstepB + kstep);
        PG8_WAIT_V(6); PG8_BAR;
    }
    for (;;) {
        const bool has_next = S.next(ui + 1, nxt);
        const char* nA = GATHER ? (const char*)g.A : (has_next ? (const char*)g.A + (size_t)nxt.pm * tstep : cA); const char* nB = has_next ? (const char*)g.Bt + (size_t)nxt.pb * tstep : cB;
        for (int t = 0; t < nt; t += 2) {
            const bool last = (t == nt - 2);
            const char* a1 = cA + (size_t)(t + 1) * kstep;
            const char* a2 = last ? nA : cA + (size_t)(t + 2) * kstep; const char* b2 = last ? nB : cB + (size_t)(t + 2) * kstep;
            const char* a3 = a2 + kstep; const char* b3 = b2 + kstep;
            if (last && has_next) S.a_ready(nxt);
            if constexpr (SP2) {
            PG8_LDB(B0, 0, 0); PG8_LDB(B1, 0, 1); PG8_SCHED; PG8_LDA(At, 0, 0); PG8_STA(PG8_SA(1, 1), a1, 1, false);
            PG8_WAIT_V(8); PG8_WAIT_L(0); PG8_BAR; PG8_MMA(0, 0, At, B0); PG8_MMA(0, 1, At, B1); PG8_BAR; PG8_SCHED;
            PG8_LDA(At, 0, 1); PG8_STAGEB(PG8_SB(0, 0), b2); PG8_STAGEB(PG8_SB(0, 1), b2 + hstepB); PG8_STA(PG8_SA(0, 0), a2, 0, last);
            PG8_WAIT_V(8); PG8_WAIT_L(0); PG8_BAR; PG8_MMA(1, 0, At, B0); PG8_MMA(1, 1, At, B1); PG8_BAR; PG8_SCHED;
            PG8_LDB(B0, 1, 0); PG8_LDB(B1, 1, 1); PG8_SCHED; PG8_LDA(At, 1, 0); PG8_STA(PG8_SA(0, 1), a2, 1, last);
            PG8_WAIT_V(8); PG8_WAIT_L(0); PG8_BAR; PG8_MMA(0, 0, At, B0); PG8_MMA(0, 1, At, B1); PG8_BAR; PG8_SCHED;
            PG8_LDA(At, 1, 1); PG8_STAGEB(PG8_SB(1, 0), b3); PG8_STAGEB(PG8_SB(1, 1), b3 + hstepB); PG8_STA(PG8_SA(1, 0), a3, 0, last);
            PG8_WAIT_V(8); PG8_WAIT_L(0); PG8_BAR; PG8_MMA(1, 0, At, B0); PG8_MMA(1, 1, At, B1); PG8_BAR; PG8_SCHED;
            } else {
            PG8_LDB(B0, 0, 0); PG8_SCHED; PG8_LDA(At, 0, 0); PG8_STAGE(PG8_SA(1, 1), a1 + hstep, voffA);
            PG8_WAIT_L(8); PG8_BAR; PG8_WAIT_L(0); PG8_MMA(0, 0, At, B0); PG8_BAR; PG8_SCHED;
            PG8_LDB(B1, 0, 1); PG8_STAGEB(PG8_SB(0, 0), b2);
            PG8_BAR; PG8_WAIT_L(0); PG8_MMA(0, 1, At, B1); PG8_BAR;
            PG8_LDA(At, 0, 1); PG8_STAGE(PG8_SA(0, 0), a2, voffA);
            PG8_BAR; PG8_WAIT_L(0); PG8_MMA(1, 0, At, B0); PG8_BAR; PG8_SCHED;
            PG8_STAGEB(PG8_SB(0, 1), b2 + hstepB);
            PG8_WAIT_V(6); PG8_BAR; PG8_MMA(1, 1, At, B1); PG8_BAR;
            PG8_LDB(B0, 1, 0); PG8_SCHED; PG8_LDA(At, 1, 0); PG8_STAGE(PG8_SA(0, 1), a2 + hstep, voffA);
            PG8_WAIT_L(8); PG8_BAR; PG8_WAIT_L(0); PG8_MMA(0, 0, At, B0); PG8_BAR; PG8_SCHED;
            PG8_LDB(B1, 1, 1); PG8_STAGEB(PG8_SB(1, 0), b3);
            PG8_BAR; PG8_WAIT_L(0); PG8_MMA(0, 1, At, B1); PG8_BAR;
            PG8_LDA(At, 1, 1); PG8_STAGE(PG8_SA(1, 0), a3, voffA);
            PG8_BAR; PG8_WAIT_L(0); PG8_MMA(1, 0, At, B0); PG8_BAR; PG8_SCHED;
            PG8_STAGEB(PG8_SB(1, 1), b3 + hstepB);
            PG8_WAIT_V(6); PG8_BAR; PG8_MMA(1, 1, At, B1); PG8_BAR;
            }
        }
        if constexpr (ALIGN_EPI) { if (wr == 0) PG8_BAR; }
        if (has_next) PG8_SCALES(nxt, (ui + 1) & 1);
        if constexpr (GATHER) { if (has_next) { Unit u2_; const bool h2_ = S.next(ui + 2, u2_); Unit un_; un_.pm = h2_ ? u2_.pm : nxt.pm; un_.pn = 0; un_.pb = 0; PG8_GTOK(tk, un_); } }
        if constexpr (!Epi::AFTER_DRAIN) { if constexpr (EpiLdsScales<Epi>::value) E(acc, cur, wr, wc, fr, fq, (const PG8_LAS float*)(lds + SCL_OFF + (ui & 1) * 2048)); else E(acc, cur, wr, wc, fr, fq); S.done(cur); }
        if (!has_next) break;
        PG8_ZERO_ACC();
        cur = nxt; cA = nA; cB = nB; ++ui;
        if constexpr (GATHER) { asm volatile("s_waitcnt vmcnt(8)" ::: "memory");
            const unsigned a0_ = PG8_TQ(tn[0]), a1_ = PG8_TQ(tn[1]), b0_ = PG8_TQ(tk[0]), b1_ = PG8_TQ(tk[1]); tk[0] = a0_; tk[1] = a1_; tn[0] = b0_; tn[1] = b1_; }
        if constexpr (ALIGN_EPI) { if (wr == 1) PG8_BAR; }
    }
    PG8_WAIT_V(0);
    if constexpr (!ALIGN_EPI) { if (wr == 0) PG8_BAR; }
    PG8_BAR;
    if constexpr (Epi::AFTER_DRAIN) { E.fused(acc, cur, wr, wc, fr, fq, lds, wid, lane); S.done(cur); }
#undef PG8_SA
#undef PG8_SB
#undef PG8_STAGE
#undef PG8_STA
#undef PG8_STAGEG
#undef PG8_STAGEB
#undef PG8_SCALES
#undef PG8_ZERO_ACC
#undef PG8_GTOK
#undef PG8_TQ
#undef PG8_LDA
#undef PG8_LDB
#undef PG8_MMA
#undef PG8_WAIT_V
#undef PG8_WAIT_L
#undef PG8_BAR
#undef PG8_SCHED
}
}

#include <hip/hip_bf16.h>
#include <cmath>
namespace attn_body {
using bf16=__hip_bfloat16;
using bf16x8=__attribute__((ext_vector_type(8)))short;
using s16x4=__attribute__((ext_vector_type(4)))short;
using f32x16=__attribute__((ext_vector_type(16)))float;
using u32x4=__attribute__((ext_vector_type(4)))unsigned;
constexpr int BATCH=4,NHEAD=16,SEQ=8192,D=64,DM=NHEAD*D;
constexpr int NW=8,QBLK=32,QB=QBLK*NW,KVBLK=64,NQB=SEQ/QB;
constexpr int ATTN_PITCH=DM, ATTN_UNIT_ROWS=QB;
__device__ __forceinline__ int crow(int r,int hi){return (r&3)+8*(r>>2)+4*hi;}
#define SBAR() __builtin_amdgcn_sched_barrier(0)
typedef __attribute__((address_space(3))) const float* lds_cfptr;
__device__ __forceinline__ void cmask4(f32x16&p0,f32x16&p1,int jb,int qrel,int hi,lds_cfptr tab4){
  const float NEG=-INFINITY; const int d0=qrel-(64*jb+4*hi);
  const int dc=d0<-4?-4:(d0>191?191:d0);
  const lds_cfptr bp=tab4+64+dc;
  #pragma unroll
  for(int r=0;r<16;++r){const int off=(r&3)+8*(r>>2); const int dA=d0-off,dB=dA-32;
    float tA=bp[-off],tB=bp[-off-32]; asm volatile("":"+v"(tA),"+v"(tB));
    p0[r]=dA<0?NEG:p0[r]+tA; p1[r]=dB<0?NEG:p1[r]+tB;}
}
__device__ __forceinline__ void cmask(f32x16&p0,f32x16&p1,int jb,int qrel,int hi,lds_cfptr tabd){
  const float NEG=-INFINITY; const int d0=qrel-(64*jb+4*hi);
  #pragma unroll
  for(int r=0;r<16;++r){const int dA=d0-((r&3)+8*(r>>2)),dB=dA-32;
    const float tA=tabd[dA<0?0:(dA>127?127:dA)],tB=tabd[dB<0?0:(dB>127?127:dB)];
    p0[r]=dA<0?NEG:p0[r]+tA; p1[r]=dB<0?NEG:p1[r]+tB;}
}

constexpr int NSLOT=3, SLOTB=8192;
constexpr int LDS_K=0, LDS_V=NSLOT*SLOTB, LDS_WS=2*NSLOT*SLOTB, LDS_OST=LDS_WS+NW*64*4, LDS_BYTES=LDS_OST+NW*4096;
constexpr float C2=0.125f*1.4426950408889634f;
__device__ __forceinline__ void glds16(const void*sbase,unsigned voff,unsigned lds_dst){unsigned keep;
  asm volatile("s_mov_b32 %0, m0\n\ts_mov_b32 m0, %3\n\ts_nop 0\n\tglobal_load_lds_dwordx4 %1, %2\n\ts_mov_b32 m0, %0":"=&s"(keep):"v"(voff),"s"(sbase),"s"(lds_dst):"memory");}
__device__ __forceinline__ float max3f(float a,float b,float c){float r;asm("v_max3_f32 %0, %1, %2, %3":"=v"(r):"v"(a),"v"(b),"v"(c));return r;}
__device__ __forceinline__ float max2f(float a,float b){float r;asm("v_max_f32_e32 %0, %1, %2":"=v"(r):"v"(a),"v"(b));return r;}
__device__ __forceinline__ float fadd_s(float a,float b){float r;asm("v_add_f32_e32 %0, %1, %2":"=v"(r):"v"(a),"v"(b));return r;}
__device__ __forceinline__ float fsub_s(float a,float b){float r;asm("v_sub_f32_e32 %0, %1, %2":"=v"(r):"v"(a),"v"(b));return r;}
typedef float f32x2_t __attribute__((ext_vector_type(2))); typedef __bf16 bf16x2_t __attribute__((ext_vector_type(2)));
__device__ __forceinline__ unsigned cvtpk_s(float lo,float hi){f32x2_t v={lo,hi};bf16x2_t b=__builtin_convertvector(v,bf16x2_t);return __builtin_bit_cast(unsigned,b);}
#define WAIT_BAR(N) asm volatile("s_waitcnt vmcnt(" #N ") lgkmcnt(0)\n\ts_barrier":::"memory")

__device__ __forceinline__ void qkt(f32x16&p0,f32x16&p1,const char*Kslot,const bf16x8*qr,const f32x16&negm,int r32,int hi){
  const char*kb=Kslot+hi*1024+r32*16;
  #pragma unroll
  for(int d0=0;d0<4;++d0){
    const bf16x8 b0=*reinterpret_cast<const bf16x8*>(kb+d0*2048);
    const bf16x8 b1=*reinterpret_cast<const bf16x8*>(kb+d0*2048+512);
    if(d0==0){p0=__builtin_amdgcn_mfma_f32_32x32x16_bf16(b0,qr[0],negm,0,0,0);p1=__builtin_amdgcn_mfma_f32_32x32x16_bf16(b1,qr[0],negm,0,0,0);}
    else{p0=__builtin_amdgcn_mfma_f32_32x32x16_bf16(b0,qr[d0],p0,0,0,0);p1=__builtin_amdgcn_mfma_f32_32x32x16_bf16(b1,qr[d0],p1,0,0,0);}}
}
typedef __attribute__((address_space(3))) const char* lds_cptr;
typedef short v4i16_t __attribute__((ext_vector_type(4)));
__device__ __forceinline__ void kload8(bf16x8*kf,lds_cptr kp){
  kf[0]=*(const __attribute__((address_space(3))) bf16x8*)(kp);      kf[1]=*(const __attribute__((address_space(3))) bf16x8*)(kp+512);
  kf[2]=*(const __attribute__((address_space(3))) bf16x8*)(kp+2048); kf[3]=*(const __attribute__((address_space(3))) bf16x8*)(kp+2560);
  kf[4]=*(const __attribute__((address_space(3))) bf16x8*)(kp+4096); kf[5]=*(const __attribute__((address_space(3))) bf16x8*)(kp+4608);
  kf[6]=*(const __attribute__((address_space(3))) bf16x8*)(kp+6144); kf[7]=*(const __attribute__((address_space(3))) bf16x8*)(kp+6656);
}
__device__ __forceinline__ void kload2(bf16x8*kf,lds_cptr kp,int j){ kf[2*j]=*(const __attribute__((address_space(3))) bf16x8*)(kp+j*2048); kf[2*j+1]=*(const __attribute__((address_space(3))) bf16x8*)(kp+j*2048+512); }
__device__ __forceinline__ s16x4 vtr(lds_cptr p){ return __builtin_bit_cast(s16x4,__builtin_amdgcn_ds_read_tr16_b64_v4i16((__attribute__((address_space(3))) v4i16_t*)p)); }
__device__ __forceinline__ float rowmax(const f32x16&p0,const f32x16&p1){
  float a=max3f(p0[0],p0[1],p1[0]),b=max3f(p0[2],p0[3],p1[1]);a=max3f(a,p1[2],p1[3]);
  #pragma unroll
  for(int r=4;r<16;r+=4){a=max3f(a,p0[r],p0[r+1]);b=max3f(b,p0[r+2],p0[r+3]);a=max3f(a,p1[r],p1[r+1]);b=max3f(b,p1[r+2],p1[r+3]);}
  const float m=max2f(a,b);
  auto rr=__builtin_amdgcn_permlane32_swap(__float_as_uint(m),__float_as_uint(m),false,false);
  return max2f(__uint_as_float(rr[0]),__uint_as_float(rr[1]));
}
__device__ __forceinline__ void pv(f32x16*o,int vb,bf16x8 pa0,bf16x8 pa1,bf16x8 pa2,bf16x8 pa3){
  #pragma unroll
  for(int d0=0;d0<2;++d0){s16x4 lo[4],hi[4];
    #pragma unroll
    for(int ks=0;ks<4;++ks){
      asm volatile("ds_read_b64_tr_b16 %0,%1 offset:%c2":"=&v"(lo[ks]):"v"(vb),"i"(d0*4096+ks*1024):"memory");
      asm volatile("ds_read_b64_tr_b16 %0,%1 offset:%c2":"=&v"(hi[ks]):"v"(vb),"i"(d0*4096+ks*1024+512):"memory");}
    asm volatile("s_waitcnt lgkmcnt(0)":::"memory");SBAR();
    #define PK(k) (bf16x8){lo[k][0],lo[k][1],lo[k][2],lo[k][3],hi[k][0],hi[k][1],hi[k][2],hi[k][3]}
    o[d0]=__builtin_amdgcn_mfma_f32_32x32x16_bf16(pa0,PK(0),o[d0],0,0,0);
    o[d0]=__builtin_amdgcn_mfma_f32_32x32x16_bf16(pa1,PK(1),o[d0],0,0,0);
    o[d0]=__builtin_amdgcn_mfma_f32_32x32x16_bf16(pa2,PK(2),o[d0],0,0,0);
    o[d0]=__builtin_amdgcn_mfma_f32_32x32x16_bf16(pa3,PK(3),o[d0],0,0,0);
    #undef PK
  }
}

#ifndef ATTN_STORE16
#define ATTN_STORE16(p,v) (*(u32x4*)(p)=(v))
#endif
template<int THRL> __device__ __forceinline__ void attn_unit(int b,int hq,int hv,int qb,const bf16*Q,const bf16*__restrict__ K,const bf16*__restrict__ V,bf16*O,char*shm,float b31s,lds_cfptr tabd){
  const int tid=threadIdx.x,lane=tid&63,r32=lane&31,hi=lane>>5; const int wid=__builtin_amdgcn_readfirstlane(tid>>6);
  const long rowbase=(long)b*SEQ; const int q0=qb*QB;
  const bf16*Qw=Q+(rowbase+q0+wid*QBLK)*DM+hq*D;
  const bf16*Kh=K+rowbase*DM+hq*D,*Vh=V+rowbase*DM+hv*D;
  const unsigned lds0=(unsigned)(uintptr_t)shm;
  float*wsf=(float*)(shm+LDS_WS)+wid*64;
  const unsigned koff=(unsigned)(lane*DM+wid*8)*2u;
  const unsigned voff=(unsigned)((16*(wid&3)+(lane>>2))*DM+(wid>>2)*32+(lane&3)*8)*2u;
  const unsigned kdst=lds0+LDS_K+wid*1024, vdst=lds0+LDS_V+wid*1024;
  #define DMA_K(t,slot) glds16(Kh+(long)(t)*KVBLK*DM,koff,(unsigned)__builtin_amdgcn_readfirstlane(kdst+(slot)))
  #define DMA_V(t,slot) glds16(Vh+(long)(t)*KVBLK*DM,voff,(unsigned)__builtin_amdgcn_readfirstlane(vdst+(slot)))
  const int vb0=(int)(lds0+LDS_V)+((lane>>4)&1)*32+(lane&3)*8+(4*hi+((lane&15)>>2))*64;
  const char*Kbase=shm+LDS_K; bf16x8 kf[8];
  const lds_cptr shm3=(lds_cptr)shm; const lds_cptr kp0=shm3+LDS_K+hi*1024+r32*16; const lds_cptr vp0=shm3+LDS_V+((lane>>4)&1)*32+(lane&3)*8+(4*hi+((lane&15)>>2))*64;
  const int NT=(q0+QB)/KVBLK;
  DMA_K(0,0);DMA_V(0,0);DMA_K(1,SLOTB);
  bf16x8 qr[4];
  { int lq=lane; asm volatile("":"+v"(lq));
  #pragma unroll
  for(int d0=0;d0<4;++d0)qr[d0]=*reinterpret_cast<const bf16x8*>(&Qw[(long)(lq&31)*DM+d0*16+(lq>>5)*8]); }
  float mhat=0.f,l_reg=0.f;f32x16 o[2];o[0]=f32x16{};o[1]=f32x16{};f32x16 negm;
  #pragma unroll
  for(int r=0;r<16;++r)negm[r]=b31s;
  asm volatile("":"+v"(negm));
  const int qrel=wid*QBLK+r32;
  #define CMASK(P0,P1,t) do{int jb_=(t)-(NT-4); if(jb_>=-2)cmask(P0,P1,jb_,qrel,hi,tabd);}while(0)
  bool resc=false;
  #define START(P0,P1) do{ const float rm=rowmax(P0,P1); resc=false; \
    { const float dl=rm; mhat=fadd_s(mhat,dl); \
      _Pragma("unroll") for(int r=0;r<16;++r){P0[r]=fsub_s(P0[r],dl);P1[r]=fsub_s(P1[r],dl);} \
      _Pragma("unroll") for(int r=0;r<16;++r)negm[r]=b31s-mhat; asm volatile("":"+v"(negm)); } \
    _Pragma("unroll") for(int r=0;r<16;++r)P0[r]=__builtin_amdgcn_exp2f(P0[r]); }while(0)
  #define RESC() do{ if(resc){ asm volatile("s_waitcnt lgkmcnt(0)":::"memory"); \
      _Pragma("unroll") for(int d_=0;d_<2;++d_) _Pragma("unroll") for(int r=0;r<16;++r)o[d_][r]*=wsf[crow(r,hi)]; } }while(0)
  f32x16 pA0,pA1,pB0,pB1;
  int sl_prev=0,sl_cur=0,sl_next=SLOTB;
  #define ROT() do{sl_prev=sl_cur;sl_cur=sl_next;sl_next=(sl_next==(NSLOT-1)*SLOTB)?0:sl_next+SLOTB;}while(0)
  DMA_K(2,2*SLOTB);
  WAIT_BAR(3);
  qkt(pA0,pA1,Kbase,qr,negm,r32,hi);asm volatile("s_nop 15\n\ts_nop 7":"+v"(pA0),"+v"(pA1));CMASK(pA0,pA1,0);
  START(pA0,pA1);
  _Pragma("unroll") for(int r=0;r<16;++r)pA1[r]=__builtin_amdgcn_exp2f(pA1[r]);
  WAIT_BAR(0);
  DMA_K(3,0);DMA_V(1,SLOTB);
  ROT();
  kload8(kf,kp0+sl_cur);
  WAIT_BAR(2);
  s16x4 vlo[8],vhi[8]; u32x4 pw0,pw1,pw2,pw3;
  #define PKW(P,B) cvtpk_s(P[B],P[B+1])
  #define PAF(k) __builtin_bit_cast(bf16x8,pw##k)
  #define VFR(i) (bf16x8){vlo[i][0],vlo[i][1],vlo[i][2],vlo[i][3],vhi[i][0],vhi[i][1],vhi[i][2],vhi[i][3]}
  #define PIN(x) asm volatile("":"+v"(x))
  #define MX3(a,b,c) __builtin_fmaxf(__builtin_fmaxf((a),(b)),(c))
  #define GAPA(MF,A0,A1,A2,A3,W0,W1,PW) do{ MF; sacc+=A0; sacc+=A1; sacc+=A2; sacc+=A3; PIN(sacc); W0; W1; PIN(PW); SBAR(); }while(0)
  #define EX(v) __builtin_amdgcn_exp2f(v)
  #define GAPB(MF,X,B) do{ MF; X[B]=EX(X[B]); X[B+1]=EX(X[B+1]); X[B+2]=EX(X[B+2]); X[B+3]=EX(X[B+3]); PIN(X); SBAR(); }while(0)
  #define VRD(i) do{ vlo[i]=vtr(vp_+(((i)>>2)*4096+((i)&3)*1024)); vhi[i]=vtr(vp_+(((i)>>2)*4096+((i)&3)*1024+512)); }while(0)
  #define KRD(G,j) do{ if(G){ kload2(kf,kp0+sl_next,j); SBAR(); } }while(0)
  #define STEP(C0,C1,P0,P1,t,GK,GV,GL) do{ SBAR(); \
    const lds_cptr vp_=vp0+sl_prev; \
    VRD(0); SBAR(); float sacc=(P0[0]+P0[1]); \
    GAPA(C0=__builtin_amdgcn_mfma_f32_32x32x16_bf16(kf[0],qr[0],negm,0,0,0), P0[2],P0[3],P0[4],P0[5],     pw0[0]=PKW(P0,0), pw0[1]=PKW(P0,2), pw0); \
    VRD(4); SBAR(); GAPA(C1=__builtin_amdgcn_mfma_f32_32x32x16_bf16(kf[1],qr[0],negm,0,0,0), P0[6],P0[7],P0[8],P0[9],     pw0[2]=PKW(P0,4), pw0[3]=PKW(P0,6), pw0); \
    VRD(1); SBAR(); GAPA(C0=__builtin_amdgcn_mfma_f32_32x32x16_bf16(kf[2],qr[1],C0,0,0,0),   P0[10],P0[11],P0[12],P0[13], pw1[0]=PKW(P0,8), pw1[1]=PKW(P0,10), pw1); \
    VRD(5); SBAR(); GAPA(C1=__builtin_amdgcn_mfma_f32_32x32x16_bf16(kf[3],qr[1],C1,0,0,0),   P0[14],P0[15],P1[0],P1[1],   pw1[2]=PKW(P0,12),pw1[3]=PKW(P0,14), pw1); \
    VRD(2); SBAR(); GAPA(C0=__builtin_amdgcn_mfma_f32_32x32x16_bf16(kf[4],qr[2],C0,0,0,0),   P1[2],P1[3],P1[4],P1[5],     pw2[0]=PKW(P1,0), pw2[1]=PKW(P1,2), pw2); \
    VRD(6); SBAR(); GAPA(C1=__builtin_amdgcn_mfma_f32_32x32x16_bf16(kf[5],qr[2],C1,0,0,0),   P1[6],P1[7],P1[8],P1[9],     pw2[2]=PKW(P1,4), pw2[3]=PKW(P1,6), pw2); \
    VRD(3); SBAR(); GAPA(C0=__builtin_amdgcn_mfma_f32_32x32x16_bf16(kf[6],qr[3],C0,0,0,0),   P1[10],P1[11],P1[12],P1[13], pw3[0]=PKW(P1,8), pw3[1]=PKW(P1,10), pw3); \
    VRD(7); SBAR(); GAPA(C1=__builtin_amdgcn_mfma_f32_32x32x16_bf16(kf[7],qr[3],C1,0,0,0),   P1[14],P1[15],0.f,0.f,       pw3[2]=PKW(P1,12),pw3[3]=PKW(P1,14), pw3); \
    l_reg+=sacc; \
    if(GK){DMA_K((t)+3,sl_cur);} if(GV){DMA_V((t)+1,sl_next);} \
    CMASK(C0,C1,t); \
    { float a=MX3(C0[0],C0[1],C1[0]),b=MX3(C0[2],C0[3],C1[1]); a=MX3(a,C1[2],C1[3]); \
      _Pragma("unroll") for(int r=4;r<16;r+=4){a=MX3(a,C0[r],C0[r+1]);b=MX3(b,C0[r+2],C0[r+3]);a=MX3(a,C1[r],C1[r+1]);b=MX3(b,C1[r+2],C1[r+3]);} \
      float rm=__builtin_fmaxf(a,b); { auto rr=__builtin_amdgcn_permlane32_swap(__float_as_uint(rm),__float_as_uint(rm),false,false); rm=__builtin_fmaxf(__uint_as_float(rr[0]),__uint_as_float(rr[1])); } \
      resc=false; \
      if(__builtin_expect(__any(rm>(float)THRL),0)){ const float dl=__builtin_fmaxf(rm,0.f); mhat+=dl; \
        _Pragma("unroll") for(int r=0;r<16;++r){C0[r]-=dl;C1[r]-=dl;} \
        _Pragma("unroll") for(int r=0;r<16;++r)negm[r]=b31s-mhat; asm volatile("":"+v"(negm)); \
        const float f=__builtin_amdgcn_exp2f(-dl); l_reg*=f; if(hi==0)wsf[r32]=f; resc=true; } } \
    SBAR(); \
    GAPB(o[0]=__builtin_amdgcn_mfma_f32_32x32x16_bf16(PAF(0),VFR(0),o[0],0,0,0), C0,0); \
    GAPB(o[1]=__builtin_amdgcn_mfma_f32_32x32x16_bf16(PAF(0),VFR(4),o[1],0,0,0), C0,4); \
    KRD(GL,0); GAPB(o[0]=__builtin_amdgcn_mfma_f32_32x32x16_bf16(PAF(1),VFR(1),o[0],0,0,0), C0,8); \
    KRD(GL,1); GAPB(o[1]=__builtin_amdgcn_mfma_f32_32x32x16_bf16(PAF(1),VFR(5),o[1],0,0,0), C0,12); \
    KRD(GL,2); GAPB(o[0]=__builtin_amdgcn_mfma_f32_32x32x16_bf16(PAF(2),VFR(2),o[0],0,0,0), C1,0); \
    KRD(GL,3); GAPB(o[1]=__builtin_amdgcn_mfma_f32_32x32x16_bf16(PAF(2),VFR(6),o[1],0,0,0), C1,4); \
    GAPB(o[0]=__builtin_amdgcn_mfma_f32_32x32x16_bf16(PAF(3),VFR(3),o[0],0,0,0), C1,8); \
    GAPB(o[1]=__builtin_amdgcn_mfma_f32_32x32x16_bf16(PAF(3),VFR(7),o[1],0,0,0), C1,12); \
    }while(0)
  int t=1;
  #undef CMASK
  #define CMASK(P0,P1,t) do{}while(0)
  for(;t+7<NT;t+=2){
    STEP(pB0,pB1,pA0,pA1,t,true,true,true);     WAIT_BAR(2); RESC(); ROT();
    STEP(pA0,pA1,pB0,pB1,t+1,true,true,true);   WAIT_BAR(2); RESC(); ROT();
  }
  #undef CMASK
  #define CMASK(P0,P1,t) do{int jb_=(t)-(NT-4); if(jb_>=-2)cmask(P0,P1,jb_,qrel,hi,tabd);}while(0)
  #define ENDW(tt) do{ if((tt)+3<NT){WAIT_BAR(2);} else if((tt)+2<NT){WAIT_BAR(1);} else {WAIT_BAR(0);} }while(0)
  for(;t+1<NT;t+=2){
    STEP(pB0,pB1,pA0,pA1,t,(t+3<NT),(t+1<NT),(t+1<NT));       ENDW(t);   RESC(); ROT();
    STEP(pA0,pA1,pB0,pB1,t+1,(t+4<NT),(t+2<NT),(t+2<NT));     ENDW(t+1); RESC(); ROT();
  }
  STEP(pB0,pB1,pA0,pA1,NT-1,false,false,false); RESC();
  { float sacc=pB0[0]+pB0[1]; _Pragma("unroll") for(int r=2;r<16;++r)sacc+=pB0[r]; _Pragma("unroll") for(int r=0;r<16;++r)sacc+=pB1[r]; l_reg+=sacc;
    pw0=(u32x4){PKW(pB0,0),PKW(pB0,2),PKW(pB0,4),PKW(pB0,6)};pw1=(u32x4){PKW(pB0,8),PKW(pB0,10),PKW(pB0,12),PKW(pB0,14)};pw2=(u32x4){PKW(pB1,0),PKW(pB1,2),PKW(pB1,4),PKW(pB1,6)};pw3=(u32x4){PKW(pB1,8),PKW(pB1,10),PKW(pB1,12),PKW(pB1,14)};
    SBAR(); pv(o,vb0+sl_cur,PAF(0),PAF(1),PAF(2),PAF(3)); }
  #undef PKW
  #undef PAF
  #undef VFR
  #undef PIN
  #undef MX3
  #undef GAPA
  #undef GAPB
  #undef EX
  #undef VRD
  #undef KRD
  #undef STEP
  #undef ENDW
  {auto rr=__builtin_amdgcn_permlane32_swap(__float_as_uint(l_reg),__float_as_uint(l_reg),false,false);l_reg=__uint_as_float(rr[0])+__uint_as_float(rr[1]);}
  if(hi==0)wsf[32+r32]=l_reg;asm volatile("s_waitcnt lgkmcnt(0)":::"memory");
  float rli[16];
  #pragma unroll
  for(int r=0;r<16;++r)rli[r]=__builtin_amdgcn_rcpf(wsf[32+crow(r,hi)]);
  bf16*Ow=O+(rowbase+q0+wid*QBLK)*DM+hv*D;
  { bf16*stg=(bf16*)(shm+LDS_OST)+wid*2048;
    #pragma unroll
    for(int r=0;r<16;++r){const int orow=crow(r,hi);
      #pragma unroll
      for(int d0=0;d0<2;++d0)stg[orow*64+d0*32+r32]=__float2bfloat16(o[d0][r]*rli[r]);}
    asm volatile("s_waitcnt lgkmcnt(0)":::"memory");
    int le=lane; asm volatile("":"+v"(le));
    #pragma unroll
    for(int i=0;i<4;++i){const int row=i*8+(le>>3),ch=le&7; const u32x4 v=*(const u32x4*)(stg+row*64+ch*8); ATTN_STORE16(Ow+(long)row*DM+ch*8,v);} }
  asm volatile("s_waitcnt lgkmcnt(0)\n\ts_barrier":::"memory");
  #undef DMA_K
  #undef DMA_V
  #undef CMASK
  #undef START
  #undef RESC
  #undef ROT
}
constexpr int ATTN_LDS_BYTES=LDS_BYTES, LDS_TAB=LDS_BYTES;
struct AttnTensors { const bf16* Q; const bf16* K; const bf16* V; bf16* O0; bf16* O1; const float* TB; const float* subg; float lam; };
template<int THRL=8> __device__ __forceinline__ void attn_phase(char*lds,const AttnTensors&T,int grid,int block){
  const int vcu=(grid%8==0)?(block%8)*(grid/8)+block/8:block;
  lds_cfptr tab=(lds_cfptr)((__attribute__((address_space(3))) const char*)lds+LDS_TAB);
  { __attribute__((address_space(3))) float* tw=(__attribute__((address_space(3))) float*)((__attribute__((address_space(3))) char*)lds+LDS_TAB);
    for(int i=threadIdx.x;i<8*128;i+=512){const int h=i>>7; tw[i]=T.TB[i]-T.TB[h*128+127];}
    asm volatile("s_waitcnt vmcnt(0) lgkmcnt(0)\n\ts_barrier":::"memory"); }
  for(int bh=vcu>>3;bh<BATCH*8;bh+=grid>>3){ const int b=bh>>3,h=bh&7,s=vcu&7; const float b31s=T.TB[h*128+127];
    for(int j=0;j<4;++j){ const int c=j>>1,vh=j&1;
      for(int i=0;i<4;++i){ const int qb=(i==0)?s:(i==1)?15-s:(i==2)?16+s:31-s;
        attn_unit<THRL>(b,h*2+c,h*2+vh,qb,T.Q,T.K,T.V,c?T.O1:T.O0,lds,b31s,tab+h*128); } } }
}
constexpr int L2_K=0, L2_VA=3*SLOTB, L2_VB=6*SLOTB, L2_P=10*SLOTB, L2_WS=14*SLOTB, L2_FAC=L2_WS+2048, L2_FLG=L2_FAC+1024, L2_LB=L2_FLG+64, L2_TAB=L2_LB+512, L2_BYTES=L2_TAB+4096;
template<int THRL> __device__ __forceinline__ void attn_unit2(int b,int h,int c,int q128,const bf16*Q,const bf16*__restrict__ K,const bf16*__restrict__ V,bf16*O,char*shm,float b31s,lds_cfptr tabd){
  const int tid=threadIdx.x,lane=tid&63,r32=lane&31,hi=lane>>5; const int wid=__builtin_amdgcn_readfirstlane(tid>>6); const int w4=wid&3; const bool roleA=wid<4;
  const long rowbase=(long)b*SEQ; const int q0=q128*128; const int hq=h*2+c;
  const bf16*Qw=Q+(rowbase+q0+w4*QBLK)*DM+hq*D;
  const bf16*Kh=K+rowbase*DM+hq*D,*Vh=V+rowbase*DM+(h*2)*D;
  const unsigned lds0=(unsigned)(uintptr_t)shm;
  float*wsf=(float*)(shm+L2_WS)+wid*64;
  float*fac=(float*)(shm+L2_FAC)+w4*64;
  volatile __attribute__((address_space(3))) unsigned*flg=(volatile __attribute__((address_space(3))) unsigned*)((__attribute__((address_space(3))) char*)shm+L2_FLG)+w4*2;
  float*lbuf=(float*)(shm+L2_LB)+w4*32;
  char*pbuf=shm+L2_P+w4*8192;
  const unsigned koff=(unsigned)(lane*DM+wid*8)*2u;
  const unsigned voff=(unsigned)((16*(wid&3)+(lane>>2))*DM+(wid>>2)*32+(lane&3)*8)*2u;
  const unsigned kdst=lds0+L2_K+wid*1024, vdst=lds0+L2_VA+wid*1024, vbdst=lds0+L2_VB+wid*1024;
  #define DMA_K(t,slot) glds16(Kh+(long)(t)*KVBLK*DM,koff,(unsigned)__builtin_amdgcn_readfirstlane(kdst+(slot)))
  #define DMA_V(t,slot) do{ glds16(Vh+(long)(t)*KVBLK*DM,voff,(unsigned)__builtin_amdgcn_readfirstlane(vdst+(slot))); \
    glds16(Vh+(long)(t)*KVBLK*DM+64,voff,(unsigned)__builtin_amdgcn_readfirstlane(vbdst+(((t)&3)*SLOTB))); }while(0)
  const int vb0=(int)(lds0+L2_VA)+((lane>>4)&1)*32+(lane&3)*8+(4*hi+((lane&15)>>2))*64;
  const int vbB=(int)(lds0+L2_VB)+((lane>>4)&1)*32+(lane&3)*8+(4*hi+((lane&15)>>2))*64;
  const char*Kbase=shm+L2_K; bf16x8 kf[8];
  const lds_cptr shm3=(lds_cptr)shm; const lds_cptr kp0=shm3+L2_K+hi*1024+r32*16; const lds_cptr vp0=shm3+L2_VA+((lane>>4)&1)*32+(lane&3)*8+(4*hi+((lane&15)>>2))*64;
  const int NTr=2*q128+2, NT=NTr<4?4:NTr;
  DMA_K(0,0);DMA_V(0,0);DMA_K(1,SLOTB);
  int sl_prev=0,sl_cur=0,sl_next=SLOTB;
  #define ROT() do{sl_prev=sl_cur;sl_cur=sl_next;sl_next=(sl_next==(NSLOT-1)*SLOTB)?0:sl_next+SLOTB;}while(0)
  #define ENDW(tt) do{ if((tt)+3<NT){WAIT_BAR(3);} else if((tt)+2<NT){WAIT_BAR(2);} else {WAIT_BAR(0);} }while(0)
  if(roleA){
  bf16x8 qr[4];
  { int lq=lane; asm volatile("":"+v"(lq));
  #pragma unroll
  for(int d0=0;d0<4;++d0)qr[d0]=*reinterpret_cast<const bf16x8*>(&Qw[(long)(lq&31)*DM+d0*16+(lq>>5)*8]); }
  float mhat=0.f,l_reg=0.f;f32x16 o[2];o[0]=f32x16{};o[1]=f32x16{};f32x16 negm;
  #pragma unroll
  for(int r=0;r<16;++r)negm[r]=b31s;
  asm volatile("":"+v"(negm));
  const int qrel=w4*QBLK+r32;
  #define CMASK(P0,P1,t) do{int jb_=(t)-(NTr-2); if(jb_>=-2)cmask(P0,P1,jb_,qrel,hi,tabd);}while(0)
  bool resc=false;
  #define START(P0,P1) do{ const float rm=rowmax(P0,P1); resc=false; \
    { const float dl=rm; mhat=fadd_s(mhat,dl); \
      _Pragma("unroll") for(int r=0;r<16;++r){P0[r]=fsub_s(P0[r],dl);P1[r]=fsub_s(P1[r],dl);} \
      _Pragma("unroll") for(int r=0;r<16;++r)negm[r]=b31s-mhat; asm volatile("":"+v"(negm)); } \
    _Pragma("unroll") for(int r=0;r<16;++r)P0[r]=__builtin_amdgcn_exp2f(P0[r]); }while(0)
  #define RESC(t) do{ const float*facp_=fac+((t)&1)*32; if(resc){ asm volatile("s_waitcnt lgkmcnt(0)":::"memory"); \
      _Pragma("unroll") for(int d_=0;d_<2;++d_) _Pragma("unroll") for(int r=0;r<16;++r)o[d_][r]*=facp_[crow(r,hi)]; } }while(0)
  f32x16 pA0,pA1,pB0,pB1;
  DMA_K(2,2*SLOTB);
  WAIT_BAR(4);
  qkt(pA0,pA1,Kbase,qr,negm,r32,hi);asm volatile("s_nop 15\n\ts_nop 7":"+v"(pA0),"+v"(pA1));CMASK(pA0,pA1,0);
  START(pA0,pA1);
  _Pragma("unroll") for(int r=0;r<16;++r)pA1[r]=__builtin_amdgcn_exp2f(pA1[r]);
  WAIT_BAR(0);
  DMA_K(3,0);DMA_V(1,SLOTB);
  ROT();
  kload8(kf,kp0+sl_cur);
  WAIT_BAR(3);
  s16x4 vlo[8],vhi[8]; u32x4 pw0,pw1,pw2,pw3;
  #define PKW(P,B) cvtpk_s(P[B],P[B+1])
  #define PAF(k) __builtin_bit_cast(bf16x8,pw##k)
  #define VFR(i) (bf16x8){vlo[i][0],vlo[i][1],vlo[i][2],vlo[i][3],vhi[i][0],vhi[i][1],vhi[i][2],vhi[i][3]}
  #define PIN(x) asm volatile("":"+v"(x))
  #define MX3(a,b,c) __builtin_fmaxf(__builtin_fmaxf((a),(b)),(c))
  #define GAPA(MF,A0,A1,A2,A3,W0,W1,PW) do{ MF; sacc+=A0; sacc+=A1; sacc+=A2; sacc+=A3; PIN(sacc); W0; W1; PIN(PW); SBAR(); }while(0)
  #define EX(v) __builtin_amdgcn_exp2f(v)
  #define GAPB(MF,X,B) do{ MF; X[B]=EX(X[B]); X[B+1]=EX(X[B+1]); X[B+2]=EX(X[B+2]); X[B+3]=EX(X[B+3]); PIN(X); SBAR(); }while(0)
  #define VRD(i) do{ vlo[i]=vtr(vp_+(((i)>>2)*4096+((i)&3)*1024)); vhi[i]=vtr(vp_+(((i)>>2)*4096+((i)&3)*1024+512)); }while(0)
  #define KRD(G,j) do{ if(G){ kload2(kf,kp0+sl_next,j); SBAR(); } }while(0)
  #define STEP(C0,C1,P0,P1,t,GK,GV,GL) do{ SBAR(); \
    const lds_cptr vp_=vp0+sl_prev; \
    VRD(0); SBAR(); float sacc=(P0[0]+P0[1]); \
    GAPA(C0=__builtin_amdgcn_mfma_f32_32x32x16_bf16(kf[0],qr[0],negm,0,0,0), P0[2],P0[3],P0[4],P0[5],     pw0[0]=PKW(P0,0), pw0[1]=PKW(P0,2), pw0); \
    VRD(4); SBAR(); GAPA(C1=__builtin_amdgcn_mfma_f32_32x32x16_bf16(kf[1],qr[0],negm,0,0,0), P0[6],P0[7],P0[8],P0[9],     pw0[2]=PKW(P0,4), pw0[3]=PKW(P0,6), pw0); \
    VRD(1); SBAR(); GAPA(C0=__builtin_amdgcn_mfma_f32_32x32x16_bf16(kf[2],qr[1],C0,0,0,0),   P0[10],P0[11],P0[12],P0[13], pw1[0]=PKW(P0,8), pw1[1]=PKW(P0,10), pw1); \
    VRD(5); SBAR(); GAPA(C1=__builtin_amdgcn_mfma_f32_32x32x16_bf16(kf[3],qr[1],C1,0,0,0),   P0[14],P0[15],P1[0],P1[1],   pw1[2]=PKW(P0,12),pw1[3]=PKW(P0,14), pw1); \
    VRD(2); SBAR(); GAPA(C0=__builtin_amdgcn_mfma_f32_32x32x16_bf16(kf[4],qr[2],C0,0,0,0),   P1[2],P1[3],P1[4],P1[5],     pw2[0]=PKW(P1,0), pw2[1]=PKW(P1,2), pw2); \
    VRD(6); SBAR(); GAPA(C1=__builtin_amdgcn_mfma_f32_32x32x16_bf16(kf[5],qr[2],C1,0,0,0),   P1[6],P1[7],P1[8],P1[9],     pw2[2]=PKW(P1,4), pw2[3]=PKW(P1,6), pw2); \
    VRD(3); SBAR(); GAPA(C0=__builtin_amdgcn_mfma_f32_32x32x16_bf16(kf[6],qr[3],C0,0,0,0),   P1[10],P1[11],P1[12],P1[13], pw3[0]=PKW(P1,8), pw3[1]=PKW(P1,10), pw3); \
    VRD(7); SBAR(); GAPA(C1=__builtin_amdgcn_mfma_f32_32x32x16_bf16(kf[7],qr[3],C1,0,0,0),   P1[14],P1[15],0.f,0.f,       pw3[2]=PKW(P1,12),pw3[3]=PKW(P1,14), pw3); \
    l_reg+=sacc; \
    { char*pb_=pbuf+(((t)-1)&1)*4096+lane*16; *(u32x4*)(pb_)=pw0; *(u32x4*)(pb_+1024)=pw1; *(u32x4*)(pb_+2048)=pw2; *(u32x4*)(pb_+3072)=pw3; }     \
    if(GK){DMA_K((t)+3,sl_cur);} if(GV){DMA_V((t)+1,sl_next);} \
    CMASK(C0,C1,t); \
    { float a=MX3(C0[0],C0[1],C1[0]),b=MX3(C0[2],C0[3],C1[1]); a=MX3(a,C1[2],C1[3]); \
      _Pragma("unroll") for(int r=4;r<16;r+=4){a=MX3(a,C0[r],C0[r+1]);b=MX3(b,C0[r+2],C0[r+3]);a=MX3(a,C1[r],C1[r+1]);b=MX3(b,C1[r+2],C1[r+3]);} \
      float rm=__builtin_fmaxf(a,b); { auto rr=__builtin_amdgcn_permlane32_swap(__float_as_uint(rm),__float_as_uint(rm),false,false); rm=__builtin_fmaxf(__uint_as_float(rr[0]),__uint_as_float(rr[1])); } \
      resc=false; \
      if(__builtin_expect(__any(rm>(float)THRL),0)){ const float dl=__builtin_fmaxf(rm,0.f); mhat+=dl; \
        _Pragma("unroll") for(int r=0;r<16;++r){C0[r]-=dl;C1[r]-=dl;} \
        _Pragma("unroll") for(int r=0;r<16;++r)negm[r]=b31s-mhat; asm volatile("":"+v"(negm)); \
        const float f=__builtin_amdgcn_exp2f(-dl); l_reg*=f; if(hi==0)fac[((t)&1)*32+r32]=f; resc=true; } \
      if(lane==0)flg[(t)&1]=resc?1u:0u; } \
    SBAR(); \
    GAPB(o[0]=__builtin_amdgcn_mfma_f32_32x32x16_bf16(PAF(0),VFR(0),o[0],0,0,0), C0,0); \
    GAPB(o[1]=__builtin_amdgcn_mfma_f32_32x32x16_bf16(PAF(0),VFR(4),o[1],0,0,0), C0,4); \
    KRD(GL,0); GAPB(o[0]=__builtin_amdgcn_mfma_f32_32x32x16_bf16(PAF(1),VFR(1),o[0],0,0,0), C0,8); \
    KRD(GL,1); GAPB(o[1]=__builtin_amdgcn_mfma_f32_32x32x16_bf16(PAF(1),VFR(5),o[1],0,0,0), C0,12); \
    KRD(GL,2); GAPB(o[0]=__builtin_amdgcn_mfma_f32_32x32x16_bf16(PAF(2),VFR(2),o[0],0,0,0), C1,0); \
    KRD(GL,3); GAPB(o[1]=__builtin_amdgcn_mfma_f32_32x32x16_bf16(PAF(2),VFR(6),o[1],0,0,0), C1,4); \
    GAPB(o[0]=__builtin_amdgcn_mfma_f32_32x32x16_bf16(PAF(3),VFR(3),o[0],0,0,0), C1,8); \
    GAPB(o[1]=__builtin_amdgcn_mfma_f32_32x32x16_bf16(PAF(3),VFR(7),o[1],0,0,0), C1,12); \
    }while(0)
  int t=1;
  #undef CMASK
  #define CMASK(P0,P1,t) do{}while(0)
  for(;t+7<NT;t+=2){
    STEP(pB0,pB1,pA0,pA1,t,true,true,true);     WAIT_BAR(3); RESC(t); ROT();
    STEP(pA0,pA1,pB0,pB1,t+1,true,true,true);   WAIT_BAR(3); RESC(t+1); ROT();
  }
  #undef CMASK
  #define CMASK(P0,P1,t) do{int jb_=(t)-(NTr-2); if(jb_>=-2)cmask(P0,P1,jb_,qrel,hi,tabd);}while(0)
  for(;t+1<NT;t+=2){
    STEP(pB0,pB1,pA0,pA1,t,(t+3<NT),(t+1<NT),(t+1<NT));       ENDW(t);   RESC(t); ROT();
    STEP(pA0,pA1,pB0,pB1,t+1,(t+4<NT),(t+2<NT),(t+2<NT));     ENDW(t+1); RESC(t+1); ROT();
  }
  STEP(pB0,pB1,pA0,pA1,NT-1,false,false,false); RESC(NT-1);
  WAIT_BAR(0);
  { float sacc=pB0[0]+pB0[1]; _Pragma("unroll") for(int r=2;r<16;++r)sacc+=pB0[r]; _Pragma("unroll") for(int r=0;r<16;++r)sacc+=pB1[r]; l_reg+=sacc;
    pw0=(u32x4){PKW(pB0,0),PKW(pB0,2),PKW(pB0,4),PKW(pB0,6)};pw1=(u32x4){PKW(pB0,8),PKW(pB0,10),PKW(pB0,12),PKW(pB0,14)};pw2=(u32x4){PKW(pB1,0),PKW(pB1,2),PKW(pB1,4),PKW(pB1,6)};pw3=(u32x4){PKW(pB1,8),PKW(pB1,10),PKW(pB1,12),PKW(pB1,14)};
    { char*pb_=pbuf+((NT-1)&1)*4096+lane*16; *(u32x4*)(pb_)=pw0; *(u32x4*)(pb_+1024)=pw1; *(u32x4*)(pb_+2048)=pw2; *(u32x4*)(pb_+3072)=pw3; }
    SBAR(); pv(o,vb0+sl_cur,PAF(0),PAF(1),PAF(2),PAF(3)); }
  #undef PKW
  #undef PAF
  #undef VFR
  #undef PIN
  #undef MX3
  #undef GAPA
  #undef GAPB
  #undef EX
  #undef VRD
  #undef KRD
  #undef STEP
  {auto rr=__builtin_amdgcn_permlane32_swap(__float_as_uint(l_reg),__float_as_uint(l_reg),false,false);l_reg=__uint_as_float(rr[0])+__uint_as_float(rr[1]);}
  if(hi==0)lbuf[r32]=l_reg;
  WAIT_BAR(0);
  float rli[16];
  #pragma unroll
  for(int r=0;r<16;++r)rli[r]=__builtin_amdgcn_rcpf(lbuf[crow(r,hi)]);
  bf16*Ow=O+(rowbase+q0+w4*QBLK)*DM+(h*2)*D;
  { bf16*stg=(bf16*)(shm+L2_VA)+w4*2048;
    #pragma unroll
    for(int r=0;r<16;++r){const int orow=crow(r,hi);
      #pragma unroll
      for(int d0=0;d0<2;++d0)stg[orow*64+d0*32+r32]=__float2bfloat16(o[d0][r]*rli[r]);}
    asm volatile("s_waitcnt lgkmcnt(0)":::"memory");
    int le=lane; asm volatile("":"+v"(le));
    #pragma unroll
    for(int i=0;i<4;++i){const int row=i*8+(le>>3),ch=le&7; const u32x4 v=*(const u32x4*)(stg+row*64+ch*8); ATTN_STORE16(Ow+(long)row*DM+ch*8,v);} }
  } else {
  f32x16 o[2];o[0]=f32x16{};o[1]=f32x16{};
  #define LDP(k,par) (*(const bf16x8*)(pbuf+(par)*4096+(k)*1024+lane*16))
  #define PVB(tt) do{ const int par_=(tt)&1; asm volatile("s_waitcnt lgkmcnt(0)":::"memory"); pv(o,vbB+(((tt)&3)*SLOTB),LDP(0,par_),LDP(1,par_),LDP(2,par_),LDP(3,par_)); }while(0)
  #define RESCB(tt) do{ if(flg[(tt)&1]){ const float*facp_=fac+((tt)&1)*32; _Pragma("unroll") for(int d_=0;d_<2;++d_) _Pragma("unroll") for(int r=0;r<16;++r)o[d_][r]*=facp_[crow(r,hi)]; } }while(0)
  DMA_K(2,2*SLOTB);
  WAIT_BAR(4);
  WAIT_BAR(0);
  DMA_K(3,0);DMA_V(1,SLOTB);
  ROT();
  WAIT_BAR(3);
  for(int t=1;t<NT;++t){
    if(t>=2){ PVB(t-2); RESCB(t-1); }
    if(t+3<NT){DMA_K(t+3,sl_cur);} if(t+1<NT){DMA_V(t+1,sl_next);}
    if(t+1<NT){ ENDW(t); } else { WAIT_BAR(0); }
    ROT();
  }
  WAIT_BAR(0);
  PVB(NT-2); RESCB(NT-1); PVB(NT-1);
  float rli[16];
  #pragma unroll
  for(int r=0;r<16;++r)rli[r]=__builtin_amdgcn_rcpf(lbuf[crow(r,hi)]);
  bf16*Ow=O+(rowbase+q0+w4*QBLK)*DM+(h*2+1)*D;
  { bf16*stg=(bf16*)(shm+L2_K)+w4*2048;
    #pragma unroll
    for(int r=0;r<16;++r){const int orow=crow(r,hi);
      #pragma unroll
      for(int d0=0;d0<2;++d0)stg[orow*64+d0*32+r32]=__float2bfloat16(o[d0][r]*rli[r]);}
    asm volatile("s_waitcnt lgkmcnt(0)":::"memory");
    int le=lane; asm volatile("":"+v"(le));
    #pragma unroll
    for(int i=0;i<4;++i){const int row=i*8+(le>>3),ch=le&7; const u32x4 v=*(const u32x4*)(stg+row*64+ch*8); ATTN_STORE16(Ow+(long)row*DM+ch*8,v);} }
  #undef LDP
  #undef PVB
  #undef RESCB
  }
  asm volatile("s_waitcnt lgkmcnt(0)\n\ts_barrier":::"memory");
  #undef ENDW
  #undef DMA_K
  #undef DMA_V
  #undef CMASK
  #undef START
  #undef RESC
  #undef ROT
}
constexpr int ATTN2_LDS_BYTES=L2_BYTES;
template<int THRL=8> __device__ __forceinline__ void attn_phase2(char*lds,const AttnTensors&T,int grid,int block){
  const int vcu=(grid%8==0)?(block%8)*(grid/8)+block/8:block;
  lds_cfptr tab=(lds_cfptr)((__attribute__((address_space(3))) const char*)lds+L2_TAB);
  { __attribute__((address_space(3))) float* tw=(__attribute__((address_space(3))) float*)((__attribute__((address_space(3))) char*)lds+L2_TAB);
    for(int i=threadIdx.x;i<8*128;i+=512){const int h=i>>7; tw[i]=T.TB[i]-T.TB[h*128+127];}
    asm volatile("s_waitcnt vmcnt(0) lgkmcnt(0)\n\ts_barrier":::"memory"); }
  for(int bh=vcu>>3;bh<BATCH*8;bh+=grid>>3){ const int b=bh>>3,h=bh&7,s=vcu&7; const float b31s=T.TB[h*128+127];
    for(int c=0;c<2;++c){
      for(int i=0;i<8;++i){ const int q=(i&1)?(16*(i>>1)+15-s):(16*(i>>1)+s);
        attn_unit2<THRL>(b,h,c,q,T.Q,T.K,T.V,c?T.O1:T.O0,lds,b31s,tab+h*128); } } }
}
constexpr int L3_K=0, L3_V=3*SLOTB, L3_P=11*SLOTB, L3_WS=15*SLOTB, L3_FAC=L3_WS+2048, L3_FLG=L3_FAC+1024, L3_LB=L3_FLG+64, L3_TAB=L3_LB+512, L3_BYTES=L3_TAB+4096;
template<int THRL> __device__ __forceinline__ void attn_unit3(int b,int h,int c,int q128,const bf16*Q,const bf16*__restrict__ K,const bf16*__restrict__ V,bf16*O,char*shm,float b31s,lds_cfptr tabd){
  const int tid=threadIdx.x,lane=tid&63,r32=lane&31,hi=lane>>5; const int wid=__builtin_amdgcn_readfirstlane(tid>>6); const int w4=wid&3; const bool roleA=wid<4;
  const long rowbase=(long)b*SEQ; const int q0=q128*128; const int hq=h*2+c;
  const bf16*Qw=Q+(rowbase+q0+w4*QBLK)*DM+hq*D;
  const bf16*Kh=K+rowbase*DM+hq*D,*Vh=V+rowbase*DM+(h*2)*D;
  const unsigned lds0=(unsigned)(uintptr_t)shm;
  float*wsf=(float*)(shm+L3_WS)+wid*64;
  float*fac=(float*)(shm+L3_FAC)+w4*64;
  volatile __attribute__((address_space(3))) unsigned*flg=(volatile __attribute__((address_space(3))) unsigned*)((__attribute__((address_space(3))) char*)shm+L3_FLG)+w4*2;
  float*lbuf=(float*)(shm+L3_LB)+w4*32;
  char*pbuf=shm+L3_P+w4*8192;
  const unsigned koff=(unsigned)(lane*DM+wid*8)*2u;
  const unsigned voff=(unsigned)((16*(wid&3)+(lane>>2))*DM+(wid>>2)*32+(lane&3)*8)*2u;
  const unsigned kdst=lds0+L3_K+wid*1024, vbdst=lds0+L3_V+wid*1024;
  #define DMA_K(t,slot) glds16(Kh+(long)(t)*KVBLK*DM,koff,(unsigned)__builtin_amdgcn_readfirstlane(kdst+(slot)))
  #define DMA_V(t,slot) do{ glds16(Vh+(long)(t)*KVBLK*DM,voff,(unsigned)__builtin_amdgcn_readfirstlane(vbdst+(((t)&3)*2*SLOTB))); \
    glds16(Vh+(long)(t)*KVBLK*DM+64,voff,(unsigned)__builtin_amdgcn_readfirstlane(vbdst+(((t)&3)*2*SLOTB+SLOTB))); }while(0)
  const int vbB=(int)(lds0+L3_V)+((lane>>4)&1)*32+(lane&3)*8+(4*hi+((lane&15)>>2))*64;
  const char*Kbase=shm+L3_K; bf16x8 kf[8];
  const lds_cptr shm3=(lds_cptr)shm; const lds_cptr kp0=shm3+L3_K+hi*1024+r32*16;
  const int NTr=2*q128+2, NT=NTr<4?4:NTr;
  DMA_K(0,0);DMA_V(0,0);DMA_K(1,SLOTB);
  int sl_prev=0,sl_cur=0,sl_next=SLOTB;
  #define ROT() do{sl_prev=sl_cur;sl_cur=sl_next;sl_next=(sl_next==(NSLOT-1)*SLOTB)?0:sl_next+SLOTB;}while(0)
  #define ENDW(tt) do{ if((tt)+3<NT){WAIT_BAR(3);} else if((tt)+2<NT){WAIT_BAR(2);} else {WAIT_BAR(0);} }while(0)
  if(roleA){
  bf16x8 qr[4];
  { int lq=lane; asm volatile("":"+v"(lq));
  #pragma unroll
  for(int d0=0;d0<4;++d0)qr[d0]=*reinterpret_cast<const bf16x8*>(&Qw[(long)(lq&31)*DM+d0*16+(lq>>5)*8]); }
  float mhat=0.f,l_reg=0.f;f32x16 negm;
  #pragma unroll
  for(int r=0;r<16;++r)negm[r]=b31s;
  asm volatile("":"+v"(negm));
  const int qrel=w4*QBLK+r32;
  #define CMASK(P0,P1,t) do{int jb_=(t)-(NTr-2); if(jb_>=-2)cmask(P0,P1,jb_,qrel,hi,tabd);}while(0)
  bool resc=false;
  #define START(P0,P1) do{ const float rm=rowmax(P0,P1); resc=false; \
    { const float dl=rm; mhat=fadd_s(mhat,dl); \
      _Pragma("unroll") for(int r=0;r<16;++r){P0[r]=fsub_s(P0[r],dl);P1[r]=fsub_s(P1[r],dl);} \
      _Pragma("unroll") for(int r=0;r<16;++r)negm[r]=b31s-mhat; asm volatile("":"+v"(negm)); } \
    _Pragma("unroll") for(int r=0;r<16;++r)P0[r]=__builtin_amdgcn_exp2f(P0[r]); }while(0)
  #define RESC(t) do{}while(0)
  f32x16 pA0,pA1,pB0,pB1;
  DMA_K(2,2*SLOTB);
  WAIT_BAR(4);
  qkt(pA0,pA1,Kbase,qr,negm,r32,hi);asm volatile("s_nop 15\n\ts_nop 7":"+v"(pA0),"+v"(pA1));CMASK(pA0,pA1,0);
  START(pA0,pA1);
  _Pragma("unroll") for(int r=0;r<16;++r)pA1[r]=__builtin_amdgcn_exp2f(pA1[r]);
  WAIT_BAR(0);
  DMA_K(3,0);DMA_V(1,SLOTB);
  ROT();
  kload8(kf,kp0+sl_cur);
  WAIT_BAR(3);
  u32x4 pw0,pw1,pw2,pw3;
  #define PKW(P,B) cvtpk_s(P[B],P[B+1])
  #define PAF(k) __builtin_bit_cast(bf16x8,pw##k)
  #define PIN(x) asm volatile("":"+v"(x))
  #define MX3(a,b,c) __builtin_fmaxf(__builtin_fmaxf((a),(b)),(c))
  #define GAPA(MF,A0,A1,A2,A3,W0,W1,PW) do{ MF; sacc+=A0; sacc+=A1; sacc+=A2; sacc+=A3; PIN(sacc); W0; W1; PIN(PW); SBAR(); }while(0)
  #define EX(v) __builtin_amdgcn_exp2f(v)
  #define GAPX(X,B) do{ X[B]=EX(X[B]); X[B+1]=EX(X[B+1]); X[B+2]=EX(X[B+2]); X[B+3]=EX(X[B+3]); PIN(X); SBAR(); }while(0)
  #define KRD(G,j) do{ if(G){ kload2(kf,kp0+sl_next,j); SBAR(); } }while(0)
  #define STEP(C0,C1,P0,P1,t,GK,GV,GL) do{ SBAR(); \
    float sacc=(P0[0]+P0[1]); \
    GAPA(C0=__builtin_amdgcn_mfma_f32_32x32x16_bf16(kf[0],qr[0],negm,0,0,0), P0[2],P0[3],P0[4],P0[5],     pw0[0]=PKW(P0,0), pw0[1]=PKW(P0,2), pw0); \
    GAPA(C1=__builtin_amdgcn_mfma_f32_32x32x16_bf16(kf[1],qr[0],negm,0,0,0), P0[6],P0[7],P0[8],P0[9],     pw0[2]=PKW(P0,4), pw0[3]=PKW(P0,6), pw0); \
    GAPA(C0=__builtin_amdgcn_mfma_f32_32x32x16_bf16(kf[2],qr[1],C0,0,0,0),   P0[10],P0[11],P0[12],P0[13], pw1[0]=PKW(P0,8), pw1[1]=PKW(P0,10), pw1); \
    GAPA(C1=__builtin_amdgcn_mfma_f32_32x32x16_bf16(kf[3],qr[1],C1,0,0,0),   P0[14],P0[15],P1[0],P1[1],   pw1[2]=PKW(P0,12),pw1[3]=PKW(P0,14), pw1); \
    GAPA(C0=__builtin_amdgcn_mfma_f32_32x32x16_bf16(kf[4],qr[2],C0,0,0,0),   P1[2],P1[3],P1[4],P1[5],     pw2[0]=PKW(P1,0), pw2[1]=PKW(P1,2), pw2); \
    GAPA(C1=__builtin_amdgcn_mfma_f32_32x32x16_bf16(kf[5],qr[2],C1,0,0,0),   P1[6],P1[7],P1[8],P1[9],     pw2[2]=PKW(P1,4), pw2[3]=PKW(P1,6), pw2); \
    GAPA(C0=__builtin_amdgcn_mfma_f32_32x32x16_bf16(kf[6],qr[3],C0,0,0,0),   P1[10],P1[11],P1[12],P1[13], pw3[0]=PKW(P1,8), pw3[1]=PKW(P1,10), pw3); \
    GAPA(C1=__builtin_amdgcn_mfma_f32_32x32x16_bf16(kf[7],qr[3],C1,0,0,0),   P1[14],P1[15],0.f,0.f,       pw3[2]=PKW(P1,12),pw3[3]=PKW(P1,14), pw3); \
    l_reg+=sacc; \
    { char*pb_=pbuf+(((t)-1)&1)*4096+lane*16; *(u32x4*)(pb_)=pw0; *(u32x4*)(pb_+1024)=pw1; *(u32x4*)(pb_+2048)=pw2; *(u32x4*)(pb_+3072)=pw3; }     \
    if(GK){DMA_K((t)+3,sl_cur);} if(GV){DMA_V((t)+1,sl_next);} \
    CMASK(C0,C1,t); \
    { float a=MX3(C0[0],C0[1],C1[0]),b=MX3(C0[2],C0[3],C1[1]); a=MX3(a,C1[2],C1[3]); \
      _Pragma("unroll") for(int r=4;r<16;r+=4){a=MX3(a,C0[r],C0[r+1]);b=MX3(b,C0[r+2],C0[r+3]);a=MX3(a,C1[r],C1[r+1]);b=MX3(b,C1[r+2],C1[r+3]);} \
      float rm=__builtin_fmaxf(a,b); { auto rr=__builtin_amdgcn_permlane32_swap(__float_as_uint(rm),__float_as_uint(rm),false,false); rm=__builtin_fmaxf(__uint_as_float(rr[0]),__uint_as_float(rr[1])); } \
      resc=false; \
      if(__builtin_expect(__any(rm>(float)THRL),0)){ const float dl=__builtin_fmaxf(rm,0.f); mhat+=dl; \
        _Pragma("unroll") for(int r=0;r<16;++r){C0[r]-=dl;C1[r]-=dl;} \
        _Pragma("unroll") for(int r=0;r<16;++r)negm[r]=b31s-mhat; asm volatile("":"+v"(negm)); \
        const float f=__builtin_amdgcn_exp2f(-dl); l_reg*=f; if(hi==0)fac[((t)&1)*32+r32]=f; resc=true; } \
      if(lane==0)flg[(t)&1]=resc?1u:0u; } \
    SBAR(); \
    GAPX(C0,0); \
    GAPX(C0,4); \
    KRD(GL,0); GAPX(C0,8); \
    KRD(GL,1); GAPX(C0,12); \
    KRD(GL,2); GAPX(C1,0); \
    KRD(GL,3); GAPX(C1,4); \
    GAPX(C1,8); \
    GAPX(C1,12); \
    }while(0)
  int t=1;
  #undef CMASK
  #define CMASK(P0,P1,t) do{}while(0)
  for(;t+7<NT;t+=2){
    STEP(pB0,pB1,pA0,pA1,t,true,true,true);     WAIT_BAR(3); RESC(t); ROT();
    STEP(pA0,pA1,pB0,pB1,t+1,true,true,true);   WAIT_BAR(3); RESC(t+1); ROT();
  }
  #undef CMASK
  #define CMASK(P0,P1,t) do{int jb_=(t)-(NTr-2); if(jb_>=-2)cmask(P0,P1,jb_,qrel,hi,tabd);}while(0)
  for(;t+1<NT;t+=2){
    STEP(pB0,pB1,pA0,pA1,t,(t+3<NT),(t+1<NT),(t+1<NT));       ENDW(t);   RESC(t); ROT();
    STEP(pA0,pA1,pB0,pB1,t+1,(t+4<NT),(t+2<NT),(t+2<NT));     ENDW(t+1); RESC(t+1); ROT();
  }
  STEP(pB0,pB1,pA0,pA1,NT-1,false,false,false); RESC(NT-1);
  WAIT_BAR(0);
  { float sacc=pB0[0]+pB0[1]; _Pragma("unroll") for(int r=2;r<16;++r)sacc+=pB0[r]; _Pragma("unroll") for(int r=0;r<16;++r)sacc+=pB1[r]; l_reg+=sacc;
    pw0=(u32x4){PKW(pB0,0),PKW(pB0,2),PKW(pB0,4),PKW(pB0,6)};pw1=(u32x4){PKW(pB0,8),PKW(pB0,10),PKW(pB0,12),PKW(pB0,14)};pw2=(u32x4){PKW(pB1,0),PKW(pB1,2),PKW(pB1,4),PKW(pB1,6)};pw3=(u32x4){PKW(pB1,8),PKW(pB1,10),PKW(pB1,12),PKW(pB1,14)};
    { char*pb_=pbuf+((NT-1)&1)*4096+lane*16; *(u32x4*)(pb_)=pw0; *(u32x4*)(pb_+1024)=pw1; *(u32x4*)(pb_+2048)=pw2; *(u32x4*)(pb_+3072)=pw3; }
    }
  #undef PKW
  #undef PAF
  #undef PIN
  #undef MX3
  #undef GAPA
  #undef GAPX
  #undef EX
  #undef KRD
  #undef STEP
  {auto rr=__builtin_amdgcn_permlane32_swap(__float_as_uint(l_reg),__float_as_uint(l_reg),false,false);l_reg=__uint_as_float(rr[0])+__uint_as_float(rr[1]);}
  if(hi==0)lbuf[r32]=l_reg;
  WAIT_BAR(0);
  } else {
  f32x16 o[4];o[0]=f32x16{};o[1]=f32x16{};o[2]=f32x16{};o[3]=f32x16{};
  #define LDP(k,par) (*(const bf16x8*)(pbuf+(par)*4096+(k)*1024+lane*16))
  #define PVB(tt) do{ const int par_=(tt)&1; asm volatile("s_waitcnt lgkmcnt(0)":::"memory"); const bf16x8 p0_=LDP(0,par_),p1_=LDP(1,par_),p2_=LDP(2,par_),p3_=LDP(3,par_); pv(o,vbB+(((tt)&3)*2*SLOTB),p0_,p1_,p2_,p3_); pv(o+2,vbB+(((tt)&3)*2*SLOTB+SLOTB),p0_,p1_,p2_,p3_); }while(0)
  #define RESCB(tt) do{ if(flg[(tt)&1]){ const float*facp_=fac+((tt)&1)*32; _Pragma("unroll") for(int d_=0;d_<4;++d_) _Pragma("unroll") for(int r=0;r<16;++r)o[d_][r]*=facp_[crow(r,hi)]; } }while(0)
  DMA_K(2,2*SLOTB);
  WAIT_BAR(4);
  WAIT_BAR(0);
  DMA_K(3,0);DMA_V(1,SLOTB);
  ROT();
  WAIT_BAR(3);
  for(int t=1;t<NT;++t){
    if(t>=2){ PVB(t-2); RESCB(t-1); }
    if(t+3<NT){DMA_K(t+3,sl_cur);} if(t+1<NT){DMA_V(t+1,sl_next);}
    if(t+1<NT){ ENDW(t); } else { WAIT_BAR(0); }
    ROT();
  }
  WAIT_BAR(0);
  PVB(NT-2); RESCB(NT-1); PVB(NT-1);
  float rli[16];
  #pragma unroll
  for(int r=0;r<16;++r)rli[r]=__builtin_amdgcn_rcpf(lbuf[crow(r,hi)]);
  bf16*Ow=O+(rowbase+q0+w4*QBLK)*DM+(h*2)*D;
  { bf16*stg=(bf16*)(pbuf);
    #pragma unroll
    for(int r=0;r<16;++r){const int orow=crow(r,hi);
      #pragma unroll
      for(int d0=0;d0<4;++d0)stg[orow*128+d0*32+r32]=__float2bfloat16(o[d0][r]*rli[r]);}
    asm volatile("s_waitcnt lgkmcnt(0)":::"memory");
    int le=lane; asm volatile("":"+v"(le));
    #pragma unroll
    for(int i=0;i<8;++i){const int row=i*4+(le>>4),ch=le&15; const u32x4 v=*(const u32x4*)(stg+row*128+ch*8); ATTN_STORE16(Ow+(long)row*DM+ch*8,v);} }
  #undef LDP
  #undef PVB
  #undef RESCB
  }
  asm volatile("s_waitcnt lgkmcnt(0)\n\ts_barrier":::"memory");
  #undef ENDW
  #undef DMA_K
  #undef DMA_V
  #undef CMASK
  #undef START
  #undef RESC
  #undef ROT
}
constexpr int ATTN3_LDS_BYTES=L3_BYTES;
template<int THRL=8> __device__ __forceinline__ void attn_phase3(char*lds,const AttnTensors&T,int grid,int block){
  const int vcu=(grid%8==0)?(block%8)*(grid/8)+block/8:block;
  lds_cfptr tab=(lds_cfptr)((__attribute__((address_space(3))) const char*)lds+L3_TAB);
  { __attribute__((address_space(3))) float* tw=(__attribute__((address_space(3))) float*)((__attribute__((address_space(3))) char*)lds+L3_TAB);
    for(int i=threadIdx.x;i<8*128;i+=512){const int h=i>>7; tw[i]=T.TB[i]-T.TB[h*128+127];}
    asm volatile("s_waitcnt vmcnt(0) lgkmcnt(0)\n\ts_barrier":::"memory"); }
  for(int bh=vcu>>3;bh<BATCH*8;bh+=grid>>3){ const int b=bh>>3,h=bh&7,s=vcu&7; const float b31s=T.TB[h*128+127];
    for(int c=0;c<2;++c){
      for(int i=0;i<8;++i){ const int q=(i&1)?(16*(i>>1)+15-s):(16*(i>>1)+s);
        attn_unit3<THRL>(b,h,c,q,T.Q,T.K,T.V,c?T.O1:T.O0,lds,b31s,tab+h*128); } } }
}
constexpr int L4_K=0, L4_V=3*SLOTB, L4_WS=9*SLOTB, L4_TAB=L4_WS+2048, L4_BYTES=L4_TAB+4096;
template<int THRL> __device__ __forceinline__ void attn_unit4(int b,int h,int c,int qb,const bf16*Q,const bf16*__restrict__ K,const bf16*__restrict__ V,bf16*O,bf16*OC,const float*subg,float lam,char*shm,float b31s,lds_cfptr tabd){
  const int tid=threadIdx.x,lane=tid&63,r32=lane&31,hi=lane>>5; const int wid=__builtin_amdgcn_readfirstlane(tid>>6);
  const long rowbase=(long)b*SEQ; const int q0=qb*QB; const int hq=h*2+c;
  const bf16*Qw=Q+(rowbase+q0+wid*QBLK)*DM+hq*D;
  const bf16*Kh=K+rowbase*DM+hq*D,*Vh=V+rowbase*DM+(h*2)*D;
  const unsigned lds0=(unsigned)(uintptr_t)shm;
  float*wsf=(float*)(shm+L4_WS)+wid*64;
  const unsigned koff=(unsigned)(lane*DM+wid*8)*2u;
  const unsigned voff=(unsigned)((16*(wid&3)+(lane>>2))*DM+(wid>>2)*32+(lane&3)*8)*2u;
  const unsigned kdst=lds0+L4_K+wid*1024, vdst=lds0+L4_V+wid*1024;
  #define DMA_K(t,slot) glds16(Kh+(long)(t)*KVBLK*DM,koff,(unsigned)__builtin_amdgcn_readfirstlane(kdst+(slot)))
  #define DMA_V(t,slot) do{ glds16(Vh+(long)(t)*KVBLK*DM,voff,(unsigned)__builtin_amdgcn_readfirstlane(vdst+2*(slot))); \
    glds16(Vh+(long)(t)*KVBLK*DM+64,voff,(unsigned)__builtin_amdgcn_readfirstlane(vdst+2*(slot)+SLOTB)); }while(0)
  const int vb0=(int)(lds0+L4_V)+((lane>>4)&1)*32+(lane&3)*8+(4*hi+((lane&15)>>2))*64;
  const char*Kbase=shm+L4_K; bf16x8 kf[8];
  const lds_cptr shm3=(lds_cptr)shm; const lds_cptr kp0=shm3+L4_K+hi*1024+r32*16; const lds_cptr vp0=shm3+L4_V+((lane>>4)&1)*32+(lane&3)*8+(4*hi+((lane&15)>>2))*64;
  const int NT=(q0+QB)/KVBLK, NTr=NT-2;
  DMA_K(0,0);DMA_V(0,0);DMA_K(1,SLOTB);
  int sl_prev=0,sl_cur=0,sl_next=SLOTB;
  #define ROT() do{sl_prev=sl_cur;sl_cur=sl_next;sl_next=(sl_next==(NSLOT-1)*SLOTB)?0:sl_next+SLOTB;}while(0)
  #define ENDW(tt) do{ if((tt)+3<NT){WAIT_BAR(3);} else if((tt)+2<NT){WAIT_BAR(2);} else {WAIT_BAR(0);} }while(0)
  bf16x8 qr[4];
  { int lq=lane; asm volatile("":"+v"(lq));
  #pragma unroll
  for(int d0=0;d0<4;++d0)qr[d0]=*reinterpret_cast<const bf16x8*>(&Qw[(long)(lq&31)*DM+d0*16+(lq>>5)*8]); }
  float mhat=0.f,l_reg=0.f;f32x16 o[4];o[0]=f32x16{};o[1]=f32x16{};o[2]=f32x16{};o[3]=f32x16{};float nm=0.f; (void)b31s; const f32x16 zc=f32x16{};
  const int qrel=wid*QBLK+r32;
  #define CMASK(P0,P1,t) do{int jb_=(t)-(NTr-2); if(jb_>=-2)cmask4(P0,P1,jb_,qrel,hi,tabd);}while(0)
  bool resc=false;
  #define START(P0,P1) do{ const float rm=rowmax(P0,P1); resc=false; \
    { const float dl=(rm>(float)THRL||rm<-(float)THRL)?rm:0.f; mhat=fadd_s(mhat,dl);     \
      _Pragma("unroll") for(int r=0;r<16;++r){P0[r]=fsub_s(P0[r],dl);P1[r]=fsub_s(P1[r],dl);} \
      nm=-mhat; } \
    _Pragma("unroll") for(int r=0;r<16;++r)P0[r]=__builtin_amdgcn_exp2f(P0[r]); }while(0)
  #define RESC(t) do{ if(resc){ asm volatile("s_waitcnt lgkmcnt(0)":::"memory"); \
      _Pragma("unroll") for(int d_=0;d_<4;++d_) _Pragma("unroll") for(int r=0;r<16;++r)o[d_][r]*=wsf[crow(r,hi)]; } }while(0)
  f32x16 pA0,pA1,pB0,pB1;
  DMA_K(2,2*SLOTB);
  WAIT_BAR(4);
  qkt(pA0,pA1,Kbase,qr,zc,r32,hi);asm volatile("s_nop 15\n\ts_nop 7":"+v"(pA0),"+v"(pA1));
  CMASK(pA0,pA1,0);
  START(pA0,pA1);
  _Pragma("unroll") for(int r=0;r<16;++r)pA1[r]=__builtin_amdgcn_exp2f(pA1[r]);
  WAIT_BAR(0);
  DMA_K(3,0);DMA_V(1,SLOTB);
  ROT();
  kload8(kf,kp0+sl_cur);
  WAIT_BAR(3);
  u32x4 pw0,pw1,pw2,pw3;
  #define PKW(P,B) cvtpk_s(P[B],P[B+1])
  #define PAF(k) __builtin_bit_cast(bf16x8,pw##k)
  #define PIN(x) asm volatile("":"+v"(x))
  #define MX3(a,b,c) __builtin_fmaxf(__builtin_fmaxf((a),(b)),(c))
  #define GAPA(MF,A0,A1,A2,A3,W0,W1,PW) do{ MF; sacc+=A0; sacc+=A1; sacc+=A2; sacc+=A3; PIN(sacc); W0; W1; PIN(PW); SBAR(); }while(0)
  #define EX(v) __builtin_amdgcn_exp2f(v)
    \
  #define VF(lo,hi,k,d) do{ lo=vtr(vp_+(((d)>>1)*SLOTB+((d)&1)*4096+(k)*1024)); hi=vtr(vp_+(((d)>>1)*SLOTB+((d)&1)*4096+(k)*1024+512)); }while(0)
  #define VFRG(lo,hi) (bf16x8){lo[0],lo[1],lo[2],lo[3],hi[0],hi[1],hi[2],hi[3]}
  #define GAPY(g,cl0,ch0,cl1,ch1,nl0,nh0,nl1,nh1,X,B) do{ if((g)<7){ VF(nl0,nh0,((g)+1)>>1,2*(((g)+1)&1)); VF(nl1,nh1,((g)+1)>>1,2*(((g)+1)&1)+1); } \
    o[2*((g)&1)]=__builtin_amdgcn_mfma_f32_32x32x16_bf16(PAFK((g)>>1),VFRG(cl0,ch0),o[2*((g)&1)],0,0,0); o[2*((g)&1)+1]=__builtin_amdgcn_mfma_f32_32x32x16_bf16(PAFK((g)>>1),VFRG(cl1,ch1),o[2*((g)&1)+1],0,0,0); \
    X[B]=EX(X[B]); X[B+1]=EX(X[B+1]); X[B+2]=EX(X[B+2]); X[B+3]=EX(X[B+3]); PIN(X); SBAR(); }while(0)
  #define PAFK(k) ((k)==0?PAF(0):(k)==1?PAF(1):(k)==2?PAF(2):PAF(3))
  #define KRD(G,j) do{ if(G){ kload2(kf,kp0+sl_next,j); SBAR(); } }while(0)
  #define STEP(C0,C1,P0,P1,t,GK,GV,GL) do{ SBAR(); \
    float sacc=(P0[0]+P0[1]); \
    GAPA(C0=__builtin_amdgcn_mfma_f32_32x32x16_bf16(kf[0],qr[0],zc,0,0,0), P0[2],P0[3],P0[4],P0[5],     pw0[0]=PKW(P0,0), pw0[1]=PKW(P0,2), pw0); \
    GAPA(C1=__builtin_amdgcn_mfma_f32_32x32x16_bf16(kf[1],qr[0],zc,0,0,0), P0[6],P0[7],P0[8],P0[9],     pw0[2]=PKW(P0,4), pw0[3]=PKW(P0,6), pw0); \
    GAPA(C0=__builtin_amdgcn_mfma_f32_32x32x16_bf16(kf[2],qr[1],C0,0,0,0),   P0[10],P0[11],P0[12],P0[13], pw1[0]=PKW(P0,8), pw1[1]=PKW(P0,10), pw1); \
    GAPA(C1=__builtin_amdgcn_mfma_f32_32x32x16_bf16(kf[3],qr[1],C1,0,0,0),   P0[14],P0[15],P1[0],P1[1],   pw1[2]=PKW(P0,12),pw1[3]=PKW(P0,14), pw1); \
    GAPA(C0=__builtin_amdgcn_mfma_f32_32x32x16_bf16(kf[4],qr[2],C0,0,0,0),   P1[2],P1[3],P1[4],P1[5],     pw2[0]=PKW(P1,0), pw2[1]=PKW(P1,2), pw2); \
    GAPA(C1=__builtin_amdgcn_mfma_f32_32x32x16_bf16(kf[5],qr[2],C1,0,0,0),   P1[6],P1[7],P1[8],P1[9],     pw2[2]=PKW(P1,4), pw2[3]=PKW(P1,6), pw2); \
    GAPA(C0=__builtin_amdgcn_mfma_f32_32x32x16_bf16(kf[6],qr[3],C0,0,0,0),   P1[10],P1[11],P1[12],P1[13], pw3[0]=PKW(P1,8), pw3[1]=PKW(P1,10), pw3); \
    GAPA(C1=__builtin_amdgcn_mfma_f32_32x32x16_bf16(kf[7],qr[3],C1,0,0,0),   P1[14],P1[15],0.f,0.f,       pw3[2]=PKW(P1,12),pw3[3]=PKW(P1,14), pw3); \
    l_reg+=sacc; \
    if(GK){DMA_K((t)+3,sl_cur);} if(GV){DMA_V((t)+1,sl_next);} \
    if(__any(nm!=0.f)){ _Pragma("unroll") for(int r=0;r<16;++r){C0[r]+=nm;C1[r]+=nm;} } \
    CMASK(C0,C1,t); \
    { float a=MX3(C0[0],C0[1],C1[0]),b=MX3(C0[2],C0[3],C1[1]); a=MX3(a,C1[2],C1[3]); \
      _Pragma("unroll") for(int r=4;r<16;r+=4){a=MX3(a,C0[r],C0[r+1]);b=MX3(b,C0[r+2],C0[r+3]);a=MX3(a,C1[r],C1[r+1]);b=MX3(b,C1[r+2],C1[r+3]);} \
      float rm=__builtin_fmaxf(a,b); { auto rr=__builtin_amdgcn_permlane32_swap(__float_as_uint(rm),__float_as_uint(rm),false,false); rm=__builtin_fmaxf(__uint_as_float(rr[0]),__uint_as_float(rr[1])); } \
      resc=false; \
      if(__builtin_expect(__any(rm>(float)THRL),0)){ const float dl=__builtin_fmaxf(rm,0.f); mhat+=dl; \
        _Pragma("unroll") for(int r=0;r<16;++r){C0[r]-=dl;C1[r]-=dl;} \
        nm=-mhat; \
        const float f=__builtin_amdgcn_exp2f(-dl); l_reg*=f; if(hi==0)wsf[r32]=f; resc=true; } } \
    SBAR(); \
    const lds_cptr vp_=vp0+2*sl_prev; s16x4 fl0,fh0,fl1,fh1,gl0,gh0,gl1,gh1; \
    VF(fl0,fh0,0,0); VF(fl1,fh1,0,1); SBAR(); \
    GAPY(0,fl0,fh0,fl1,fh1,gl0,gh0,gl1,gh1,C0,0); \
    GAPY(1,gl0,gh0,gl1,gh1,fl0,fh0,fl1,fh1,C0,4); \
    KRD(GL,0); GAPY(2,fl0,fh0,fl1,fh1,gl0,gh0,gl1,gh1,C0,8); \
    KRD(GL,1); GAPY(3,gl0,gh0,gl1,gh1,fl0,fh0,fl1,fh1,C0,12); \
    KRD(GL,2); GAPY(4,fl0,fh0,fl1,fh1,gl0,gh0,gl1,gh1,C1,0); \
    KRD(GL,3); GAPY(5,gl0,gh0,gl1,gh1,fl0,fh0,fl1,fh1,C1,4); \
    GAPY(6,fl0,fh0,fl1,fh1,gl0,gh0,gl1,gh1,C1,8); \
    GAPY(7,gl0,gh0,gl1,gh1,fl0,fh0,fl1,fh1,C1,12); \
    }while(0)
  if(wid>=4)__builtin_amdgcn_s_setprio(1);
  int t=1;
  #undef CMASK
  #define CMASK(P0,P1,t) do{}while(0)
  for(;t+7<NT;t+=2){
    STEP(pB0,pB1,pA0,pA1,t,true,true,true);     WAIT_BAR(3); RESC(t); ROT();
    STEP(pA0,pA1,pB0,pB1,t+1,true,true,true);   WAIT_BAR(3); RESC(t+1); ROT();
  }
  #undef CMASK
  #define CMASK(P0,P1,t) do{int jb_=(t)-(NTr-2); if(jb_>=-2)cmask4(P0,P1,jb_,qrel,hi,tabd);}while(0)
  for(;t+1<NT;t+=2){
    STEP(pB0,pB1,pA0,pA1,t,(t+3<NT),(t+1<NT),(t+1<NT));       ENDW(t);   RESC(t); ROT();
    STEP(pA0,pA1,pB0,pB1,t+1,(t+4<NT),(t+2<NT),(t+2<NT));     ENDW(t+1); RESC(t+1); ROT();
  }
  STEP(pB0,pB1,pA0,pA1,NT-1,false,false,false); RESC(NT-1);
  { float sacc=pB0[0]+pB0[1]; _Pragma("unroll") for(int r=2;r<16;++r)sacc+=pB0[r]; _Pragma("unroll") for(int r=0;r<16;++r)sacc+=pB1[r]; l_reg+=sacc;
    pw0=(u32x4){PKW(pB0,0),PKW(pB0,2),PKW(pB0,4),PKW(pB0,6)};pw1=(u32x4){PKW(pB0,8),PKW(pB0,10),PKW(pB0,12),PKW(pB0,14)};pw2=(u32x4){PKW(pB1,0),PKW(pB1,2),PKW(pB1,4),PKW(pB1,6)};pw3=(u32x4){PKW(pB1,8),PKW(pB1,10),PKW(pB1,12),PKW(pB1,14)};
    SBAR(); pv(o,vb0+2*sl_cur,PAF(0),PAF(1),PAF(2),PAF(3)); pv(o+2,vb0+2*sl_cur+SLOTB,PAF(0),PAF(1),PAF(2),PAF(3)); }
  #undef PKW
  #undef PAF
  #undef PIN
  #undef MX3
  #undef GAPA
  #undef GAPY
  #undef VF
  #undef VFRG
  #undef PAFK
  #undef EX
  #undef KRD
  #undef STEP
  {auto rr=__builtin_amdgcn_permlane32_swap(__float_as_uint(l_reg),__float_as_uint(l_reg),false,false);l_reg=__uint_as_float(rr[0])+__uint_as_float(rr[1]);}
  if(hi==0)wsf[32+r32]=l_reg;asm volatile("s_waitcnt lgkmcnt(0)":::"memory");
  float rli[16];
  #pragma unroll
  for(int r=0;r<16;++r)rli[r]=__builtin_amdgcn_rcpf(wsf[32+crow(r,hi)]);
  WAIT_BAR(0);
  bf16*Ow=O+(rowbase+q0+wid*QBLK)*DM+(h*2)*D;
  { bf16*stg=(bf16*)(shm+L4_K)+wid*4096;
    #pragma unroll
    for(int r=0;r<16;++r){const int orow=crow(r,hi);
      #pragma unroll
      for(int d0=0;d0<4;++d0)stg[orow*128+d0*32+r32]=__float2bfloat16(o[d0][r]*rli[r]);}
    asm volatile("s_waitcnt lgkmcnt(0)":::"memory");
    int le=lane; asm volatile("":"+v"(le));
    if(c==0){
    #pragma unroll
    for(int i=0;i<8;++i){const int row=i*4+(le>>4),ch=le&15; const u32x4 v=*(const u32x4*)(stg+row*128+ch*8); ATTN_STORE16(Ow+(long)row*DM+ch*8,v);}
    } else {
    asm volatile("s_waitcnt vmcnt(0)":::"memory");
    bf16*OCw=OC+(rowbase+q0+wid*QBLK)*DM+(h*2)*D; const int ch=le&15;
    const float4 g0=*(const float4*)(subg+ch*8), g1=*(const float4*)(subg+ch*8+4);
    #pragma unroll
    for(int i=0;i<8;++i){const int row=i*4+(le>>4); const u32x4 v1=*(const u32x4*)(stg+row*128+ch*8); const u32x4 v0=*(const u32x4*)(Ow+(long)row*DM+ch*8);
      float x[8];
      #define BLO(u_) __builtin_bit_cast(float,(u_)<<16)
      #define BHI(u_) __builtin_bit_cast(float,(u_)&0xffff0000u)
      x[0]=BLO(v0[0])-lam*BLO(v1[0]); x[1]=BHI(v0[0])-lam*BHI(v1[0]); x[2]=BLO(v0[1])-lam*BLO(v1[1]); x[3]=BHI(v0[1])-lam*BHI(v1[1]);
      x[4]=BLO(v0[2])-lam*BLO(v1[2]); x[5]=BHI(v0[2])-lam*BHI(v1[2]); x[6]=BLO(v0[3])-lam*BLO(v1[3]); x[7]=BHI(v0[3])-lam*BHI(v1[3]);
      #undef BLO
      #undef BHI
      float ss=(x[0]*x[0]+x[1]*x[1])+(x[2]*x[2]+x[3]*x[3])+(x[4]*x[4]+x[5]*x[5])+(x[6]*x[6]+x[7]*x[7]);
      ss+=__shfl_xor(ss,1); ss+=__shfl_xor(ss,2); ss+=__shfl_xor(ss,4); ss+=__shfl_xor(ss,8);
      const float rn=(1.0f/sqrtf(ss*(1.0f/128.0f)+1e-5f))*0.8f;
      u32x4 w; w[0]=cvtpk_s(x[0]*rn*g0.x,x[1]*rn*g0.y); w[1]=cvtpk_s(x[2]*rn*g0.z,x[3]*rn*g0.w); w[2]=cvtpk_s(x[4]*rn*g1.x,x[5]*rn*g1.y); w[3]=cvtpk_s(x[6]*rn*g1.z,x[7]*rn*g1.w);
      ATTN_STORE16(OCw+(long)row*DM+ch*8,w);}
    } }
  __builtin_amdgcn_s_setprio(0);
  asm volatile("s_waitcnt lgkmcnt(0)\n\ts_barrier":::"memory");
  #undef ENDW
  #undef DMA_K
  #undef DMA_V
  #undef CMASK
  #undef START
  #undef RESC
  #undef ROT
}
constexpr int ATTN4_LDS_BYTES=L4_BYTES;
template<int THRL=8> __device__ __forceinline__ void attn_phase4(char*lds,const AttnTensors&T,int grid,int block){
  const int vcu=(grid%8==0)?(block%8)*(grid/8)+block/8:block;
  lds_cfptr tab=(lds_cfptr)((__attribute__((address_space(3))) const char*)lds+L4_TAB);
  for(int bh=vcu>>3;bh<BATCH*8;bh+=grid>>3){ const int b=bh>>3,h=bh&7,s=vcu&7; const float b31s=T.TB[h*128+127];
    { __attribute__((address_space(3))) float* tw=(__attribute__((address_space(3))) float*)((__attribute__((address_space(3))) char*)lds+L4_TAB);
      asm volatile("s_waitcnt lgkmcnt(0)\n\ts_barrier":::"memory");
      for(int i=threadIdx.x;i<4*256;i+=512){const int sf=i>>8,kk=i&255,ix=kk+sf-64; tw[i]=(ix>=0&&ix<=127)?T.TB[h*128+ix]-b31s:0.f;}
      asm volatile("s_waitcnt vmcnt(0) lgkmcnt(0)\n\ts_barrier":::"memory"); }
    for(int i=0;i<4;++i){ const int qb=(i==0)?s:(i==1)?15-s:(i==2)?16+s:31-s;
      for(int c=0;c<2;++c)
        attn_unit4<THRL>(b,h,c,qb,T.Q,T.K,T.V,T.O0,T.O1,T.subg,T.lam,lds,b31s,tab); } }
}
#undef SBAR
#undef WAIT_BAR
}

constexpr int RING_BYTES = 135168;
constexpr int LDSCTL_OFF = RING_BYTES, MISC_OFF = LDSCTL_OFF + 320;
constexpr int LDS_BYTES = 147456;

struct Args { const float* in[28]; float* out; unsigned char* ws; int ph_lo, ph_hi; };

template <class XT> __device__ __forceinline__ f32x4 ld_row4(const XT* X, int m, int lane, int j) {
    if constexpr (sizeof(XT) == 4) return ((const f32x4*)((const float*)X + (size_t)m * DM))[lane + 64 * j];
    else { const unsigned long long w = ((const unsigned long long*)((const bf16*)X + (size_t)m * DM))[lane + 64 * j]; const unsigned lo = (unsigned)w, hi = (unsigned)(w >> 32);
        return (f32x4){bflo(lo), bfhi(lo), bflo(hi), bfhi(hi)}; }
}
template <class XT> __device__ __forceinline__ void rms_rows_bf16(const XT* X, const float* g, bf16* H, int bid, int nb) {
    const int tid_ = fresh_tid(); const int lane = tid_ & 63, wave = tid_ >> 6;
    f32x4 gv[4];
#pragma unroll
    for (int j = 0; j < 4; ++j) gv[j] = *(const f32x4*)(g + 4 * lane + 256 * j);
    for (int m = bid * NWAVES + wave; m < NT; m += nb * NWAVES) {
        f32x4 v[4]; float s = 0.f;
#pragma unroll
        for (int j = 0; j < 4; ++j) { v[j] = ld_row4(X, m, lane, j); s += (v[j].x * v[j].x + v[j].y * v[j].y) + (v[j].z * v[j].z + v[j].w * v[j].w); }
        const float r = 1.f / sqrtf(wave_sum(s) * (1.f / DM) + NORM_EPS);
        unsigned long long* o8 = (unsigned long long*)(H + (size_t)m * DM) + lane;
#pragma unroll
        for (int j = 0; j < 4; ++j) { const f32x4 y = v[j] * r * gv[j]; o8[64 * j] = (unsigned long long)pk2(y.x, y.y) | ((unsigned long long)pk2(y.z, y.w) << 32); }
    }
}
template <class XT> __device__ __forceinline__ void rms_rows_final(const XT* X, const float* g, float* OUT, int bid, int nb) {
    const int tid_ = fresh_tid(); const int lane = tid_ & 63, wave = tid_ >> 6;
    f32x4 gv[4];
#pragma unroll
    for (int j = 0; j < 4; ++j) gv[j] = *(const f32x4*)(g + 4 * lane + 256 * j);
    for (int m = bid * NWAVES + wave; m < NT; m += nb * NWAVES) {
        f32x4* orow = (f32x4*)(OUT + (size_t)m * DM) + lane;
        f32x4 v[4]; float s = 0.f;
#pragma unroll
        for (int j = 0; j < 4; ++j) { v[j] = ld_row4(X, m, lane, j); s += (v[j].x * v[j].x + v[j].y * v[j].y) + (v[j].z * v[j].z + v[j].w * v[j].w); }
        const float r = 1.f / sqrtf(wave_sum(s) * (1.f / DM) + NORM_EPS);
#pragma unroll
        for (int j = 0; j < 4; ++j) orow[64 * j] = v[j] * r * gv[j];
    }
}

template <int NB, class P>
__device__ __forceinline__ void ref_gemm(const P& p, LAS float* sm, int bid, int nb) {
    constexpr int LDP = 132;
    LAS float* As = sm; LAS float* Bs = sm + 16 * LDP;
    const int tid = fresh_tid(), ty = tid >> 4, tx = tid & 15;
    const int nt = p.ntiles();
    for (int it = bid; it < nt; it += nb) {
        int m0, n0; const float* W[2]; p.tile(it, m0, n0, W[0], W[1]);
        float acc[NB][4][8];
#pragma unroll
        for (int b = 0; b < NB; ++b)
#pragma unroll
            for (int i = 0; i < 4; ++i)
#pragma unroll
                for (int j = 0; j < 8; ++j) acc[b][i][j] = 0.f;
        const bf16* ap = p.arow(m0 + (tid >> 2)) + (tid & 3) * 4;
        for (int k0 = 0; k0 < p.K; k0 += 16) {
            { const v2u v = *(const v2u*)(ap + k0); const int r = tid >> 2, kq = (tid & 3) * 4;
              As[(kq + 0) * LDP + r] = bflo(v.x); As[(kq + 1) * LDP + r] = bfhi(v.x); As[(kq + 2) * LDP + r] = bflo(v.y); As[(kq + 3) * LDP + r] = bfhi(v.y); }
#pragma unroll
            for (int b = 0; b < NB; ++b) { const int k = tid >> 5, n4 = (tid & 31) * 4;
                const f32x4 v = *(const f32x4*)(W[b] + (size_t)(k0 + k) * p.ldw + n0 + n4);
                *(LAS f32x4*)(Bs + (b * 16 + k) * LDP + n4) = v; }
            __syncthreads();
#pragma unroll 2
            for (int kk = 0; kk < 16; ++kk) {
                const f32x4 a = *(const LAS f32x4*)(As + kk * LDP + ty * 4);
#pragma unroll
                for (int b = 0; b < NB; ++b) {
                    const f32x4 b0 = *(const LAS f32x4*)(Bs + (b * 16 + kk) * LDP + tx * 8), b1 = *(const LAS f32x4*)(Bs + (b * 16 + kk) * LDP + tx * 8 + 4);
#pragma unroll
                    for (int i = 0; i < 4; ++i) {
                        acc[b][i][0] += a[i] * b0.x; acc[b][i][1] += a[i] * b0.y; acc[b][i][2] += a[i] * b0.z; acc[b][i][3] += a[i] * b0.w;
                        acc[b][i][4] += a[i] * b1.x; acc[b][i][5] += a[i] * b1.y; acc[b][i][6] += a[i] * b1.z; acc[b][i][7] += a[i] * b1.w; }
                }
            }
            __syncthreads();
        }
#pragma unroll
        for (int i = 0; i < 4; ++i) {
            float a[NB][8];
#pragma unroll
            for (int b = 0; b < NB; ++b)
#pragma unroll
                for (int j = 0; j < 8; ++j) a[b][j] = acc[b][i][j];
            p.epi(m0 + ty * 4 + i, n0 + tx * 8, a);
        }
    }
}
__device__ __forceinline__ void st_bf16x8(bf16* p, const float* v) { v4u w; w.x = pk2(v[0], v[1]); w.y = pk2(v[2], v[3]); w.z = pk2(v[4], v[5]); w.w = pk2(v[6], v[7]); *(v4u*)p = w; }
__device__ __forceinline__ float silu_(float x) { return x / (1.f + __expf(-x)); }
__device__ __forceinline__ float gelu_tanh_(float x) { const float u = 0.7978845608028654f * (x + 0.044715f * x * x * x); return 0.5f * x * (1.f + tanhf(u)); }

struct PQkv {
    int K, ldw; const bf16* H; const float* W; bf16 *Q, *Kb, *V;
    __device__ int ntiles() const { return (NT / 128) * (3 * DM / 128); }
    __device__ void tile(int i, int& m0, int& n0, const float*& W0, const float*& W1) const { m0 = (i / 24) * 128; n0 = (i % 24) * 128; W0 = W; W1 = W; }
    __device__ const bf16* arow(int r) const { return H + (size_t)r * DM; }
    __device__ void epi(int r, int c0, const float (&a)[1][8]) const {
        const int t = c0 >> 10, c = c0 & 1023; float v[8]; const float sc = (t == 0) ? C2 : 1.f;
#pragma unroll
        for (int j = 0; j < 8; ++j) v[j] = a[0][j] * sc;
        st_bf16x8(Q + (size_t)t * (size_t)(32u << 20) + (size_t)r * DM + c, v); }
};
struct PResid {
    int K, ldw; const bf16* A; int lda; const float* W; const float* base; float* out;
    __device__ int ntiles() const { return (NT / 128) * (DM / 128); }
    __device__ void tile(int i, int& m0, int& n0, const float*& W0, const float*& W1) const { m0 = (i / 8) * 128; n0 = (i % 8) * 128; W0 = W; W1 = W; }
    __device__ const bf16* arow(int r) const { return A + (size_t)r * lda; }
    __device__ void epi(int r, int c0, const float (&a)[1][8]) const {
        const f32x4 b0 = *(const f32x4*)(base + (size_t)r * DM + c0), b1 = *(const f32x4*)(base + (size_t)r * DM + c0 + 4);
        *(f32x4*)(out + (size_t)r * DM + c0) = (f32x4){b0.x + a[0][0], b0.y + a[0][1], b0.z + a[0][2], b0.w + a[0][3]};
        *(f32x4*)(out + (size_t)r * DM + c0 + 4) = (f32x4){b1.x + a[0][4], b1.y + a[0][5], b1.z + a[0][6], b1.w + a[0][7]}; }
};
struct PSwiglu {
    int K, ldw; const bf16* H; const float *Wg, *Wu; bf16* ACT;
    __device__ int ntiles() const { return (NT / 128) * (DFF / 128); }
    __device__ void tile(int i, int& m0, int& n0, const float*& W0, const float*& W1) const { m0 = (i / 22) * 128; n0 = (i % 22) * 128; W0 = Wg; W1 = Wu; }
    __device__ const bf16* arow(int r) const { return H + (size_t)r * DM; }
    __device__ void epi(int r, int c0, const float (&a)[2][8]) const { float v[8];
#pragma unroll
        for (int j = 0; j < 8; ++j) v[j] = silu_(a[0][j]) * a[1][j];
        st_bf16x8(ACT + (size_t)r * DFF + c0, v); }
};
struct PWin {
    int K, ldw; const bf16* H; const float* W; bf16 *G, *XB;
    __device__ int ntiles() const { return (NT / 128) * (2 * DRNN / 128); }
    __device__ void tile(int i, int& m0, int& n0, const float*& W0, const float*& W1) const { m0 = (i / 20) * 128; n0 = (i % 20) * 128; W0 = W; W1 = W; }
    __device__ const bf16* arow(int r) const { return H + (size_t)r * DM; }
    __device__ void epi(int r, int c0, const float (&a)[1][8]) const { float v[8];
        if (c0 < DRNN) {
#pragma unroll
            for (int j = 0; j < 8; ++j) v[j] = gelu_tanh_(a[0][j]);
            st_bf16x8(G + (size_t)r * DRNN + c0, v);
        } else {
#pragma unroll
            for (int j = 0; j < 8; ++j) v[j] = a[0][j];
            st_bf16x8(XB + (size_t)r * DRNN + (c0 - DRNN), v); } }
};
struct PMoeGU {
    int K, ldw; const bf16* H; const float *Wg, *Wu; bf16* ACT; const int* tok; const int* base;
    __device__ int ntiles() const { return (base[8] / 128) * (DFE / 128); }
    __device__ void tile(int i, int& m0, int& n0, const float*& W0, const float*& W1) const {
        m0 = (i / 28) * 128; n0 = (i % 28) * 128; int e = 0;
#pragma unroll
        for (int j = 1; j < 8; ++j) e += (m0 >= base[j]) ? 1 : 0;
        W0 = Wg + (size_t)e * DM * DFE; W1 = Wu + (size_t)e * DM * DFE; }
    __device__ const bf16* arow(int r) const { int t = tok[r]; if (t < 0) t = 0; return H + (size_t)t * DM; }
    __device__ void epi(int r, int c0, const float (&a)[2][8]) const { float v[8];
#pragma unroll
        for (int j = 0; j < 8; ++j) v[j] = silu_(a[0][j]) * a[1][j];
        st_bf16x8(ACT + (size_t)r * DFE + c0, v); }
};
struct PMoeDown {
    int K, ldw; const bf16* ACT; const float* Wd; float* out; const int* tok; const float* gatev; const int* base;
    __device__ int ntiles() const { return (base[8] / 128) * (DM / 128); }
    __device__ void tile(int i, int& m0, int& n0, const float*& W0, const float*& W1) const {
        m0 = (i / 8) * 128; n0 = (i % 8) * 128; int e = 0;
#pragma unroll
        for (int j = 1; j < 8; ++j) e += (m0 >= base[j]) ? 1 : 0;
        W0 = Wd + (size_t)e * DFE * DM; W1 = W0; }
    __device__ const bf16* arow(int r) const { return ACT + (size_t)r * DFE; }
    __device__ void epi(int r, int c0, const float (&a)[1][8]) const {
        const int t = tok[r]; if (t < 0) return; const float g = gatev[r];
        float* o = out + (size_t)t * DM + c0; const f32x4 b0 = *(const f32x4*)o, b1 = *(const f32x4*)(o + 4);
        *(f32x4*)o = (f32x4){b0.x + g * a[0][0], b0.y + g * a[0][1], b0.z + g * a[0][2], b0.w + g * a[0][3]};
        *(f32x4*)(o + 4) = (f32x4){b1.x + g * a[0][4], b1.y + g * a[0][5], b1.z + g * a[0][6], b1.w + g * a[0][7]}; }
};

__device__ __forceinline__ int t5_bucket(int n) {
    const float nf = (float)(n < 1 ? 1 : n);
    int large = 16 + (int)(logf(nf / 16.0f) / 2.0794415416798357f * 16.0f);
    large = large < 31 ? large : 31;
    return n < 16 ? n : large;
}
__device__ __forceinline__ void build_tables(const float* rel_bias, float* TB) {
    for (int i = fresh_tid(); i < NH * 128; i += NTHR) { const int h = i >> 7, n = i & 127; TB[i] = rel_bias[t5_bucket(n) * NH + h] * LOG2E; }
}
__device__ __forceinline__ float compute_lam(const float* lq1, const float* lk1, const float* lq2, const float* lk2) {
    const int lane = fresh_tid() & 63;
    const float s1 = wave_sum(lq1[lane] * lk1[lane]), s2 = wave_sum(lq2[lane] * lk2[lane]);
    return expf(s1) - expf(s2) + LAM_INIT;
}

__device__ __forceinline__ void ref_attention(const bf16* Q, const bf16* Kb, const bf16* V, bf16* O0, bf16* O1, const float* TB, LAS float* sm, int bid, int nb) {
    LAS float* Ks = sm; LAS float* Vs = sm + 32 * 128; LAS float* tb = sm + 2 * 32 * 128;
    const int tid = fresh_tid(), qr = tid & 127, cv = tid >> 7, c = cv >> 1, vh = cv & 1;
    const int NU = NB_ * NH * (SEQ / 128);
    for (int u = bid; u < NU; u += nb) {
        const int uu = NU - 1 - u;
        const int qblk = uu / (NB_ * NH), bh = uu % (NB_ * NH), b = bh / NH, h = bh % NH;
        const int q0 = qblk * 128, q = q0 + qr; const size_t rb = (size_t)b * SEQ;
        __syncthreads();
        if (tid < 128) tb[tid] = TB[h * 128 + tid];
        float qv[64];
        { const v4u* qp = (const v4u*)(Q + (rb + q) * DM + h * 128 + c * 64);
#pragma unroll
          for (int i = 0; i < 8; ++i) { const v4u w = qp[i]; qv[8 * i] = bflo(w.x); qv[8 * i + 1] = bfhi(w.x); qv[8 * i + 2] = bflo(w.y); qv[8 * i + 3] = bfhi(w.y); qv[8 * i + 4] = bflo(w.z); qv[8 * i + 5] = bfhi(w.z); qv[8 * i + 6] = bflo(w.w); qv[8 * i + 7] = bfhi(w.w); } }
        float o[64]; float m = -INFINITY, l = 0.f;
#pragma unroll
        for (int d = 0; d < 64; ++d) o[d] = 0.f;
        const int nkt = (q0 + 127) / 32 + 1;
        for (int kt = 0; kt < nkt; ++kt) {
            __syncthreads();
            { const int r = tid >> 4, c8 = (tid & 15) * 8; const size_t g = (rb + kt * 32 + r) * DM + h * 128 + c8;
              const v4u kw = *(const v4u*)(Kb + g), vw = *(const v4u*)(V + g);
              LAS float* kd = Ks + r * 128 + c8; LAS float* vd = Vs + r * 128 + c8;
              kd[0] = bflo(kw.x); kd[1] = bfhi(kw.x); kd[2] = bflo(kw.y); kd[3] = bfhi(kw.y); kd[4] = bflo(kw.z); kd[5] = bfhi(kw.z); kd[6] = bflo(kw.w); kd[7] = bfhi(kw.w);
              vd[0] = bflo(vw.x); vd[1] = bfhi(vw.x); vd[2] = bflo(vw.y); vd[3] = bfhi(vw.y); vd[4] = bflo(vw.z); vd[5] = bfhi(vw.z); vd[6] = bflo(vw.w); vd[7] = bfhi(vw.w); }
            __syncthreads();
            if (kt * 32 <= q) {
#pragma unroll 1
                for (int j = 0; j < 32; ++j) {
                    const int dist = q - (kt * 32 + j);
                    if (dist >= 0) {
                        const LAS float* kr = Ks + j * 128 + c * 64; float a = 0.f;
#pragma unroll
                        for (int d = 0; d < 64; d += 4) { const f32x4 kv = *(const LAS f32x4*)(kr + d); a += qv[d] * kv.x + qv[d + 1] * kv.y + qv[d + 2] * kv.z + qv[d + 3] * kv.w; }
                        a += tb[dist > 127 ? 127 : dist];
                        const float mn = fmaxf(m, a), al = exp2f(m - mn), pj = exp2f(a - mn); m = mn; l = l * al + pj;
                        const LAS float* vr = Vs + j * 128 + vh * 64;
#pragma unroll
                        for (int d = 0; d < 64; d += 4) { const f32x4 vv = *(const LAS f32x4*)(vr + d);
                            o[d] = o[d] * al + pj * vv.x; o[d + 1] = o[d + 1] * al + pj * vv.y; o[d + 2] = o[d + 2] * al + pj * vv.z; o[d + 3] = o[d + 3] * al + pj * vv.w; }
                    }
                }
            }
        }
        const float rl = 1.f / l;
        bf16* op = (c == 0 ? O0 : O1) + (rb + q) * DM + h * 128 + vh * 64;
#pragma unroll
        for (int i = 0; i < 8; ++i) { float v[8];
#pragma unroll
            for (int j = 0; j < 8; ++j) v[j] = o[8 * i + j] * rl;
            st_bf16x8(op + 8 * i, v); }
    }
}
__device__ __forceinline__ void combine_rows(const bf16* O0, const bf16* O1, bf16* OC, const float* subg, float lam, int bid, int nb) {
    const int tid_ = fresh_tid(); const int lane = tid_ & 63, wave = tid_ >> 6;
    const float g0 = subg[2 * lane], g1 = subg[2 * lane + 1];
    for (long it = (long)bid * NWAVES + wave; it < (long)NT * NH; it += (long)nb * NWAVES) {
        const size_t off = (size_t)it * 128 + 2 * lane;
        const unsigned a = *(const unsigned*)(O0 + off), b = *(const unsigned*)(O1 + off);
        const float x0 = bflo(a) - lam * bflo(b), x1 = bfhi(a) - lam * bfhi(b);
        const float r = 1.f / sqrtf(wave_sum(x0 * x0 + x1 * x1) * (1.f / 128.f) + SUBLN_EPS) * (1.f - LAM_INIT);
        *(unsigned*)(OC + off) = pk2(x0 * r * g0, x1 * r * g1);
    }
}

__device__ __forceinline__ void ref_lru_local(const bf16* XB, const float* convw, const float* convb, const float* gaw, const float* gab, const float* gxw, const float* gxb,
                                              const float* lamp, bf16* HL, bf16* CA, float* AEND, float* HEND, LAS float* sm, int bid, int nb) {
    LAS float* xc = sm;
    LAS float* av = sm + 64 * 128;
    LAS float* bv = sm + 2 * 64 * 128;
    const int tid = fresh_tid();
    const int NU = NB_ * NCH * NLB;
    for (int u = bid; u < NU; u += nb) {
        const int n = u % NLB, ch = (u / NLB) % NCH, b = u / (NLB * NCH);
        const int t0 = ch * LCH; const size_t rb = (size_t)b * SEQ;
        __syncthreads();
        for (int i = tid; i < LCH * 128; i += NTHR) { const int t = i >> 7, c = i & 127, cg = n * 128 + c; float a = convb[cg];
#pragma unroll
            for (int j = 0; j < CW; ++j) { const int tt = t0 + t + j - (CW - 1); if (tt >= 0) a += bf2f(XB[(rb + tt) * DRNN + cg]) * convw[j * DRNN + cg]; }
            xc[i] = a; }
        __syncthreads();
        { const int e = tid & 127, tq = tid >> 7, cg = n * 128 + e;
          const float* wa = gaw + (size_t)n * 128 * 128 + e; const float* wx = gxw + (size_t)n * 128 * 128 + e;
          const float ba = gab[cg], bx = gxb[cg]; const float sp = log1pf(expf(-lamp[cg]));
          for (int tb4 = 0; tb4 < 4; ++tb4) {
              float ar[4] = {0.f, 0.f, 0.f, 0.f}, ai[4] = {0.f, 0.f, 0.f, 0.f};
              const int tbase = tq * 16 + tb4 * 4;
              for (int d = 0; d < 128; ++d) { const float w1 = wa[d * 128], w2 = wx[d * 128];
#pragma unroll
                  for (int k = 0; k < 4; ++k) { const float xv = xc[(tbase + k) * 128 + d]; ar[k] += xv * w1; ai[k] += xv * w2; } }
#pragma unroll
              for (int k = 0; k < 4; ++k) { const int t = tbase + k; const float r = sigmoidf_(ar[k] + ba), ig = sigmoidf_(ai[k] + bx);
                  const float la = -8.0f * r * sp, a = expf(la), mult = sqrtf(-expm1f(2.0f * la));
                  av[t * 128 + e] = a; bv[t * 128 + e] = mult * (ig * xc[t * 128 + e]); }
          } }
        __syncthreads();
        if (tid < 128) { const int cg = n * 128 + tid; float hh = 0.f, cp = 1.f;
            for (int t = 0; t < LCH; ++t) { const float a = av[t * 128 + tid]; hh = a * hh + bv[t * 128 + tid]; cp *= a;
                HL[(rb + t0 + t) * DRNN + cg] = (bf16)f2bf(hh); CA[(rb + t0 + t) * DRNN + cg] = (bf16)f2bf(cp); }
            AEND[((size_t)b * NCH + ch) * DRNN + cg] = cp; HEND[((size_t)b * NCH + ch) * DRNN + cg] = hh; }
    }
}
__device__ __forceinline__ void lru_carry(const float* AEND, const float* HEND, float* CIN, int bid, int nb) {
    for (int i = bid * NTHR + fresh_tid(); i < NB_ * DRNN; i += nb * NTHR) { const int b = i / DRNN, c = i % DRNN; float cin = 0.f;
        for (int ch = 0; ch < NCH; ++ch) { const size_t o = ((size_t)b * NCH + ch) * DRNN + c; CIN[o] = cin; cin = AEND[o] * cin + HEND[o]; } }
}
__device__ __forceinline__ void lru_fixup(const bf16* HL, const bf16* CA, const bf16* G, const float* CIN, bf16* Y, int bid, int nb) {
    const size_t total = (size_t)NT * DRNN / 2;
    for (size_t i = (size_t)bid * NTHR + fresh_tid(); i < total; i += (size_t)nb * NTHR) {
        const size_t el = 2 * i; const int row = (int)(el / DRNN), c = (int)(el % DRNN); const int b = row / SEQ, ch = (row % SEQ) / LCH;
        const unsigned hl = *(const unsigned*)(HL + el), ca = *(const unsigned*)(CA + el), g = *(const unsigned*)(G + el);
        const float* ci = CIN + ((size_t)b * NCH + ch) * DRNN + c;
        const float h0 = bflo(hl) + bflo(ca) * ci[0], h1 = bfhi(hl) + bfhi(ca) * ci[1];
        *(unsigned*)(Y + el) = pk2(h0 * bflo(g), h1 * bfhi(g));
    }
}

__device__ __forceinline__ float wave_max(float v) {
#pragma unroll
    for (int o = 1; o < 64; o <<= 1) v = fmaxf(v, __shfl_xor(v, o));
    return v;
}
__device__ __forceinline__ unsigned pack_i8x4(float a, float b, float c, float d) {
    const int ia = (int)rintf(a), ib = (int)rintf(b), ic = (int)rintf(c), id = (int)rintf(d);
    return (unsigned)(ia & 0xff) | ((unsigned)(ib & 0xff) << 8) | ((unsigned)(ic & 0xff) << 16) | ((unsigned)(id & 0xff) << 24);
}
constexpr int RT = 128, NRT = NT / RT;
template <class XT> __device__ __forceinline__ void moe_route(const XT* X, const float* g, const float* router, bf16* H, signed char* HQ, float* SA, int* RE, float* RG, int* RR, int* CNT, LAS float* sm, int bid, int nb) {
    LAS int* e_s = (LAS int*)sm;
    const int tid = fresh_tid(), lane = tid & 63, wave = tid >> 6;
    f32x4 gv[4];
#pragma unroll
    for (int j = 0; j < 4; ++j) gv[j] = *(const f32x4*)(g + 4 * lane + 256 * j);
    const int b0 = lane & 1, b1 = (lane >> 1) & 1, b2 = (lane >> 2) & 1;
    f32x4 rw[4][4][2];
#pragma unroll
    for (int j = 0; j < 4; ++j)
#pragma unroll
        for (int q = 0; q < 4; ++q) { const float* rp = router + (size_t)(4 * lane + 256 * j + q) * NE; rw[j][q][0] = *(const f32x4*)rp; rw[j][q][1] = *(const f32x4*)(rp + 4); }
    for (int tile = bid; tile < NRT; tile += nb) {
        __syncthreads();
#pragma unroll 2
        for (int rr = 0; rr < RT / NWAVES; ++rr) {
            const int lr = wave * (RT / NWAVES) + rr, m = tile * RT + lr;
            f32x4 v[4]; float s = 0.f;
#pragma unroll
            for (int j = 0; j < 4; ++j) { v[j] = ld_row4(X, m, lane, j); s += (v[j].x * v[j].x + v[j].y * v[j].y) + (v[j].z * v[j].z + v[j].w * v[j].w); }
            const float r = 1.f / sqrtf(wave_sum(s) * (1.f / DM) + NORM_EPS);
            unsigned long long* o8 = (unsigned long long*)(H + (size_t)m * DM) + lane;
            float lg[NE];
#pragma unroll
            for (int e = 0; e < NE; ++e) lg[e] = 0.f;
            if (HQ) { float am = 0.f;
#pragma unroll
                for (int j = 0; j < 4; ++j) { const f32x4 y = v[j] * r * gv[j]; am = fmaxf(am, fmaxf(fmaxf(fabsf(y.x), fabsf(y.y)), fmaxf(fabsf(y.z), fabsf(y.w)))); }
                am = wave_max(am); const float inv = am > 0.f ? 127.f / am : 0.f; unsigned* o4 = (unsigned*)(HQ + (size_t)m * DM) + lane;
#pragma unroll
                for (int j = 0; j < 4; ++j) { const f32x4 y = v[j] * r * gv[j]; o4[64 * j] = pack_i8x4(y.x * inv, y.y * inv, y.z * inv, y.w * inv); }
                if (lane == 0) SA[m] = am * (1.f / 127.f); }
#pragma unroll
            for (int j = 0; j < 4; ++j) { const f32x4 y = v[j] * r * gv[j]; if (!HQ) o8[64 * j] = (unsigned long long)pk2(y.x, y.y) | ((unsigned long long)pk2(y.z, y.w) << 32);
#pragma unroll
                for (int q = 0; q < 4; ++q) { const f32x4 r0 = rw[j][q][0], r1 = rw[j][q][1]; const float yy = y[q];
                    lg[0] += yy * r0.x; lg[1] += yy * r0.y; lg[2] += yy * r0.z; lg[3] += yy * r0.w; lg[4] += yy * r1.x; lg[5] += yy * r1.y; lg[6] += yy * r1.z; lg[7] += yy * r1.w; } }
            float k4[4], k2[2], k1;
#pragma unroll
            for (int i = 0; i < 4; ++i) { const float snd = b0 ? lg[i] : lg[4 + i]; const float rcv = __shfl_xor(snd, 1); k4[i] = (b0 ? lg[4 + i] : lg[i]) + rcv; }
#pragma unroll
            for (int i = 0; i < 2; ++i) { const float snd = b1 ? k4[i] : k4[2 + i]; const float rcv = __shfl_xor(snd, 2); k2[i] = (b1 ? k4[2 + i] : k4[i]) + rcv; }
            { const float snd = b2 ? k2[0] : k2[1]; const float rcv = __shfl_xor(snd, 4); k1 = (b2 ? k2[1] : k2[0]) + rcv; }
            k1 += __shfl_xor(k1, 8); k1 += __shfl_xor(k1, 16); k1 += __shfl_xor(k1, 32);
            float lt[NE];
#pragma unroll
            for (int e = 0; e < NE; ++e) { const int src = ((e >> 2) & 1) | (((e >> 1) & 1) << 1) | ((e & 1) << 2); lt[e] = __builtin_bit_cast(float, __builtin_amdgcn_readlane(__builtin_bit_cast(int, k1), src)); }
            int i0 = 0; float v0 = lt[0];
#pragma unroll
            for (int e = 1; e < NE; ++e) if (lt[e] > v0) { v0 = lt[e]; i0 = e; }
            int i1 = -1; float v1 = -INFINITY;
#pragma unroll
            for (int e = 0; e < NE; ++e) if (e != i0 && lt[e] > v1) { v1 = lt[e]; i1 = e; }
            const float g1 = 1.f / (1.f + expf(v0 - v1)), g0 = 1.f - g1;
            if (lane == 0) { e_s[lr] = i0; e_s[RT + lr] = i1; RE[m] = i0; RE[NT + m] = i1; RG[m] = g0; RG[NT + m] = g1; }
        }
        __syncthreads();
        if (tid < 2 * RT) { const int s = tid / RT, i = tid % RT; const int me = e_s[s * RT + i]; int rk = 0;
          for (int j = 0; j < i; ++j) rk += (e_s[s * RT + j] == me) ? 1 : 0;
          RR[s * NT + tile * RT + i] = rk; }
        if (tid >= 2 * RT && tid < 2 * RT + 16) { const int k = tid - 2 * RT, s = k >> 3, e = k & 7; int c = 0; for (int j = 0; j < RT; ++j) c += (e_s[s * RT + j] == e) ? 1 : 0; CNT[tile * 16 + k] = c; }
    }
}
__device__ __forceinline__ int tok16_index(int p) { const int rr = p & 127; return (p & ~127) + 2 * (rr & 63) + (rr >> 6); }
__device__ __forceinline__ void moe_scatter(const int* RE, const float* RG, const int* RR, const int* CNT, int* BASE, int* TOK, float* GATEV, const float* SA, float* SAS, bf16* TOK16, LAS float* sm, int bid, int nb) {
    LAS int* tbase = (LAS int*)sm;
    LAS int* segt = tbase + NRT * 16;
    LAS int* gbase = segt + 256;
    LAS int* tot = gbase + 32;
    const int tid = fresh_tid();
    __syncthreads();
    for (int i = tid; i < NRT * 16; i += NTHR) tbase[i] = CNT[i];
    __syncthreads();
    if (tid < 256) { const int k = tid & 15, seg = tid >> 4; int run = 0;
        for (int t = 0; t < 16; ++t) { const int idx = (seg * 16 + t) * 16 + k; const int c = tbase[idx]; tbase[idx] = run; run += c; }
        segt[seg * 16 + k] = run; }
    __syncthreads();
    if (tid < 16) { int run = 0; for (int sg = 0; sg < 16; ++sg) { const int c = segt[sg * 16 + tid]; segt[sg * 16 + tid] = run; run += c; } tot[tid] = run; }
    __syncthreads();
    if (tid < 2) { int run = 0; for (int e = 0; e < NE; ++e) { gbase[tid * 9 + e] = run; run += (tot[tid * 8 + e] + 255) & ~255; } gbase[tid * 9 + 8] = run; }
    __syncthreads();
    if (bid == 0 && tid < 18) BASE[tid] = gbase[tid];
    for (int i = bid * NTHR + tid; i < 2 * NT; i += nb * NTHR) { const int s = i / NT, m = i % NT; const int e = RE[i]; const int tl = m / RT;
        const int pos = gbase[s * 9 + e] + segt[(tl >> 4) * 16 + s * 8 + e] + tbase[tl * 16 + s * 8 + e] + RR[i];
        TOK[s * SLOT_ROWS + pos] = m; GATEV[s * SLOT_ROWS + pos] = RG[i]; SAS[s * SLOT_ROWS + pos] = SA[m]; TOK16[s * SLOT_ROWS + tok16_index(pos)] = (bf16)m; }
    for (int gi = bid; gi < 16; gi += nb) { const int s = gi >> 3, e = gi & 7; const int lo = gbase[s * 9 + e] + tot[gi], hi = gbase[s * 9 + e + 1];
        for (int p = lo + tid; p < hi; p += NTHR) { TOK[s * SLOT_ROWS + p] = -1; GATEV[s * SLOT_ROWS + p] = 0.f; SAS[s * SLOT_ROWS + p] = 0.f; TOK16[s * SLOT_ROWS + tok16_index(p)] = 0; } }
}

template <class XT> __device__ __forceinline__ void rms_rows_q(const XT* X, const float* g, signed char* HQ, float* SA, int bid, int nb) {
    const int tid_ = fresh_tid(); const int lane = tid_ & 63, wave = tid_ >> 6;
    f32x4 gv[4];
#pragma unroll
    for (int j = 0; j < 4; ++j) gv[j] = *(const f32x4*)(g + 4 * lane + 256 * j);
    for (int m = bid * NWAVES + wave; m < NT; m += nb * NWAVES) {
        f32x4 v[4]; float s = 0.f;
#pragma unroll
        for (int j = 0; j < 4; ++j) { v[j] = ld_row4(X, m, lane, j); s += (v[j].x * v[j].x + v[j].y * v[j].y) + (v[j].z * v[j].z + v[j].w * v[j].w); }
        const float r = 1.f / sqrtf(wave_sum(s) * (1.f / DM) + NORM_EPS);
        float am = 0.f;
#pragma unroll
        for (int j = 0; j < 4; ++j) { v[j] = v[j] * r * gv[j]; am = fmaxf(am, fmaxf(fmaxf(fabsf(v[j].x), fabsf(v[j].y)), fmaxf(fabsf(v[j].z), fabsf(v[j].w)))); }
        am = wave_max(am); const float inv = am > 0.f ? 127.f / am : 0.f;
        unsigned* o4 = (unsigned*)(HQ + (size_t)m * DM) + lane;
#pragma unroll
        for (int j = 0; j < 4; ++j) o4[64 * j] = pack_i8x4(v[j].x * inv, v[j].y * inv, v[j].z * inv, v[j].w * inv);
        if (lane == 0) SA[m] = am * (1.f / 127.f);
    }
}
__device__ __forceinline__ void quant_item_wg(const float* W, int N, signed char* WQ, float* SB, int n0, int drow0, LAS unsigned char* L, int tid) {
    const int lane = tid & 63, wave = __builtin_amdgcn_readfirstlane(tid >> 6);
    LAS float* pm = (LAS float*)L;
    LAS unsigned char* tile = L + 2048 + wave * (64 * 144);
    float tv[128]; float am = 0.f;
#pragma unroll
    for (int i = 0; i < 128; ++i) { tv[i] = __builtin_nontemporal_load(W + (size_t)(wave * 128 + i) * N + n0 + lane); am = fmaxf(am, fabsf(tv[i])); }
    pm[wave * 64 + lane] = am;
    __syncthreads();
#pragma unroll
    for (int w = 0; w < 8; ++w) am = fmaxf(am, pm[w * 64 + lane]);
    const float inv = am > 0.f ? 127.f / am : 0.f;
#pragma unroll
    for (int c = 0; c < 8; ++c) { v4u o;
        o.x = pack_i8x4(tv[16 * c + 0] * inv, tv[16 * c + 1] * inv, tv[16 * c + 2] * inv, tv[16 * c + 3] * inv); o.y = pack_i8x4(tv[16 * c + 4] * inv, tv[16 * c + 5] * inv, tv[16 * c + 6] * inv, tv[16 * c + 7] * inv);
        o.z = pack_i8x4(tv[16 * c + 8] * inv, tv[16 * c + 9] * inv, tv[16 * c + 10] * inv, tv[16 * c + 11] * inv); o.w = pack_i8x4(tv[16 * c + 12] * inv, tv[16 * c + 13] * inv, tv[16 * c + 14] * inv, tv[16 * c + 15] * inv);
        *(LAS v4u*)(tile + lane * 144 + 16 * c) = o; }
    asm volatile("s_waitcnt lgkmcnt(0)" ::: "memory");
    { const int c = lane & 7;
#pragma unroll
      for (int j = 0; j < 8; ++j) { const int n = (lane >> 3) + 8 * j; const v4u o = *(const LAS v4u*)(tile + n * 144 + 16 * c);
          *(v4u*)(WQ + (size_t)(drow0 + n) * 1024 + wave * 128 + 16 * c) = o; } }
    if (wave == 0) SB[drow0 + lane] = am * (1.f / 127.f);
    __syncthreads();
}
#define LDS_WAIT() asm volatile("s_waitcnt lgkmcnt(0)" ::: "memory")
__device__ __forceinline__ void transpose_item(const float* W, int N, bf16* WT, int K, int k0, int n0, int drow0, LAS float* scr, int lane) {
    float tv[32];
#pragma unroll
    for (int i = 0; i < 32; ++i) { const int kk = 2 * i + (lane >> 5); tv[i] = W[(size_t)(k0 + kk) * N + n0 + (lane & 31)]; }
#pragma unroll
    for (int i = 0; i < 32; ++i) { const int kk = 2 * i + (lane >> 5); scr[kk * 33 + (lane & 31)] = tv[i]; }
    LDS_WAIT(); asm volatile("" ::: "memory");
    const int c = lane & 7;
#pragma unroll
    for (int j = 0; j < 4; ++j) { const int n = (lane >> 3) + 8 * j; const LAS float* sp = scr + (8 * c) * 33 + n;
        v4u o; o.x = pk2(sp[0 * 33], sp[1 * 33]); o.y = pk2(sp[2 * 33], sp[3 * 33]); o.z = pk2(sp[4 * 33], sp[5 * 33]); o.w = pk2(sp[6 * 33], sp[7 * 33]);
        *(v4u*)(WT + (size_t)(drow0 + n) * K + k0 + 8 * c) = o; }
    LDS_WAIT(); asm volatile("" ::: "memory");
}
__device__ __forceinline__ void convert_matrix(const float* W, int K, int N, bf16* WT, int mode, LAS float* scr, int gw, int ngw, int lane) {
    const int nblk = N / 32, nitems = (K / 64) * nblk;
    for (int it = gw; it < nitems; it += ngw) { const int kb = it / nblk, nbk = it % nblk, n0 = 32 * nbk;
        const int drow0 = mode == 0 ? n0 : ((n0 >> 7) * 256 + (mode == 2 ? 128 : 0) + (n0 & 127));
        transpose_item(W, N, WT, K, 64 * kb, n0, drow0, scr, lane); }
}
constexpr size_t WA_QKV = 0, WA_O = 6 * MiB, WA_GU = 8 * MiB, WA_D = 19 * MiB, WA_IN = 19 * MiB + 5632 * 1024, WA_OUT = WA_IN + 5 * MiB, WA_GATES = WA_OUT + 2560 * 1024;
static_assert(8 * 64 * 65 * 4 <= RING_BYTES, "conversion tiles fit the ring");
static_assert(WA_GATES + 2 * NLB * 128 * 128 * 2 <= 33 * MiB, "weights map");
__device__ __forceinline__ void convert_weights_a(const __attribute__((address_space(4))) Args* args, unsigned char* ws, LAS unsigned char* L, int bid, int nb) {
    const int tid = fresh_tid(), lane = tid & 63, wave = tid >> 6; LAS float* scr = (LAS float*)(L + wave * 16384);
    const int gw = bid * NWAVES + wave, ngw = nb * NWAVES; unsigned char* wa = ws + WS_WA;
    { float* SB = (float*)(ws + WS_SMALL + SM_SB); __syncthreads();
      constexpr int NQ = I8_QKV ? 3 * DM / 64 : 0, NF = I8_FFN ? DFF / 64 : 0, NW = I8_WIN ? 2 * DRNN / 64 : 0;
      for (int it = bid; it < NQ + 2 * NF + NW; it += nb) {
          if (it < NQ) quant_item_wg(args->in[5], 3 * DM, (signed char*)(wa + WA_QKV), SB + SB_QKV, 64 * it, 64 * it, L, tid);
          else if (it >= NQ + 2 * NF) { const int n0 = 64 * (it - NQ - 2 * NF); quant_item_wg(args->in[12], 2 * DRNN, (signed char*)(wa + WA_IN), SB + SB_IN, n0, n0, L, tid); }
          else { const int j = it - NQ, up = j >= NF ? 1 : 0, n0 = 64 * (j - up * NF);
              quant_item_wg(args->in[21 + up], DFF, (signed char*)(wa + WA_GU), SB + SB_GU, n0, (n0 >> 7) * 256 + up * 128 + (n0 & 127), L, tid); } }
      __syncthreads(); }
#if !I8_QKV
    convert_matrix(args->in[5], DM, 3 * DM, (bf16*)(wa + WA_QKV), 0, scr, gw, ngw, lane);
#endif
    convert_matrix(args->in[6], DM, DM, (bf16*)(wa + WA_O), 0, scr, gw, ngw, lane);
#if !I8_FFN
    convert_matrix(args->in[21], DM, DFF, (bf16*)(wa + WA_GU), 1, scr, gw, ngw, lane);
    convert_matrix(args->in[22], DM, DFF, (bf16*)(wa + WA_GU), 2, scr, gw, ngw, lane);
#endif
    convert_matrix(args->in[23], DFF, DM, (bf16*)(wa + WA_D), 0, scr, gw, ngw, lane);
#if !I8_WIN
    convert_matrix(args->in[12], DM, 2 * DRNN, (bf16*)(wa + WA_IN), 0, scr, gw, ngw, lane);
#endif
    convert_matrix(args->in[20], DRNN, DM, (bf16*)(wa + WA_OUT), 0, scr, gw, ngw, lane);
}
constexpr size_t WM_GU = 0, WM_D = 56 * MiB;
static_assert(I8_MOE && I8_FFN && I8_WIN && ATTN_PC == 3 && FAST_LRU && WS_WM + WM_D + (size_t)NE * DM * DFE * 2 <= WS_XS, "this d_ws map holds the int8 gate|up copies (56 MiB) + bf16 down copies (56 MiB)");
__device__ __forceinline__ void convert_weights_moe(const __attribute__((address_space(4))) Args* args, unsigned char* ws, LAS unsigned char* L, int bid, int nb) {
    const int tid = fresh_tid(), lane = tid & 63, wave = tid >> 6; LAS float* scr = (LAS float*)(L + wave * 16384);
    const int gw = bid * NWAVES + wave, ngw = nb * NWAVES; unsigned char* wm = ws + WS_WM;
    for (int e = 0; e < NE; ++e) {
        convert_matrix(args->in[25] + (size_t)e * DM * DFE, DM, DFE, (bf16*)(wm + WM_GU) + (size_t)e * 2 * DFE * DM, 1, scr, gw, ngw, lane);
        convert_matrix(args->in[26] + (size_t)e * DM * DFE, DM, DFE, (bf16*)(wm + WM_GU) + (size_t)e * 2 * DFE * DM, 2, scr, gw, ngw, lane);
        convert_matrix(args->in[27] + (size_t)e * DFE * DM, DFE, DM, (bf16*)(wm + WM_D) + (size_t)e * DM * DFE, 0, scr, gw, ngw, lane);
    }
}
namespace lru {
typedef short bf16x8 __attribute__((ext_vector_type(8)));
typedef float f32x16 __attribute__((ext_vector_type(16)));
__device__ __forceinline__ unsigned cvtpk(float lo, float hi) { unsigned r; asm volatile("v_cvt_pk_bf16_f32 %0, %1, %2" : "=v"(r) : "v"(lo), "v"(hi)); return r; }
__device__ __forceinline__ float sigm(float x) { return __builtin_amdgcn_rcpf(1.0f + __builtin_amdgcn_exp2f(-1.4426950408889634f * x)); }
constexpr int NITEMS = NB_ * NLB * 4, CHUNK = 256, NCHK = SEQ / CHUNK;
__device__ __forceinline__ void conv_pass(const bf16* XB, bf16* XC, const float* convw, const float* convb, LAS unsigned char* L, int bid, int nb) {
    const int tid = fresh_tid(); LAS float* cw = (LAS float*)L;
    __syncthreads();
    for (int i = tid; i < 5 * DRNN; i += NTHR) cw[i] = (i < 4 * DRNN) ? convw[i] : convb[i - 4 * DRNN];
    __syncthreads();
    constexpr int NG = DRNN / 8; const long total = (long)NT * NG;
    for (long it = (long)bid * NTHR + tid; it < total; it += (long)nb * NTHR) {
        const int row = (int)(it / NG), c0 = (int)(it % NG) * 8, t = row % SEQ;
        float acc[8];
        { const f32x4 b0 = *(const LAS f32x4*)(cw + 4 * DRNN + c0), b1 = *(const LAS f32x4*)(cw + 4 * DRNN + c0 + 4);
          acc[0] = b0.x; acc[1] = b0.y; acc[2] = b0.z; acc[3] = b0.w; acc[4] = b1.x; acc[5] = b1.y; acc[6] = b1.z; acc[7] = b1.w; }
#pragma unroll
        for (int tp = 0; tp < 4; ++tp) { const int dt = 3 - tp;
            v4u xv = (v4u){0u, 0u, 0u, 0u}; if (t - dt >= 0) xv = *(const v4u*)(XB + (size_t)(row - dt) * DRNN + c0);
            const f32x4 w0 = *(const LAS f32x4*)(cw + tp * DRNN + c0), w1 = *(const LAS f32x4*)(cw + tp * DRNN + c0 + 4);
            acc[0] += w0.x * bflo(xv.x); acc[1] += w0.y * bfhi(xv.x); acc[2] += w0.z * bflo(xv.y); acc[3] += w0.w * bfhi(xv.y);
            acc[4] += w1.x * bflo(xv.z); acc[5] += w1.y * bfhi(xv.z); acc[6] += w1.z * bflo(xv.w); acc[7] += w1.w * bfhi(xv.w); }
        *(v4u*)(XC + (size_t)row * DRNN + c0) = (v4u){cvtpk(acc[0], acc[1]), cvtpk(acc[2], acc[3]), cvtpk(acc[4], acc[5]), cvtpk(acc[6], acc[7])};
    }
}
__device__ __forceinline__ void lru_items(const bf16* XC, const bf16* G, bf16* Y, const float* gaw, const float* gab, const float* gxw, const float* gxb,
                                          const float* lamp, LAS unsigned char* L, int bid, int nb) {
    const int tid = fresh_tid(), lane = tid & 63, wave = __builtin_amdgcn_readfirstlane(tid >> 6), e = lane & 31, hi = lane >> 5;
    LAS float* xch = (LAS float*)(L + 4096);
    for (int item = bid; item < NITEMS; item += nb) {
        const int q = item & 3, n = (item >> 2) % NLB, b = item / (4 * NLB);
        const int cb0 = n * 128, cg = cb0 + 32 * q + e;
        __syncthreads();
        bf16x8 Ba[8], Bx[8];
#pragma unroll
        for (int ks = 0; ks < 8; ++ks) { float wa[8], wx[8];
#pragma unroll
            for (int j = 0; j < 8; ++j) { const size_t o = ((size_t)n * 128 + 16 * ks + 8 * hi + j) * 128 + 32 * q + e; wa[j] = gaw[o]; wx[j] = gxw[o]; }
            unsigned pa[4], px[4];
#pragma unroll
            for (int j = 0; j < 4; ++j) { pa[j] = cvtpk(wa[2 * j], wa[2 * j + 1]); px[j] = cvtpk(wx[2 * j], wx[2 * j + 1]); }
            Ba[ks] = __builtin_bit_cast(bf16x8, (v4u){pa[0], pa[1], pa[2], pa[3]}); Bx[ks] = __builtin_bit_cast(bf16x8, (v4u){px[0], px[1], px[2], px[3]}); }
        const float ba = gab[cg], bx = gxb[cg], sp8 = -8.0f * 1.4426950408889634f * log1pf(expf(-lamp[cg]));
        float hprev = 0.f;
        const bf16* XCb = XC + (size_t)b * SEQ * DRNN; const bf16* Gb = G + (size_t)b * SEQ * DRNN; bf16* Yb = Y + (size_t)b * SEQ * DRNN;
        v4u Ag[8]; unsigned xraw[8], graw[8];
        LAS unsigned char* atile = L + 8192 + wave * 8192; const int arow = lane >> 4, acol = lane & 15;
#define LRU_LD_A(chn) do { const bf16* p_ = XCb + (size_t)((chn) * CHUNK + wave * 32 + arow) * DRNN + cb0 + 8 * acol; _Pragma("unroll") for (int i = 0; i < 8; ++i) Ag[i] = *(const v4u*)(p_ + (size_t)(4 * i) * DRNN); } while (0)
#define LRU_ROWOF(r) (((r) & 3) + 8 * ((r) >> 2) + 4 * hi)
#define LRU_LD_X(chn) do { const bf16* p_ = XCb + (size_t)((chn) * CHUNK + wave * 32) * DRNN + cg; _Pragma("unroll") for (int k = 0; k < 8; ++k) xraw[k] = (unsigned)p_[(size_t)LRU_ROWOF(2 * k) * DRNN] | ((unsigned)p_[(size_t)LRU_ROWOF(2 * k + 1) * DRNN] << 16); } while (0)
#define LRU_LD_G(chn) do { const bf16* p_ = Gb + (size_t)((chn) * CHUNK + wave * 32) * DRNN + cg; _Pragma("unroll") for (int k = 0; k < 8; ++k) graw[k] = (unsigned)p_[(size_t)LRU_ROWOF(2 * k) * DRNN] | ((unsigned)p_[(size_t)LRU_ROWOF(2 * k + 1) * DRNN] << 16); } while (0)
        LRU_LD_A(0); LRU_LD_X(0); LRU_LD_G(0);
        for (int ch = 0; ch < NCHK; ++ch) {
            const int tb = ch * CHUNK + wave * 32;
            const int chn = ch + 1 < NCHK ? ch + 1 : ch;
            f32x16 ar = {}, ai = {};
            bf16x8 Af[8];
#pragma unroll
            for (int i = 0; i < 8; ++i) { const int row = 4 * i + arow; *(LAS v4u*)(atile + row * 256 + ((acol ^ (row & 15)) << 4)) = Ag[i]; }
#pragma unroll
            for (int ks = 0; ks < 8; ++ks) Af[ks] = *(const LAS bf16x8*)(atile + e * 256 + (((2 * ks + hi) ^ (e & 15)) << 4));
#pragma unroll
            for (int ks = 0; ks < 8; ++ks) { ar = __builtin_amdgcn_mfma_f32_32x32x16_bf16(Af[ks], Ba[ks], ar, 0, 0, 0); ai = __builtin_amdgcn_mfma_f32_32x32x16_bf16(Af[ks], Bx[ks], ai, 0, 0, 0); }
            LRU_LD_A(chn);
            float av[16], hl[16];
#pragma unroll
            for (int r = 0; r < 16; ++r) {
                const float xc = (r & 1) ? bfhi(xraw[r >> 1]) : bflo(xraw[r >> 1]);
                const float rg = sigm(ar[r] + ba), ig = sigm(ai[r] + bx);
                const float la2 = sp8 * rg, a = __builtin_amdgcn_exp2f(la2), x2 = la2 * (2.0f * 0.6931471805599453f);
                const float em = x2 > -0.02f ? -x2 * (1.0f + x2 * (0.5f + x2 * (1.0f / 6.0f))) : 1.0f - a * a;
                av[r] = a; hl[r] = __builtin_amdgcn_sqrtf(em) * (ig * xc); }
            LRU_LD_X(chn);
#pragma unroll
            for (int g = 0; g < 4; ++g) {
#pragma unroll
                for (int i = 1; i < 4; ++i) { const int r = 4 * g + i; hl[r] = av[r] * hl[r - 1] + hl[r]; av[r] = av[r] * av[r - 1]; } }
            float PA = 1.f, PH = 0.f;
#pragma unroll
            for (int g = 0; g < 4; ++g) { const float As = av[4 * g + 3], Hs = hl[4 * g + 3];
                const float Ap = __shfl_xor(As, 32), Hp = __shfl_xor(Hs, 32);
                const float Alo = hi ? Ap : As, Hlo = hi ? Hp : Hs, Ahi = hi ? As : Ap, Hhi = hi ? Hs : Hp;
                const float PA1 = PA * Alo, PH1 = Alo * PH + Hlo;
                const float EA = hi ? PA1 : PA, EH = hi ? PH1 : PH;
#pragma unroll
                for (int i = 0; i < 4; ++i) { const int r = 4 * g + i; hl[r] = hl[r] + av[r] * EH; av[r] = av[r] * EA; }
                PH = Ahi * PH1 + Hhi; PA = PA1 * Ahi; }
            LAS float* xb = xch + (ch & 1) * 512;
            if (hi == 0) { xb[wave * 64 + e] = PA; xb[wave * 64 + 32 + e] = PH; }
            __syncthreads();
            float hin = 0.f, h = hprev;
#pragma unroll
            for (int w = 0; w < 8; ++w) { if (w == wave) hin = h; h = xb[w * 64 + e] * h + xb[w * 64 + 32 + e]; }
            hprev = h;
#pragma unroll
            for (int r = 0; r < 16; ++r) { const int t = tb + (r & 3) + 8 * (r >> 2) + 4 * hi; const size_t o = (size_t)t * DRNN + cg;
                const float hv = hl[r] + av[r] * hin; Yb[o] = (bf16)f2bf(hv * ((r & 1) ? bfhi(graw[r >> 1]) : bflo(graw[r >> 1]))); }
            LRU_LD_G(chn);
        }
#undef LRU_LD_A
#undef LRU_LD_X
#undef LRU_LD_G
#undef LRU_ROWOF
    }
}
constexpr int CV_LD = 65, CV_WAVE_BYTES = 64 * CV_LD * 4;
__device__ __forceinline__ void transpose_item64(const float* W, int N, bf16* WT, int K, int k0, int n0, int drow0, LAS float* scr, int lane) {
#pragma unroll
    for (int hh = 0; hh < 2; ++hh) { float tv[32];
#pragma unroll
        for (int i = 0; i < 32; ++i) tv[i] = __builtin_nontemporal_load(W + (size_t)(k0 + hh * 32 + i) * N + n0 + lane);
#pragma unroll
        for (int i = 0; i < 32; ++i) scr[(hh * 32 + i) * CV_LD + lane] = tv[i]; }
    LDS_WAIT(); asm volatile("" ::: "memory");
    const int c = lane & 7;
#pragma unroll
    for (int j = 0; j < 8; ++j) { const int n = (lane >> 3) + 8 * j; const LAS float* sp = scr + (8 * c) * CV_LD + n;
        v4u o; o.x = pk2(sp[0 * CV_LD], sp[1 * CV_LD]); o.y = pk2(sp[2 * CV_LD], sp[3 * CV_LD]); o.z = pk2(sp[4 * CV_LD], sp[5 * CV_LD]); o.w = pk2(sp[6 * CV_LD], sp[7 * CV_LD]);
        *(v4u*)(WT + (size_t)(drow0 + n) * K + k0 + 8 * c) = o; }
    LDS_WAIT(); asm volatile("" ::: "memory");
}
constexpr int CONV_PER_MAT = (DM / 64) * (DFE / 64), CONV_PER_E = 3 * CONV_PER_MAT, CONV_TOTAL = NE * CONV_PER_E;
constexpr int QWG_PER_E = 2 * (DFE / 64), QWG_TOTAL = NE * QWG_PER_E;
__device__ __forceinline__ void convert_moe_queue(const float* wg, const float* wu, const float* wd, bf16* WGU, bf16* WD, float* SBM, unsigned* ticket, LAS unsigned char* L) {
    const int tid = fresh_tid(), lane = tid & 63, wave = __builtin_amdgcn_readfirstlane(tid >> 6); LAS float* scr = (LAS float*)(L + wave * CV_WAVE_BYTES);
#if I8_MOE
    { LAS unsigned* tk = (LAS unsigned*)(L + 81920);
      for (;;) { __syncthreads();
          if (tid == 0) tk[0] = __hip_atomic_fetch_add(ticket + 64, 1u, __ATOMIC_RELAXED, __HIP_MEMORY_SCOPE_AGENT);
          __syncthreads();
          const unsigned it = tk[0];
          if (it >= (unsigned)QWG_TOTAL) break;
          const int ex = it / QWG_PER_E, r = it % QWG_PER_E, up = r / (DFE / 64), n0 = 64 * (r % (DFE / 64));
          quant_item_wg((up ? wu : wg) + (size_t)ex * DM * DFE, DFE, (signed char*)WGU + (size_t)ex * 2 * DFE * DM, SBM + (size_t)ex * 2 * DFE, n0, (n0 >> 7) * 256 + up * 128 + (n0 & 127), L, tid); }
      __syncthreads(); }
#endif
    for (;;) {
        unsigned it = 0; if (lane == 0) it = __hip_atomic_fetch_add(ticket, 1u, __ATOMIC_RELAXED, __HIP_MEMORY_SCOPE_AGENT);
        it = (unsigned)__builtin_amdgcn_readfirstlane((int)it);
#if I8_MOE
        if (it >= (unsigned)(NE * CONV_PER_MAT)) break;
        const int ex = it / CONV_PER_MAT, m = 2, idx = it % CONV_PER_MAT;
#else
        if (it >= (unsigned)CONV_TOTAL) break;
        const int ex = it / CONV_PER_E, r = it % CONV_PER_E, m = r / CONV_PER_MAT, idx = r % CONV_PER_MAT;
#endif
        if (m < 2) { const int nblk = DFE / 64, kb = idx / nblk, n0 = 64 * (idx % nblk); const int drow0 = (n0 >> 7) * 256 + (m == 1 ? 128 : 0) + (n0 & 127);
            transpose_item64((m == 0 ? wg : wu) + (size_t)ex * DM * DFE, DFE, WGU + (size_t)ex * 2 * DFE * DM, DM, 64 * kb, n0, drow0, scr, lane); }
        else { const int nblk = DM / 64, kb = idx / nblk, n0 = 64 * (idx % nblk);
            transpose_item64(wd + (size_t)ex * DFE * DM, DM, WD + (size_t)ex * DM * DFE, DFE, 64 * kb, n0, n0, scr, lane); }
    }
}
}
template <class OT> __device__ __forceinline__ void moe_down_tail(const bf16* ACTM, const bf16* WD, OT* out, const int* tok, const float* gatev, const LAS int* pexp, int rows, LAS unsigned char* L, int bid, int nb) {
    typedef short bf16x8 __attribute__((ext_vector_type(8)));
    const int tid = fresh_tid(), lane = tid & 63, wave = __builtin_amdgcn_readfirstlane(tid >> 6), fr = lane & 15, fq = lane >> 4;
    pg8::StaticOrder S; S.init(rows, DM, nb, 0);
    const int first = (S.nwg / nb) * nb, ntask = (S.nwg - first) * 16;
    LAS f32x4* red = (LAS f32x4*)L;
    constexpr int KW = DFE / 8, NPR = KW / 64;
    LAS unsigned char* tile = L + wave * 16384;
    const int lr = lane >> 3, lc = lane & 7;
    for (int task = bid; task < ntask; task += nb) {
        pg8::Unit u; S.unit_at(first + (task >> 4), u); const int sub = task & 15;
        const int rowbase = u.pm * 256 + 64 * (sub >> 2), colbase = u.pn * 256 + 64 * (sub & 3), ex = pexp[u.pm];
        const bf16* Ag = ACTM + (size_t)(rowbase + lr) * DFE + wave * KW + 8 * lc;
        const bf16* Bg = WD + ((size_t)ex * DM + colbase + lr) * DFE + wave * KW + 8 * lc;
        f32x4 acc[4][4];
#pragma unroll
        for (int m = 0; m < 4; ++m)
#pragma unroll
            for (int n = 0; n < 4; ++n) acc[m][n] = (f32x4){0.f, 0.f, 0.f, 0.f};
        __syncthreads();
        v4u g[16];
#define TAIL_GLD(pr) do { _Pragma("unroll") for (int i = 0; i < 8; ++i) { g[i] = *(const v4u*)(Ag + (size_t)(8 * i) * DFE + 64 * (pr)); g[8 + i] = *(const v4u*)(Bg + (size_t)(8 * i) * DFE + 64 * (pr)); } } while (0)
        TAIL_GLD(0);
#pragma unroll 1
        for (int pr = 0; pr < NPR; ++pr) {
#pragma unroll
            for (int i = 0; i < 16; ++i) { const int row = 8 * i + lr; *(LAS v4u*)(tile + row * 128 + ((lc ^ ((row >> 1) & 7)) << 4)) = g[i]; }
            __builtin_amdgcn_sched_barrier(0);
            if (pr + 1 < NPR) TAIL_GLD(pr + 1);
            __builtin_amdgcn_sched_barrier(0);
            bf16x8 a[2][4], b[2][4];
#pragma unroll
            for (int h = 0; h < 2; ++h)
#pragma unroll
                for (int m = 0; m < 4; ++m) { const int ra = 16 * m + fr, rb = 64 + 16 * m + fr, ch = 4 * h + fq;
                    a[h][m] = *(const LAS bf16x8*)(tile + ra * 128 + ((ch ^ ((ra >> 1) & 7)) << 4)); b[h][m] = *(const LAS bf16x8*)(tile + rb * 128 + ((ch ^ ((rb >> 1) & 7)) << 4)); }
#pragma unroll
            for (int h = 0; h < 2; ++h)
#pragma unroll
                for (int m = 0; m < 4; ++m)
#pragma unroll
                    for (int n = 0; n < 4; ++n) acc[m][n] = __builtin_amdgcn_mfma_f32_16x16x32_bf16(b[h][n], a[h][m], acc[m][n], 0, 0, 0);
            __builtin_amdgcn_sched_barrier(0);
        }
#undef TAIL_GLD
        __syncthreads();
#pragma unroll
        for (int m = 0; m < 4; ++m)
#pragma unroll
            for (int n = 0; n < 4; ++n) red[(wave * 16 + m * 4 + n) * 64 + lane] = acc[m][n];
        __syncthreads();
        { const int id = tid >> 5, m = id >> 2, n = id & 3;
#pragma unroll
          for (int k = 0; k < 2; ++k) { const int ls = (tid & 31) * 2 + k; f32x4 v = red[id * 64 + ls];
#pragma unroll
              for (int w = 1; w < 8; ++w) v = v + red[(w * 16 + id) * 64 + ls];
              const int r = rowbase + 16 * m + (ls & 15), cc = colbase + 16 * n + 4 * (ls >> 4); const int t = tok[r];
              if (t >= 0) { OT* o = out + (size_t)t * DM + cc; const f32x4 av = v * gatev[r];
                  if constexpr (sizeof(OT) == 4) { *(f32x4*)o = *(const f32x4*)o + av; }
                  else { const v2u w = *(const v2u*)o; v2u y; y.x = pk2(bflo(w.x) + av[0], bfhi(w.x) + av[1]); y.y = pk2(bflo(w.y) + av[2], bfhi(w.y) + av[3]); *(v2u*)o = y; } } } }
    }
    __syncthreads();
}
constexpr int PEXP_OFF = LDSCTL_OFF + 1024;
__device__ __forceinline__ const LAS int* moe_panel_table(const int* base, int rows, LAS unsigned char* L) {
    LAS int* t = (LAS int*)(L + PEXP_OFF); const int tid = fresh_tid();
    if (tid < rows / 256) { int e = 0;
#pragma unroll
        for (int j = 1; j < 8; ++j) e += (tid * 256 >= base[j]) ? 1 : 0;
        t[tid] = e; }
    __syncthreads();
    return t;
}
constexpr int N_PHASES = 21;
typedef const __attribute__((address_space(4))) Args* KArgs;
__device__ __forceinline__ KArgs fresh_args() { KArgs k = (KArgs)__builtin_amdgcn_kernarg_segment_ptr(); asm volatile("" : "+s"(k)); return k; }
#define WSP(T, off) ((T*)(ws + (off)))
__global__ void __launch_bounds__(NTHR, 2) fwd(Args args_unused) {
    extern __shared__ __attribute__((aligned(16))) unsigned char lds[];
    LAS unsigned char* L = (LAS unsigned char*)lds;
    LAS float* sm = (LAS float*)L;
    volatile LAS unsigned* MISC = (volatile LAS unsigned*)(L + MISC_OFF);
    const int bid = blockIdx.x, nb = gridDim.x;
    { const int tid = threadIdx.x; for (int u = tid; u < (LDS_BYTES - LDSCTL_OFF) / 4; u += NTHR) ((LAS unsigned*)(L + LDSCTL_OFF))[u] = 0u; }
    __syncthreads();
    int lo, hi;
    XcdBarrier bar;
    { KArgs ka = fresh_args(); lo = ka->ph_lo; hi = ka->ph_hi; bar.bar = (unsigned*)(ka->ws + WS_CTL) + CW_BAR; bar.x = 0; bar.st = nullptr; }
#if MK_ONE_LAUNCH
    bar = xcd_barrier_post(bar.bar, MISC + 8);
#endif
#ifndef PH_MASK
#define PH_MASK 0x1FFFFF
#endif
#define IN(k) (((PH_MASK >> (k)) & 1) && lo <= (k) && (k) < hi)
#if MK_ONE_LAUNCH
#define SEAM(k) do { if (IN(k) && IN((k) + 1)) xcd_barrier(bar); } while (0)
#else
#define SEAM(k) do { } while (0)
#endif
#ifndef PROBE_MASK
#define PROBE_MASK 0
#endif
#if XS_BF16
#define XSTREAM WSP(bf16, WS_XS)
#else
#define XSTREAM (ka->out)
#endif
#define PH_BEGIN KArgs ka = fresh_args(); unsigned char* ws = ka->ws; (void)ws; const unsigned long long t0_ = PROBE_MASK ? __builtin_amdgcn_s_memrealtime() : 0ull; (void)t0_;
#define PH_END(k) if (PROBE_MASK && ((PROBE_MASK >> ((k) > 20 ? 20 : (k))) & 1)) { __syncthreads(); const unsigned long long t1_ = __builtin_amdgcn_s_memrealtime(); while (__builtin_amdgcn_s_memrealtime() - t1_ < t1_ - t0_) __builtin_amdgcn_s_sleep(8); }
#define SMALLP(T, off) WSP(T, WS_SMALL + (off))
#define WAT(off) WSP(const pg8::bf16_t, WS_WA + (off))

    if (IN(0)) { PH_BEGIN if (bid == 0) build_tables(ka->in[4], SMALLP(float, SM_TB));
        convert_weights_a(ka, ws, L, bid, nb); __syncthreads();
#if I8_QKV
        rms_rows_q(ka->in[0], ka->in[1], WSP(signed char, WS_H), SMALLP(float, SM_SA), bid, nb);
#else
        rms_rows_bf16(ka->in[0], ka->in[1], WSP(bf16, WS_HB), bid, nb);
#endif
        PH_END(0) } SEAM(0);
#if I8_QKV
    if (IN(1)) { PH_BEGIN pg8::Gemm g{WSP(bf16, WS_H), WAT(WA_QKV), NT, 3 * DM, DM / 2}; pg8::StaticOrder S; S.init(NT, 3 * DM, nb, bid);
        pg8::EpiBf16Q E{WSP(bf16, WS_Q), DM, DM, (size_t)(WS_K - WS_Q) / 2, C2, SMALLP(const float, SM_SA), SMALLP(const float, SM_SB) + SB_QKV};
        pg8::gemm_phase<pg8::EpiBf16Q, pg8::StaticOrder, true, true, false, true>(L, g, S, E); PH_END(1) } SEAM(1);
#else
    if (IN(1)) { PH_BEGIN pg8::Gemm g{WSP(bf16, WS_HB), WAT(WA_QKV), NT, 3 * DM, DM}; pg8::StaticOrder S; S.init(NT, 3 * DM, nb, bid);
        pg8::EpiBf16<0> E{WSP(bf16, WS_Q), DM, nullptr, DM, (size_t)(WS_K - WS_Q) / 2, C2};
        pg8::gemm_phase<pg8::EpiBf16<0>, pg8::StaticOrder, true, true>(L, g, S, E); PH_END(1) } SEAM(1);
#endif
#if FAST_ATTN
    if (IN(2)) { PH_BEGIN const attn_body::AttnTensors AT{WSP(const attn_body::bf16, WS_Q), WSP(const attn_body::bf16, WS_K), WSP(const attn_body::bf16, WS_V), WSP(attn_body::bf16, WS_O0), ATTN_PC == 3 ? WSP(attn_body::bf16, WS_OC) : WSP(attn_body::bf16, WS_O1), SMALLP(const float, SM_TB), ka->in[11], compute_lam(ka->in[7], ka->in[8], ka->in[9], ka->in[10])};
#if ATTN_PC
        static_assert(attn_body::ATTN2_LDS_BYTES <= RING_BYTES, "attention scratch fits the ring");
#if ATTN_PC == 3
        static_assert(attn_body::ATTN4_LDS_BYTES <= RING_BYTES, "attention scratch fits the ring");
        attn_body::attn_phase4<16>((char*)lds, AT, nb, bid);
#elif ATTN_PC == 2
        static_assert(attn_body::ATTN3_LDS_BYTES <= RING_BYTES, "attention scratch fits the ring");
        attn_body::attn_phase3<8>((char*)lds, AT, nb, bid);
#else
        attn_body::attn_phase2<8>((char*)lds, AT, nb, bid);
#endif
#else
        attn_body::attn_phase<8>((char*)lds, AT, nb, bid);
#endif
        PH_END(2) } SEAM(2);
#else
    if (IN(2)) { PH_BEGIN ref_attention(WSP(bf16, WS_Q), WSP(bf16, WS_K), WSP(bf16, WS_V), WSP(bf16, WS_O0), WSP(bf16, WS_O1), SMALLP(float, SM_TB), sm, bid, nb); PH_END(2) } SEAM(2);
#endif
#if ATTN_PC != 3
    if (IN(3)) { PH_BEGIN const float lam = compute_lam(ka->in[7], ka->in[8], ka->in[9], ka->in[10]); combine_rows(WSP(bf16, WS_O0), WSP(bf16, WS_O1), WSP(bf16, WS_H), ka->in[11], lam, bid, nb); PH_END(3) } SEAM(3);
#endif
    if (IN(4)) { PH_BEGIN pg8::Gemm g{WSP(bf16, WS_OC), WAT(WA_O), NT, DM, DM}; pg8::StaticOrder S; S.init(NT, DM, nb, bid);
#if XS_BF16
        pg8::EpiResX<float> E{ka->in[0], WSP(bf16, WS_XS), DM};
        pg8::gemm_phase<pg8::EpiResX<float>, pg8::StaticOrder, true, true>(L, g, S, E); PH_END(4) } SEAM(4);
#else
        pg8::EpiResF32 E{ka->in[0], ka->out, DM};
        pg8::gemm_phase<pg8::EpiResF32, pg8::StaticOrder, true, true>(L, g, S, E); PH_END(4) } SEAM(4);
#endif
#if I8_FFN
    if (IN(5)) { PH_BEGIN rms_rows_q(XSTREAM, ka->in[2], WSP(signed char, WS_H), SMALLP(float, SM_SA), bid, nb); PH_END(5) } SEAM(5);
#else
    if (IN(5)) { PH_BEGIN rms_rows_bf16(XSTREAM, ka->in[2], WSP(bf16, WS_H), bid, nb); PH_END(5) } SEAM(5);
#endif
#if I8_FFN
    if (IN(6)) { PH_BEGIN pg8::Gemm g{WSP(bf16, WS_H), WAT(WA_GU), NT, 2 * DFF, DM / 2}; pg8::StaticOrder S; S.init(NT, 2 * DFF, nb, bid);
        pg8::EpiSwigluQ E{WSP(bf16, WS_ACT), DFF, SMALLP(const float, SM_SA), SMALLP(const float, SM_SB) + SB_GU, nullptr};
        pg8::gemm_phase<pg8::EpiSwigluQ, pg8::StaticOrder, true, true, false, true>(L, g, S, E); PH_END(6) } SEAM(6);
#else
    if (IN(6)) { PH_BEGIN pg8::Gemm g{WSP(bf16, WS_H), WAT(WA_GU), NT, 2 * DFF, DM}; pg8::StaticOrder S; S.init(NT, 2 * DFF, nb, bid);
        pg8::EpiSwiglu E{WSP(bf16, WS_ACT), DFF};
        pg8::gemm_phase<pg8::EpiSwiglu, pg8::StaticOrder, true, true>(L, g, S, E); PH_END(6) } SEAM(6);
#endif
    if (IN(7)) { PH_BEGIN pg8::Gemm g{WSP(bf16, WS_ACT), WAT(WA_D), NT, DM, DFF}; pg8::StaticOrder S; S.init(NT, DM, nb, bid);
#if XS_BF16
        pg8::EpiResX<pg8::bf16_t> E{WSP(bf16, WS_XS), WSP(bf16, WS_XS), DM};
        pg8::gemm_phase<pg8::EpiResX<pg8::bf16_t>, pg8::StaticOrder, true, true>(L, g, S, E); PH_END(7) } SEAM(7);
#else
        pg8::EpiResF32 E{ka->out, ka->out, DM};
        pg8::gemm_phase<pg8::EpiResF32, pg8::StaticOrder, true, true>(L, g, S, E); PH_END(7) } SEAM(7);
#endif
#if I8_WIN
    if (IN(8)) { PH_BEGIN rms_rows_q(XSTREAM, ka->in[1] + DM, WSP(signed char, WS_H), SMALLP(float, SM_SA), bid, nb); PH_END(8) } SEAM(8);
#else
    if (IN(8)) { PH_BEGIN rms_rows_bf16(XSTREAM, ka->in[1] + DM, WSP(bf16, WS_H), bid, nb); PH_END(8) } SEAM(8);
#endif
#if I8_WIN
    if (IN(9)) { PH_BEGIN pg8::Gemm g{WSP(bf16, WS_H), WAT(WA_IN), NT, 2 * DRNN, DM / 2}; pg8::StaticOrder S; S.init(NT, 2 * DRNN, nb, bid);
        pg8::EpiWinQ E{WSP(bf16, WS_G), WSP(bf16, WS_XB), DRNN, DRNN / 256, SMALLP(const float, SM_SA), SMALLP(const float, SM_SB) + SB_IN};
        pg8::gemm_phase<pg8::EpiWinQ, pg8::StaticOrder, true, true, false, true>(L, g, S, E); PH_END(9) } SEAM(9);
#else
    if (IN(9)) { PH_BEGIN pg8::Gemm g{WSP(bf16, WS_H), WAT(WA_IN), NT, 2 * DRNN, DM}; pg8::StaticOrder S; S.init(NT, 2 * DRNN, nb, bid);
        pg8::EpiWin E{WSP(bf16, WS_G), WSP(bf16, WS_XB), DRNN, DRNN / 256};
        pg8::gemm_phase<pg8::EpiWin, pg8::StaticOrder, true, true>(L, g, S, E); PH_END(9) } SEAM(9);
#endif
#if FAST_LRU
    if (IN(10)) { PH_BEGIN lru::conv_pass(WSP(bf16, WS_XB), WSP(bf16, WS_XC), ka->in[13], ka->in[14], L, bid, nb); PH_END(10) } SEAM(10);
    if (IN(11)) { PH_BEGIN lru::lru_items(WSP(bf16, WS_XC), WSP(bf16, WS_G), WSP(bf16, WS_YF), ka->in[15], ka->in[16], ka->in[17], ka->in[18], ka->in[19], L, bid, nb);
        __syncthreads(); PH_END(11) }
    if (IN(11)) { PH_BEGIN lru::convert_moe_queue(ka->in[25], ka->in[26], ka->in[27], WSP(bf16, WS_WM + WM_GU), WSP(bf16, WS_WM + WM_D), SMALLP(float, SM_SB) + SB_MOE, (unsigned*)(ws + WS_CTL) + CW_TICKET, L); PH_END(12) } SEAM(12);
#else
    if (IN(10)) { PH_BEGIN ref_lru_local(WSP(bf16, WS_XB), ka->in[13], ka->in[14], ka->in[15], ka->in[16], ka->in[17], ka->in[18], ka->in[19], WSP(bf16, WS_HL), WSP(bf16, WS_CA), SMALLP(float, SM_AEND), SMALLP(float, SM_HEND), sm, bid, nb); PH_END(10) } SEAM(10);
    if (IN(11)) { PH_BEGIN lru_carry(SMALLP(float, SM_AEND), SMALLP(float, SM_HEND), SMALLP(float, SM_CIN), bid, nb); PH_END(11) } SEAM(11);
    if (IN(12)) { PH_BEGIN lru_fixup(WSP(bf16, WS_HL), WSP(bf16, WS_CA), WSP(bf16, WS_G), SMALLP(float, SM_CIN), WSP(bf16, WS_Y), bid, nb); PH_END(12) } SEAM(12);
#endif
    if (IN(13)) { PH_BEGIN pg8::Gemm g{WSP(bf16, FAST_LRU ? WS_YF : WS_Y), WAT(WA_OUT), NT, DM, DRNN}; pg8::StaticOrder S; S.init(NT, DM, nb, bid);
#if XS_BF16
        pg8::EpiResX<pg8::bf16_t> E{WSP(bf16, WS_XS), WSP(bf16, WS_XS), DM};
        pg8::gemm_phase<pg8::EpiResX<pg8::bf16_t>, pg8::StaticOrder, true, true>(L, g, S, E); PH_END(13) } SEAM(13);
#else
        pg8::EpiResF32 E{ka->out, ka->out, DM};
        pg8::gemm_phase<pg8::EpiResF32, pg8::StaticOrder, true, true>(L, g, S, E); PH_END(13) } SEAM(13);
#endif
    if (IN(14)) { PH_BEGIN int* RE = SMALLP(int, SM_ROUTE); moe_route(XSTREAM, ka->in[2] + DM, ka->in[24], WSP(bf16, WS_H), I8_MOE ? WSP(signed char, WS_H) : nullptr, SMALLP(float, SM_SA), RE, (float*)(RE + 2 * NT), RE + 4 * NT, SMALLP(int, SM_CNT), sm, bid, nb); PH_END(14) } SEAM(14);
    if (IN(15)) { PH_BEGIN int* RE = SMALLP(int, SM_ROUTE); moe_scatter(RE, (float*)(RE + 2 * NT), RE + 4 * NT, SMALLP(int, SM_CNT), SMALLP(int, SM_BASE), SMALLP(int, SM_TOK), SMALLP(float, SM_GATEV), SMALLP(const float, SM_SA), SMALLP(float, SM_SAS), SMALLP(bf16, SM_TOK16), sm, bid, nb);
#if !FAST_LRU
        __syncthreads(); convert_weights_moe(ka, ws, L, bid, nb);
#endif
    PH_END(15) } SEAM(15);
        if (IN(16 + 2 * 0)) { PH_BEGIN const int* tok_s = SMALLP(int, SM_TOK) + 0 * SLOT_ROWS; const int* base_s = SMALLP(int, SM_BASE) + 0 * 9; const int rows = __builtin_amdgcn_readfirstlane(base_s[8]); const unsigned short* tok16_s = SMALLP(const unsigned short, SM_TOK16) + 0 * SLOT_ROWS; const LAS int* pexp = moe_panel_table(base_s, rows, L);
#if I8_MOE
            pg8::Gemm g{WSP(bf16, WS_H), WSP(const pg8::bf16_t, WS_WM + WM_GU), rows, 2 * DFE, DM / 2}; pg8::MoeOrder S; S.init_moe(rows, 2 * DFE, nb, bid, tok16_s, pexp);
            pg8::EpiSwigluQ E{WSP(bf16, WS_ACTM), DFE, SMALLP(const float, SM_SAS) + 0 * SLOT_ROWS, SMALLP(const float, SM_SB) + SB_MOE, nullptr};
            pg8::gemm_phase<pg8::EpiSwigluQ, pg8::MoeOrder, true, true, true, true>(L, g, S, E); PH_END(16 + 2 * 0) } SEAM(16 + 2 * 0);
#else
            pg8::Gemm g{WSP(bf16, WS_H), WSP(const pg8::bf16_t, WS_WM + WM_GU), rows, 2 * DFE, DM}; pg8::MoeOrder S; S.init_moe(rows, 2 * DFE, nb, bid, tok16_s, pexp);
            pg8::EpiSwiglu E{WSP(bf16, WS_ACTM), DFE};
            pg8::gemm_phase<pg8::EpiSwiglu, pg8::MoeOrder, true, true, true>(L, g, S, E); PH_END(16 + 2 * 0) } SEAM(16 + 2 * 0);
#endif
        if (IN(17 + 2 * 0)) { PH_BEGIN const int* tok_s = SMALLP(int, SM_TOK) + 0 * SLOT_ROWS; const float* gate_s = SMALLP(float, SM_GATEV) + 0 * SLOT_ROWS; const int* base_s = SMALLP(int, SM_BASE) + 0 * 9; const int rows = __builtin_amdgcn_readfirstlane(base_s[8]); const unsigned short* tok16_s = SMALLP(const unsigned short, SM_TOK16) + 0 * SLOT_ROWS; const LAS int* pexp = moe_panel_table(base_s, rows, L);
            pg8::Gemm g{WSP(bf16, WS_ACTM), WSP(const pg8::bf16_t, WS_WM + WM_D), rows, DM, DFE}; pg8::MoeOrder S; S.init_moe(rows, DM, nb, bid, tok16_s, pexp); S.nlim = (S.nwg / nb) * nb;
#if XS_BF16
            pg8::EpiMoeDownX E{WSP(bf16, WS_XS), DM, tok_s, gate_s};
            pg8::gemm_phase<pg8::EpiMoeDownX, pg8::MoeOrder, true, true, false>(L, g, S, E);
            __syncthreads(); moe_down_tail(WSP(bf16, WS_ACTM), WSP(const bf16, WS_WM + WM_D), WSP(bf16, WS_XS), tok_s, gate_s, pexp, rows, L, bid, nb); PH_END(17 + 2 * 0) }
#else
            pg8::EpiMoeDown E{ka->out, DM, tok_s, gate_s};
            pg8::gemm_phase<pg8::EpiMoeDown, pg8::MoeOrder, true, true, false>(L, g, S, E);
            __syncthreads(); moe_down_tail(WSP(bf16, WS_ACTM), WSP(const bf16, WS_WM + WM_D), ka->out, tok_s, gate_s, pexp, rows, L, bid, nb); PH_END(17 + 2 * 0) }
#endif
        SEAM(17 + 2 * 0);
        if (IN(16 + 2 * 1)) { PH_BEGIN const int* tok_s = SMALLP(int, SM_TOK) + 1 * SLOT_ROWS; const int* base_s = SMALLP(int, SM_BASE) + 1 * 9; const int rows = __builtin_amdgcn_readfirstlane(base_s[8]); const unsigned short* tok16_s = SMALLP(const unsigned short, SM_TOK16) + 1 * SLOT_ROWS; const LAS int* pexp = moe_panel_table(base_s, rows, L);
#if I8_MOE
            pg8::Gemm g{WSP(bf16, WS_H), WSP(const pg8::bf16_t, WS_WM + WM_GU), rows, 2 * DFE, DM / 2}; pg8::MoeOrder S; S.init_moe(rows, 2 * DFE, nb, bid, tok16_s, pexp);
            pg8::EpiSwigluQ E{WSP(bf16, WS_ACTM), DFE, SMALLP(const float, SM_SAS) + 1 * SLOT_ROWS, SMALLP(const float, SM_SB) + SB_MOE, nullptr};
            pg8::gemm_phase<pg8::EpiSwigluQ, pg8::MoeOrder, true, true, true, true>(L, g, S, E); PH_END(16 + 2 * 1) } SEAM(16 + 2 * 1);
#else
            pg8::Gemm g{WSP(bf16, WS_H), WSP(const pg8::bf16_t, WS_WM + WM_GU), rows, 2 * DFE, DM}; pg8::MoeOrder S; S.init_moe(rows, 2 * DFE, nb, bid, tok16_s, pexp);
            pg8::EpiSwiglu E{WSP(bf16, WS_ACTM), DFE};
            pg8::gemm_phase<pg8::EpiSwiglu, pg8::MoeOrder, true, true, true>(L, g, S, E); PH_END(16 + 2 * 1) } SEAM(16 + 2 * 1);
#endif
        if (IN(17 + 2 * 1)) { PH_BEGIN const int* tok_s = SMALLP(int, SM_TOK) + 1 * SLOT_ROWS; const float* gate_s = SMALLP(float, SM_GATEV) + 1 * SLOT_ROWS; const int* base_s = SMALLP(int, SM_BASE) + 1 * 9; const int rows = __builtin_amdgcn_readfirstlane(base_s[8]); const unsigned short* tok16_s = SMALLP(const unsigned short, SM_TOK16) + 1 * SLOT_ROWS; const LAS int* pexp = moe_panel_table(base_s, rows, L);
            pg8::Gemm g{WSP(bf16, WS_ACTM), WSP(const pg8::bf16_t, WS_WM + WM_D), rows, DM, DFE}; pg8::MoeOrder S; S.init_moe(rows, DM, nb, bid, tok16_s, pexp); S.nlim = (S.nwg / nb) * nb;
#if XS_BF16
            pg8::EpiMoeDownX E{WSP(bf16, WS_XS), DM, tok_s, gate_s};
            pg8::gemm_phase<pg8::EpiMoeDownX, pg8::MoeOrder, true, true, false>(L, g, S, E);
            __syncthreads(); moe_down_tail(WSP(bf16, WS_ACTM), WSP(const bf16, WS_WM + WM_D), WSP(bf16, WS_XS), tok_s, gate_s, pexp, rows, L, bid, nb); PH_END(17 + 2 * 1) }
#else
            pg8::EpiMoeDown E{ka->out, DM, tok_s, gate_s};
            pg8::gemm_phase<pg8::EpiMoeDown, pg8::MoeOrder, true, true, false>(L, g, S, E);
            __syncthreads(); moe_down_tail(WSP(bf16, WS_ACTM), WSP(const bf16, WS_WM + WM_D), ka->out, tok_s, gate_s, pexp, rows, L, bid, nb); PH_END(17 + 2 * 1) }
#endif
        SEAM(17 + 2 * 1);
    if (IN(20)) { PH_BEGIN rms_rows_final(XSTREAM, ka->in[3], ka->out, bid, nb); PH_END(20) }
#undef IN
#undef SEAM
}

extern "C" void kernel_launch(void* const* d_in, const int* in_sizes, int n_in, void* d_out, int out_size, void* d_ws, size_t ws_size, hipStream_t stream) {
    static int grid = 0;
    if (grid == 0) {
        if (n_in != 28 || in_sizes[0] != NT * DM || out_size != NT * DM || ws_size < WS_END) { fprintf(stderr, "kernel_launch: unexpected shapes (n_in %d, in0 %d, out %d, ws %zu); nothing launched\n", n_in, n_in > 0 ? in_sizes[0] : -1, out_size, ws_size); grid = -1; return; }
        int dev = 0, cus = 0, per_cu = 0;
        if (hipGetDevice(&dev) != hipSuccess || hipDeviceGetAttribute(&cus, hipDeviceAttributeMultiprocessorCount, dev) != hipSuccess) { grid = -1; return; }
        if (hipFuncSetAttribute((const void*)fwd, hipFuncAttributeMaxDynamicSharedMemorySize, LDS_BYTES) != hipSuccess) { fprintf(stderr, "kernel_launch: hipFuncSetAttribute failed\n"); grid = -1; return; }
        if (hipOccupancyMaxActiveBlocksPerMultiprocessor(&per_cu, (const void*)fwd, NTHR, LDS_BYTES) != hipSuccess || per_cu < 1) { fprintf(stderr, "kernel_launch: occupancy query reports %d\n", per_cu); }
        (void)hipGetLastError();
        grid = cus & ~7;
    }
    if (grid < 0) return;
    if (hipMemsetAsync((char*)d_ws + WS_CTL, 0, CTL_ZERO_BYTES, stream) != hipSuccess) return;
    Args a{};
    for (int i = 0; i < 28; ++i) a.in[i] = (const float*)d_in[i];
    a.out = (float*)d_out; a.ws = (unsigned char*)d_ws;
#if MK_ONE_LAUNCH
    a.ph_lo = 0; a.ph_hi = N_PHASES;
    hipLaunchKernelGGL(fwd, dim3(grid), dim3(NTHR), LDS_BYTES, stream, a);
#else
    for (int p = 0; p < N_PHASES; ++p) { a.ph_lo = p; a.ph_hi = p + 1; hipLaunchKernelGGL(fwd, dim3(grid), dim3(NTHR), LDS_BYTES, stream, a); }
#endif
}
```
